# Optimizing an MI355X kernel written in HIP

```python
import jax
import jax.numpy as jnp
from jax import lax
import numpy as np

D_MODEL = 1024
BATCH = 2
SEQ = 8192
DEPTH = 1

CHUNK = 64
N_META = 16
Q_BLOCK = 128

A_HEADS = 8
A_HEAD_DIM = 64
A_KV_RANK = 128
IDX_HEADS = 8
IDX_DIM = 64
TOPK_MAX = 256

B_HEADS = 8
B_HEAD_DIM = 64
DECAY_LORA = 64
AAA_LORA = 64
GATE_LORA = 128
B_LNX_EPS = 64e-5

PEER_HEADS = 8
PEER_NKEYS = 128
PEER_QDIM = 256
PEER_HALF = PEER_QDIM // 2
PEER_TOPK = 16
PEER_EXPERTS = PEER_NKEYS * PEER_NKEYS

A_WIDTH = A_HEADS * A_HEAD_DIM
B_WIDTH = B_HEADS * B_HEAD_DIM
N_BRANCH = 2
A_SIZES = (A_WIDTH, A_KV_RANK, IDX_HEADS * IDX_DIM, IDX_DIM, IDX_HEADS)
B_SIZES = (B_WIDTH, B_WIDTH, B_WIDTH, DECAY_LORA, AAA_LORA, GATE_LORA)
B_COLS = sum(B_SIZES)
GATE_COLS = N_BRANCH * D_MODEL
IN_SIZES = A_SIZES + (B_COLS, GATE_COLS)
N_IN = sum(IN_SIZES)
LN_EPS = 1e-5

kernel_name = "hybrid_dsa_rwkv7_peer_block"


def _split(t, sizes):
    idx = np.cumsum(np.array(sizes))[:-1]
    return jnp.split(t, [int(i) for i in idx], axis=-1)


def _layernorm(x, g, b, eps=LN_EPS):
    xf = x.astype(jnp.float32)
    mu = jnp.mean(xf, axis=-1, keepdims=True)
    var = jnp.mean(jnp.square(xf - mu), axis=-1, keepdims=True)
    return ((xf - mu) * lax.rsqrt(var + eps) * g + b).astype(x.dtype)


def _rmsnorm(x, g, eps=1e-6):
    xf = x.astype(jnp.float32)
    return (xf * lax.rsqrt(jnp.mean(xf * xf, axis=-1, keepdims=True) + eps) * g).astype(x.dtype)


def _chunk_ids(n):
    t = jnp.arange(n, dtype=jnp.int32)
    return jnp.where(t < N_META, 0, 1 + (t - N_META) // CHUNK)


def _token_shift(p, mu):
    prev = jnp.pad(p, ((0, 0), (1, 0), (0, 0)))[:, :-1]
    return p + (prev - p) * mu


def _dsa_mixer(q, c_kv, q_idx, k_idx, w_idx, kv_norm_g, w_uk, w_uv, kidx_g, kidx_b, k_sel):
    Bn, T = q.shape[0], q.shape[1]
    c_kv = _rmsnorm(c_kv, kv_norm_g)
    k_idx = _layernorm(k_idx, kidx_g, kidx_b)
    q_abs = jnp.einsum('bthd,rhd->bthr', q, w_uk)
    cid = _chunk_ids(T)
    nblk = T // Q_BLOCK
    w_scale = (IDX_HEADS ** -0.5) * (IDX_DIM ** -0.5)
    att_scale = A_HEAD_DIM ** -0.5

    def blocks(a):
        return jnp.moveaxis(a.reshape((Bn, nblk, Q_BLOCK) + a.shape[2:]), 1, 0)

    def one_block(args):
        qa, qi, wi, qc = args
        logits = jnp.einsum('bqhd,bsd->bqhs', qi, k_idx).astype(jnp.float32)
        score = jnp.einsum('bqh,bqhs->bqs', wi.astype(jnp.float32) * w_scale, jax.nn.relu(logits))
        admissible = cid[None, :] <= qc[:, None]
        score = jnp.where(admissible[None], score, -jnp.inf)
        top_s, top_i = lax.top_k(score, k_sel)
        valid = jnp.isfinite(top_s)
        c_sel = jax.vmap(lambda c, i: c[i])(c_kv, top_i)
        s = jnp.einsum('bqhr,bqkr->bqhk', qa, c_sel).astype(jnp.float32) * att_scale
        s = jnp.where(valid[:, :, None, :], s, -jnp.inf)
        p = jax.nn.softmax(s, axis=-1).astype(c_sel.dtype)
        o_lat = jnp.einsum('bqhk,bqkr->bqhr', p, c_sel)
        return jnp.einsum('bqhr,rhd->bqhd', o_lat, w_uv)

    out = lax.map(one_block, (blocks(q_abs), blocks(q_idx), blocks(w_idx), cid.reshape(nblk, Q_BLOCK)))
    return jnp.moveaxis(out, 0, 1).reshape(Bn, T, A_WIDTH)


def _rwkv7_mixer(r, k, v, wl, al, gl, w0, w2, a0, a2, g2, k_k, k_a, r_k, lnx_g, lnx_b):
    Bn, T = r.shape[0], r.shape[1]
    H, N = B_HEADS, B_HEAD_DIM
    f32 = jnp.float32
    w_log = -jax.nn.softplus(-(w0 + jnp.tanh(wl) @ w2).astype(f32)) - 0.5
    decay = jnp.exp(-jnp.exp(w_log))
    a = jax.nn.sigmoid((a0 + al @ a2).astype(f32))
    g = jax.nn.sigmoid(gl) @ g2
    heads = lambda t: t.reshape(Bn, T, H, N).astype(f32)
    kk = heads(k * k_k)
    kk = kk * lax.rsqrt(jnp.sum(kk * kk, axis=-1, keepdims=True) + 1e-12)
    k = k * (1.0 + (a - 1.0) * k_a)
    rh, kh, vh, ah, dh = heads(r), heads(k), heads(v), heads(a), heads(decay)
    bh = kk * ah

    def step(S, inp):
        r_t, w_t, k_t, v_t, kk_t, b_t = inp
        sa = jnp.einsum('bhvk,bhk->bhv', S, -kk_t)
        S = S * w_t[:, :, None, :] + sa[..., None] * b_t[:, :, None, :] + v_t[..., None] * k_t[:, :, None, :]
        return S, jnp.einsum('bhvk,bhk->bhv', S, r_t)

    tm = lambda t: jnp.moveaxis(t, 1, 0)
    S0 = jnp.zeros((Bn, H, N, N), f32)
    _, y = lax.scan(step, S0, (tm(rh), tm(dh), tm(kh), tm(vh), tm(kk), tm(bh)))
    y = jnp.moveaxis(y, 0, 1)
    mu = jnp.mean(y, axis=-1, keepdims=True)
    var = jnp.mean(jnp.square(y - mu), axis=-1, keepdims=True)
    y = ((y - mu) * lax.rsqrt(var + B_LNX_EPS)).reshape(Bn, T, B_WIDTH) * lnx_g + lnx_b
    bonus = jnp.sum(rh * kh * r_k.reshape(H, N).astype(f32), axis=-1, keepdims=True) * vh
    y = (y + bonus.reshape(Bn, T, B_WIDTH)) * g
    return y.astype(r.dtype)


def _peer(x, wq, subkeys, u, v):
    Bn, T, D = x.shape
    n = Bn * T
    xf = x.reshape(n, D)
    q = (xf @ wq).reshape(n, PEER_HEADS, 2, PEER_HALF)
    s = jnp.einsum('nhpd,hpkd->nhpk', q, subkeys).astype(jnp.float32)
    s_top, i_top = lax.top_k(s, PEER_TOPK)
    cand = s_top[:, :, 0, :, None] + s_top[:, :, 1, None, :]
    cand_idx = i_top[:, :, 0, :, None] * PEER_NKEYS + i_top[:, :, 1, None, :]
    best_s, best_j = lax.top_k(cand.reshape(n, PEER_HEADS, -1), PEER_TOPK)
    expert = jnp.take_along_axis(cand_idx.reshape(n, PEER_HEADS, -1), best_j, axis=-1)
    gate = jax.nn.softmax(best_s, axis=-1)
    nblk = n // Q_BLOCK

    def one_block(args):
        xb, eb, gb = args
        h = jnp.einsum('nd,nhkd->nhk', xb, u[eb]).astype(jnp.float32)
        coef = (gb * jax.nn.gelu(h, approximate=False)).astype(xb.dtype)
        return jnp.einsum('nhk,nhkd->nd', coef, v[eb])

    out = lax.map(one_block, (xf.reshape(nblk, Q_BLOCK, D),
                              expert.reshape(nblk, Q_BLOCK, PEER_HEADS, PEER_TOPK),
                              gate.reshape(nblk, Q_BLOCK, PEER_HEADS, PEER_TOPK)))
    return out.reshape(Bn, T, D)


def setup_inputs(seed: int = 0) -> dict:
    key = jax.random.key(seed)
    ks = iter(jax.random.split(key, 40))
    f32 = jnp.float32
    L, D = DEPTH, D_MODEL
    beta = (8.0 * DEPTH) ** -0.25
    nrm = lambda shape, scale: jax.random.normal(next(ks), shape, f32) * scale
    uni = lambda shape: jax.random.uniform(next(ks), shape, f32)
    return {
        "x": nrm((BATCH, SEQ, D), 1.0),
        "meta": nrm((N_META, D), 1.0),
        "ln_in_g": 1.0 + nrm((D,), 0.02),
        "ln_in_b": nrm((D,), 0.02),
        "w_in": nrm((L, D, N_IN), D ** -0.5),
        "b_gate": nrm((L, GATE_COLS), 0.02),
        "a_kv_norm_g": 1.0 + nrm((L, A_KV_RANK), 0.02),
        "a_w_uk": nrm((L, A_KV_RANK, A_HEADS, A_HEAD_DIM), A_KV_RANK ** -0.5),
        "a_w_uv": nrm((L, A_KV_RANK, A_HEADS, A_HEAD_DIM), A_KV_RANK ** -0.5),
        "a_kidx_g": 1.0 + nrm((L, IDX_DIM), 0.02),
        "a_kidx_b": nrm((L, IDX_DIM), 0.02),
        "b_mu": uni((L, B_COLS)),
        "b_w0": -6.0 + 5.0 * uni((L, B_WIDTH)),
        "b_w2": nrm((L, DECAY_LORA, B_WIDTH), 0.1),
        "b_a0": nrm((L, B_WIDTH), 0.1),
        "b_a2": nrm((L, AAA_LORA, B_WIDTH), 0.1),
        "b_g2": nrm((L, GATE_LORA, B_WIDTH), GATE_LORA ** -0.5),
        "b_k_k": 0.85 + nrm((L, B_WIDTH), 0.02),
        "b_k_a": 1.0 + nrm((L, B_WIDTH), 0.02),
        "b_r_k": nrm((L, B_WIDTH), 0.1),
        "b_lnx_g": 1.0 + nrm((L, B_WIDTH), 0.02),
        "b_lnx_b": nrm((L, B_WIDTH), 0.02),
        "w_pa": nrm((L, A_WIDTH, D), beta * A_WIDTH ** -0.5),
        "w_pb": nrm((L, B_WIDTH, D), beta * B_WIDTH ** -0.5),
        "w_o": nrm((L, D, D), beta * D ** -0.5),
        "ln1_g": 1.0 + nrm((L, D), 0.02),
        "ln1_b": nrm((L, D), 0.02),
        "peer_wq": nrm((L, D, PEER_HEADS * PEER_QDIM), D ** -0.5),
        "peer_subkeys": nrm((L, PEER_HEADS, 2, PEER_NKEYS, PEER_HALF), PEER_HALF ** -0.5),
        "peer_u": nrm((L, PEER_EXPERTS, D), D ** -0.5),
        "peer_v": nrm((L, PEER_EXPERTS, D), beta),
        "ln2_g": 1.0 + nrm((L, D), 0.02),
        "ln2_b": nrm((L, D), 0.02),
    }


def reference(x, meta, ln_in_g, ln_in_b, w_in, b_gate, a_kv_norm_g, a_w_uk, a_w_uv, a_kidx_g, a_kidx_b,
              b_mu, b_w0, b_w2, b_a0, b_a2, b_g2, b_k_k, b_k_a, b_r_k, b_lnx_g, b_lnx_b,
              w_pa, w_pb, w_o, ln1_g, ln1_b, peer_wq, peer_subkeys, peer_u, peer_v, ln2_g, ln2_b):
    Bn, S, D = x.shape
    T = N_META + S
    T_pad = -(-T // Q_BLOCK) * Q_BLOCK
    k_sel = min(TOPK_MAX, S // 4)
    alpha = (2.0 * DEPTH) ** 0.25
    h = jnp.concatenate([jnp.broadcast_to(meta[None].astype(x.dtype), (Bn, N_META, D)), x,
                         jnp.zeros((Bn, T_pad - T, D), x.dtype)], axis=1)
    h = _layernorm(h, ln_in_g, ln_in_b)
    for l in range(DEPTH):
        p = h @ w_in[l]
        aq, ackv, aqi, aki, awi, bcols, gcols = _split(p, IN_SIZES)
        bcols = _token_shift(bcols, b_mu[l])
        br, bk, bv, bwl, bal, bgl = _split(bcols, B_SIZES)
        o_a = _dsa_mixer(aq.reshape(Bn, T_pad, A_HEADS, A_HEAD_DIM), ackv,
                         aqi.reshape(Bn, T_pad, IDX_HEADS, IDX_DIM), aki, awi,
                         a_kv_norm_g[l], a_w_uk[l], a_w_uv[l], a_kidx_g[l], a_kidx_b[l], k_sel)
        o_b = _rwkv7_mixer(br, bk, bv, bwl, bal, bgl, b_w0[l], b_w2[l], b_a0[l], b_a2[l], b_g2[l],
                           b_k_k[l], b_k_a[l], b_r_k[l], b_lnx_g[l], b_lnx_b[l])
        gates = jax.nn.sigmoid((gcols + b_gate[l]).astype(jnp.float32)).astype(h.dtype)
        mixed = gates[..., :D] * (o_a @ w_pa[l]) + gates[..., D:] * (o_b @ w_pb[l])
        h = _layernorm(alpha * h + mixed @ w_o[l], ln1_g[l], ln1_b[l])
        h = _layernorm(alpha * h + _peer(h, peer_wq[l], peer_subkeys[l], peer_u[l], peer_v[l]),
                       ln2_g[l], ln2_b[l])
    return h[:, N_META:T]
```

```cpp
#include <hip/hip_runtime.h>
#include <hip/hip_cooperative_groups.h>
#include <cstdio>
#include <cstdint>
namespace cg = cooperative_groups;

#define LAS __attribute__((address_space(3)))
typedef _Float16 f16;
typedef _Float16 f16x2 __attribute__((ext_vector_type(2)));
typedef _Float16 f16x4 __attribute__((ext_vector_type(4)));
typedef _Float16 f16x8 __attribute__((ext_vector_type(8)));
typedef float f32x2 __attribute__((ext_vector_type(2)));
typedef float f32x4 __attribute__((ext_vector_type(4)));
typedef float f32x16 __attribute__((ext_vector_type(16)));
typedef unsigned u32x4 __attribute__((ext_vector_type(4)));

constexpr int D = 1024, SEQ = 8192, NMETA = 16, TT = 8208;
constexpr int MREAL = 16384, MR = 16640;
constexpr int NIN = 5064;
constexpr int N1 = 3584;
constexpr int C_QABS = 0, C_QI = 1024, C_CKV = 1536, C_KI = 1664, C_WI = 1728, C_BC = 1792;
constexpr int NT = 512;
constexpr float LN_EPS = 1e-5f;
constexpr float ALPHA = 1.189207115002721f;

__device__ __forceinline__ int row_of(int b, int t) { return t < NMETA ? MREAL + b * NMETA + t : b * SEQ + (t - NMETA); }

constexpr size_t MiB = 1u << 20;
constexpr size_t WS_CTL = 0, WS_STAT = 1 * MiB, WS_WIS = 2 * MiB, WS_W1T = 3 * MiB, WS_WGT = 10 * MiB, WS_WPAT = 14 * MiB, WS_WPBT = 16 * MiB,
                 WS_WOT = 17 * MiB, WS_WSKT = 19 * MiB, WS_WLT = 23 * MiB, WS_CKV = 24 * MiB, WS_KIDX = 29 * MiB, WS_H0 = 32 * MiB,
                 WS_OLAT = 65 * MiB, WS_OB = 97 * MiB, WS_PB = 113 * MiB, WS_END = 227 * MiB;
constexpr size_t WS_MIXED = WS_PB, WS_H1H = WS_PB, WS_TMP = WS_PB + 32 * MiB, WS_SC = WS_PB + 32 * MiB, WS_EIDX = WS_PB + 96 * MiB, WS_EGATE = WS_PB + 100 * MiB;
constexpr size_t WS_U16 = WS_H0, WS_V16 = WS_OLAT;
constexpr size_t DO_LORAIN = 0, DO_LW = 9 * MiB, DO_AA = 26 * MiB, DO_GG = 43 * MiB;

struct Params {
    const float *x, *meta, *ln_in_g, *ln_in_b, *w_in, *b_gate, *a_kv_norm_g, *a_w_uk, *a_w_uv, *a_kidx_g, *a_kidx_b, *b_mu, *b_w0, *b_w2, *b_a0, *b_a2,
        *b_g2, *b_k_k, *b_k_a, *b_r_k, *b_lnx_g, *b_lnx_b, *w_pa, *w_pb, *w_o, *ln1_g, *ln1_b, *peer_wq, *peer_subkeys, *peer_u, *peer_v, *ln2_g, *ln2_b;
    float* out;
    unsigned char* ws;
    int ph_lo, ph_hi;
};

__device__ __forceinline__ float wave_sum(float v) {
#pragma unroll
    for (int o = 1; o < 64; o <<= 1) v += __shfl_xor(v, o);
    return v;
}
__device__ __forceinline__ float wave_max(float v) {
#pragma unroll
    for (int o = 1; o < 64; o <<= 1) v = fmaxf(v, __shfl_xor(v, o));
    return v;
}
__device__ __forceinline__ float sigmoidf_(float x) { return __builtin_amdgcn_rcpf(1.f + __expf(-x)); }
__device__ __forceinline__ float softplusf_(float z) { return fmaxf(z, 0.f) + __logf(1.f + __expf(-fabsf(z))); }
__device__ __forceinline__ unsigned fkey(float f) { unsigned u = __float_as_uint(f); return u ^ ((u >> 31) ? 0xFFFFFFFFu : 0x80000000u); }

namespace pg8 {
#define PG8_LAS __attribute__((address_space(3)))
typedef short h16x8 __attribute__((ext_vector_type(8)));
constexpr int BM = 256, BK = 64, HALF = 128, HTB = HALF * BK * 2, STAGE_BYTES = 8 * HTB, NXCD = 8, WGM = 8;
__host__ __device__ __forceinline__ int lds_byte(int r, int c) { const int st = (r >> 4) * 2 + (c >> 5), rr = r & 15, cc = c & 31, ob = rr * 64 + cc * 2; return st * 1024 + (ob ^ (((ob >> 9) & 1) << 5)); }
__host__ __device__ __forceinline__ void stage_rc(int b, int& R, int& C) { const int st = b / 1024, sb = b % 1024, swz = sb ^ (((sb >> 9) & 1) << 5); R = (st >> 1) * 16 + swz / 64; C = (st & 1) * 32 + (swz % 64) / 2; }
struct Unit { int pm, pn; };
struct Gemm { const f16* A; const f16* Bt; int M, N, K; };
struct StaticOrder {
    int nM, nN, nwg, G, c;
    __host__ __device__ void init(int M, int N, int G_, int c_) { nM = M / BM; nN = N / BM; nwg = nM * nN; G = G_; c = c_; }
    __host__ __device__ bool next(int i, Unit& u) const {
        const long L = (long)i * G + c; if (L >= nwg) return false;
        int wgid = (int)L; { const int q = nwg / NXCD, r = nwg % NXCD, xcd = wgid % NXCD, off = wgid / NXCD; wgid = (xcd < r ? xcd * (q + 1) : r * (q + 1) + (xcd - r) * q) + off; }
        const int nig = WGM * nN, gid = wgid / nig, fm = gid * WGM, gsz = (nM - fm) < WGM ? (nM - fm) : WGM;
        u.pm = fm + ((wgid % nig) % gsz); u.pn = (wgid % nig) / gsz; return true;
    }
};
template <class F> struct EpiElem {
    F f;
    __device__ __forceinline__ void operator()(const f32x4 (&acc)[2][2][4][2], const Unit& u, int wr, int wc, int fr, int fq) const {
        const int row0 = u.pm * BM + wr * 64 + fr, col0 = u.pn * BM + wc * 32 + 4 * fq;
#pragma unroll
        for (int ai = 0; ai < 2; ++ai)
#pragma unroll
            for (int m = 0; m < 4; ++m)
#pragma unroll
                for (int bj = 0; bj < 2; ++bj)
#pragma unroll
                    for (int n = 0; n < 2; ++n) f(row0 + ai * HALF + m * 16, col0 + bj * HALF + n * 16, acc[ai][bj][m][n]);
    }
};
template <class Epi>
__device__ __forceinline__ void gemm_phase(PG8_LAS unsigned char* lds, const Gemm g, const StaticOrder& S, const Epi& E) {
    const int tid = threadIdx.x, wid = __builtin_amdgcn_readfirstlane(tid >> 6), lane = tid & 63, wr = wid >> 2, wc = wid & 3, fr = lane & 15, fq = lane >> 4;
    int K = g.K; asm volatile("" : "+s"(K));
    const int nt = K / BK;
    unsigned voffA[2], voffB[2];
#pragma unroll
    for (int i = 0; i < 2; ++i) { int R, C; stage_rc(tid * 16 + i * 8192, R, C); voffA[i] = (unsigned)(R * K + C) * 2u; voffB[i] = (unsigned)(R * K + C) * 2u; }
    const size_t kstep = (size_t)(BK * 2);
    const size_t hstep = (size_t)HALF * K * 2;
    const size_t tstep = 2 * hstep;
    const unsigned ldsw = (unsigned)wid * 1024u;
    const int aoff = lds_byte(wr * 64 + fr, fq * 8), boff = lds_byte(wc * 32 + fr, fq * 8);
#define PG8_SA(b, h) (((b) * 2 + (h)) * HTB)
#define PG8_SB(b, h) ((4 + (b) * 2 + (h)) * HTB)
#define PG8_STAGE(bufoff, gbase, voff) do { _Pragma("unroll") for (int _i = 0; _i < 2; ++_i) \
        __builtin_amdgcn_global_load_lds((const unsigned*)((const char*)(gbase) + (voff)[_i]), (PG8_LAS unsigned*)(lds + (bufoff) + ldsw + _i * 8192), 16, 0, 0); } while (0)
#define PG8_LDA(dst, b, h) do { _Pragma("unroll") for (int m = 0; m < 4; ++m) _Pragma("unroll") for (int k = 0; k < 2; ++k) dst[m][k] = *(const PG8_LAS h16x8*)(lds + PG8_SA(b, h) + aoff + m * 2048 + k * 1024); } while (0)
#define PG8_LDB(dst, b, h) do { _Pragma("unroll") for (int n = 0; n < 2; ++n) _Pragma("unroll") for (int k = 0; k < 2; ++k) dst[n][k] = *(const PG8_LAS h16x8*)(lds + PG8_SB(b, h) + boff + n * 2048 + k * 1024); } while (0)
#define PG8_MMA(ai, bj, At, Bt) do { __builtin_amdgcn_s_setprio(1); _Pragma("unroll") for (int m = 0; m < 4; ++m) _Pragma("unroll") for (int n = 0; n < 2; ++n) _Pragma("unroll") for (int k = 0; k < 2; ++k) \
        acc[ai][bj][m][n] = __builtin_amdgcn_mfma_f32_16x16x32_f16(__builtin_bit_cast(f16x8, Bt[n][k]), __builtin_bit_cast(f16x8, At[m][k]), acc[ai][bj][m][n], 0, 0, 0); __builtin_amdgcn_s_setprio(0); } while (0)
#define PG8_WAIT_V(n) asm volatile("s_waitcnt vmcnt(" #n ")" ::: "memory")
#define PG8_WAIT_L(n) asm volatile("s_waitcnt lgkmcnt(" #n ")" ::: "memory")
#define PG8_BAR __builtin_amdgcn_s_barrier()
#define PG8_SCHED __builtin_amdgcn_sched_barrier(0)
    Unit cur, nxt; int ui = 0;
    if (!S.next(0, cur)) return;
    f32x4 acc[2][2][4][2];
#pragma unroll
    for (int a = 0; a < 2; ++a)
#pragma unroll
        for (int b = 0; b < 2; ++b)
#pragma unroll
            for (int m = 0; m < 4; ++m)
#pragma unroll
                for (int n = 0; n < 2; ++n) acc[a][b][m][n] = (f32x4){0.f, 0.f, 0.f, 0.f};
    h16x8 At[4][2], B0[2][2], B1[2][2];
    const char* cA = (const char*)g.A + (size_t)cur.pm * tstep; const char* cB = (const char*)g.Bt + (size_t)cur.pn * tstep;
    PG8_STAGE(PG8_SB(0, 0), cB, voffB); PG8_STAGE(PG8_SA(0, 0), cA, voffA); PG8_STAGE(PG8_SB(0, 1), cB + hstep, voffB); PG8_STAGE(PG8_SA(0, 1), cA + hstep, voffA);
    if (wr == 1) PG8_BAR;
    PG8_WAIT_V(4); PG8_BAR;
    PG8_STAGE(PG8_SB(1, 0), cB + kstep, voffB); PG8_STAGE(PG8_SA(1, 0), cA + kstep, voffA); PG8_STAGE(PG8_SB(1, 1), cB + hstep + kstep, voffB);
    PG8_WAIT_V(6); PG8_BAR;
    for (;;) {
        const bool has_next = S.next(ui + 1, nxt);
        const char* nA = has_next ? (const char*)g.A + (size_t)nxt.pm * tstep : cA; const char* nB = has_next ? (const char*)g.Bt + (size_t)nxt.pn * tstep : cB;
        for (int t = 0; t < nt; t += 2) {
            const bool last = (t == nt - 2);
            const char* a1 = cA + (size_t)(t + 1) * kstep;
            const char* a2 = last ? nA : cA + (size_t)(t + 2) * kstep; const char* b2 = last ? nB : cB + (size_t)(t + 2) * kstep;
            const char* a3 = a2 + kstep; const char* b3 = b2 + kstep;
            PG8_LDB(B0, 0, 0); PG8_SCHED; PG8_LDA(At, 0, 0); PG8_STAGE(PG8_SA(1, 1), a1 + hstep, voffA);
            PG8_WAIT_L(8); PG8_BAR; PG8_WAIT_L(0); PG8_MMA(0, 0, At, B0); PG8_BAR; PG8_SCHED;
            PG8_LDB(B1, 0, 1); PG8_STAGE(PG8_SB(0, 0), b2, voffB);
            PG8_BAR; PG8_WAIT_L(0); PG8_MMA(0, 1, At, B1); PG8_BAR;
            PG8_LDA(At, 0, 1); PG8_STAGE(PG8_SA(0, 0), a2, voffA);
            PG8_BAR; PG8_WAIT_L(0); PG8_MMA(1, 0, At, B0); PG8_BAR; PG8_SCHED;
            PG8_STAGE(PG8_SB(0, 1), b2 + hstep, voffB);
            PG8_WAIT_V(6); PG8_BAR; PG8_MMA(1, 1, At, B1); PG8_BAR;
            PG8_LDB(B0, 1, 0); PG8_SCHED; PG8_LDA(At, 1, 0); PG8_STAGE(PG8_SA(0, 1), a2 + hstep, voffA);
            PG8_WAIT_L(8); PG8_BAR; PG8_WAIT_L(0); PG8_MMA(0, 0, At, B0); PG8_BAR; PG8_SCHED;
            PG8_LDB(B1, 1, 1); PG8_STAGE(PG8_SB(1, 0), b3, voffB);
            PG8_BAR; PG8_WAIT_L(0); PG8_MMA(0, 1, At, B1); PG8_BAR;
            PG8_LDA(At, 1, 1); PG8_STAGE(PG8_SA(1, 0), a3, voffA);
            PG8_BAR; PG8_WAIT_L(0); PG8_MMA(1, 0, At, B0); PG8_BAR; PG8_SCHED;
            PG8_STAGE(PG8_SB(1, 1), b3 + hstep, voffB);
            PG8_WAIT_V(6); PG8_BAR; PG8_MMA(1, 1, At, B1); PG8_BAR;
        }
        E(acc, cur, wr, wc, fr, fq);
        if (!has_next) break;
#pragma unroll
        for (int a = 0; a < 2; ++a)
#pragma unroll
            for (int b = 0; b < 2; ++b)
#pragma unroll
                for (int m = 0; m < 4; ++m)
#pragma unroll
                    for (int n = 0; n < 2; ++n) acc[a][b][m][n] = (f32x4){0.f, 0.f, 0.f, 0.f};
        cur = nxt; cA = nA; cB = nB; ++ui;
    }
    PG8_WAIT_V(0);
    if (wr == 0) PG8_BAR;
    PG8_BAR;
#undef PG8_SA
#undef PG8_SB
#undef PG8_STAGE
#undef PG8_LDA
#undef PG8_LDB
#undef PG8_MMA
#undef PG8_WAIT_V
#undef PG8_WAIT_L
#undef PG8_BAR
#undef PG8_SCHED
}
template <class F>
__device__ __forceinline__ void run_gemm(unsigned char* lds, const f16* A, const f16* Bt, int M, int N, int K, const F& f) {
    Gemm g{A, Bt, M, N, K}; StaticOrder S; S.init(M, N, (int)gridDim.x, (int)blockIdx.x);
    EpiElem<F> E{f};
    gemm_phase<EpiElem<F>>((PG8_LAS unsigned char*)lds, g, S, E);
    __syncthreads();
}
}

__device__ __forceinline__ f16x4 to_h4(f32x4 v) { f16x4 r; r.x = (f16)v.x; r.y = (f16)v.y; r.z = (f16)v.z; r.w = (f16)v.w; return r; }

__device__ __forceinline__ void tr_item(const float* W, int ldw, int col0, int nvalid, int K, f16* out, int nrow0, int item, int nblk, float* scr, int lane) {
    const int kb = item / nblk, nb = item % nblk, k0 = 64 * kb, n0 = 32 * nb;
#pragma unroll 8
    for (int i = 0; i < 32; ++i) { const int kk = 2 * i + (lane >> 5); const int j = n0 + (lane & 31);
        scr[kk * 33 + (lane & 31)] = (j < nvalid) ? W[(size_t)(k0 + kk) * ldw + col0 + j] : 0.f; }
    asm volatile("s_waitcnt vmcnt(0) lgkmcnt(0)" ::: "memory");
    const int c = lane & 7;
#pragma unroll
    for (int jj = 0; jj < 4; ++jj) { const int n = (lane >> 3) + 8 * jj; const float* s = scr + (8 * c) * 33 + n;
        f16x8 o;
#pragma unroll
        for (int e = 0; e < 8; ++e) o[e] = (f16)s[e * 33];
        *(f16x8*)(out + (size_t)(nrow0 + n0 + n) * K + k0 + 8 * c) = o; }
    asm volatile("s_waitcnt lgkmcnt(0)" ::: "memory");
}

__device__ __forceinline__ void ph0_prep(const Params& p, unsigned char* lds) {
    const int tid = threadIdx.x, lane = tid & 63, wave = tid >> 6;
    const int gw = blockIdx.x * 8 + wave, NGW = gridDim.x * 8;
    f16* H0 = (f16*)(p.ws + WS_H0); float* STAT = (float*)(p.ws + WS_STAT);
    for (int m = gw; m < MR; m += NGW) {
        f16* orow = H0 + (size_t)m * D;
        if (m >= MREAL + 2 * NMETA) {
#pragma unroll
            for (int j = 0; j < 4; ++j) *(f16x4*)(orow + j * 256 + lane * 4) = (f16x4){(f16)0.f, (f16)0.f, (f16)0.f, (f16)0.f};
            continue;
        }
        const float* src = (m < MREAL) ? p.x + (size_t)m * D : p.meta + (size_t)((m - MREAL) & 15) * D;
        f32x4 v[4]; float s = 0.f;
#pragma unroll
        for (int j = 0; j < 4; ++j) { v[j] = *(const f32x4*)(src + j * 256 + lane * 4); s += (v[j].x + v[j].y) + (v[j].z + v[j].w); }
        const float mean = wave_sum(s) * (1.f / D); float s2 = 0.f;
#pragma unroll
        for (int j = 0; j < 4; ++j) { v[j] = v[j] - mean; s2 += (v[j].x * v[j].x + v[j].y * v[j].y) + (v[j].z * v[j].z + v[j].w * v[j].w); }
        const float rstd = 1.f / sqrtf(wave_sum(s2) * (1.f / D) + LN_EPS);
        if (lane == 0) { STAT[2 * m] = mean; STAT[2 * m + 1] = rstd; }
#pragma unroll
        for (int j = 0; j < 4; ++j) { const f32x4 g = *(const f32x4*)(p.ln_in_g + j * 256 + lane * 4), bb = *(const f32x4*)(p.ln_in_b + j * 256 + lane * 4);
            *(f16x4*)(orow + j * 256 + lane * 4) = to_h4(v[j] * rstd * g + bb); }
    }
    float* scr = (float*)lds + wave * (64 * 33);
    f16* W1T = (f16*)(p.ws + WS_W1T); f16* WGT = (f16*)(p.ws + WS_WGT); f16* WPBT = (f16*)(p.ws + WS_WPBT); f16* WOT = (f16*)(p.ws + WS_WOT);
    constexpr int I_QI = 16 * 16, I_CKV = 4 * 16, I_KI = 4 * 16, I_BC = 56 * 16, I_G = 64 * 16, I_PB = 32 * 8, I_O = 32 * 16;
    constexpr int NITEMS = I_QI + I_CKV + I_KI + I_BC + I_G + I_PB + I_O;
    for (int it = gw; it < NITEMS; it += NGW) {
        int r = it;
        if (r < I_QI) { tr_item(p.w_in, NIN, 640, 512, D, W1T, C_QI, r, 16, scr, lane); continue; } r -= I_QI;
        if (r < I_CKV) { tr_item(p.w_in, NIN, 512, 128, D, W1T, C_CKV, r, 4, scr, lane); continue; } r -= I_CKV;
        if (r < I_KI) { tr_item(p.w_in, NIN, 1152, 72, D, W1T, C_KI, r, 4, scr, lane); continue; } r -= I_KI;
        if (r < I_BC) { tr_item(p.w_in, NIN, 1224, 1792, D, W1T, C_BC, r, 56, scr, lane); continue; } r -= I_BC;
        if (r < I_G) { tr_item(p.w_in, NIN, 3016, 2048, D, WGT, 0, r, 64, scr, lane); continue; } r -= I_G;
        if (r < I_PB) { tr_item(p.w_pb, D, 0, 1024, 512, WPBT, 0, r, 32, scr, lane); continue; } r -= I_PB;
        tr_item(p.w_o, D, 0, 1024, D, WOT, 0, r, 32, scr, lane);
    }
    const long gt = (long)blockIdx.x * NT + tid, NGT = (long)gridDim.x * NT;
    f16* W1Tq = W1T;
    for (long e = gt; e < 1024L * 1024; e += NGT) { const int n = (int)(e >> 10), k = (int)(e & 1023), h = n >> 7, r = n & 127;
        const float* a = p.w_in + (size_t)k * NIN + h * 64; const float* bq = p.a_w_uk + (size_t)(r * 8 + h) * 64; float s = 0.f;
#pragma unroll 8
        for (int d = 0; d < 64; ++d) s += a[d] * bq[d];
        W1Tq[(size_t)n * D + k] = (f16)s; }
    f16* WPAT = (f16*)(p.ws + WS_WPAT);
    for (long e = gt; e < 1024L * 1024; e += NGT) { const int n = (int)(e >> 10), k = (int)(e & 1023), h = k >> 7, r = k & 127;
        const float* a = p.a_w_uv + (size_t)(r * 8 + h) * 64; const float* bq = p.w_pa + (size_t)(h * 64) * D + n; float s = 0.f;
#pragma unroll 8
        for (int d = 0; d < 64; ++d) s += a[d] * bq[(size_t)d * D];
        WPAT[(size_t)n * D + k] = (f16)s; }
    f16* WSKT = (f16*)(p.ws + WS_WSKT);
    for (long e = gt; e < 2048L * 1024; e += NGT) { const int n = (int)(e >> 10), k = (int)(e & 1023), hp = n >> 7;
        const float* a = p.peer_wq + (size_t)k * 2048 + hp * 128; const float* bq = p.peer_subkeys + (size_t)n * 128; float s = 0.f;
#pragma unroll 8
        for (int j = 0; j < 128; ++j) s += a[j] * bq[j];
        WSKT[(size_t)n * D + k] = (f16)s; }
    f16* WLT = (f16*)(p.ws + WS_WLT);
    for (long e = gt; e < 1536L * 256; e += NGT) { const int n = (int)(e >> 8), k = (int)(e & 255); float v = 0.f;
        if (n < 512) { if (k < 64) v = p.b_w2[(size_t)k * 512 + n]; }
        else if (n < 1024) { if (k >= 64 && k < 128) v = p.b_a2[(size_t)(k - 64) * 512 + (n - 512)]; }
        else { if (k >= 128) v = p.b_g2[(size_t)(k - 128) * 512 + (n - 1024)]; }
        WLT[e] = (f16)v; }
}

__device__ __forceinline__ void phc1_rowprep(const Params& p) {
    const int tid = threadIdx.x, lane = tid & 63, wave = tid >> 6;
    const int gw = blockIdx.x * 8 + wave, NGW = gridDim.x * 8;
    const f16* PB = (const f16*)(p.ws + WS_PB); f16* CKV = (f16*)(p.ws + WS_CKV); f16* KIDX = (f16*)(p.ws + WS_KIDX); float* WIS = (float*)(p.ws + WS_WIS);
    f16* LORAIN = (f16*)((unsigned char*)p.out + DO_LORAIN);
    for (int m = gw; m < MR; m += NGW) {
        if (m >= MREAL + 2 * NMETA) { *(f16x4*)(LORAIN + (size_t)m * 256 + lane * 4) = (f16x4){(f16)0.f, (f16)0.f, (f16)0.f, (f16)0.f}; continue; }
        const f16* pr = PB + (size_t)m * N1;
        { const f16x2 c2 = *(const f16x2*)(pr + C_CKV + 2 * lane); const float a = (float)c2.x, b = (float)c2.y;
          const float ss = wave_sum(a * a + b * b); const float r = 1.f / sqrtf(ss * (1.f / 128.f) + 1e-6f);
          f16x2 o; o.x = (f16)(a * r * p.a_kv_norm_g[2 * lane]); o.y = (f16)(b * r * p.a_kv_norm_g[2 * lane + 1]);
          *(f16x2*)(CKV + (size_t)m * 128 + 2 * lane) = o; }
        { const float a = (float)pr[C_KI + lane]; const float mu = wave_sum(a) * (1.f / 64.f); const float d = a - mu;
          const float var = wave_sum(d * d) * (1.f / 64.f);
          KIDX[(size_t)m * 64 + lane] = (f16)(d * (1.f / sqrtf(var + LN_EPS)) * p.a_kidx_g[lane] + p.a_kidx_b[lane]); }
        if (lane < 8) WIS[(size_t)m * 8 + lane] = (float)pr[C_WI + lane] * 0.04419417382415922f;
        { int b, t; if (m < MREAL) { b = m >> 13; t = NMETA + (m & 8191); } else { b = (m - MREAL) >> 4; t = (m - MREAL) & 15; }
          const f16x4 cur = *(const f16x4*)(pr + C_BC + 1536 + lane * 4);
          f16x4 prv = (f16x4){(f16)0.f, (f16)0.f, (f16)0.f, (f16)0.f};
          if (t > 0) prv = *(const f16x4*)(PB + (size_t)row_of(b, t - 1) * N1 + C_BC + 1536 + lane * 4);
          const f32x4 mu = *(const f32x4*)(p.b_mu + 1536 + lane * 4);
          f16x4 o;
#pragma unroll
          for (int e = 0; e < 4; ++e) { const float c = (float)cur[e], q = (float)prv[e]; float xs = c + (q - c) * mu[e];
              const int j = lane * 4 + e; if (j < 64) xs = tanhf(xs); else if (j >= 128) xs = sigmoidf_(xs); o[e] = (f16)xs; }
          *(f16x4*)(LORAIN + (size_t)m * 256 + lane * 4) = o; }
    }
}

__device__ __forceinline__ void rwkv_item(const Params& p, int b, int h, unsigned char* lds) {
    const int tid = threadIdx.x, v = tid >> 3, kq = tid & 7;
    const f16* PB = (const f16*)(p.ws + WS_PB);
    const f16* LW = (const f16*)((unsigned char*)p.out + DO_LW); const f16* AA = (const f16*)((unsigned char*)p.out + DO_AA); const f16* GG = (const f16*)((unsigned char*)p.out + DO_GG);
    f16* OB = (f16*)(p.ws + WS_OB);
    float* sR = (float*)lds; float* sK = sR + 2048; float* sV = sK + 2048; float* sW = sV + 2048; float* sKK = sW + 2048; float* sB = sKK + 2048; float* sG = sB + 2048; float* sY = sG + 2048;
    float S[8];
#pragma unroll
    for (int j = 0; j < 8; ++j) S[j] = 0.f;
    const int ps = tid >> 4, cg4 = (tid & 15) * 4, hc = h * 64 + cg4;
    const f32x4 mu_r = *(const f32x4*)(p.b_mu + hc), mu_k = *(const f32x4*)(p.b_mu + 512 + hc), mu_v = *(const f32x4*)(p.b_mu + 1024 + hc);
    const f32x4 kkw = *(const f32x4*)(p.b_k_k + hc), kaw = *(const f32x4*)(p.b_k_a + hc), rkw = *(const f32x4*)(p.b_r_k + hc);
    const f32x4 lng = *(const f32x4*)(p.b_lnx_g + hc), lnb = *(const f32x4*)(p.b_lnx_b + hc);
    for (int t0 = 0; t0 < TT; t0 += 32) {
        const int nst = (TT - t0) < 32 ? (TT - t0) : 32;
        const int t = t0 + ps; const bool valid = ps < nst;
        f32x4 r4 = {0, 0, 0, 0}, k4 = r4, v4 = r4, w4 = r4, kk4 = r4, b4 = r4, g4 = r4;
        if (valid) {
            const int m = row_of(b, t);
            const f16* pr = PB + (size_t)m * N1 + C_BC + hc;
            const f16x4 cr = *(const f16x4*)(pr), ck = *(const f16x4*)(pr + 512), cv = *(const f16x4*)(pr + 1024);
            f16x4 qr = (f16x4){(f16)0.f, (f16)0.f, (f16)0.f, (f16)0.f}, qk = qr, qv = qr;
            if (t > 0) { const f16* pp = PB + (size_t)row_of(b, t - 1) * N1 + C_BC + hc; qr = *(const f16x4*)(pp); qk = *(const f16x4*)(pp + 512); qv = *(const f16x4*)(pp + 1024); }
            const f16x4 lw = *(const f16x4*)(LW + (size_t)m * 512 + hc), aa = *(const f16x4*)(AA + (size_t)m * 512 + hc), gg = *(const f16x4*)(GG + (size_t)m * 512 + hc);
#pragma unroll
            for (int e = 0; e < 4; ++e) {
                const float c0 = (float)cr[e], c1 = (float)ck[e], c2 = (float)cv[e];
                r4[e] = c0 + ((float)qr[e] - c0) * mu_r[e];
                const float k0 = c1 + ((float)qk[e] - c1) * mu_k[e];
                v4[e] = c2 + ((float)qv[e] - c2) * mu_v[e];
                const float a = (float)aa[e];
                w4[e] = __expf((float)lw[e]);
                kk4[e] = k0 * kkw[e];
                k4[e] = k0 * (1.f + (a - 1.f) * kaw[e]);
                b4[e] = a;
                g4[e] = (float)gg[e];
            }
        }
        float ss = kk4[0] * kk4[0] + kk4[1] * kk4[1] + kk4[2] * kk4[2] + kk4[3] * kk4[3];
        float bo = r4[0] * k4[0] * rkw[0] + r4[1] * k4[1] * rkw[1] + r4[2] * k4[2] * rkw[2] + r4[3] * k4[3] * rkw[3];
#pragma unroll
        for (int o = 1; o < 16; o <<= 1) { ss += __shfl_xor(ss, o); bo += __shfl_xor(bo, o); }
        const float rn = 1.f / sqrtf(ss + 1e-12f);
#pragma unroll
        for (int e = 0; e < 4; ++e) { kk4[e] *= rn; b4[e] *= kk4[e]; }
        *(f32x4*)(sR + ps * 64 + cg4) = r4; *(f32x4*)(sK + ps * 64 + cg4) = k4; *(f32x4*)(sV + ps * 64 + cg4) = v4; *(f32x4*)(sW + ps * 64 + cg4) = w4;
        *(f32x4*)(sKK + ps * 64 + cg4) = kk4; *(f32x4*)(sB + ps * 64 + cg4) = b4;
        __syncthreads();
        for (int s = 0; s < nst; ++s) {
            const f32x4 ka = *(const f32x4*)(sKK + s * 64 + kq * 8), kb = *(const f32x4*)(sKK + s * 64 + kq * 8 + 4);
            const f32x4 wa = *(const f32x4*)(sW + s * 64 + kq * 8), wb = *(const f32x4*)(sW + s * 64 + kq * 8 + 4);
            const f32x4 ba = *(const f32x4*)(sB + s * 64 + kq * 8), bb = *(const f32x4*)(sB + s * 64 + kq * 8 + 4);
            const f32x4 xa = *(const f32x4*)(sK + s * 64 + kq * 8), xb = *(const f32x4*)(sK + s * 64 + kq * 8 + 4);
            const f32x4 ra = *(const f32x4*)(sR + s * 64 + kq * 8), rb = *(const f32x4*)(sR + s * 64 + kq * 8 + 4);
            const float vv = sV[s * 64 + v];
            float sa = 0.f;
#pragma unroll
            for (int j = 0; j < 4; ++j) { sa += S[j] * ka[j]; sa += S[4 + j] * kb[j]; }
            sa += __shfl_xor(sa, 1); sa += __shfl_xor(sa, 2); sa += __shfl_xor(sa, 4);
            sa = -sa;
            float y = 0.f;
#pragma unroll
            for (int j = 0; j < 4; ++j) {
                S[j] = S[j] * wa[j] + sa * ba[j] + vv * xa[j];
                S[4 + j] = S[4 + j] * wb[j] + sa * bb[j] + vv * xb[j];
                y += S[j] * ra[j]; y += S[4 + j] * rb[j];
            }
            y += __shfl_xor(y, 1); y += __shfl_xor(y, 2); y += __shfl_xor(y, 4);
            if (kq == 0) sY[s * 64 + v] = y;
        }
        __syncthreads();
        {
            const f32x4 y4 = *(const f32x4*)(sY + ps * 64 + cg4);
            float sm = (y4[0] + y4[1]) + (y4[2] + y4[3]);
#pragma unroll
            for (int o = 1; o < 16; o <<= 1) sm += __shfl_xor(sm, o);
            const float mean = sm * (1.f / 64.f);
            float q = 0.f;
#pragma unroll
            for (int e = 0; e < 4; ++e) { const float d = y4[e] - mean; q += d * d; }
#pragma unroll
            for (int o = 1; o < 16; o <<= 1) q += __shfl_xor(q, o);
            const float rstd = 1.f / sqrtf(q * (1.f / 64.f) + 64e-5f);
            if (valid && t >= NMETA) {
                f16x4 o;
#pragma unroll
                for (int e = 0; e < 4; ++e) o[e] = (f16)((((y4[e] - mean) * rstd) * lng[e] + lnb[e] + bo * v4[e]) * g4[e]);
                *(f16x4*)(OB + (size_t)(b * SEQ + (t - NMETA)) * 512 + hc) = o;
            }
        }
        __syncthreads();
    }
}

constexpr int SCW = 8224;
__device__ __forceinline__ void dsa_item(const Params& p, int b, int g, unsigned char* lds) {
    const int tid = threadIdx.x, lane = tid & 63, wave = tid >> 6;
    const f16* PB = (const f16*)(p.ws + WS_PB); const f16* CKV = (const f16*)(p.ws + WS_CKV); const f16* KIDX = (const f16*)(p.ws + WS_KIDX); const float* WIS = (const float*)(p.ws + WS_WIS);
    f16* OLAT = (f16*)(p.ws + WS_OLAT);
    float* sc = (float*)lds;
    unsigned* hist = (unsigned*)(lds + 4 * SCW * 4);
    unsigned short* sel = (unsigned short*)(lds + 4 * SCW * 4 + 4096);
    unsigned* misc = (unsigned*)(lds + 4 * SCW * 4 + 4096 + 2048);
    f16* sq = (f16*)(lds + 4 * SCW * 4 + 4096 + 2048 + 128);
    const int i0 = 4 * g, n_adm = 80 + 64 * (i0 >> 6), ntile = (n_adm + 31) >> 5;
    const int mq0 = b * SEQ + i0;
    {
        const int rho = lane & 31, q = rho >> 3, hd = rho & 7, hh = lane >> 5;
        const f16* qip = PB + (size_t)(mq0 + q) * N1 + C_QI + hd * 64 + 8 * hh;
        f16x8 af[4];
#pragma unroll
        for (int ks = 0; ks < 4; ++ks) af[ks] = *(const f16x8*)(qip + 16 * ks);
        float wsc[16];
#pragma unroll
        for (int j = 0; j < 16; ++j) wsc[j] = WIS[(size_t)(mq0 + (j >> 2)) * 8 + (j & 3) + 4 * hh];
        for (int kt = wave; kt < ntile; kt += 8) {
            const int key = kt * 32 + (lane & 31);
            const int rowk = row_of(b, key);
            const f16* kp = KIDX + (size_t)rowk * 64 + 8 * hh;
            f16x8 bf[4];
#pragma unroll
            for (int ks = 0; ks < 4; ++ks) bf[ks] = *(const f16x8*)(kp + 16 * ks);
            f32x16 acc;
#pragma unroll
            for (int j = 0; j < 16; ++j) acc[j] = 0.f;
#pragma unroll
            for (int ks = 0; ks < 4; ++ks) acc = __builtin_amdgcn_mfma_f32_32x32x16_f16(af[ks], bf[ks], acc, 0, 0, 0);
            float s4[4];
#pragma unroll
            for (int qq = 0; qq < 4; ++qq) { float s = 0.f;
#pragma unroll
                for (int jj = 0; jj < 4; ++jj) s += wsc[4 * qq + jj] * fmaxf(acc[4 * qq + jj], 0.f);
                s += __shfl_xor(s, 32); s4[qq] = s; }
            if (lane < 32) {
#pragma unroll
                for (int qq = 0; qq < 4; ++qq) sc[qq * SCW + key] = s4[qq]; }
        }
        *(f16x8*)(sq + tid * 8) = *(const f16x8*)(PB + (size_t)(mq0 + (tid >> 7)) * N1 + C_QABS + (tid & 127) * 8);
    }
    __syncthreads();
    const int qs = tid >> 7, tl = tid & 127;
    int nsel;
    {
        const float* scq = sc + qs * SCW;
        if (n_adm <= 256) { for (int idx = tl; idx < n_adm; idx += 128) sel[qs * 256 + idx] = (unsigned short)idx; nsel = n_adm; }
        else {
            unsigned prefix = 0u, mask = 0u; int kth = 256;
            for (int pass = 0; pass < 4; ++pass) {
                const int shift = 24 - 8 * pass;
                hist[qs * 256 + tl] = 0u; hist[qs * 256 + 128 + tl] = 0u;
                __syncthreads();
                for (int idx = tl; idx < n_adm; idx += 128) { const unsigned u = fkey(scq[idx]); if ((u & mask) == prefix) atomicAdd(&hist[qs * 256 + ((u >> shift) & 255u)], 1u); }
                __syncthreads();
                if (tl < 64) {
                    const int c0 = (int)hist[qs * 256 + 4 * tl], c1 = (int)hist[qs * 256 + 4 * tl + 1], c2 = (int)hist[qs * 256 + 4 * tl + 2], c3 = (int)hist[qs * 256 + 4 * tl + 3];
                    const int tot = c0 + c1 + c2 + c3; int s = tot;
#pragma unroll
                    for (int off = 1; off < 64; off <<= 1) { const int tv = __shfl_down(s, off); if (tl + off < 64) s += tv; }
                    const int above = s - tot;
                    if (above < kth && kth <= s) { const int rem = kth - above; int bin, nk;
                        if (rem <= c3) { bin = 4 * tl + 3; nk = rem; } else if (rem <= c3 + c2) { bin = 4 * tl + 2; nk = rem - c3; }
                        else if (rem <= c3 + c2 + c1) { bin = 4 * tl + 1; nk = rem - c3 - c2; } else { bin = 4 * tl; nk = rem - c3 - c2 - c1; }
                        misc[qs * 8] = (unsigned)bin; misc[qs * 8 + 1] = (unsigned)nk; }
                }
                __syncthreads();
                prefix |= misc[qs * 8] << shift; mask |= 0xFFu << shift; kth = (int)misc[qs * 8 + 1];
            }
            if (tl == 0) { misc[qs * 8 + 2] = 0u; misc[qs * 8 + 3] = 0u; }
            __syncthreads();
            for (int idx = tl; idx < n_adm; idx += 128) { const unsigned u = fkey(scq[idx]);
                if (u > prefix) { const unsigned pos = atomicAdd(&misc[qs * 8 + 2], 1u); sel[qs * 256 + pos] = (unsigned short)idx; }
                else if (u == prefix) { const unsigned e = atomicAdd(&misc[qs * 8 + 3], 1u); if ((int)e < kth) { const unsigned pos = atomicAdd(&misc[qs * 8 + 2], 1u); sel[qs * 256 + pos] = (unsigned short)idx; } } }
            nsel = 256;
        }
    }
    __syncthreads();
    float* sS = (float*)lds;
    const int aq = wave >> 1, hg = wave & 1;
    for (int tile = 0; tile < 4; ++tile) {
        const int kk = tile * 64 + lane; const bool valid = kk < nsel;
        const int kidx = valid ? (int)sel[aq * 256 + kk] : 0;
        const f16* cp = CKV + (size_t)row_of(b, kidx) * 128;
        f16x8 cr[16];
#pragma unroll
        for (int r8 = 0; r8 < 16; ++r8) cr[r8] = *(const f16x8*)(cp + r8 * 8);
#pragma unroll
        for (int hd = 0; hd < 4; ++hd) { const int head = hg * 4 + hd; const f16* qp = sq + (aq * 8 + head) * 128; float s = 0.f;
#pragma unroll
            for (int r8 = 0; r8 < 16; ++r8) { const f16x8 qv = *(const f16x8*)(qp + r8 * 8);
#pragma unroll
                for (int e = 0; e < 8; ++e) s += (float)qv[e] * (float)cr[r8][e]; }
            sS[(aq * 8 + head) * 256 + kk] = valid ? s * 0.125f : -INFINITY; }
    }
    __syncthreads();
#pragma unroll
    for (int hd = 0; hd < 4; ++hd) { float* sp = sS + (aq * 8 + hg * 4 + hd) * 256;
        float v0 = sp[lane], v1 = sp[64 + lane], v2 = sp[128 + lane], v3 = sp[192 + lane];
        const float mx = wave_max(fmaxf(fmaxf(v0, v1), fmaxf(v2, v3)));
        v0 = __expf(v0 - mx); v1 = __expf(v1 - mx); v2 = __expf(v2 - mx); v3 = __expf(v3 - mx);
        const float inv = 1.f / wave_sum((v0 + v1) + (v2 + v3));
        sp[lane] = v0 * inv; sp[64 + lane] = v1 * inv; sp[128 + lane] = v2 * inv; sp[192 + lane] = v3 * inv; }
    __syncthreads();
    {
        float o[4][2];
#pragma unroll
        for (int hd = 0; hd < 4; ++hd) { o[hd][0] = 0.f; o[hd][1] = 0.f; }
        const float* pp = sS + (aq * 8 + hg * 4) * 256;
#pragma unroll 4
        for (int k = 0; k < nsel; ++k) {
            const int kidx = (int)sel[aq * 256 + k];
            const f16x2 c2 = *(const f16x2*)(CKV + (size_t)row_of(b, kidx) * 128 + 2 * lane);
            const float cx = (float)c2.x, cy = (float)c2.y;
#pragma unroll
            for (int hd = 0; hd < 4; ++hd) { const float pk = pp[hd * 256 + k]; o[hd][0] += pk * cx; o[hd][1] += pk * cy; }
        }
#pragma unroll
        for (int hd = 0; hd < 4; ++hd) { f16x2 w; w.x = (f16)o[hd][0]; w.y = (f16)o[hd][1];
            *(f16x2*)(OLAT + (size_t)(mq0 + aq) * 1024 + (hg * 4 + hd) * 128 + 2 * lane) = w; }
    }
    __syncthreads();
}

__device__ __forceinline__ void phc2_mixers(const Params& p, unsigned char* lds) {
    unsigned* ctr = (unsigned*)(p.ws + WS_CTL) + 64;
    int* s_item = (int*)(lds + 150 * 1024 - 16);
    constexpr int NRW = 16, NDSA = 2 * (SEQ / 4);
    for (;;) {
        if (threadIdx.x == 0) *s_item = (int)atomicAdd(ctr, 1u);
        __syncthreads();
        const int item = *s_item;
        __syncthreads();
        if (item >= NRW + NDSA) break;
        if (item < NRW) rwkv_item(p, item >> 3, item & 7, lds);
        else { const int d = item - NRW; dsa_item(p, d & 1, (SEQ / 4 - 1) - (d >> 1), lds); }
    }
}

__device__ __forceinline__ void phd3_ln1(const Params& p) {
    const int tid = threadIdx.x, lane = tid & 63, wave = tid >> 6;
    const int gw = blockIdx.x * 8 + wave, NGW = gridDim.x * 8;
    f16* H1H = (f16*)(p.ws + WS_H1H);
    for (int m = gw; m < MREAL; m += NGW) {
        float* row = p.out + (size_t)m * D;
        f32x4 v[4]; float s = 0.f;
#pragma unroll
        for (int j = 0; j < 4; ++j) { v[j] = *(const f32x4*)(row + j * 256 + lane * 4); s += (v[j].x + v[j].y) + (v[j].z + v[j].w); }
        const float mean = wave_sum(s) * (1.f / D); float s2 = 0.f;
#pragma unroll
        for (int j = 0; j < 4; ++j) { v[j] = v[j] - mean; s2 += (v[j].x * v[j].x + v[j].y * v[j].y) + (v[j].z * v[j].z + v[j].w * v[j].w); }
        const float rstd = 1.f / sqrtf(wave_sum(s2) * (1.f / D) + LN_EPS);
#pragma unroll
        for (int j = 0; j < 4; ++j) { const f32x4 g = *(const f32x4*)(p.ln1_g + j * 256 + lane * 4), bb = *(const f32x4*)(p.ln1_b + j * 256 + lane * 4);
            const f32x4 o = v[j] * rstd * g + bb; *(f32x4*)(row + j * 256 + lane * 4) = o; *(f16x4*)(H1H + (size_t)m * D + j * 256 + lane * 4) = to_h4(o); }
    }
    f16* U16 = (f16*)(p.ws + WS_U16); f16* V16 = (f16*)(p.ws + WS_V16);
    const long gt = (long)blockIdx.x * NT + tid, NGT = (long)gridDim.x * NT;
    for (long e = gt; e < 16384L * 1024 / 4; e += NGT) {
        *(f16x4*)(U16 + e * 4) = to_h4(*(const f32x4*)(p.peer_u + e * 4));
        *(f16x4*)(V16 + e * 4) = to_h4(*(const f32x4*)(p.peer_v + e * 4));
    }
}

#define CSWAP(j) do { if (tv[j] > tv[j - 1]) { const float _t = tv[j]; tv[j] = tv[j - 1]; tv[j - 1] = _t; const int _i = ti[j]; ti[j] = ti[j - 1]; ti[j - 1] = _i; } } while (0)
__device__ __forceinline__ void top16_of_128(const f16* src, float (&tv)[16], int (&ti)[16]) {
#pragma unroll
    for (int j = 0; j < 16; ++j) { tv[j] = -INFINITY; ti[j] = 0; }
    for (int c = 0; c < 16; ++c) {
        const f16x8 x8 = *(const f16x8*)(src + c * 8);
#pragma unroll
        for (int e = 0; e < 8; ++e) {
            const float x = (float)x8[e];
            if (x > tv[15]) { tv[15] = x; ti[15] = c * 8 + e;
                CSWAP(15); CSWAP(14); CSWAP(13); CSWAP(12); CSWAP(11); CSWAP(10); CSWAP(9); CSWAP(8); CSWAP(7); CSWAP(6); CSWAP(5); CSWAP(4); CSWAP(3); CSWAP(2); CSWAP(1); }
        }
    }
}
__device__ __forceinline__ void phd5_topk(const Params& p) {
    const f16* SC = (const f16*)(p.ws + WS_SC);
    unsigned short* EIDX = (unsigned short*)(p.ws + WS_EIDX); float* EGATE = (float*)(p.ws + WS_EGATE);
    const long gt = (long)blockIdx.x * NT + threadIdx.x, NGT = (long)gridDim.x * NT;
    for (long e = gt; e < (long)MREAL * 8; e += NGT) {
        const int m = (int)(e >> 3), h = (int)(e & 7);
        float av[16], bv[16]; int ai[16], bi[16];
        top16_of_128(SC + (size_t)m * 2048 + h * 256, av, ai);
        top16_of_128(SC + (size_t)m * 2048 + h * 256 + 128, bv, bi);
        float tv[16]; int ti[16];
#pragma unroll
        for (int j = 0; j < 16; ++j) { tv[j] = -INFINITY; ti[j] = 0; }
#pragma unroll
        for (int i = 0; i < 16; ++i)
#pragma unroll
            for (int j = 0; j < 16; ++j)
                if ((i + 1) * (j + 1) <= 16) {
                    const float x = av[i] + bv[j];
                    if (x > tv[15]) { tv[15] = x; ti[15] = ai[i] * 128 + bi[j];
                        CSWAP(15); CSWAP(14); CSWAP(13); CSWAP(12); CSWAP(11); CSWAP(10); CSWAP(9); CSWAP(8); CSWAP(7); CSWAP(6); CSWAP(5); CSWAP(4); CSWAP(3); CSWAP(2); CSWAP(1); }
                }
        float sum = 0.f; float ex[16];
#pragma unroll
        for (int j = 0; j < 16; ++j) { ex[j] = __expf(tv[j] - tv[0]); sum += ex[j]; }
        const float inv = 1.f / sum;
#pragma unroll
        for (int j = 0; j < 16; ++j) { EIDX[(size_t)m * 128 + h * 16 + j] = (unsigned short)ti[j]; EGATE[(size_t)m * 128 + h * 16 + j] = ex[j] * inv; }
    }
}

__device__ __forceinline__ void phd6_gather(const Params& p) {
    const int tid = threadIdx.x, lane = tid & 63, wave = tid >> 6;
    const int gw = blockIdx.x * 8 + wave, NGW = gridDim.x * 8;
    const f16* U16 = (const f16*)(p.ws + WS_U16); const f16* V16 = (const f16*)(p.ws + WS_V16);
    const unsigned short* EIDX = (const unsigned short*)(p.ws + WS_EIDX); const float* EGATE = (const float*)(p.ws + WS_EGATE);
    for (int m = gw; m < MREAL; m += NGW) {
        float* row = p.out + (size_t)m * D;
        float hv[16];
#pragma unroll
        for (int sg = 0; sg < 2; ++sg)
#pragma unroll
            for (int q = 0; q < 2; ++q) { const f32x4 t = *(const f32x4*)(row + sg * 512 + lane * 8 + q * 4); hv[sg * 8 + q * 4] = t.x; hv[sg * 8 + q * 4 + 1] = t.y; hv[sg * 8 + q * 4 + 2] = t.z; hv[sg * 8 + q * 4 + 3] = t.w; }
        const int e_lo = (int)EIDX[(size_t)m * 128 + lane], e_hi = (int)EIDX[(size_t)m * 128 + 64 + lane];
        const float g_lo = EGATE[(size_t)m * 128 + lane], g_hi = EGATE[(size_t)m * 128 + 64 + lane];
        float hd_lo = 0.f, hd_hi = 0.f;
#pragma unroll 4
        for (int e = 0; e < 64; ++e) {
            const int id0 = __builtin_amdgcn_readlane(e_lo, e), id1 = __builtin_amdgcn_readlane(e_hi, e);
            const f16* u0 = U16 + (size_t)id0 * D + lane * 8; const f16* u1 = U16 + (size_t)id1 * D + lane * 8;
            const f16x8 a0 = *(const f16x8*)(u0), a1 = *(const f16x8*)(u0 + 512), b0 = *(const f16x8*)(u1), b1 = *(const f16x8*)(u1 + 512);
            float s0 = 0.f, s1 = 0.f;
#pragma unroll
            for (int j = 0; j < 8; ++j) { s0 += hv[j] * (float)a0[j]; s0 += hv[8 + j] * (float)a1[j]; s1 += hv[j] * (float)b0[j]; s1 += hv[8 + j] * (float)b1[j]; }
            s0 = wave_sum(s0); s1 = wave_sum(s1);
            if (lane == e) { hd_lo = s0; hd_hi = s1; }
        }
        const float c_lo = g_lo * 0.5f * hd_lo * (1.f + erff(hd_lo * 0.70710678118654752f));
        const float c_hi = g_hi * 0.5f * hd_hi * (1.f + erff(hd_hi * 0.70710678118654752f));
        float acc[16];
#pragma unroll
        for (int j = 0; j < 16; ++j) acc[j] = 0.f;
#pragma unroll 4
        for (int e = 0; e < 64; ++e) {
            const int id0 = __builtin_amdgcn_readlane(e_lo, e), id1 = __builtin_amdgcn_readlane(e_hi, e);
            const float cf0 = __builtin_bit_cast(float, __builtin_amdgcn_readlane(__builtin_bit_cast(int, c_lo), e)), cf1 = __builtin_bit_cast(float, __builtin_amdgcn_readlane(__builtin_bit_cast(int, c_hi), e));
            const f16* v0 = V16 + (size_t)id0 * D + lane * 8; const f16* v1 = V16 + (size_t)id1 * D + lane * 8;
            const f16x8 a0 = *(const f16x8*)(v0), a1 = *(const f16x8*)(v0 + 512), b0 = *(const f16x8*)(v1), b1 = *(const f16x8*)(v1 + 512);
#pragma unroll
            for (int j = 0; j < 8; ++j) { acc[j] += cf0 * (float)a0[j] + cf1 * (float)b0[j]; acc[8 + j] += cf0 * (float)a1[j] + cf1 * (float)b1[j]; }
        }
        float s = 0.f;
#pragma unroll
        for (int j = 0; j < 16; ++j) { acc[j] += ALPHA * hv[j]; s += acc[j]; }
        const float mean = wave_sum(s) * (1.f / D); float s2 = 0.f;
#pragma unroll
        for (int j = 0; j < 16; ++j) { acc[j] -= mean; s2 += acc[j] * acc[j]; }
        const float rstd = 1.f / sqrtf(wave_sum(s2) * (1.f / D) + LN_EPS);
#pragma unroll
        for (int sg = 0; sg < 2; ++sg)
#pragma unroll
            for (int q = 0; q < 2; ++q) { const int col = sg * 512 + lane * 8 + q * 4; const f32x4 g = *(const f32x4*)(p.ln2_g + col), bb = *(const f32x4*)(p.ln2_b + col);
                f32x4 o; o.x = acc[sg * 8 + q * 4] * rstd * g.x + bb.x; o.y = acc[sg * 8 + q * 4 + 1] * rstd * g.y + bb.y; o.z = acc[sg * 8 + q * 4 + 2] * rstd * g.z + bb.z; o.w = acc[sg * 8 + q * 4 + 3] * rstd * g.w + bb.w;
                *(f32x4*)(row + col) = o; }
    }
}

struct EpiLora {
    f16 *LW, *AA, *GG; const float *w0, *a0;
    __device__ __forceinline__ void operator()(const f32x4 (&acc)[2][2][4][2], const pg8::Unit& u, int wr, int wc, int fr, int fq) const {
        const int row0 = u.pm * 256 + wr * 64 + fr, col0 = (u.pn & 1) * 256 + wc * 32 + 4 * fq;
        if (u.pn < 2) {
#pragma unroll
            for (int bj = 0; bj < 2; ++bj)
#pragma unroll
                for (int n = 0; n < 2; ++n) { const int col = col0 + bj * 128 + n * 16; const f32x4 c = *(const f32x4*)(w0 + col);
#pragma unroll
                    for (int ai = 0; ai < 2; ++ai)
#pragma unroll
                        for (int m = 0; m < 4; ++m) { const f32x4 v = acc[ai][bj][m][n]; f16x4 o;
#pragma unroll
                            for (int e = 0; e < 4; ++e) { const float wl = -softplusf_(-(c[e] + v[e])) - 0.5f; o[e] = (f16)(-__expf(wl)); }
                            *(f16x4*)(LW + (size_t)(row0 + ai * 128 + m * 16) * 512 + col) = o; } }
        } else if (u.pn < 4) {
#pragma unroll
            for (int bj = 0; bj < 2; ++bj)
#pragma unroll
                for (int n = 0; n < 2; ++n) { const int col = col0 + bj * 128 + n * 16; const f32x4 c = *(const f32x4*)(a0 + col);
#pragma unroll
                    for (int ai = 0; ai < 2; ++ai)
#pragma unroll
                        for (int m = 0; m < 4; ++m) { const f32x4 v = acc[ai][bj][m][n]; f16x4 o;
#pragma unroll
                            for (int e = 0; e < 4; ++e) o[e] = (f16)sigmoidf_(c[e] + v[e]);
                            *(f16x4*)(AA + (size_t)(row0 + ai * 128 + m * 16) * 512 + col) = o; } }
        } else {
#pragma unroll
            for (int bj = 0; bj < 2; ++bj)
#pragma unroll
                for (int n = 0; n < 2; ++n) { const int col = col0 + bj * 128 + n * 16;
#pragma unroll
                    for (int ai = 0; ai < 2; ++ai)
#pragma unroll
                        for (int m = 0; m < 4; ++m) *(f16x4*)(GG + (size_t)(row0 + ai * 128 + m * 16) * 512 + col) = to_h4(acc[ai][bj][m][n]); }
        }
    }
};

constexpr int LDS_BYTES = 150 * 1024;
constexpr int NPHASE = 11;
__global__ void __launch_bounds__(NT) mk_fwd(Params p) {
    extern __shared__ __attribute__((aligned(16))) unsigned char lds[];
    cg::grid_group grid = cg::this_grid();
    unsigned char* ws = p.ws;
    const int lo = p.ph_lo, hi = p.ph_hi;
#define IN(k) (lo <= (k) && (k) < hi)
#define SEAM(k) do { if (IN(k) && IN((k) + 1)) grid.sync(); } while (0)
    if (IN(0)) ph0_prep(p, lds);
    SEAM(0);
    if (IN(1)) {
        f16* PB = (f16*)(ws + WS_PB);
        auto f = [=](int row, int col, f32x4 v) { *(f16x4*)(PB + (size_t)row * N1 + col) = to_h4(v); };
        pg8::run_gemm(lds, (const f16*)(ws + WS_H0), (const f16*)(ws + WS_W1T), MR, N1, D, f);
    }
    SEAM(1);
    if (IN(2)) phc1_rowprep(p);
    SEAM(2);
    if (IN(3)) {
        pg8::Gemm g{(const f16*)((unsigned char*)p.out + DO_LORAIN), (const f16*)(ws + WS_WLT), MR, 1536, 256}; pg8::StaticOrder S; S.init(MR, 1536, (int)gridDim.x, (int)blockIdx.x);
        EpiLora E{(f16*)((unsigned char*)p.out + DO_LW), (f16*)((unsigned char*)p.out + DO_AA), (f16*)((unsigned char*)p.out + DO_GG), p.b_w0, p.b_a0};
        pg8::gemm_phase<EpiLora>((PG8_LAS unsigned char*)lds, g, S, E);
        __syncthreads();
    }
    SEAM(3);
    if (IN(4)) phc2_mixers(p, lds);
    SEAM(4);
    if (IN(5)) {
        f16* MIX = (f16*)(ws + WS_MIXED); f16* TMP = (f16*)(ws + WS_TMP); const float* bg = p.b_gate;
        auto f1 = [=](int row, int col, f32x4 v) { const f32x4 c = *(const f32x4*)(bg + col); f16x4 o;
#pragma unroll
            for (int e = 0; e < 4; ++e) o[e] = (f16)sigmoidf_(v[e] + c[e]);
            *(f16x4*)(MIX + (size_t)row * D + col) = o; };
        pg8::run_gemm(lds, (const f16*)(ws + WS_H0), (const f16*)(ws + WS_WGT), MREAL, D, D, f1);
        auto f2 = [=](int row, int col, f32x4 v) { f16x4* q = (f16x4*)(MIX + (size_t)row * D + col); const f16x4 gq = *q; f16x4 o;
#pragma unroll
            for (int e = 0; e < 4; ++e) o[e] = (f16)((float)gq[e] * v[e]);
            *q = o; };
        pg8::run_gemm(lds, (const f16*)(ws + WS_OLAT), (const f16*)(ws + WS_WPAT), MREAL, D, D, f2);
        auto f3 = [=](int row, int col, f32x4 v) { const f32x4 c = *(const f32x4*)(bg + 1024 + col); f16x4 o;
#pragma unroll
            for (int e = 0; e < 4; ++e) o[e] = (f16)sigmoidf_(v[e] + c[e]);
            *(f16x4*)(TMP + (size_t)row * D + col) = o; };
        pg8::run_gemm(lds, (const f16*)(ws + WS_H0), (const f16*)(ws + WS_WGT) + (size_t)1024 * D, MREAL, D, D, f3);
        auto f4 = [=](int row, int col, f32x4 v) { f16x4* q = (f16x4*)(MIX + (size_t)row * D + col); const f16x4 m0 = *q; const f16x4 gq = *(const f16x4*)(TMP + (size_t)row * D + col); f16x4 o;
#pragma unroll
            for (int e = 0; e < 4; ++e) o[e] = (f16)((float)m0[e] + (float)gq[e] * v[e]);
            *q = o; };
        pg8::run_gemm(lds, (const f16*)(ws + WS_OB), (const f16*)(ws + WS_WPBT), MREAL, D, 512, f4);
    }
    SEAM(5);
    if (IN(6)) {
        const float* x = p.x; const float* STAT = (const float*)(ws + WS_STAT); const float* lg = p.ln_in_g; const float* lb = p.ln_in_b; float* out = p.out;
        auto f = [=](int row, int col, f32x4 v) { const f32x4 xv = *(const f32x4*)(x + (size_t)row * D + col); const float mean = STAT[2 * row], rstd = STAT[2 * row + 1];
            const f32x4 g = *(const f32x4*)(lg + col), bb = *(const f32x4*)(lb + col);
            *(f32x4*)(out + (size_t)row * D + col) = ((xv - mean) * rstd * g + bb) * ALPHA + v; };
        pg8::run_gemm(lds, (const f16*)(ws + WS_MIXED), (const f16*)(ws + WS_WOT), MREAL, D, D, f);
    }
    SEAM(6);
    if (IN(7)) phd3_ln1(p);
    SEAM(7);
    if (IN(8)) {
        f16* SC = (f16*)(ws + WS_SC);
        auto f = [=](int row, int col, f32x4 v) { *(f16x4*)(SC + (size_t)row * 2048 + col) = to_h4(v); };
        pg8::run_gemm(lds, (const f16*)(ws + WS_H1H), (const f16*)(ws + WS_WSKT), MREAL, 2048, D, f);
    }
    SEAM(8);
    if (IN(9)) phd5_topk(p);
    SEAM(9);
    if (IN(10)) phd6_gather(p);
#undef IN
#undef SEAM
}

extern "C" void kernel_launch(void* const* d_in, const int* in_sizes, int n_in, void* d_out, int out_size, void* d_ws, size_t ws_size, hipStream_t stream) {
    static int grid = 0;
    if (grid == 0) {
        int dev = 0, cus = 0, per_cu = 0;
        if (hipGetDevice(&dev) != hipSuccess || hipDeviceGetAttribute(&cus, hipDeviceAttributeMultiprocessorCount, dev) != hipSuccess) { fprintf(stderr, "kernel_launch: device query failed\n"); grid = -1; return; }
        if (hipFuncSetAttribute((const void*)mk_fwd, hipFuncAttributeMaxDynamicSharedMemorySize, LDS_BYTES) != hipSuccess) { fprintf(stderr, "kernel_launch: hipFuncSetAttribute failed\n"); grid = -1; return; }
        if (hipOccupancyMaxActiveBlocksPerMultiprocessor(&per_cu, (const void*)mk_fwd, NT, LDS_BYTES) != hipSuccess || per_cu < 1) { fprintf(stderr, "kernel_launch: occupancy query says %d\n", per_cu); grid = -1; return; }
        if (n_in != 33 || out_size != MREAL * D || ws_size < WS_END) { fprintf(stderr, "kernel_launch: unexpected shapes n_in %d out %d ws %zu\n", n_in, out_size, ws_size); grid = -1; return; }
        grid = cus;
    }
    if (grid < 0) return;
    (void)hipMemsetAsync((char*)d_ws + WS_CTL, 0, 1 * MiB, stream);
    Params p{};
    const float** pf = (const float**)&p;
    for (int i = 0; i < 33; ++i) pf[i] = (const float*)d_in[i];
    p.out = (float*)d_out; p.ws = (unsigned char*)d_ws; p.ph_lo = 0; p.ph_hi = NPHASE;
    void* args[] = {&p};
    hipError_t e = hipLaunchCooperativeKernel((void*)mk_fwd, dim3(grid), dim3(NT), args, LDS_BYTES, stream);
    if (e != hipSuccess) fprintf(stderr, "kernel_launch: cooperative launch failed: %s (grid %d)\n", hipGetErrorString(e), grid);
}
```

```cpp
#include <hip/hip_runtime.h>
#include <hip/hip_cooperative_groups.h>
#include <cstdio>
#include <cstdint>
namespace cg = cooperative_groups;

#define LAS __attribute__((address_space(3)))
typedef _Float16 f16;
typedef _Float16 f16x2 __attribute__((ext_vector_type(2)));
typedef _Float16 f16x4 __attribute__((ext_vector_type(4)));
typedef _Float16 f16x8 __attribute__((ext_vector_type(8)));
typedef float f32x2 __attribute__((ext_vector_type(2)));
typedef float f32x4 __attribute__((ext_vector_type(4)));
typedef float f32x16 __attribute__((ext_vector_type(16)));
typedef unsigned u32x4 __attribute__((ext_vector_type(4)));

constexpr int D = 1024, SEQ = 8192, NMETA = 16, TT = 8208;
constexpr int MREAL = 16384, MR = 16640;
constexpr int NIN = 5064;
constexpr int N1 = 3584;
constexpr int C_QABS = 0, C_QI = 1024, C_CKV = 1536, C_KI = 1664, C_WI = 1728, C_BC = 1792;
constexpr int NT = 512;
constexpr float LN_EPS = 1e-5f;
constexpr float ALPHA = 1.189207115002721f;

__device__ __forceinline__ int row_of(int b, int t) { return t < NMETA ? MREAL + b * NMETA + t : b * SEQ + (t - NMETA); }

constexpr size_t MiB = 1u << 20;
constexpr size_t WS_CTL = 0, WS_STAT = 1 * MiB, WS_WIS = 2 * MiB, WS_W1T = 3 * MiB, WS_WGT = 10 * MiB, WS_WPAT = 14 * MiB, WS_WPBT = 16 * MiB,
                 WS_WOT = 17 * MiB, WS_WSKT = 19 * MiB, WS_WLT = 23 * MiB, WS_CKV = 24 * MiB, WS_KIDX = 29 * MiB, WS_H0 = 32 * MiB,
                 WS_OLAT = 65 * MiB, WS_OB = 97 * MiB, WS_PB = 113 * MiB, WS_END = 227 * MiB;
constexpr size_t WS_MIXED = WS_PB, WS_H1H = WS_PB, WS_TMP = WS_PB + 32 * MiB, WS_SC = WS_PB + 32 * MiB, WS_EIDX = WS_PB + 96 * MiB, WS_EGATE = WS_PB + 100 * MiB;
constexpr size_t WS_U16 = WS_H0, WS_V16 = WS_OLAT;
constexpr size_t DO_LORAIN = 0, DO_LW = 9 * MiB, DO_AA = 26 * MiB, DO_GG = 43 * MiB;

struct Params {
    const float *x, *meta, *ln_in_g, *ln_in_b, *w_in, *b_gate, *a_kv_norm_g, *a_w_uk, *a_w_uv, *a_kidx_g, *a_kidx_b, *b_mu, *b_w0, *b_w2, *b_a0, *b_a2,
        *b_g2, *b_k_k, *b_k_a, *b_r_k, *b_lnx_g, *b_lnx_b, *w_pa, *w_pb, *w_o, *ln1_g, *ln1_b, *peer_wq, *peer_subkeys, *peer_u, *peer_v, *ln2_g, *ln2_b;
    float* out;
    unsigned char* ws;
    int ph_lo, ph_hi;
};

__device__ __forceinline__ float wave_sum(float v) {
#pragma unroll
    for (int o = 1; o < 64; o <<= 1) v += __shfl_xor(v, o);
    return v;
}
__device__ __forceinline__ float wave_max(float v) {
#pragma unroll
    for (int o = 1; o < 64; o <<= 1) v = fmaxf(v, __shfl_xor(v, o));
    return v;
}
__device__ __forceinline__ float sigmoidf_(float x) { return __builtin_amdgcn_rcpf(1.f + __expf(-x)); }
__device__ __forceinline__ float softplusf_(float z) { return fmaxf(z, 0.f) + __logf(1.f + __expf(-fabsf(z))); }
__device__ __forceinline__ unsigned fkey(float f) { unsigned u = __float_as_uint(f); return u ^ ((u >> 31) ? 0xFFFFFFFFu : 0x80000000u); }

namespace pg8 {
#define PG8_LAS __attribute__((address_space(3)))
typedef short h16x8 __attribute__((ext_vector_type(8)));
constexpr int BM = 256, BK = 64, HALF = 128, HTB = HALF * BK * 2, STAGE_BYTES = 8 * HTB, NXCD = 8, WGM = 8;
__host__ __device__ __forceinline__ int lds_byte(int r, int c) { const int st = (r >> 4) * 2 + (c >> 5), rr = r & 15, cc = c & 31, ob = rr * 64 + cc * 2; return st * 1024 + (ob ^ (((ob >> 9) & 1) << 5)); }
__host__ __device__ __forceinline__ void stage_rc(int b, int& R, int& C) { const int st = b / 1024, sb = b % 1024, swz = sb ^ (((sb >> 9) & 1) << 5); R = (st >> 1) * 16 + swz / 64; C = (st & 1) * 32 + (swz % 64) / 2; }
struct Unit { int pm, pn; };
struct Gemm { const f16* A; const f16* Bt; int M, N, K; };
struct StaticOrder {
    int nM, nN, nwg, G, c;
    __host__ __device__ void init(int M, int N, int G_, int c_) { nM = M / BM; nN = N / BM; nwg = nM * nN; G = G_; c = c_; }
    __host__ __device__ bool next(int i, Unit& u) const {
        const long L = (long)i * G + c; if (L >= nwg) return false;
        int wgid = (int)L; { const int q = nwg / NXCD, r = nwg % NXCD, xcd = wgid % NXCD, off = wgid / NXCD; wgid = (xcd < r ? xcd * (q + 1) : r * (q + 1) + (xcd - r) * q) + off; }
        const int nig = WGM * nN, gid = wgid / nig, fm = gid * WGM, gsz = (nM - fm) < WGM ? (nM - fm) : WGM;
        u.pm = fm + ((wgid % nig) % gsz); u.pn = (wgid % nig) / gsz; return true;
    }
};
template <class F> struct EpiElem {
    F f;
    __device__ __forceinline__ void operator()(const f32x4 (&acc)[2][2][4][2], const Unit& u, int wr, int wc, int fr, int fq) const {
        const int row0 = u.pm * BM + wr * 64 + fr, col0 = u.pn * BM + wc * 32 + 4 * fq;
#pragma unroll
        for (int ai = 0; ai < 2; ++ai)
#pragma unroll
            for (int m = 0; m < 4; ++m)
#pragma unroll
                for (int bj = 0; bj < 2; ++bj)
#pragma unroll
                    for (int n = 0; n < 2; ++n) f(row0 + ai * HALF + m * 16, col0 + bj * HALF + n * 16, acc[ai][bj][m][n]);
    }
};
template <class Epi>
__device__ __forceinline__ void gemm_phase(PG8_LAS unsigned char* lds, const Gemm g, const StaticOrder& S, const Epi& E) {
    const int tid = threadIdx.x, wid = __builtin_amdgcn_readfirstlane(tid >> 6), lane = tid & 63, wr = wid >> 2, wc = wid & 3, fr = lane & 15, fq = lane >> 4;
    int K = g.K; asm volatile("" : "+s"(K));
    const int nt = K / BK;
    unsigned voffA[2], voffB[2];
#pragma unroll
    for (int i = 0; i < 2; ++i) { int R, C; stage_rc(tid * 16 + i * 8192, R, C); voffA[i] = (unsigned)(R * K + C) * 2u; voffB[i] = (unsigned)(R * K + C) * 2u; }
    const size_t kstep = (size_t)(BK * 2);
    const size_t hstep = (size_t)HALF * K * 2;
    const size_t tstep = 2 * hstep;
    const unsigned ldsw = (unsigned)wid * 1024u;
    const int aoff = lds_byte(wr * 64 + fr, fq * 8), boff = lds_byte(wc * 32 + fr, fq * 8);
#define PG8_SA(b, h) (((b) * 2 + (h)) * HTB)
#define PG8_SB(b, h) ((4 + (b) * 2 + (h)) * HTB)
#define PG8_STAGE(bufoff, gbase, voff) do { _Pragma("unroll") for (int _i = 0; _i < 2; ++_i) \
        __builtin_amdgcn_global_load_lds((const unsigned*)((const char*)(gbase) + (voff)[_i]), (PG8_LAS unsigned*)(lds + (bufoff) + ldsw + _i * 8192), 16, 0, 0); } while (0)
#define PG8_LDA(dst, b, h) do { _Pragma("unroll") for (int m = 0; m < 4; ++m) _Pragma("unroll") for (int k = 0; k < 2; ++k) dst[m][k] = *(const PG8_LAS h16x8*)(lds + PG8_SA(b, h) + aoff + m * 2048 + k * 1024); } while (0)
#define PG8_LDB(dst, b, h) do { _Pragma("unroll") for (int n = 0; n < 2; ++n) _Pragma("unroll") for (int k = 0; k < 2; ++k) dst[n][k] = *(const PG8_LAS h16x8*)(lds + PG8_SB(b, h) + boff + n * 2048 + k * 1024); } while (0)
#define PG8_MMA(ai, bj, At, Bt) do { __builtin_amdgcn_s_setprio(1); _Pragma("unroll") for (int m = 0; m < 4; ++m) _Pragma("unroll") for (int n = 0; n < 2; ++n) _Pragma("unroll") for (int k = 0; k < 2; ++k) \
        acc[ai][bj][m][n] = __builtin_amdgcn_mfma_f32_16x16x32_f16(__builtin_bit_cast(f16x8, Bt[n][k]), __builtin_bit_cast(f16x8, At[m][k]), acc[ai][bj][m][n], 0, 0, 0); __builtin_amdgcn_s_setprio(0); } while (0)
#define PG8_WAIT_V(n) asm volatile("s_waitcnt vmcnt(" #n ")" ::: "memory")
#define PG8_WAIT_L(n) asm volatile("s_waitcnt lgkmcnt(" #n ")" ::: "memory")
#define PG8_BAR __builtin_amdgcn_s_barrier()
#define PG8_SCHED __builtin_amdgcn_sched_barrier(0)
    Unit cur, nxt; int ui = 0;
    if (!S.next(0, cur)) return;
    f32x4 acc[2][2][4][2];
#pragma unroll
    for (int a = 0; a < 2; ++a)
#pragma unroll
        for (int b = 0; b < 2; ++b)
#pragma unroll
            for (int m = 0; m < 4; ++m)
#pragma unroll
                for (int n = 0; n < 2; ++n) acc[a][b][m][n] = (f32x4){0.f, 0.f, 0.f, 0.f};
    h16x8 At[4][2], B0[2][2], B1[2][2];
    const char* cA = (const char*)g.A + (size_t)cur.pm * tstep; const char* cB = (const char*)g.Bt + (size_t)cur.pn * tstep;
    PG8_STAGE(PG8_SB(0, 0), cB, voffB); PG8_STAGE(PG8_SA(0, 0), cA, voffA); PG8_STAGE(PG8_SB(0, 1), cB + hstep, voffB); PG8_STAGE(PG8_SA(0, 1), cA + hstep, voffA);
    if (wr == 1) PG8_BAR;
    PG8_WAIT_V(4); PG8_BAR;
    PG8_STAGE(PG8_SB(1, 0), cB + kstep, voffB); PG8_STAGE(PG8_SA(1, 0), cA + kstep, voffA); PG8_STAGE(PG8_SB(1, 1), cB + hstep + kstep, voffB);
    PG8_WAIT_V(6); PG8_BAR;
    for (;;) {
        const bool has_next = S.next(ui + 1, nxt);
        const char* nA = has_next ? (const char*)g.A + (size_t)nxt.pm * tstep : cA; const char* nB = has_next ? (const char*)g.Bt + (size_t)nxt.pn * tstep : cB;
        for (int t = 0; t < nt; t += 2) {
            const bool last = (t == nt - 2);
            const char* a1 = cA + (size_t)(t + 1) * kstep;
            const char* a2 = last ? nA : cA + (size_t)(t + 2) * kstep; const char* b2 = last ? nB : cB + (size_t)(t + 2) * kstep;
            const char* a3 = a2 + kstep; const char* b3 = b2 + kstep;
            PG8_LDB(B0, 0, 0); PG8_SCHED; PG8_LDA(At, 0, 0); PG8_STAGE(PG8_SA(1, 1), a1 + hstep, voffA);
            PG8_WAIT_L(8); PG8_BAR; PG8_WAIT_L(0); PG8_MMA(0, 0, At, B0); PG8_BAR; PG8_SCHED;
            PG8_LDB(B1, 0, 1); PG8_STAGE(PG8_SB(0, 0), b2, voffB);
            PG8_BAR; PG8_WAIT_L(0); PG8_MMA(0, 1, At, B1); PG8_BAR;
            PG8_LDA(At, 0, 1); PG8_STAGE(PG8_SA(0, 0), a2, voffA);
            PG8_BAR; PG8_WAIT_L(0); PG8_MMA(1, 0, At, B0); PG8_BAR; PG8_SCHED;
            PG8_STAGE(PG8_SB(0, 1), b2 + hstep, voffB);
            PG8_WAIT_V(6); PG8_BAR; PG8_MMA(1, 1, At, B1); PG8_BAR;
            PG8_LDB(B0, 1, 0); PG8_SCHED; PG8_LDA(At, 1, 0); PG8_STAGE(PG8_SA(0, 1), a2 + hstep, voffA);
            PG8_WAIT_L(8); PG8_BAR; PG8_WAIT_L(0); PG8_MMA(0, 0, At, B0); PG8_BAR; PG8_SCHED;
            PG8_LDB(B1, 1, 1); PG8_STAGE(PG8_SB(1, 0), b3, voffB);
            PG8_BAR; PG8_WAIT_L(0); PG8_MMA(0, 1, At, B1); PG8_BAR;
            PG8_LDA(At, 1, 1); PG8_STAGE(PG8_SA(1, 0), a3, voffA);
            PG8_BAR; PG8_WAIT_L(0); PG8_MMA(1, 0, At, B0); PG8_BAR; PG8_SCHED;
            PG8_STAGE(PG8_SB(1, 1), b3 + hstep, voffB);
            PG8_WAIT_V(6); PG8_BAR; PG8_MMA(1, 1, At, B1); PG8_BAR;
        }
        E(acc, cur, wr, wc, fr, fq);
        if (!has_next) break;
#pragma unroll
        for (int a = 0; a < 2; ++a)
#pragma unroll
            for (int b = 0; b < 2; ++b)
#pragma unroll
                for (int m = 0; m < 4; ++m)
#pragma unroll
                    for (int n = 0; n < 2; ++n) acc[a][b][m][n] = (f32x4){0.f, 0.f, 0.f, 0.f};
        cur = nxt; cA = nA; cB = nB; ++ui;
    }
    PG8_WAIT_V(0);
    if (wr == 0) PG8_BAR;
    PG8_BAR;
#undef PG8_SA
#undef PG8_SB
#undef PG8_STAGE
#undef PG8_LDA
#undef PG8_LDB
#undef PG8_MMA
#undef PG8_WAIT_V
#undef PG8_WAIT_L
#undef PG8_BAR
#undef PG8_SCHED
}
template <class F>
__device__ __forceinline__ void run_gemm(unsigned char* lds, const f16* A, const f16* Bt, int M, int N, int K, const F& f) {
    Gemm g{A, Bt, M, N, K}; StaticOrder S; S.init(M, N, (int)gridDim.x, (int)blockIdx.x);
    EpiElem<F> E{f};
    gemm_phase<EpiElem<F>>((PG8_LAS unsigned char*)lds, g, S, E);
    __syncthreads();
}
}

__device__ __forceinline__ f16x4 to_h4(f32x4 v) { f16x4 r; r.x = (f16)v.x; r.y = (f16)v.y; r.z = (f16)v.z; r.w = (f16)v.w; return r; }

__device__ __forceinline__ void tr_item(const float* W, int ldw, int col0, int nvalid, int K, f16* out, int nrow0, int item, int nblk, float* scr, int lane) {
    const int kb = item / nblk, nb = item % nblk, k0 = 64 * kb, n0 = 32 * nb;
#pragma unroll 8
    for (int i = 0; i < 32; ++i) { const int kk = 2 * i + (lane >> 5); const int j = n0 + (lane & 31);
        scr[kk * 33 + (lane & 31)] = (j < nvalid) ? W[(size_t)(k0 + kk) * ldw + col0 + j] : 0.f; }
    asm volatile("s_waitcnt vmcnt(0) lgkmcnt(0)" ::: "memory");
    const int c = lane & 7;
#pragma unroll
    for (int jj = 0; jj < 4; ++jj) { const int n = (lane >> 3) + 8 * jj; const float* s = scr + (8 * c) * 33 + n;
        f16x8 o;
#pragma unroll
        for (int e = 0; e < 8; ++e) o[e] = (f16)s[e * 33];
        *(f16x8*)(out + (size_t)(nrow0 + n0 + n) * K + k0 + 8 * c) = o; }
    asm volatile("s_waitcnt lgkmcnt(0)" ::: "memory");
}

__device__ __forceinline__ void ph0_prep(const Params& p, unsigned char* lds) {
    const int tid = threadIdx.x, lane = tid & 63, wave = tid >> 6;
    const int gw = blockIdx.x * 8 + wave, NGW = gridDim.x * 8;
    f16* H0 = (f16*)(p.ws + WS_H0); float* STAT = (float*)(p.ws + WS_STAT);
    for (int m = gw; m < MR; m += NGW) {
        f16* orow = H0 + (size_t)m * D;
        if (m >= MREAL + 2 * NMETA) {
#pragma unroll
            for (int j = 0; j < 4; ++j) *(f16x4*)(orow + j * 256 + lane * 4) = (f16x4){(f16)0.f, (f16)0.f, (f16)0.f, (f16)0.f};
            continue;
        }
        const float* src = (m < MREAL) ? p.x + (size_t)m * D : p.meta + (size_t)((m - MREAL) & 15) * D;
        f32x4 v[4]; float s = 0.f;
#pragma unroll
        for (int j = 0; j < 4; ++j) { v[j] = *(const f32x4*)(src + j * 256 + lane * 4); s += (v[j].x + v[j].y) + (v[j].z + v[j].w); }
        const float mean = wave_sum(s) * (1.f / D); float s2 = 0.f;
#pragma unroll
        for (int j = 0; j < 4; ++j) { v[j] = v[j] - mean; s2 += (v[j].x * v[j].x + v[j].y * v[j].y) + (v[j].z * v[j].z + v[j].w * v[j].w); }
        const float rstd = 1.f / sqrtf(wave_sum(s2) * (1.f / D) + LN_EPS);
        if (lane == 0) { STAT[2 * m] = mean; STAT[2 * m + 1] = rstd; }
#pragma unroll
        for (int j = 0; j < 4; ++j) { const f32x4 g = *(const f32x4*)(p.ln_in_g + j * 256 + lane * 4), bb = *(const f32x4*)(p.ln_in_b + j * 256 + lane * 4);
            *(f16x4*)(orow + j * 256 + lane * 4) = to_h4(v[j] * rstd * g + bb); }
    }
    float* scr = (float*)lds + wave * (64 * 33);
    f16* W1T = (f16*)(p.ws + WS_W1T); f16* WGT = (f16*)(p.ws + WS_WGT); f16* WPBT = (f16*)(p.ws + WS_WPBT); f16* WOT = (f16*)(p.ws + WS_WOT);
    constexpr int I_QI = 16 * 16, I_CKV = 4 * 16, I_KI = 4 * 16, I_BC = 56 * 16, I_G = 64 * 16, I_PB = 32 * 8, I_O = 32 * 16;
    constexpr int NITEMS = I_QI + I_CKV + I_KI + I_BC + I_G + I_PB + I_O;
    for (int it = gw; it < NITEMS; it += NGW) {
        int r = it;
        if (r < I_QI) { tr_item(p.w_in, NIN, 640, 512, D, W1T, C_QI, r, 16, scr, lane); continue; } r -= I_QI;
        if (r < I_CKV) { tr_item(p.w_in, NIN, 512, 128, D, W1T, C_CKV, r, 4, scr, lane); continue; } r -= I_CKV;
        if (r < I_KI) { tr_item(p.w_in, NIN, 1152, 72, D, W1T, C_KI, r, 4, scr, lane); continue; } r -= I_KI;
        if (r < I_BC) { tr_item(p.w_in, NIN, 1224, 1792, D, W1T, C_BC, r, 56, scr, lane); continue; } r -= I_BC;
        if (r < I_G) { tr_item(p.w_in, NIN, 3016, 2048, D, WGT, 0, r, 64, scr, lane); continue; } r -= I_G;
        if (r < I_PB) { tr_item(p.w_pb, D, 0, 1024, 512, WPBT, 0, r, 32, scr, lane); continue; } r -= I_PB;
        tr_item(p.w_o, D, 0, 1024, D, WOT, 0, r, 32, scr, lane);
    }
    const long gt = (long)blockIdx.x * NT + tid, NGT = (long)gridDim.x * NT;
    f16* W1Tq = W1T;
    for (long e = gt; e < 1024L * 1024; e += NGT) { const int n = (int)(e >> 10), k = (int)(e & 1023), h = n >> 7, r = n & 127;
        const float* a = p.w_in + (size_t)k * NIN + h * 64; const float* bq = p.a_w_uk + (size_t)(r * 8 + h) * 64; float s = 0.f;
#pragma unroll 8
        for (int d = 0; d < 64; ++d) s += a[d] * bq[d];
        W1Tq[(size_t)n * D + k] = (f16)s; }
    f16* WPAT = (f16*)(p.ws + WS_WPAT);
    for (long e = gt; e < 1024L * 1024; e += NGT) { const int n = (int)(e >> 10), k = (int)(e & 1023), h = k >> 7, r = k & 127;
        const float* a = p.a_w_uv + (size_t)(r * 8 + h) * 64; const float* bq = p.w_pa + (size_t)(h * 64) * D + n; float s = 0.f;
#pragma unroll 8
        for (int d = 0; d < 64; ++d) s += a[d] * bq[(size_t)d * D];
        WPAT[(size_t)n * D + k] = (f16)s; }
    f16* WSKT = (f16*)(p.ws + WS_WSKT);
    for (long e = gt; e < 2048L * 1024; e += NGT) { const int n = (int)(e >> 10), k = (int)(e & 1023), hp = n >> 7;
        const float* a = p.peer_wq + (size_t)k * 2048 + hp * 128; const float* bq = p.peer_subkeys + (size_t)n * 128; float s = 0.f;
#pragma unroll 8
        for (int j = 0; j < 128; ++j) s += a[j] * bq[j];
        WSKT[(size_t)n * D + k] = (f16)s; }
    f16* WLT = (f16*)(p.ws + WS_WLT);
    for (long e = gt; e < 1536L * 256; e += NGT) { const int n = (int)(e >> 8), k = (int)(e & 255); float v = 0.f;
        if (n < 512) { if (k < 64) v = p.b_w2[(size_t)k * 512 + n]; }
        else if (n < 1024) { if (k >= 64 && k < 128) v = p.b_a2[(size_t)(k - 64) * 512 + (n - 512)]; }
        else { if (k >= 128) v = p.b_g2[(size_t)(k - 128) * 512 + (n - 1024)]; }
        WLT[e] = (f16)v; }
}

__device__ __forceinline__ void phc1_rowprep(const Params& p) {
    const int tid = threadIdx.x, lane = tid & 63, wave = tid >> 6;
    const int gw = blockIdx.x * 8 + wave, NGW = gridDim.x * 8;
    const f16* PB = (const f16*)(p.ws + WS_PB); f16* CKV = (f16*)(p.ws + WS_CKV); f16* KIDX = (f16*)(p.ws + WS_KIDX); float* WIS = (float*)(p.ws + WS_WIS);
    f16* LORAIN = (f16*)((unsigned char*)p.out + DO_LORAIN);
    for (int m = gw; m < MR; m += NGW) {
        if (m >= MREAL + 2 * NMETA) { *(f16x4*)(LORAIN + (size_t)m * 256 + lane * 4) = (f16x4){(f16)0.f, (f16)0.f, (f16)0.f, (f16)0.f}; continue; }
        const f16* pr = PB + (size_t)m * N1;
        { const f16x2 c2 = *(const f16x2*)(pr + C_CKV + 2 * lane); const float a = (float)c2.x, b = (float)c2.y;
          const float ss = wave_sum(a * a + b * b); const float r = 1.f / sqrtf(ss * (1.f / 128.f) + 1e-6f);
          f16x2 o; o.x = (f16)(a * r * p.a_kv_norm_g[2 * lane]); o.y = (f16)(b * r * p.a_kv_norm_g[2 * lane + 1]);
          *(f16x2*)(CKV + (size_t)m * 128 + 2 * lane) = o; }
        { const float a = (float)pr[C_KI + lane]; const float mu = wave_sum(a) * (1.f / 64.f); const float d = a - mu;
          const float var = wave_sum(d * d) * (1.f / 64.f);
          KIDX[(size_t)m * 64 + lane] = (f16)(d * (1.f / sqrtf(var + LN_EPS)) * p.a_kidx_g[lane] + p.a_kidx_b[lane]); }
        if (lane < 8) WIS[(size_t)m * 8 + lane] = (float)pr[C_WI + lane] * 0.04419417382415922f;
        { int b, t; if (m < MREAL) { b = m >> 13; t = NMETA + (m & 8191); } else { b = (m - MREAL) >> 4; t = (m - MREAL) & 15; }
          const f16x4 cur = *(const f16x4*)(pr + C_BC + 1536 + lane * 4);
          f16x4 prv = (f16x4){(f16)0.f, (f16)0.f, (f16)0.f, (f16)0.f};
          if (t > 0) prv = *(const f16x4*)(PB + (size_t)row_of(b, t - 1) * N1 + C_BC + 1536 + lane * 4);
          const f32x4 mu = *(const f32x4*)(p.b_mu + 1536 + lane * 4);
          f16x4 o;
#pragma unroll
          for (int e = 0; e < 4; ++e) { const float c = (float)cur[e], q = (float)prv[e]; float xs = c + (q - c) * mu[e];
              const int j = lane * 4 + e; if (j < 64) xs = tanhf(xs); else if (j >= 128) xs = sigmoidf_(xs); o[e] = (f16)xs; }
          *(f16x4*)(LORAIN + (size_t)m * 256 + lane * 4) = o; }
    }
}

typedef short bf16x8 __attribute__((ext_vector_type(8)));
typedef unsigned short bf16_t;
typedef unsigned u32x2 __attribute__((ext_vector_type(2)));
typedef __bf16 bf16x2_t __attribute__((ext_vector_type(2)));
__device__ __forceinline__ unsigned cvt_pk_bf16(float lo, float hi) { const f32x2 v = {lo, hi}; const bf16x2_t b = __builtin_convertvector(v, bf16x2_t); return __builtin_bit_cast(unsigned, b); }
__device__ __forceinline__ bf16_t f2bf(float f) { unsigned u = __float_as_uint(f); return (bf16_t)((u + 0x7fffu + ((u >> 16) & 1u)) >> 16); }
__device__ __forceinline__ u32x2 pk4(f32x4 v) { u32x2 r; r.x = cvt_pk_bf16(v[0], v[1]); r.y = cvt_pk_bf16(v[2], v[3]); return r; }
__device__ __forceinline__ bf16x8 pk8(f32x4 a, f32x4 b) { u32x4 r; r.x = cvt_pk_bf16(a[0], a[1]); r.y = cvt_pk_bf16(a[2], a[3]); r.z = cvt_pk_bf16(b[0], b[1]); r.w = cvt_pk_bf16(b[2], b[3]); return __builtin_bit_cast(bf16x8, r); }
#define MFMA_BF(a, b, c) __builtin_amdgcn_mfma_f32_16x16x32_bf16((a), (b), (c), 0, 0, 0)
constexpr int RS = 72, PSt = 40, FS = 36, YS = 68;
__device__ __forceinline__ void rwkv_item(const Params& p, int b, int h, unsigned char* lds) {
    const int tid = threadIdx.x, lane = tid & 63, wave = tid >> 6, fr = lane & 15, fq = lane >> 4;
    const f16* PB = (const f16*)(p.ws + WS_PB);
    const f16* LW = (const f16*)((unsigned char*)p.out + DO_LW); const f16* AA = (const f16*)((unsigned char*)p.out + DO_AA); const f16* GG = (const f16*)((unsigned char*)p.out + DO_GG);
    f16* OB = (f16*)(p.ws + WS_OB);
    bf16_t* sAt = (bf16_t*)lds; bf16_t* sRt = sAt + 32 * RS; bf16_t* sBt = sRt + 32 * RS; bf16_t* sKt = sBt + 32 * RS; bf16_t* sW1 = sKt + 32 * RS;
    bf16_t* sAtT = sW1 + 32 * RS; bf16_t* sBPT = sAtT + 64 * PSt; bf16_t* sKPT = sBPT + 64 * PSt; bf16_t* sVT = sKPT + 64 * PSt;
    bf16_t* sAakT = sVT + 64 * PSt; bf16_t* sMrb = sAakT + 32 * PSt; bf16_t* sMrk = sMrb + 32 * PSt; bf16_t* sT = sMrk + 32 * PSt; bf16_t* sW2 = sT + 32 * PSt;
    float* sAab = (float*)(sW2 + 32 * PSt); float* sTf = sAab + 32 * FS; float* sX = sTf + 32 * FS; float* sTot = sX + 16 * 20; float* sPL = sTot + 8 * 64; float* sY = sPL + 64;
    float* sEnd = sY + 32 * YS;
    for (unsigned* z = (unsigned*)lds + tid; z < (unsigned*)sEnd; z += NT) *z = 0u;
    const int ps = tid >> 4, cg = tid & 15, c4 = cg * 4, hc = h * 64 + c4;
    const int chslot = 32 * (cg >> 3) + 8 * (cg & 3) + 4 * ((cg >> 2) & 1);
    const int pslot = 8 * ((ps & 15) >> 2) + 4 * (ps >> 4) + (ps & 3);
    const f32x4 mu_r = *(const f32x4*)(p.b_mu + hc), mu_k = *(const f32x4*)(p.b_mu + 512 + hc), mu_v = *(const f32x4*)(p.b_mu + 1024 + hc);
    const f32x4 kkw = *(const f32x4*)(p.b_k_k + hc), kaw = *(const f32x4*)(p.b_k_a + hc), rkw = *(const f32x4*)(p.b_r_k + hc);
    const f32x4 lng = *(const f32x4*)(p.b_lnx_g + hc), lnb = *(const f32x4*)(p.b_lnx_b + hc);
    f32x4 Hacc[4];
#pragma unroll
    for (int i = 0; i < 4; ++i) Hacc[i] = (f32x4){0.f, 0.f, 0.f, 0.f};
    __syncthreads();
    for (int t0 = 0; t0 < TT; t0 += 32) {
        const int t = t0 + ps; const bool valid = t < TT;
        f32x4 r4 = {0, 0, 0, 0}, k4 = r4, v4 = r4, kk4 = r4, a4 = r4, g4 = r4, lw4 = r4;
        if (valid) {
            const int m = row_of(b, t);
            const f16* pr = PB + (size_t)m * N1 + C_BC + hc;
            const f16x4 cr = *(const f16x4*)(pr), ck = *(const f16x4*)(pr + 512), cv = *(const f16x4*)(pr + 1024);
            f16x4 qr = (f16x4){(f16)0.f, (f16)0.f, (f16)0.f, (f16)0.f}, qk = qr, qv = qr;
            if (t > 0) { const f16* pp = PB + (size_t)row_of(b, t - 1) * N1 + C_BC + hc; qr = *(const f16x4*)(pp); qk = *(const f16x4*)(pp + 512); qv = *(const f16x4*)(pp + 1024); }
            const f16x4 lw = *(const f16x4*)(LW + (size_t)m * 512 + hc), aa = *(const f16x4*)(AA + (size_t)m * 512 + hc), gg = *(const f16x4*)(GG + (size_t)m * 512 + hc);
#pragma unroll
            for (int e = 0; e < 4; ++e) {
                const float c0 = (float)cr[e], c1 = (float)ck[e], c2 = (float)cv[e];
                r4[e] = c0 + ((float)qr[e] - c0) * mu_r[e];
                const float k0 = c1 + ((float)qk[e] - c1) * mu_k[e];
                v4[e] = c2 + ((float)qv[e] - c2) * mu_v[e];
                a4[e] = (float)aa[e]; lw4[e] = (float)lw[e]; g4[e] = (float)gg[e];
                kk4[e] = k0 * kkw[e];
                k4[e] = k0 * (1.f + (a4[e] - 1.f) * kaw[e]);
            }
        }
        float ss = kk4[0] * kk4[0] + kk4[1] * kk4[1] + kk4[2] * kk4[2] + kk4[3] * kk4[3];
        float bo = r4[0] * k4[0] * rkw[0] + r4[1] * k4[1] * rkw[1] + r4[2] * k4[2] * rkw[2] + r4[3] * k4[3] * rkw[3];
#pragma unroll
        for (int o = 1; o < 16; o <<= 1) { ss += __shfl_xor(ss, o); bo += __shfl_xor(bo, o); }
        const float rn = 1.f / sqrtf(ss + 1e-12f);
        f32x4 bb4;
#pragma unroll
        for (int e = 0; e < 4; ++e) { kk4[e] *= rn; bb4[e] = kk4[e] * a4[e]; }
        f32x4 cum = lw4;
        { f32x4 u1;
#pragma unroll
          for (int e = 0; e < 4; ++e) u1[e] = __shfl_up(cum[e], 16);
          if (lane >= 16) cum += u1;
#pragma unroll
          for (int e = 0; e < 4; ++e) u1[e] = __shfl_up(cum[e], 32);
          if (lane >= 32) cum += u1; }
        if (lane >= 48) *(f32x4*)(sTot + wave * 64 + c4) = cum;
        __syncthreads();
        f32x4 tot = {0, 0, 0, 0};
#pragma unroll
        for (int w = 0; w < 8; ++w) { const f32x4 tw = *(const f32x4*)(sTot + w * 64 + c4); tot += tw; if (w < wave) cum += tw; }
        {
            f32x4 xa, xb, xk, xr, xbp, xkp;
#pragma unroll
            for (int e = 0; e < 4; ++e) { const float e1 = __expf(cum[e]), e2 = __expf(-cum[e]), e3 = __expf(cum[e] - lw4[e]), e4 = __expf(tot[e] - cum[e]);
                xa[e] = -kk4[e] * e3; xb[e] = bb4[e] * e2; xk[e] = k4[e] * e2; xr[e] = r4[e] * e1; xbp[e] = bb4[e] * e4; xkp[e] = k4[e] * e4; }
            *(u32x2*)(sAt + ps * RS + chslot) = pk4(xa); *(u32x2*)(sBt + ps * RS + chslot) = pk4(xb); *(u32x2*)(sKt + ps * RS + chslot) = pk4(xk); *(u32x2*)(sRt + ps * RS + chslot) = pk4(xr);
#pragma unroll
            for (int e = 0; e < 4; ++e) { sAtT[(c4 + e) * PSt + pslot] = f2bf(xa[e]); sBPT[(c4 + e) * PSt + pslot] = f2bf(xbp[e]); sKPT[(c4 + e) * PSt + pslot] = f2bf(xkp[e]); sVT[(c4 + e) * PSt + pslot] = f2bf(v4[e]); }
            if (ps == 0) { f32x4 pl;
#pragma unroll
                for (int e = 0; e < 4; ++e) pl[e] = __expf(tot[e]);
                *(f32x4*)(sPL + c4) = pl; }
        }
        __syncthreads();
        for (int jb = wave; jb < 12; jb += 8) {
            const int prod = jb / 3, ti = jb % 3;
            const bf16_t *Ab, *Bb; int ta, tb;
            if (prod <= 1) { ta = (ti >= 1) ? 1 : 0; tb = (ti == 2) ? 1 : 0; Ab = sAt; Bb = (prod == 0) ? sBt : sKt; }
            else { ta = (ti == 2) ? 1 : 0; tb = (ti >= 1) ? 1 : 0; Ab = (prod == 2) ? sBt : sKt; Bb = sRt; }
            f32x4 acc = {0, 0, 0, 0};
#pragma unroll
            for (int ks = 0; ks < 2; ++ks) { const bf16x8 a = *(const bf16x8*)(Ab + (16 * ta + fr) * RS + 32 * ks + 8 * fq); const bf16x8 bq = *(const bf16x8*)(Bb + (16 * tb + fr) * RS + 32 * ks + 8 * fq); acc = MFMA_BF(a, bq, acc); }
            const int rbase = 16 * ta + 4 * fq, col = 16 * tb + fr;
            if (prod == 0) {
#pragma unroll
                for (int e = 0; e < 4; ++e) sAab[(rbase + e) * FS + col] = (col < rbase + e) ? acc[e] : 0.f;
            } else if (prod == 1) {
#pragma unroll
                for (int e = 0; e < 4; ++e) acc[e] = (col < rbase + e) ? acc[e] : 0.f;
                *(u32x2*)(sAakT + col * PSt + 8 * fq + 4 * ta) = pk4(acc);
            } else {
#pragma unroll
                for (int e = 0; e < 4; ++e) acc[e] = (rbase + e <= col) ? acc[e] : 0.f;
                *(u32x2*)(((prod == 2) ? sMrb : sMrk) + col * PSt + 8 * fq + 4 * ta) = pk4(acc);
            }
        }
        __syncthreads();
        if (wave == 0 && lane < 32) {
            const int blk = lane >> 4, col = lane & 15;
            const float* Ab = sAab + (16 * blk) * FS + 16 * blk;
            float x[16];
#pragma unroll
            for (int s = 0; s < 16; ++s) {
                float acc = (s == col) ? 1.f : 0.f;
#pragma unroll
                for (int j4 = 0; j4 < (s + 3) / 4; ++j4) { const f32x4 a = *(const f32x4*)(Ab + s * FS + 4 * j4);
#pragma unroll
                    for (int e = 0; e < 4; ++e) if (4 * j4 + e < s) acc += a[e] * x[4 * j4 + e]; }
                x[s] = acc;
            }
#pragma unroll
            for (int s = 0; s < 16; ++s) { sTf[(16 * blk + s) * FS + 16 * blk + col] = x[s]; sT[(16 * blk + s) * PSt + 8 * (col >> 2) + 4 * blk + (col & 3)] = f2bf(x[s]); }
        }
        __syncthreads();
        if (tid < 256) { const int i = tid >> 4, j = tid & 15; float acc = 0.f;
#pragma unroll
            for (int k = 0; k < 16; ++k) acc += sAab[(16 + i) * FS + k] * sTf[k * FS + j];
            sX[i * 20 + j] = acc; }
        __syncthreads();
        if (tid < 256) { const int i = tid >> 4, j = tid & 15; float acc = 0.f;
#pragma unroll
            for (int k = 0; k < 16; ++k) acc += sTf[(16 + i) * FS + 16 + k] * sX[k * 20 + j];
            sT[(16 + i) * PSt + 8 * (j >> 2) + (j & 3)] = f2bf(acc); }
        __syncthreads();
        for (int jb = wave; jb < 11; jb += 8) {
            if (jb < 8) { const int tc = jb >> 1, ts = jb & 1;
                const bf16x8 a = *(const bf16x8*)(sAtT + (16 * tc + fr) * PSt + 8 * fq); const bf16x8 bq = *(const bf16x8*)(sT + (16 * ts + fr) * PSt + 8 * fq);
                const f32x4 acc = MFMA_BF(a, bq, ((f32x4){0, 0, 0, 0}));
                *(u32x2*)(sW1 + (16 * ts + fr) * RS + 32 * (tc >> 1) + 8 * fq + 4 * (tc & 1)) = pk4(acc);
            } else {
                const int tj2 = (jb == 10) ? 1 : 0, ts2 = (jb == 8) ? 0 : 1;
                const bf16x8 a = *(const bf16x8*)(sAakT + (16 * tj2 + fr) * PSt + 8 * fq); const bf16x8 bq = *(const bf16x8*)(sT + (16 * ts2 + fr) * PSt + 8 * fq);
                const f32x4 acc = MFMA_BF(a, bq, ((f32x4){0, 0, 0, 0}));
                *(u32x2*)(sW2 + (16 * ts2 + fr) * PSt + 8 * fq + 4 * tj2) = pk4(acc);
            }
        }
        __syncthreads();
        if (wave < 4) {
            const int v0 = 16 * wave;
            const bf16x8 hb0 = pk8(Hacc[0], Hacc[1]), hb1 = pk8(Hacc[2], Hacc[3]);
            const bf16x8 vb = *(const bf16x8*)(sVT + (v0 + fr) * PSt + 8 * fq);
            f32x4 u[2];
#pragma unroll
            for (int ts = 0; ts < 2; ++ts) { const bf16_t* w1r = sW1 + (16 * ts + fr) * RS;
                f32x4 acc = MFMA_BF(*(const bf16x8*)(w1r + 8 * fq), hb0, ((f32x4){0, 0, 0, 0}));
                acc = MFMA_BF(*(const bf16x8*)(w1r + 32 + 8 * fq), hb1, acc);
                acc = MFMA_BF(*(const bf16x8*)(sW2 + (16 * ts + fr) * PSt + 8 * fq), vb, acc);
                u[ts] = acc; }
            const bf16x8 ub = pk8(u[0], u[1]);
#pragma unroll
            for (int ts = 0; ts < 2; ++ts) { const bf16_t* rtr = sRt + (16 * ts + fr) * RS;
                f32x4 acc = MFMA_BF(*(const bf16x8*)(rtr + 8 * fq), hb0, ((f32x4){0, 0, 0, 0}));
                acc = MFMA_BF(*(const bf16x8*)(rtr + 32 + 8 * fq), hb1, acc);
                acc = MFMA_BF(*(const bf16x8*)(sMrk + (16 * ts + fr) * PSt + 8 * fq), vb, acc);
                acc = MFMA_BF(*(const bf16x8*)(sMrb + (16 * ts + fr) * PSt + 8 * fq), ub, acc);
#pragma unroll
                for (int e = 0; e < 4; ++e) sY[(16 * ts + 4 * fq + e) * YS + v0 + fr] = acc[e]; }
#pragma unroll
            for (int tc = 0; tc < 4; ++tc) { const f32x4 pl = *(const f32x4*)(sPL + 16 * tc + 4 * fq);
                f32x4 acc = Hacc[tc] * pl;
                acc = MFMA_BF(*(const bf16x8*)(sBPT + (16 * tc + fr) * PSt + 8 * fq), ub, acc);
                acc = MFMA_BF(*(const bf16x8*)(sKPT + (16 * tc + fr) * PSt + 8 * fq), vb, acc);
                Hacc[tc] = acc; }
        }
        __syncthreads();
        {
            const f32x4 y4 = *(const f32x4*)(sY + ps * YS + c4);
            float sm = (y4[0] + y4[1]) + (y4[2] + y4[3]);
#pragma unroll
            for (int o = 1; o < 16; o <<= 1) sm += __shfl_xor(sm, o);
            const float mean = sm * (1.f / 64.f);
            float q = 0.f;
#pragma unroll
            for (int e = 0; e < 4; ++e) { const float d = y4[e] - mean; q += d * d; }
#pragma unroll
            for (int o = 1; o < 16; o <<= 1) q += __shfl_xor(q, o);
            const float rstd = 1.f / sqrtf(q * (1.f / 64.f) + 64e-5f);
            if (valid && t >= NMETA) {
                f16x4 o;
#pragma unroll
                for (int e = 0; e < 4; ++e) o[e] = (f16)((((y4[e] - mean) * rstd) * lng[e] + lnb[e] + bo * v4[e]) * g4[e]);
                *(f16x4*)(OB + (size_t)(b * SEQ + (t - NMETA)) * 512 + hc) = o;
            }
        }
    }
    __syncthreads();
}

constexpr int SCW = 8224;
__device__ __forceinline__ void dsa_item(const Params& p, int b, int g, unsigned char* lds) {
    const int tid = threadIdx.x, lane = tid & 63, wave = tid >> 6;
    const f16* PB = (const f16*)(p.ws + WS_PB); const f16* CKV = (const f16*)(p.ws + WS_CKV); const f16* KIDX = (const f16*)(p.ws + WS_KIDX); const float* WIS = (const float*)(p.ws + WS_WIS);
    f16* OLAT = (f16*)(p.ws + WS_OLAT);
    float* sc = (float*)lds;
    unsigned* hist = (unsigned*)(lds + 4 * SCW * 4);
    unsigned short* sel = (unsigned short*)(lds + 4 * SCW * 4 + 4096);
    unsigned* misc = (unsigned*)(lds + 4 * SCW * 4 + 4096 + 2048);
    f16* sq = (f16*)(lds + 4 * SCW * 4 + 4096 + 2048 + 128);
    const int i0 = 4 * g, n_adm = 80 + 64 * (i0 >> 6), ntile = (n_adm + 31) >> 5;
    const int mq0 = b * SEQ + i0;
    {
        const int rho = lane & 31, q = rho >> 3, hd = rho & 7, hh = lane >> 5;
        const f16* qip = PB + (size_t)(mq0 + q) * N1 + C_QI + hd * 64 + 8 * hh;
        f16x8 af[4];
#pragma unroll
        for (int ks = 0; ks < 4; ++ks) af[ks] = *(const f16x8*)(qip + 16 * ks);
        float wsc[16];
#pragma unroll
        for (int j = 0; j < 16; ++j) wsc[j] = WIS[(size_t)(mq0 + (j >> 2)) * 8 + (j & 3) + 4 * hh];
        for (int kt = wave; kt < ntile; kt += 8) {
            const int key = kt * 32 + (lane & 31);
            const int rowk = row_of(b, key);
            const f16* kp = KIDX + (size_t)rowk * 64 + 8 * hh;
            f16x8 bf[4];
#pragma unroll
            for (int ks = 0; ks < 4; ++ks) bf[ks] = *(const f16x8*)(kp + 16 * ks);
            f32x16 acc;
#pragma unroll
            for (int j = 0; j < 16; ++j) acc[j] = 0.f;
#pragma unroll
            for (int ks = 0; ks < 4; ++ks) acc = __builtin_amdgcn_mfma_f32_32x32x16_f16(af[ks], bf[ks], acc, 0, 0, 0);
            float s4[4];
#pragma unroll
            for (int qq = 0; qq < 4; ++qq) { float s = 0.f;
#pragma unroll
                for (int jj = 0; jj < 4; ++jj) s += wsc[4 * qq + jj] * fmaxf(acc[4 * qq + jj], 0.f);
                s += __shfl_xor(s, 32); s4[qq] = s; }
            if (lane < 32) {
#pragma unroll
                for (int qq = 0; qq < 4; ++qq) sc[qq * SCW + key] = s4[qq]; }
        }
        *(f16x8*)(sq + tid * 8) = *(const f16x8*)(PB + (size_t)(mq0 + (tid >> 7)) * N1 + C_QABS + (tid & 127) * 8);
    }
    __syncthreads();
    const int qs = tid >> 7, tl = tid & 127;
    int nsel;
    {
        const float* scq = sc + qs * SCW;
        if (n_adm <= 256) { for (int idx = tl; idx < n_adm; idx += 128) sel[qs * 256 + idx] = (unsigned short)idx; nsel = n_adm; }
        else {
            unsigned prefix = 0u, mask = 0u; int kth = 256;
            for (int pass = 0; pass < 4; ++pass) {
                const int shift = 24 - 8 * pass;
                hist[qs * 256 + tl] = 0u; hist[qs * 256 + 128 + tl] = 0u;
                __syncthreads();
                for (int idx = tl; idx < n_adm; idx += 128) { const unsigned u = fkey(scq[idx]); if ((u & mask) == prefix) atomicAdd(&hist[qs * 256 + ((u >> shift) & 255u)], 1u); }
                __syncthreads();
                if (tl < 64) {
                    const int c0 = (int)hist[qs * 256 + 4 * tl], c1 = (int)hist[qs * 256 + 4 * tl + 1], c2 = (int)hist[qs * 256 + 4 * tl + 2], c3 = (int)hist[qs * 256 + 4 * tl + 3];
                    const int tot = c0 + c1 + c2 + c3; int s = tot;
#pragma unroll
                    for (int off = 1; off < 64; off <<= 1) { const int tv = __shfl_down(s, off); if (tl + off < 64) s += tv; }
                    const int above = s - tot;
                    if (above < kth && kth <= s) { const int rem = kth - above; int bin, nk;
                        if (rem <= c3) { bin = 4 * tl + 3; nk = rem; } else if (rem <= c3 + c2) { bin = 4 * tl + 2; nk = rem - c3; }
                        else if (rem <= c3 + c2 + c1) { bin = 4 * tl + 1; nk = rem - c3 - c2; } else { bin = 4 * tl; nk = rem - c3 - c2 - c1; }
                        misc[qs * 8] = (unsigned)bin; misc[qs * 8 + 1] = (unsigned)nk; }
                }
                __syncthreads();
                prefix |= misc[qs * 8] << shift; mask |= 0xFFu << shift; kth = (int)misc[qs * 8 + 1];
            }
            if (tl == 0) { misc[qs * 8 + 2] = 0u; misc[qs * 8 + 3] = 0u; }
            __syncthreads();
            for (int idx = tl; idx < n_adm; idx += 128) { const unsigned u = fkey(scq[idx]);
                if (u > prefix) { const unsigned pos = atomicAdd(&misc[qs * 8 + 2], 1u); sel[qs * 256 + pos] = (unsigned short)idx; }
                else if (u == prefix) { const unsigned e = atomicAdd(&misc[qs * 8 + 3], 1u); if ((int)e < kth) { const unsigned pos = atomicAdd(&misc[qs * 8 + 2], 1u); sel[qs * 256 + pos] = (unsigned short)idx; } } }
            nsel = 256;
        }
    }
    __syncthreads();
    float* sS = (float*)lds;
    const int aq = wave >> 1, hg = wave & 1;
    for (int tile = 0; tile < 4; ++tile) {
        const int kk = tile * 64 + lane; const bool valid = kk < nsel;
        const int kidx = valid ? (int)sel[aq * 256 + kk] : 0;
        const f16* cp = CKV + (size_t)row_of(b, kidx) * 128;
        f16x8 cr[16];
#pragma unroll
        for (int r8 = 0; r8 < 16; ++r8) cr[r8] = *(const f16x8*)(cp + r8 * 8);
#pragma unroll
        for (int hd = 0; hd < 4; ++hd) { const int head = hg * 4 + hd; const f16* qp = sq + (aq * 8 + head) * 128; float s = 0.f;
#pragma unroll
            for (int r8 = 0; r8 < 16; ++r8) { const f16x8 qv = *(const f16x8*)(qp + r8 * 8);
#pragma unroll
                for (int e = 0; e < 8; ++e) s += (float)qv[e] * (float)cr[r8][e]; }
            sS[(aq * 8 + head) * 256 + kk] = valid ? s * 0.125f : -INFINITY; }
    }
    __syncthreads();
#pragma unroll
    for (int hd = 0; hd < 4; ++hd) { float* sp = sS + (aq * 8 + hg * 4 + hd) * 256;
        float v0 = sp[lane], v1 = sp[64 + lane], v2 = sp[128 + lane], v3 = sp[192 + lane];
        const float mx = wave_max(fmaxf(fmaxf(v0, v1), fmaxf(v2, v3)));
        v0 = __expf(v0 - mx); v1 = __expf(v1 - mx); v2 = __expf(v2 - mx); v3 = __expf(v3 - mx);
        const float inv = 1.f / wave_sum((v0 + v1) + (v2 + v3));
        sp[lane] = v0 * inv; sp[64 + lane] = v1 * inv; sp[128 + lane] = v2 * inv; sp[192 + lane] = v3 * inv; }
    __syncthreads();
    {
        float o[4][2];
#pragma unroll
        for (int hd = 0; hd < 4; ++hd) { o[hd][0] = 0.f; o[hd][1] = 0.f; }
        const float* pp = sS + (aq * 8 + hg * 4) * 256;
#pragma unroll 4
        for (int k = 0; k < nsel; ++k) {
            const int kidx = (int)sel[aq * 256 + k];
            const f16x2 c2 = *(const f16x2*)(CKV + (size_t)row_of(b, kidx) * 128 + 2 * lane);
            const float cx = (float)c2.x, cy = (float)c2.y;
#pragma unroll
            for (int hd = 0; hd < 4; ++hd) { const float pk = pp[hd * 256 + k]; o[hd][0] += pk * cx; o[hd][1] += pk * cy; }
        }
#pragma unroll
        for (int hd = 0; hd < 4; ++hd) { f16x2 w; w.x = (f16)o[hd][0]; w.y = (f16)o[hd][1];
            *(f16x2*)(OLAT + (size_t)(mq0 + aq) * 1024 + (hg * 4 + hd) * 128 + 2 * lane) = w; }
    }
    __syncthreads();
}

__device__ __forceinline__ void phc2_mixers(const Params& p, unsigned char* lds, int rep) {
    unsigned* ctr = (unsigned*)(p.ws + WS_CTL) + 64 + 64 * rep;
    int* s_item = (int*)(lds + 150 * 1024 - 16);
    constexpr int NRW = 16, NDSA = 2 * (SEQ / 4);
    for (;;) {
        if (threadIdx.x == 0) *s_item = (int)atomicAdd(ctr, 1u);
        __syncthreads();
        const int item = *s_item;
        __syncthreads();
        if (item >= NRW + (rep ? 0 : NDSA)) break;
        if (item < NRW) rwkv_item(p, item >> 3, item & 7, lds);
        else { const int d = item - NRW; dsa_item(p, d & 1, (SEQ / 4 - 1) - (d >> 1), lds); }
    }
}

__device__ __forceinline__ void phd3_ln1(const Params& p) {
    const int tid = threadIdx.x, lane = tid & 63, wave = tid >> 6;
    const int gw = blockIdx.x * 8 + wave, NGW = gridDim.x * 8;
    f16* H1H = (f16*)(p.ws + WS_H1H);
    for (int m = gw; m < MREAL; m += NGW) {
        float* row = p.out + (size_t)m * D;
        f32x4 v[4]; float s = 0.f;
#pragma unroll
        for (int j = 0; j < 4; ++j) { v[j] = *(const f32x4*)(row + j * 256 + lane * 4); s += (v[j].x + v[j].y) + (v[j].z + v[j].w); }
        const float mean = wave_sum(s) * (1.f / D); float s2 = 0.f;
#pragma unroll
        for (int j = 0; j < 4; ++j) { v[j] = v[j] - mean; s2 += (v[j].x * v[j].x + v[j].y * v[j].y) + (v[j].z * v[j].z + v[j].w * v[j].w); }
        const float rstd = 1.f / sqrtf(wave_sum(s2) * (1.f / D) + LN_EPS);
#pragma unroll
        for (int j = 0; j < 4; ++j) { const f32x4 g = *(const f32x4*)(p.ln1_g + j * 256 + lane * 4), bb = *(const f32x4*)(p.ln1_b + j * 256 + lane * 4);
            const f32x4 o = v[j] * rstd * g + bb; *(f32x4*)(row + j * 256 + lane * 4) = o; *(f16x4*)(H1H + (size_t)m * D + j * 256 + lane * 4) = to_h4(o); }
    }
    f16* U16 = (f16*)(p.ws + WS_U16); f16* V16 = (f16*)(p.ws + WS_V16);
    const long gt = (long)blockIdx.x * NT + tid, NGT = (long)gridDim.x * NT;
    for (long e = gt; e < 16384L * 1024 / 4; e += NGT) {
        *(f16x4*)(U16 + e * 4) = to_h4(*(const f32x4*)(p.peer_u + e * 4));
        *(f16x4*)(V16 + e * 4) = to_h4(*(const f32x4*)(p.peer_v + e * 4));
    }
}

#define CSWAP(j) do { if (tv[j] > tv[j - 1]) { const int _t = tv[j]; tv[j] = tv[j - 1]; tv[j - 1] = _t; const int _i = ti[j]; ti[j] = ti[j - 1]; ti[j - 1] = _i; } } while (0)
#define CSWAP_ALL() do { CSWAP(15); CSWAP(14); CSWAP(13); CSWAP(12); CSWAP(11); CSWAP(10); CSWAP(9); CSWAP(8); CSWAP(7); CSWAP(6); CSWAP(5); CSWAP(4); CSWAP(3); CSWAP(2); CSWAP(1); } while (0)
__device__ __forceinline__ void top16_of_128(const unsigned short* src, int (&tv)[16], int (&ti)[16]) {
#pragma unroll
    for (int j = 0; j < 16; ++j) { tv[j] = -1; ti[j] = 0; }
    for (int c = 0; c < 16; ++c) {
        const u32x4 w = *(const u32x4*)(src + c * 8);
#pragma unroll
        for (int e = 0; e < 8; ++e) {
            const int x = (int)((w[e >> 1] >> (16 * (e & 1))) & 0xFFFFu);
            if (x > tv[15]) { tv[15] = x; ti[15] = c * 8 + e; CSWAP_ALL(); }
        }
    }
}
__device__ __forceinline__ void phd5_topk(const Params& p) {
    const unsigned short* SC = (const unsigned short*)(p.ws + WS_SC);
    unsigned short* EIDX = (unsigned short*)(p.ws + WS_EIDX); float* EGATE = (float*)(p.ws + WS_EGATE);
    const long gt = (long)blockIdx.x * NT + threadIdx.x, NGT = (long)gridDim.x * NT;
    for (long e = gt; e < (long)MREAL * 8; e += NGT) {
        const int m = (int)(e >> 3), h = (int)(e & 7);
        int av[16], bv[16]; int ai[16], bi[16];
        top16_of_128(SC + (size_t)m * 2048 + h * 256, av, ai);
        top16_of_128(SC + (size_t)m * 2048 + h * 256 + 128, bv, bi);
        int tv[16]; int ti[16];
#pragma unroll
        for (int j = 0; j < 16; ++j) { tv[j] = -1; ti[j] = 0; }
#pragma unroll
        for (int i = 0; i < 16; ++i)
#pragma unroll
            for (int j = 0; j < 16; ++j)
                if ((i + 1) * (j + 1) <= 16) {
                    const int x = av[i] + bv[j];
                    if (x > tv[15]) { tv[15] = x; ti[15] = ai[i] * 128 + bi[j]; CSWAP_ALL(); }
                }
        float sum = 0.f; float ex[16];
#pragma unroll
        for (int j = 0; j < 16; ++j) { ex[j] = __expf((float)(tv[j] - tv[0]) * (1.f / 8192.f)); sum += ex[j]; }
        const float inv = 1.f / sum;
#pragma unroll
        for (int j = 0; j < 16; ++j) { EIDX[(size_t)m * 128 + h * 16 + j] = (unsigned short)ti[j]; EGATE[(size_t)m * 128 + h * 16 + j] = ex[j] * inv; }
    }
}

__device__ __forceinline__ void phd6_gather(const Params& p) {
    const int tid = threadIdx.x, lane = tid & 63, wave = tid >> 6;
    const int gw = blockIdx.x * 8 + wave, NGW = gridDim.x * 8;
    const f16* U16 = (const f16*)(p.ws + WS_U16); const f16* V16 = (const f16*)(p.ws + WS_V16);
    const unsigned short* EIDX = (const unsigned short*)(p.ws + WS_EIDX); const float* EGATE = (const float*)(p.ws + WS_EGATE);
    for (int m = gw; m < MREAL; m += NGW) {
        float* row = p.out + (size_t)m * D;
        float hv[16];
#pragma unroll
        for (int sg = 0; sg < 2; ++sg)
#pragma unroll
            for (int q = 0; q < 2; ++q) { const f32x4 t = *(const f32x4*)(row + sg * 512 + lane * 8 + q * 4); hv[sg * 8 + q * 4] = t.x; hv[sg * 8 + q * 4 + 1] = t.y; hv[sg * 8 + q * 4 + 2] = t.z; hv[sg * 8 + q * 4 + 3] = t.w; }
        const int e_lo = (int)EIDX[(size_t)m * 128 + lane], e_hi = (int)EIDX[(size_t)m * 128 + 64 + lane];
        const float g_lo = EGATE[(size_t)m * 128 + lane], g_hi = EGATE[(size_t)m * 128 + 64 + lane];
        float hd_lo = 0.f, hd_hi = 0.f;
#pragma unroll 4
        for (int e = 0; e < 64; ++e) {
            const int id0 = __builtin_amdgcn_readlane(e_lo, e), id1 = __builtin_amdgcn_readlane(e_hi, e);
            const f16* u0 = U16 + (size_t)id0 * D + lane * 8; const f16* u1 = U16 + (size_t)id1 * D + lane * 8;
            const f16x8 a0 = *(const f16x8*)(u0), a1 = *(const f16x8*)(u0 + 512), b0 = *(const f16x8*)(u1), b1 = *(const f16x8*)(u1 + 512);
            float s0 = 0.f, s1 = 0.f;
#pragma unroll
            for (int j = 0; j < 8; ++j) { s0 += hv[j] * (float)a0[j]; s0 += hv[8 + j] * (float)a1[j]; s1 += hv[j] * (float)b0[j]; s1 += hv[8 + j] * (float)b1[j]; }
            s0 = wave_sum(s0); s1 = wave_sum(s1);
            if (lane == e) { hd_lo = s0; hd_hi = s1; }
        }
        const float c_lo = g_lo * 0.5f * hd_lo * (1.f + erff(hd_lo * 0.70710678118654752f));
        const float c_hi = g_hi * 0.5f * hd_hi * (1.f + erff(hd_hi * 0.70710678118654752f));
        float acc[16];
#pragma unroll
        for (int j = 0; j < 16; ++j) acc[j] = 0.f;
#pragma unroll 4
        for (int e = 0; e < 64; ++e) {
            const int id0 = __builtin_amdgcn_readlane(e_lo, e), id1 = __builtin_amdgcn_readlane(e_hi, e);
            const float cf0 = __builtin_bit_cast(float, __builtin_amdgcn_readlane(__builtin_bit_cast(int, c_lo), e)), cf1 = __builtin_bit_cast(float, __builtin_amdgcn_readlane(__builtin_bit_cast(int, c_hi), e));
            const f16* v0 = V16 + (size_t)id0 * D + lane * 8; const f16* v1 = V16 + (size_t)id1 * D + lane * 8;
            const f16x8 a0 = *(const f16x8*)(v0), a1 = *(const f16x8*)(v0 + 512), b0 = *(const f16x8*)(v1), b1 = *(const f16x8*)(v1 + 512);
#pragma unroll
            for (int j = 0; j < 8; ++j) { acc[j] += cf0 * (float)a0[j] + cf1 * (float)b0[j]; acc[8 + j] += cf0 * (float)a1[j] + cf1 * (float)b1[j]; }
        }
        float s = 0.f;
#pragma unroll
        for (int j = 0; j < 16; ++j) { acc[j] += ALPHA * hv[j]; s += acc[j]; }
        const float mean = wave_sum(s) * (1.f / D); float s2 = 0.f;
#pragma unroll
        for (int j = 0; j < 16; ++j) { acc[j] -= mean; s2 += acc[j] * acc[j]; }
        const float rstd = 1.f / sqrtf(wave_sum(s2) * (1.f / D) + LN_EPS);
#pragma unroll
        for (int sg = 0; sg < 2; ++sg)
#pragma unroll
            for (int q = 0; q < 2; ++q) { const int col = sg * 512 + lane * 8 + q * 4; const f32x4 g = *(const f32x4*)(p.ln2_g + col), bb = *(const f32x4*)(p.ln2_b + col);
                f32x4 o; o.x = acc[sg * 8 + q * 4] * rstd * g.x + bb.x; o.y = acc[sg * 8 + q * 4 + 1] * rstd * g.y + bb.y; o.z = acc[sg * 8 + q * 4 + 2] * rstd * g.z + bb.z; o.w = acc[sg * 8 + q * 4 + 3] * rstd * g.w + bb.w;
                *(f32x4*)(row + col) = o; }
    }
}

struct EpiLora {
    f16 *LW, *AA, *GG; const float *w0, *a0;
    __device__ __forceinline__ void operator()(const f32x4 (&acc)[2][2][4][2], const pg8::Unit& u, int wr, int wc, int fr, int fq) const {
        const int row0 = u.pm * 256 + wr * 64 + fr, col0 = (u.pn & 1) * 256 + wc * 32 + 4 * fq;
        if (u.pn < 2) {
#pragma unroll
            for (int bj = 0; bj < 2; ++bj)
#pragma unroll
                for (int n = 0; n < 2; ++n) { const int col = col0 + bj * 128 + n * 16; const f32x4 c = *(const f32x4*)(w0 + col);
#pragma unroll
                    for (int ai = 0; ai < 2; ++ai)
#pragma unroll
                        for (int m = 0; m < 4; ++m) { const f32x4 v = acc[ai][bj][m][n]; f16x4 o;
#pragma unroll
                            for (int e = 0; e < 4; ++e) { const float wl = -softplusf_(-(c[e] + v[e])) - 0.5f; o[e] = (f16)(-__expf(wl)); }
                            *(f16x4*)(LW + (size_t)(row0 + ai * 128 + m * 16) * 512 + col) = o; } }
        } else if (u.pn < 4) {
#pragma unroll
            for (int bj = 0; bj < 2; ++bj)
#pragma unroll
                for (int n = 0; n < 2; ++n) { const int col = col0 + bj * 128 + n * 16; const f32x4 c = *(const f32x4*)(a0 + col);
#pragma unroll
                    for (int ai = 0; ai < 2; ++ai)
#pragma unroll
                        for (int m = 0; m < 4; ++m) { const f32x4 v = acc[ai][bj][m][n]; f16x4 o;
#pragma unroll
                            for (int e = 0; e < 4; ++e) o[e] = (f16)sigmoidf_(c[e] + v[e]);
                            *(f16x4*)(AA + (size_t)(row0 + ai * 128 + m * 16) * 512 + col) = o; } }
        } else {
#pragma unroll
            for (int bj = 0; bj < 2; ++bj)
#pragma unroll
                for (int n = 0; n < 2; ++n) { const int col = col0 + bj * 128 + n * 16;
#pragma unroll
                    for (int ai = 0; ai < 2; ++ai)
#pragma unroll
                        for (int m = 0; m < 4; ++m) *(f16x4*)(GG + (size_t)(row0 + ai * 128 + m * 16) * 512 + col) = to_h4(acc[ai][bj][m][n]); }
        }
    }
};

constexpr int LDS_BYTES = 150 * 1024;
constexpr int REP0 = 1, REP1 = 1, REP4 = 1, REP5 = 1, REP8 = 1, REP9 = 1;
constexpr int NPHASE = 11;
__global__ void __launch_bounds__(NT) mk_fwd(Params p) {
    extern __shared__ __attribute__((aligned(16))) unsigned char lds[];
    cg::grid_group grid = cg::this_grid();
    unsigned char* ws = p.ws;
    const int lo = p.ph_lo, hi = p.ph_hi;
#define IN(k) (lo <= (k) && (k) < hi)
#define SEAM(k) do { if (IN(k) && IN((k) + 1)) grid.sync(); } while (0)
    if (IN(0)) ph0_prep(p, lds);
    SEAM(0);
    if (IN(1)) {
        f16* PB = (f16*)(ws + WS_PB);
        auto f = [=](int row, int col, f32x4 v) { *(f16x4*)(PB + (size_t)row * N1 + col) = to_h4(v); };
        pg8::run_gemm(lds, (const f16*)(ws + WS_H0), (const f16*)(ws + WS_W1T), MR, N1, D, f);
    }
    SEAM(1);
    if (IN(2)) phc1_rowprep(p);
    SEAM(2);
    if (IN(3)) {
        pg8::Gemm g{(const f16*)((unsigned char*)p.out + DO_LORAIN), (const f16*)(ws + WS_WLT), MR, 1536, 256}; pg8::StaticOrder S; S.init(MR, 1536, (int)gridDim.x, (int)blockIdx.x);
        EpiLora E{(f16*)((unsigned char*)p.out + DO_LW), (f16*)((unsigned char*)p.out + DO_AA), (f16*)((unsigned char*)p.out + DO_GG), p.b_w0, p.b_a0};
        pg8::gemm_phase<EpiLora>((PG8_LAS unsigned char*)lds, g, S, E);
        __syncthreads();
    }
    SEAM(3);
    if (IN(4)) for (int rep = 0; rep < REP4; ++rep) { if (rep) grid.sync(); phc2_mixers(p, lds, rep); }
    SEAM(4);
    if (IN(5)) {
        f16* MIX = (f16*)(ws + WS_MIXED); f16* TMP = (f16*)(ws + WS_TMP); const float* bg = p.b_gate;
        auto f1 = [=](int row, int col, f32x4 v) { const f32x4 c = *(const f32x4*)(bg + col); f16x4 o;
#pragma unroll
            for (int e = 0; e < 4; ++e) o[e] = (f16)sigmoidf_(v[e] + c[e]);
            *(f16x4*)(MIX + (size_t)row * D + col) = o; };
        pg8::run_gemm(lds, (const f16*)(ws + WS_H0), (const f16*)(ws + WS_WGT), MREAL, D, D, f1);
        auto f2 = [=](int row, int col, f32x4 v) { f16x4* q = (f16x4*)(MIX + (size_t)row * D + col); const f16x4 gq = *q; f16x4 o;
#pragma unroll
            for (int e = 0; e < 4; ++e) o[e] = (f16)((float)gq[e] * v[e]);
            *q = o; };
        pg8::run_gemm(lds, (const f16*)(ws + WS_OLAT), (const f16*)(ws + WS_WPAT), MREAL, D, D, f2);
        auto f3 = [=](int row, int col, f32x4 v) { const f32x4 c = *(const f32x4*)(bg + 1024 + col); f16x4 o;
#pragma unroll
            for (int e = 0; e < 4; ++e) o[e] = (f16)sigmoidf_(v[e] + c[e]);
            *(f16x4*)(TMP + (size_t)row * D + col) = o; };
        pg8::run_gemm(lds, (const f16*)(ws + WS_H0), (const f16*)(ws + WS_WGT) + (size_t)1024 * D, MREAL, D, D, f3);
        auto f4 = [=](int row, int col, f32x4 v) { f16x4* q = (f16x4*)(MIX + (size_t)row * D + col); const f16x4 m0 = *q; const f16x4 gq = *(const f16x4*)(TMP + (size_t)row * D + col); f16x4 o;
#pragma unroll
            for (int e = 0; e < 4; ++e) o[e] = (f16)((float)m0[e] + (float)gq[e] * v[e]);
            *q = o; };
        pg8::run_gemm(lds, (const f16*)(ws + WS_OB), (const f16*)(ws + WS_WPBT), MREAL, D, 512, f4);
    }
    SEAM(5);
    if (IN(6)) {
        const float* x = p.x; const float* STAT = (const float*)(ws + WS_STAT); const float* lg = p.ln_in_g; const float* lb = p.ln_in_b; float* out = p.out;
        auto f = [=](int row, int col, f32x4 v) { const f32x4 xv = *(const f32x4*)(x + (size_t)row * D + col); const float mean = STAT[2 * row], rstd = STAT[2 * row + 1];
            const f32x4 g = *(const f32x4*)(lg + col), bb = *(const f32x4*)(lb + col);
            *(f32x4*)(out + (size_t)row * D + col) = ((xv - mean) * rstd * g + bb) * ALPHA + v; };
        pg8::run_gemm(lds, (const f16*)(ws + WS_MIXED), (const f16*)(ws + WS_WOT), MREAL, D, D, f);
    }
    SEAM(6);
    if (IN(7)) phd3_ln1(p);
    SEAM(7);
    if (IN(8)) {
        unsigned short* SC = (unsigned short*)(ws + WS_SC);
        auto f = [=](int row, int col, f32x4 v) { u32x2 o; unsigned q[4];
#pragma unroll
            for (int e = 0; e < 4; ++e) q[e] = (unsigned)__float2int_rn(fminf(fmaxf((v[e] + 2.f) * 8192.f, 0.f), 65535.f));
            o.x = q[0] | (q[1] << 16); o.y = q[2] | (q[3] << 16); *(u32x2*)(SC + (size_t)row * 2048 + col) = o; };
        pg8::run_gemm(lds, (const f16*)(ws + WS_H1H), (const f16*)(ws + WS_WSKT), MREAL, 2048, D, f);
    }
    SEAM(8);
    if (IN(9)) phd5_topk(p);
    SEAM(9);
    if (IN(10)) phd6_gather(p);
#undef IN
#undef SEAM
}

extern "C" void kernel_launch(void* const* d_in, const int* in_sizes, int n_in, void* d_out, int out_size, void* d_ws, size_t ws_size, hipStream_t stream) {
    static int grid = 0;
    if (grid == 0) {
        int dev = 0, cus = 0, per_cu = 0;
        if (hipGetDevice(&dev) != hipSuccess || hipDeviceGetAttribute(&cus, hipDeviceAttributeMultiprocessorCount, dev) != hipSuccess) { fprintf(stderr, "kernel_launch: device query failed\n"); grid = -1; return; }
        if (hipFuncSetAttribute((const void*)mk_fwd, hipFuncAttributeMaxDynamicSharedMemorySize, LDS_BYTES) != hipSuccess) { fprintf(stderr, "kernel_launch: hipFuncSetAttribute failed\n"); grid = -1; return; }
        if (hipOccupancyMaxActiveBlocksPerMultiprocessor(&per_cu, (const void*)mk_fwd, NT, LDS_BYTES) != hipSuccess || per_cu < 1) { fprintf(stderr, "kernel_launch: occupancy query says %d\n", per_cu); grid = -1; return; }
        if (n_in != 33 || out_size != MREAL * D || ws_size < WS_END) { fprintf(stderr, "kernel_launch: unexpected shapes n_in %d out %d ws %zu\n", n_in, out_size, ws_size); grid = -1; return; }
        grid = cus;
    }
    if (grid < 0) return;
    (void)hipMemsetAsync((char*)d_ws + WS_CTL, 0, 1 * MiB, stream);
    Params p{};
    const float** pf = (const float**)&p;
    for (int i = 0; i < 33; ++i) pf[i] = (const float*)d_in[i];
    p.out = (float*)d_out; p.ws = (unsigned char*)d_ws; p.ph_lo = 0; p.ph_hi = NPHASE;
    void* args[] = {&p};
    hipError_t e = hipLaunchCooperativeKernel((void*)mk_fwd, dim3(grid), dim3(NT), args, LDS_BYTES, stream);
    if (e != hipSuccess) fprintf(stderr, "kernel_launch: cooperative launch failed: %s (grid %d)\n", hipGetErrorString(e), grid);
}
```

```cpp
#include <hip/hip_runtime.h>
#include <hip/hip_cooperative_groups.h>
#include <cstdio>
#include <cstdint>
namespace cg = cooperative_groups;

#define LAS __attribute__((address_space(3)))
typedef _Float16 f16;
typedef _Float16 f16x2 __attribute__((ext_vector_type(2)));
typedef _Float16 f16x4 __attribute__((ext_vector_type(4)));
typedef _Float16 f16x8 __attribute__((ext_vector_type(8)));
typedef float f32x2 __attribute__((ext_vector_type(2)));
typedef float f32x4 __attribute__((ext_vector_type(4)));
typedef float f32x16 __attribute__((ext_vector_type(16)));
typedef unsigned u32x4 __attribute__((ext_vector_type(4)));

constexpr int D = 1024, SEQ = 8192, NMETA = 16, TT = 8208;
constexpr int MREAL = 16384, MR = 16640;
constexpr int NIN = 5064;
constexpr int N1 = 3584;
constexpr int C_QABS = 0, C_QI = 1024, C_CKV = 1536, C_KI = 1664, C_WI = 1728, C_BC = 1792;
constexpr int NT = 512;
constexpr float LN_EPS = 1e-5f;
constexpr float ALPHA = 1.189207115002721f;

__device__ __forceinline__ int row_of(int b, int t) { return t < NMETA ? MREAL + b * NMETA + t : b * SEQ + (t - NMETA); }

constexpr size_t MiB = 1u << 20;
constexpr size_t WS_CTL = 0, WS_STAT = 1 * MiB, WS_WIS = 2 * MiB, WS_W1T = 3 * MiB, WS_WGT = 10 * MiB, WS_WPAT = 14 * MiB, WS_WPBT = 16 * MiB,
                 WS_WOT = 17 * MiB, WS_WSKT = 19 * MiB, WS_WLT = 23 * MiB, WS_CKV = 24 * MiB, WS_KIDX = 29 * MiB, WS_H0 = 32 * MiB,
                 WS_OLAT = 65 * MiB, WS_OB = 97 * MiB, WS_PB = 113 * MiB, WS_END = 227 * MiB;
constexpr size_t WS_MIXED = WS_PB, WS_H1H = WS_PB, WS_TMP = WS_PB + 32 * MiB, WS_SC = WS_PB + 32 * MiB, WS_EIDX = WS_PB + 96 * MiB, WS_EGATE = WS_PB + 100 * MiB;
constexpr size_t WS_U16 = WS_H0, WS_V16 = WS_OLAT;
constexpr size_t DO_LORAIN = 0, DO_LW = 9 * MiB, DO_AA = 26 * MiB, DO_GG = 43 * MiB;

struct Params {
    const float *x, *meta, *ln_in_g, *ln_in_b, *w_in, *b_gate, *a_kv_norm_g, *a_w_uk, *a_w_uv, *a_kidx_g, *a_kidx_b, *b_mu, *b_w0, *b_w2, *b_a0, *b_a2,
        *b_g2, *b_k_k, *b_k_a, *b_r_k, *b_lnx_g, *b_lnx_b, *w_pa, *w_pb, *w_o, *ln1_g, *ln1_b, *peer_wq, *peer_subkeys, *peer_u, *peer_v, *ln2_g, *ln2_b;
    float* out;
    unsigned char* ws;
    int ph_lo, ph_hi;
};

__device__ __forceinline__ float wave_sum(float v) {
#pragma unroll
    for (int o = 1; o < 64; o <<= 1) v += __shfl_xor(v, o);
    return v;
}
__device__ __forceinline__ float wave_max(float v) {
#pragma unroll
    for (int o = 1; o < 64; o <<= 1) v = fmaxf(v, __shfl_xor(v, o));
    return v;
}
#define DPP_F(v, ctrl) __builtin_bit_cast(float, __builtin_amdgcn_update_dpp(0, __builtin_bit_cast(int, (v)), (ctrl), 0xF, 0xF, true))
__device__ __forceinline__ float row16_sum(float v) {
    v += DPP_F(v, 0xB1);
    v += DPP_F(v, 0x4E);
    v += DPP_F(v, 0x141);
    v += DPP_F(v, 0x140);
    return v;
}
__device__ __forceinline__ float sigmoidf_(float x) { return __builtin_amdgcn_rcpf(1.f + __expf(-x)); }
__device__ __forceinline__ float softplusf_(float z) { return fmaxf(z, 0.f) + __logf(1.f + __expf(-fabsf(z))); }
__device__ __forceinline__ unsigned fkey(float f) { unsigned u = __float_as_uint(f); return u ^ ((u >> 31) ? 0xFFFFFFFFu : 0x80000000u); }

namespace pg8 {
#define PG8_LAS __attribute__((address_space(3)))
typedef short h16x8 __attribute__((ext_vector_type(8)));
constexpr int BM = 256, BK = 64, HALF = 128, HTB = HALF * BK * 2, STAGE_BYTES = 8 * HTB, NXCD = 8, WGM = 8;
__host__ __device__ __forceinline__ int lds_byte(int r, int c) { const int st = (r >> 4) * 2 + (c >> 5), rr = r & 15, cc = c & 31, ob = rr * 64 + cc * 2; return st * 1024 + (ob ^ (((ob >> 9) & 1) << 5)); }
__host__ __device__ __forceinline__ void stage_rc(int b, int& R, int& C) { const int st = b / 1024, sb = b % 1024, swz = sb ^ (((sb >> 9) & 1) << 5); R = (st >> 1) * 16 + swz / 64; C = (st & 1) * 32 + (swz % 64) / 2; }
struct Unit { int pm, pn; };
struct Gemm { const f16* A; const f16* Bt; int M, N, K; };
struct StaticOrder {
    int nM, nN, nwg, G, c;
    __host__ __device__ void init(int M, int N, int G_, int c_) { nM = M / BM; nN = N / BM; nwg = nM * nN; G = G_; c = c_; }
    __host__ __device__ bool next(int i, Unit& u) const {
        const long L = (long)i * G + c; if (L >= nwg) return false;
        int wgid = (int)L; { const int q = nwg / NXCD, r = nwg % NXCD, xcd = wgid % NXCD, off = wgid / NXCD; wgid = (xcd < r ? xcd * (q + 1) : r * (q + 1) + (xcd - r) * q) + off; }
        const int nig = WGM * nN, gid = wgid / nig, fm = gid * WGM, gsz = (nM - fm) < WGM ? (nM - fm) : WGM;
        u.pm = fm + ((wgid % nig) % gsz); u.pn = (wgid % nig) / gsz; return true;
    }
};
template <class F> struct EpiElem {
    F f;
    __device__ __forceinline__ void operator()(const f32x4 (&acc)[2][2][4][2], const Unit& u, int wr, int wc, int fr, int fq) const {
        const int row0 = u.pm * BM + wr * 64 + fr, col0 = u.pn * BM + wc * 32 + 4 * fq;
#pragma unroll
        for (int ai = 0; ai < 2; ++ai)
#pragma unroll
            for (int m = 0; m < 4; ++m)
#pragma unroll
                for (int bj = 0; bj < 2; ++bj)
#pragma unroll
                    for (int n = 0; n < 2; ++n) f(row0 + ai * HALF + m * 16, col0 + bj * HALF + n * 16, acc[ai][bj][m][n]);
    }
};
template <class Epi>
__device__ __forceinline__ void gemm_phase(PG8_LAS unsigned char* lds, const Gemm g, const StaticOrder& S, const Epi& E) {
    const int tid = threadIdx.x, wid = __builtin_amdgcn_readfirstlane(tid >> 6), lane = tid & 63, wr = wid >> 2, wc = wid & 3, fr = lane & 15, fq = lane >> 4;
    int K = g.K; asm volatile("" : "+s"(K));
    const int nt = K / BK;
    unsigned voffA[2], voffB[2];
#pragma unroll
    for (int i = 0; i < 2; ++i) { int R, C; stage_rc(tid * 16 + i * 8192, R, C); voffA[i] = (unsigned)(R * K + C) * 2u; voffB[i] = (unsigned)(R * K + C) * 2u; }
    const size_t kstep = (size_t)(BK * 2);
    const size_t hstep = (size_t)HALF * K * 2;
    const size_t tstep = 2 * hstep;
    const unsigned ldsw = (unsigned)wid * 1024u;
    const int aoff = lds_byte(wr * 64 + fr, fq * 8), boff = lds_byte(wc * 32 + fr, fq * 8);
#define PG8_SA(b, h) (((b) * 2 + (h)) * HTB)
#define PG8_SB(b, h) ((4 + (b) * 2 + (h)) * HTB)
#define PG8_STAGE(bufoff, gbase, voff) do { _Pragma("unroll") for (int _i = 0; _i < 2; ++_i) \
        __builtin_amdgcn_global_load_lds((const unsigned*)((const char*)(gbase) + (voff)[_i]), (PG8_LAS unsigned*)(lds + (bufoff) + ldsw + _i * 8192), 16, 0, 0); } while (0)
#define PG8_LDA(dst, b, h) do { _Pragma("unroll") for (int m = 0; m < 4; ++m) _Pragma("unroll") for (int k = 0; k < 2; ++k) dst[m][k] = *(const PG8_LAS h16x8*)(lds + PG8_SA(b, h) + aoff + m * 2048 + k * 1024); } while (0)
#define PG8_LDB(dst, b, h) do { _Pragma("unroll") for (int n = 0; n < 2; ++n) _Pragma("unroll") for (int k = 0; k < 2; ++k) dst[n][k] = *(const PG8_LAS h16x8*)(lds + PG8_SB(b, h) + boff + n * 2048 + k * 1024); } while (0)
#define PG8_MMA(ai, bj, At, Bt) do { __builtin_amdgcn_s_setprio(1); _Pragma("unroll") for (int m = 0; m < 4; ++m) _Pragma("unroll") for (int n = 0; n < 2; ++n) _Pragma("unroll") for (int k = 0; k < 2; ++k) \
        acc[ai][bj][m][n] = __builtin_amdgcn_mfma_f32_16x16x32_f16(__builtin_bit_cast(f16x8, Bt[n][k]), __builtin_bit_cast(f16x8, At[m][k]), acc[ai][bj][m][n], 0, 0, 0); __builtin_amdgcn_s_setprio(0); } while (0)
#define PG8_WAIT_V(n) asm volatile("s_waitcnt vmcnt(" #n ")" ::: "memory")
#define PG8_WAIT_L(n) asm volatile("s_waitcnt lgkmcnt(" #n ")" ::: "memory")
#define PG8_BAR __builtin_amdgcn_s_barrier()
#define PG8_SCHED __builtin_amdgcn_sched_barrier(0)
    Unit cur, nxt; int ui = 0;
    if (!S.next(0, cur)) return;
    f32x4 acc[2][2][4][2];
#pragma unroll
    for (int a = 0; a < 2; ++a)
#pragma unroll
        for (int b = 0; b < 2; ++b)
#pragma unroll
            for (int m = 0; m < 4; ++m)
#pragma unroll
                for (int n = 0; n < 2; ++n) acc[a][b][m][n] = (f32x4){0.f, 0.f, 0.f, 0.f};
    h16x8 At[4][2], B0[2][2], B1[2][2];
    const char* cA = (const char*)g.A + (size_t)cur.pm * tstep; const char* cB = (const char*)g.Bt + (size_t)cur.pn * tstep;
    PG8_STAGE(PG8_SB(0, 0), cB, voffB); PG8_STAGE(PG8_SA(0, 0), cA, voffA); PG8_STAGE(PG8_SB(0, 1), cB + hstep, voffB); PG8_STAGE(PG8_SA(0, 1), cA + hstep, voffA);
    if (wr == 1) PG8_BAR;
    PG8_WAIT_V(4); PG8_BAR;
    PG8_STAGE(PG8_SB(1, 0), cB + kstep, voffB); PG8_STAGE(PG8_SA(1, 0), cA + kstep, voffA); PG8_STAGE(PG8_SB(1, 1), cB + hstep + kstep, voffB);
    PG8_WAIT_V(6); PG8_BAR;
    for (;;) {
        const bool has_next = S.next(ui + 1, nxt);
        const char* nA = has_next ? (const char*)g.A + (size_t)nxt.pm * tstep : cA; const char* nB = has_next ? (const char*)g.Bt + (size_t)nxt.pn * tstep : cB;
        for (int t = 0; t < nt; t += 2) {
            const bool last = (t == nt - 2);
            const char* a1 = cA + (size_t)(t + 1) * kstep;
            const char* a2 = last ? nA : cA + (size_t)(t + 2) * kstep; const char* b2 = last ? nB : cB + (size_t)(t + 2) * kstep;
            const char* a3 = a2 + kstep; const char* b3 = b2 + kstep;
            PG8_LDB(B0, 0, 0); PG8_SCHED; PG8_LDA(At, 0, 0); PG8_STAGE(PG8_SA(1, 1), a1 + hstep, voffA);
            PG8_WAIT_L(8); PG8_BAR; PG8_WAIT_L(0); PG8_MMA(0, 0, At, B0); PG8_BAR; PG8_SCHED;
            PG8_LDB(B1, 0, 1); PG8_STAGE(PG8_SB(0, 0), b2, voffB);
            PG8_BAR; PG8_WAIT_L(0); PG8_MMA(0, 1, At, B1); PG8_BAR;
            PG8_LDA(At, 0, 1); PG8_STAGE(PG8_SA(0, 0), a2, voffA);
            PG8_BAR; PG8_WAIT_L(0); PG8_MMA(1, 0, At, B0); PG8_BAR; PG8_SCHED;
            PG8_STAGE(PG8_SB(0, 1), b2 + hstep, voffB);
            PG8_WAIT_V(6); PG8_BAR; PG8_MMA(1, 1, At, B1); PG8_BAR;
            PG8_LDB(B0, 1, 0); PG8_SCHED; PG8_LDA(At, 1, 0); PG8_STAGE(PG8_SA(0, 1), a2 + hstep, voffA);
            PG8_WAIT_L(8); PG8_BAR; PG8_WAIT_L(0); PG8_MMA(0, 0, At, B0); PG8_BAR; PG8_SCHED;
            PG8_LDB(B1, 1, 1); PG8_STAGE(PG8_SB(1, 0), b3, voffB);
            PG8_BAR; PG8_WAIT_L(0); PG8_MMA(0, 1, At, B1); PG8_BAR;
            PG8_LDA(At, 1, 1); PG8_STAGE(PG8_SA(1, 0), a3, voffA);
            PG8_BAR; PG8_WAIT_L(0); PG8_MMA(1, 0, At, B0); PG8_BAR; PG8_SCHED;
            PG8_STAGE(PG8_SB(1, 1), b3 + hstep, voffB);
            PG8_WAIT_V(6); PG8_BAR; PG8_MMA(1, 1, At, B1); PG8_BAR;
        }
        E(acc, cur, wr, wc, fr, fq);
        if (!has_next) break;
#pragma unroll
        for (int a = 0; a < 2; ++a)
#pragma unroll
            for (int b = 0; b < 2; ++b)
#pragma unroll
                for (int m = 0; m < 4; ++m)
#pragma unroll
                    for (int n = 0; n < 2; ++n) acc[a][b][m][n] = (f32x4){0.f, 0.f, 0.f, 0.f};
        cur = nxt; cA = nA; cB = nB; ++ui;
    }
    PG8_WAIT_V(0);
    if (wr == 0) PG8_BAR;
    PG8_BAR;
#undef PG8_SA
#undef PG8_SB
#undef PG8_STAGE
#undef PG8_LDA
#undef PG8_LDB
#undef PG8_MMA
#undef PG8_WAIT_V
#undef PG8_WAIT_L
#undef PG8_BAR
#undef PG8_SCHED
}
template <class F>
__device__ __forceinline__ void run_gemm(unsigned char* lds, const f16* A, const f16* Bt, int M, int N, int K, const F& f) {
    Gemm g{A, Bt, M, N, K}; StaticOrder S; S.init(M, N, (int)gridDim.x, (int)blockIdx.x);
    EpiElem<F> E{f};
    gemm_phase<EpiElem<F>>((PG8_LAS unsigned char*)lds, g, S, E);
    __syncthreads();
}
}

__device__ __forceinline__ f16x4 to_h4(f32x4 v) { f16x4 r; r.x = (f16)v.x; r.y = (f16)v.y; r.z = (f16)v.z; r.w = (f16)v.w; return r; }

__device__ __forceinline__ void tr_item(const float* W, int ldw, int col0, int nvalid, int K, f16* out, int nrow0, int item, int nblk, float* scr, int lane) {
    const int kb = item / nblk, nb = item % nblk, k0 = 64 * kb, n0 = 32 * nb;
#pragma unroll 8
    for (int i = 0; i < 32; ++i) { const int kk = 2 * i + (lane >> 5); const int j = n0 + (lane & 31);
        scr[kk * 33 + (lane & 31)] = (j < nvalid) ? W[(size_t)(k0 + kk) * ldw + col0 + j] : 0.f; }
    asm volatile("s_waitcnt vmcnt(0) lgkmcnt(0)" ::: "memory");
    const int c = lane & 7;
#pragma unroll
    for (int jj = 0; jj < 4; ++jj) { const int n = (lane >> 3) + 8 * jj; const float* s = scr + (8 * c) * 33 + n;
        f16x8 o;
#pragma unroll
        for (int e = 0; e < 8; ++e) o[e] = (f16)s[e * 33];
        *(f16x8*)(out + (size_t)(nrow0 + n0 + n) * K + k0 + 8 * c) = o; }
    asm volatile("s_waitcnt lgkmcnt(0)" ::: "memory");
}

__device__ __forceinline__ void ph0_prep(const Params& p, unsigned char* lds) {
    const int tid = threadIdx.x, lane = tid & 63, wave = tid >> 6;
    const int gw = blockIdx.x * 8 + wave, NGW = gridDim.x * 8;
    f16* H0 = (f16*)(p.ws + WS_H0); float* STAT = (float*)(p.ws + WS_STAT);
    for (int m = gw; m < MR; m += NGW) {
        f16* orow = H0 + (size_t)m * D;
        if (m >= MREAL + 2 * NMETA) {
#pragma unroll
            for (int j = 0; j < 4; ++j) *(f16x4*)(orow + j * 256 + lane * 4) = (f16x4){(f16)0.f, (f16)0.f, (f16)0.f, (f16)0.f};
            continue;
        }
        const float* src = (m < MREAL) ? p.x + (size_t)m * D : p.meta + (size_t)((m - MREAL) & 15) * D;
        f32x4 v[4]; float s = 0.f;
#pragma unroll
        for (int j = 0; j < 4; ++j) { v[j] = *(const f32x4*)(src + j * 256 + lane * 4); s += (v[j].x + v[j].y) + (v[j].z + v[j].w); }
        const float mean = wave_sum(s) * (1.f / D); float s2 = 0.f;
#pragma unroll
        for (int j = 0; j < 4; ++j) { v[j] = v[j] - mean; s2 += (v[j].x * v[j].x + v[j].y * v[j].y) + (v[j].z * v[j].z + v[j].w * v[j].w); }
        const float rstd = 1.f / sqrtf(wave_sum(s2) * (1.f / D) + LN_EPS);
        if (lane == 0) { STAT[2 * m] = mean; STAT[2 * m + 1] = rstd; }
#pragma unroll
        for (int j = 0; j < 4; ++j) { const f32x4 g = *(const f32x4*)(p.ln_in_g + j * 256 + lane * 4), bb = *(const f32x4*)(p.ln_in_b + j * 256 + lane * 4);
            *(f16x4*)(orow + j * 256 + lane * 4) = to_h4(v[j] * rstd * g + bb); }
    }
    float* scr = (float*)lds + wave * (64 * 33);
    f16* W1T = (f16*)(p.ws + WS_W1T); f16* WGT = (f16*)(p.ws + WS_WGT); f16* WPBT = (f16*)(p.ws + WS_WPBT); f16* WOT = (f16*)(p.ws + WS_WOT);
    constexpr int I_QI = 16 * 16, I_CKV = 4 * 16, I_KI = 4 * 16, I_BC = 56 * 16, I_G = 64 * 16, I_PB = 32 * 8, I_O = 32 * 16;
    constexpr int NITEMS = I_QI + I_CKV + I_KI + I_BC + I_G + I_PB + I_O;
    for (int it = gw; it < NITEMS; it += NGW) {
        int r = it;
        if (r < I_QI) { tr_item(p.w_in, NIN, 640, 512, D, W1T, C_QI, r, 16, scr, lane); continue; } r -= I_QI;
        if (r < I_CKV) { tr_item(p.w_in, NIN, 512, 128, D, W1T, C_CKV, r, 4, scr, lane); continue; } r -= I_CKV;
        if (r < I_KI) { tr_item(p.w_in, NIN, 1152, 72, D, W1T, C_KI, r, 4, scr, lane); continue; } r -= I_KI;
        if (r < I_BC) { tr_item(p.w_in, NIN, 1224, 1792, D, W1T, C_BC, r, 56, scr, lane); continue; } r -= I_BC;
        if (r < I_G) { tr_item(p.w_in, NIN, 3016, 2048, D, WGT, 0, r, 64, scr, lane); continue; } r -= I_G;
        if (r < I_PB) { tr_item(p.w_pb, D, 0, 1024, 512, WPBT, 0, r, 32, scr, lane); continue; } r -= I_PB;
        tr_item(p.w_o, D, 0, 1024, D, WOT, 0, r, 32, scr, lane);
    }
    const long gt = (long)blockIdx.x * NT + tid, NGT = (long)gridDim.x * NT;
    f16* W1Tq = W1T;
    for (long e = gt; e < 1024L * 1024; e += NGT) { const int n = (int)(e >> 10), k = (int)(e & 1023), h = n >> 7, r = n & 127;
        const float* a = p.w_in + (size_t)k * NIN + h * 64; const float* bq = p.a_w_uk + (size_t)(r * 8 + h) * 64; float s = 0.f;
#pragma unroll 8
        for (int d = 0; d < 64; ++d) s += a[d] * bq[d];
        W1Tq[(size_t)n * D + k] = (f16)s; }
    f16* WPAT = (f16*)(p.ws + WS_WPAT);
    for (long e = gt; e < 1024L * 1024; e += NGT) { const int n = (int)(e >> 10), k = (int)(e & 1023), h = k >> 7, r = k & 127;
        const float* a = p.a_w_uv + (size_t)(r * 8 + h) * 64; const float* bq = p.w_pa + (size_t)(h * 64) * D + n; float s = 0.f;
#pragma unroll 8
        for (int d = 0; d < 64; ++d) s += a[d] * bq[(size_t)d * D];
        WPAT[(size_t)n * D + k] = (f16)s; }
    f16* WSKT = (f16*)(p.ws + WS_WSKT);
    for (long e = gt; e < 2048L * 1024; e += NGT) { const int n = (int)(e >> 10), k = (int)(e & 1023), hp = n >> 7;
        const float* a = p.peer_wq + (size_t)k * 2048 + hp * 128; const float* bq = p.peer_subkeys + (size_t)n * 128; float s = 0.f;
#pragma unroll 8
        for (int j = 0; j < 128; ++j) s += a[j] * bq[j];
        WSKT[(size_t)n * D + k] = (f16)s; }
    f16* WLT = (f16*)(p.ws + WS_WLT);
    for (long e = gt; e < 1536L * 256; e += NGT) { const int n = (int)(e >> 8), k = (int)(e & 255); float v = 0.f;
        if (n < 512) { if (k < 64) v = p.b_w2[(size_t)k * 512 + n]; }
        else if (n < 1024) { if (k >= 64 && k < 128) v = p.b_a2[(size_t)(k - 64) * 512 + (n - 512)]; }
        else { if (k >= 128) v = p.b_g2[(size_t)(k - 128) * 512 + (n - 1024)]; }
        WLT[e] = (f16)v; }
}

__device__ __forceinline__ void phc1_rowprep(const Params& p) {
    const int tid = threadIdx.x, lane = tid & 63, wave = tid >> 6;
    const int gw = blockIdx.x * 8 + wave, NGW = gridDim.x * 8;
    const f16* PB = (const f16*)(p.ws + WS_PB); f16* CKV = (f16*)(p.ws + WS_CKV); f16* KIDX = (f16*)(p.ws + WS_KIDX); float* WIS = (float*)(p.ws + WS_WIS);
    f16* LORAIN = (f16*)((unsigned char*)p.out + DO_LORAIN);
    for (int m = gw; m < MR; m += NGW) {
        if (m >= MREAL + 2 * NMETA) { *(f16x4*)(LORAIN + (size_t)m * 256 + lane * 4) = (f16x4){(f16)0.f, (f16)0.f, (f16)0.f, (f16)0.f}; continue; }
        const f16* pr = PB + (size_t)m * N1;
        { const f16x2 c2 = *(const f16x2*)(pr + C_CKV + 2 * lane); const float a = (float)c2.x, b = (float)c2.y;
          const float ss = wave_sum(a * a + b * b); const float r = 1.f / sqrtf(ss * (1.f / 128.f) + 1e-6f);
          f16x2 o; o.x = (f16)(a * r * p.a_kv_norm_g[2 * lane]); o.y = (f16)(b * r * p.a_kv_norm_g[2 * lane + 1]);
          *(f16x2*)(CKV + (size_t)m * 128 + 2 * lane) = o; }
        { const float a = (float)pr[C_KI + lane]; const float mu = wave_sum(a) * (1.f / 64.f); const float d = a - mu;
          const float var = wave_sum(d * d) * (1.f / 64.f);
          KIDX[(size_t)m * 64 + lane] = (f16)(d * (1.f / sqrtf(var + LN_EPS)) * p.a_kidx_g[lane] + p.a_kidx_b[lane]); }
        if (lane < 8) WIS[(size_t)m * 8 + lane] = (float)pr[C_WI + lane] * 0.04419417382415922f;
        { int b, t; if (m < MREAL) { b = m >> 13; t = NMETA + (m & 8191); } else { b = (m - MREAL) >> 4; t = (m - MREAL) & 15; }
          const f16x4 cur = *(const f16x4*)(pr + C_BC + 1536 + lane * 4);
          f16x4 prv = (f16x4){(f16)0.f, (f16)0.f, (f16)0.f, (f16)0.f};
          if (t > 0) prv = *(const f16x4*)(PB + (size_t)row_of(b, t - 1) * N1 + C_BC + 1536 + lane * 4);
          const f32x4 mu = *(const f32x4*)(p.b_mu + 1536 + lane * 4);
          f16x4 o;
#pragma unroll
          for (int e = 0; e < 4; ++e) { const float c = (float)cur[e], q = (float)prv[e]; float xs = c + (q - c) * mu[e];
              const int j = lane * 4 + e; if (j < 64) xs = tanhf(xs); else if (j >= 128) xs = sigmoidf_(xs); o[e] = (f16)xs; }
          *(f16x4*)(LORAIN + (size_t)m * 256 + lane * 4) = o; }
    }
}

typedef short bf16x8 __attribute__((ext_vector_type(8)));
typedef unsigned short bf16_t;
typedef unsigned u32x2 __attribute__((ext_vector_type(2)));
typedef __bf16 bf16x2_t __attribute__((ext_vector_type(2)));
__device__ __forceinline__ unsigned cvt_pk_bf16(float lo, float hi) { const f32x2 v = {lo, hi}; const bf16x2_t b = __builtin_convertvector(v, bf16x2_t); return __builtin_bit_cast(unsigned, b); }
__device__ __forceinline__ bf16_t f2bf(float f) { unsigned u = __float_as_uint(f); return (bf16_t)((u + 0x7fffu + ((u >> 16) & 1u)) >> 16); }
__device__ __forceinline__ u32x2 pk4(f32x4 v) { u32x2 r; r.x = cvt_pk_bf16(v[0], v[1]); r.y = cvt_pk_bf16(v[2], v[3]); return r; }
__device__ __forceinline__ bf16x8 pk8(f32x4 a, f32x4 b) { u32x4 r; r.x = cvt_pk_bf16(a[0], a[1]); r.y = cvt_pk_bf16(a[2], a[3]); r.z = cvt_pk_bf16(b[0], b[1]); r.w = cvt_pk_bf16(b[2], b[3]); return __builtin_bit_cast(bf16x8, r); }
#define MFMA_BF(a, b, c) __builtin_amdgcn_mfma_f32_16x16x32_bf16((a), (b), (c), 0, 0, 0)
constexpr int RS = 72, PSt = 40, FS = 36, YS = 68;
__device__ __forceinline__ void rwkv_item(const Params& p, int b, int h, unsigned char* lds) {
    int tid_ = threadIdx.x; asm volatile("" : "+v"(tid_));
    const int tid = tid_, lane = tid & 63, wave = __builtin_amdgcn_readfirstlane(tid >> 6), fr = lane & 15, fq = lane >> 4;
    const f16* PB = (const f16*)(p.ws + WS_PB);
    const f16* LW = (const f16*)((unsigned char*)p.out + DO_LW); const f16* AA = (const f16*)((unsigned char*)p.out + DO_AA); const f16* GG = (const f16*)((unsigned char*)p.out + DO_GG);
    f16* OB = (f16*)(p.ws + WS_OB);
    bf16_t* sAt = (bf16_t*)lds; bf16_t* sRt = sAt + 32 * RS; bf16_t* sBt = sRt + 32 * RS; bf16_t* sKt = sBt + 32 * RS; bf16_t* sW1 = sKt + 32 * RS;
    bf16_t* sAtT = sW1 + 32 * RS; bf16_t* sBPT = sAtT + 64 * PSt; bf16_t* sKPT = sBPT + 64 * PSt; bf16_t* sVT = sKPT + 64 * PSt;
    bf16_t* sAakT = sVT + 64 * PSt; bf16_t* sMrb = sAakT + 32 * PSt; bf16_t* sMrk = sMrb + 32 * PSt; bf16_t* sT = sMrk + 32 * PSt; bf16_t* sW2 = sT + 32 * PSt;
    float* sAab = (float*)(sW2 + 32 * PSt); float* sTf = sAab + 32 * FS; float* sAabT = sTf + 32 * FS; float* sX = sAabT + 32 * FS; float* sTot = sX + 16 * 20; float* sPL = sTot + 8 * 64; float* sY = sPL + 64;
    float* sEnd = sY + 32 * YS;
    for (unsigned* z = (unsigned*)lds + tid; z < (unsigned*)sEnd; z += NT) *z = 0u;
    const int ps = tid >> 4, cg = tid & 15, c4 = cg * 4, hc = h * 64 + c4;
    const int chslot = 32 * (cg >> 3) + 8 * (cg & 3) + 4 * ((cg >> 2) & 1);
    const int pslot = 8 * ((ps & 15) >> 2) + 4 * (ps >> 4) + (ps & 3);
    float* sCst = sEnd;
    if (tid < 64) { sCst[tid] = p.b_mu[h * 64 + tid]; sCst[64 + tid] = p.b_mu[512 + h * 64 + tid]; sCst[128 + tid] = p.b_mu[1024 + h * 64 + tid]; sCst[192 + tid] = p.b_k_k[h * 64 + tid];
        sCst[256 + tid] = p.b_k_a[h * 64 + tid]; sCst[320 + tid] = p.b_r_k[h * 64 + tid]; sCst[384 + tid] = p.b_lnx_g[h * 64 + tid]; sCst[448 + tid] = p.b_lnx_b[h * 64 + tid]; }
    f32x4 Hacc[4];
#pragma unroll
    for (int i = 0; i < 4; ++i) Hacc[i] = (f32x4){0.f, 0.f, 0.f, 0.f};
    const f16x4 hz = (f16x4){(f16)0.f, (f16)0.f, (f16)0.f, (f16)0.f};
    f16x4 n_cr = hz, n_ck = hz, n_cv = hz, n_qr = hz, n_qk = hz, n_qv = hz, n_lw = hz, n_aa = hz, n_gg = hz;
#define RW_PREFETCH(tt) do { const int _t = (tt); n_cr = hz; n_ck = hz; n_cv = hz; n_qr = hz; n_qk = hz; n_qv = hz; n_lw = hz; n_aa = hz; n_gg = hz; \
        if (_t < TT) { const int _m = row_of(b, _t); const f16* _pr = PB + (size_t)_m * N1 + C_BC + hc; n_cr = *(const f16x4*)(_pr); n_ck = *(const f16x4*)(_pr + 512); n_cv = *(const f16x4*)(_pr + 1024); \
            if (_t > 0) { const f16* _pp = PB + (size_t)row_of(b, _t - 1) * N1 + C_BC + hc; n_qr = *(const f16x4*)(_pp); n_qk = *(const f16x4*)(_pp + 512); n_qv = *(const f16x4*)(_pp + 1024); } \
            n_lw = *(const f16x4*)(LW + (size_t)_m * 512 + hc); n_aa = *(const f16x4*)(AA + (size_t)_m * 512 + hc); n_gg = *(const f16x4*)(GG + (size_t)_m * 512 + hc); } } while (0)
    RW_PREFETCH(ps);
    __syncthreads();
    for (int t0 = 0; t0 < TT; t0 += 32) {
        const int t = t0 + ps; const bool valid = t < TT;
        f32x4 r4 = {0, 0, 0, 0}, k4 = r4, v4 = r4, kk4 = r4, a4 = r4, g4 = r4, lw4 = r4;
        f32x4 rkw;
        {
            const f16x4 cr = n_cr, ck = n_ck, cv = n_cv, qr = n_qr, qk = n_qk, qv = n_qv, lw = n_lw, aa = n_aa, gg = n_gg;
            RW_PREFETCH(t + 32);
            const f32x4 mu_r = *(const f32x4*)(sCst + c4), mu_k = *(const f32x4*)(sCst + 64 + c4), mu_v = *(const f32x4*)(sCst + 128 + c4), kkw = *(const f32x4*)(sCst + 192 + c4), kaw = *(const f32x4*)(sCst + 256 + c4);
            rkw = *(const f32x4*)(sCst + 320 + c4);
#pragma unroll
            for (int e = 0; e < 4; ++e) {
                const float c0 = (float)cr[e], c1 = (float)ck[e], c2 = (float)cv[e];
                r4[e] = c0 + ((float)qr[e] - c0) * mu_r[e];
                const float k0 = c1 + ((float)qk[e] - c1) * mu_k[e];
                v4[e] = c2 + ((float)qv[e] - c2) * mu_v[e];
                a4[e] = (float)aa[e]; lw4[e] = (float)lw[e]; g4[e] = (float)gg[e];
                kk4[e] = k0 * kkw[e];
                k4[e] = k0 * (1.f + (a4[e] - 1.f) * kaw[e]);
            }
        }
        float ss = kk4[0] * kk4[0] + kk4[1] * kk4[1] + kk4[2] * kk4[2] + kk4[3] * kk4[3];
        float bo = r4[0] * k4[0] * rkw[0] + r4[1] * k4[1] * rkw[1] + r4[2] * k4[2] * rkw[2] + r4[3] * k4[3] * rkw[3];
        ss = row16_sum(ss); bo = row16_sum(bo);
        const float rn = __builtin_amdgcn_rsqf(ss + 1e-12f);
        f32x4 bb4;
#pragma unroll
        for (int e = 0; e < 4; ++e) { kk4[e] *= rn; bb4[e] = kk4[e] * a4[e]; }
        f32x4 cum = lw4;
        { f32x4 u1;
#pragma unroll
          for (int e = 0; e < 4; ++e) u1[e] = __shfl_up(cum[e], 16);
          if (lane >= 16) cum += u1;
#pragma unroll
          for (int e = 0; e < 4; ++e) u1[e] = __shfl_up(cum[e], 32);
          if (lane >= 32) cum += u1; }
        if (lane >= 48) *(f32x4*)(sTot + wave * 64 + c4) = cum;
        __syncthreads();
        f32x4 tot = {0, 0, 0, 0};
        { f32x4 tw[8];
#pragma unroll
          for (int w = 0; w < 8; ++w) tw[w] = *(const f32x4*)(sTot + w * 64 + c4);
          __builtin_amdgcn_sched_barrier(0);
#pragma unroll
          for (int w = 0; w < 8; ++w) { tot += tw[w]; const float msk = (w < wave) ? 1.f : 0.f; cum += tw[w] * msk; } }
        {
            f32x4 xa, xb, xk, xr, xbp, xkp;
#pragma unroll
            for (int e = 0; e < 4; ++e) { const float e1 = __expf(cum[e]), e2 = __expf(-cum[e]), e3 = __expf(cum[e] - lw4[e]), e4 = __expf(tot[e] - cum[e]);
                xa[e] = -kk4[e] * e3; xb[e] = bb4[e] * e2; xk[e] = k4[e] * e2; xr[e] = r4[e] * e1; xbp[e] = bb4[e] * e4; xkp[e] = k4[e] * e4; }
            *(u32x2*)(sAt + ps * RS + chslot) = pk4(xa); *(u32x2*)(sBt + ps * RS + chslot) = pk4(xb); *(u32x2*)(sKt + ps * RS + chslot) = pk4(xk); *(u32x2*)(sRt + ps * RS + chslot) = pk4(xr);
#pragma unroll
            for (int e = 0; e < 4; ++e) { sAtT[(c4 + e) * PSt + pslot] = f2bf(xa[e]); sBPT[(c4 + e) * PSt + pslot] = f2bf(xbp[e]); sKPT[(c4 + e) * PSt + pslot] = f2bf(xkp[e]); sVT[(c4 + e) * PSt + pslot] = f2bf(v4[e]); }
            if (ps == 0) { f32x4 pl;
#pragma unroll
                for (int e = 0; e < 4; ++e) pl[e] = __expf(tot[e]);
                *(f32x4*)(sPL + c4) = pl; }
        }
        __syncthreads();
#define RW_BJOB(jb_) do { const int jb = (jb_); const int prod = jb / 3, ti = jb % 3; const bf16_t *Ab, *Bb; int ta, tb; \
            if (prod <= 1) { ta = (ti >= 1) ? 1 : 0; tb = (ti == 2) ? 1 : 0; Ab = sAt; Bb = (prod == 0) ? sBt : sKt; } \
            else { ta = (ti == 2) ? 1 : 0; tb = (ti >= 1) ? 1 : 0; Ab = (prod == 2) ? sBt : sKt; Bb = sRt; } \
            f32x4 acc = {0, 0, 0, 0}; \
            _Pragma("unroll") for (int ks = 0; ks < 2; ++ks) { const bf16x8 a = *(const bf16x8*)(Ab + (16 * ta + fr) * RS + 32 * ks + 8 * fq); const bf16x8 bq = *(const bf16x8*)(Bb + (16 * tb + fr) * RS + 32 * ks + 8 * fq); acc = MFMA_BF(a, bq, acc); } \
            const int rbase = 16 * ta + 4 * fq, col = 16 * tb + fr; \
            if (prod == 0) { _Pragma("unroll") for (int e = 0; e < 4; ++e) acc[e] = (col < rbase + e) ? acc[e] : 0.f; \
                _Pragma("unroll") for (int e = 0; e < 4; ++e) sAab[(rbase + e) * FS + col] = acc[e]; \
                *(f32x4*)(sAabT + col * FS + rbase) = acc; } \
            else if (prod == 1) { _Pragma("unroll") for (int e = 0; e < 4; ++e) acc[e] = (col < rbase + e) ? acc[e] : 0.f; \
                *(u32x2*)(sAakT + col * PSt + 8 * fq + 4 * ta) = pk4(acc); } \
            else { _Pragma("unroll") for (int e = 0; e < 4; ++e) acc[e] = (rbase + e <= col) ? acc[e] : 0.f; \
                *(u32x2*)(((prod == 2) ? sMrb : sMrk) + col * PSt + 8 * fq + 4 * ta) = pk4(acc); } } while (0)
        RW_BJOB(wave);
        __syncthreads();
        if (wave == 0) {
            if (lane < 32) {
                const int blk = lane >> 4, col = lane & 15;
                const float* At_ = sAabT + (16 * blk) * FS + 16 * blk;
                float x[16];
#pragma unroll
                for (int s2 = 0; s2 < 16; ++s2) x[s2] = (s2 == col) ? 1.f : 0.f;
#define RW_INV_BATCH(J0, J1) do { f32x4 cv_[(J1) - (J0)][4]; \
                    _Pragma("unroll") for (int j = (J0); j < (J1); ++j) _Pragma("unroll") for (int q4 = (j + 1) / 4; q4 < 4; ++q4) cv_[j - (J0)][q4] = *(const f32x4*)(At_ + j * FS + 4 * q4); \
                    __builtin_amdgcn_sched_barrier(0); \
                    _Pragma("unroll") for (int j = (J0); j < (J1); ++j) { const float xj = x[j]; \
                        _Pragma("unroll") for (int q4 = (j + 1) / 4; q4 < 4; ++q4) _Pragma("unroll") for (int e = 0; e < 4; ++e) if (4 * q4 + e > j) x[4 * q4 + e] += cv_[j - (J0)][q4][e] * xj; } \
                    __builtin_amdgcn_sched_barrier(0); } while (0)
                RW_INV_BATCH(0, 3); RW_INV_BATCH(3, 7); RW_INV_BATCH(7, 15);
#pragma unroll
                for (int s2 = 0; s2 < 16; ++s2) { sTf[(16 * blk + s2) * FS + 16 * blk + col] = x[s2]; sT[(16 * blk + s2) * PSt + 8 * (col >> 2) + 4 * blk + (col & 3)] = f2bf(x[s2]); }
            }
        } else if (wave <= 4) { RW_BJOB(7 + wave); }
        __syncthreads();
        if (tid < 256) { const int i = tid >> 4, j = tid & 15; float acc = 0.f;
#pragma unroll
            for (int k = 0; k < 16; ++k) acc += sAab[(16 + i) * FS + k] * sTf[k * FS + j];
            sX[i * 20 + j] = acc; }
        __syncthreads();
        if (tid < 256) { const int i = tid >> 4, j = tid & 15; float acc = 0.f;
#pragma unroll
            for (int k = 0; k < 16; ++k) acc += sTf[(16 + i) * FS + 16 + k] * sX[k * 20 + j];
            sT[(16 + i) * PSt + 8 * (j >> 2) + (j & 3)] = f2bf(acc); }
        __syncthreads();
        for (int jb = wave; jb < 11; jb += 8) {
            if (jb < 8) { const int tc = jb >> 1, ts = jb & 1;
                const bf16x8 a = *(const bf16x8*)(sAtT + (16 * tc + fr) * PSt + 8 * fq); const bf16x8 bq = *(const bf16x8*)(sT + (16 * ts + fr) * PSt + 8 * fq);
                const f32x4 acc = MFMA_BF(a, bq, ((f32x4){0, 0, 0, 0}));
                *(u32x2*)(sW1 + (16 * ts + fr) * RS + 32 * (tc >> 1) + 8 * fq + 4 * (tc & 1)) = pk4(acc);
            } else {
                const int tj2 = (jb == 10) ? 1 : 0, ts2 = (jb == 8) ? 0 : 1;
                const bf16x8 a = *(const bf16x8*)(sAakT + (16 * tj2 + fr) * PSt + 8 * fq); const bf16x8 bq = *(const bf16x8*)(sT + (16 * ts2 + fr) * PSt + 8 * fq);
                const f32x4 acc = MFMA_BF(a, bq, ((f32x4){0, 0, 0, 0}));
                *(u32x2*)(sW2 + (16 * ts2 + fr) * PSt + 8 * fq + 4 * tj2) = pk4(acc);
            }
        }
        __syncthreads();
        if (wave < 4) {
            const int v0 = 16 * wave;
            const bf16x8 hb0 = pk8(Hacc[0], Hacc[1]), hb1 = pk8(Hacc[2], Hacc[3]);
            const bf16x8 vb = *(const bf16x8*)(sVT + (v0 + fr) * PSt + 8 * fq);
            bf16x8 fW1[2][2], fW2[2];
#pragma unroll
            for (int ts = 0; ts < 2; ++ts) { const bf16_t* w1r = sW1 + (16 * ts + fr) * RS;
                fW1[ts][0] = *(const bf16x8*)(w1r + 8 * fq); fW1[ts][1] = *(const bf16x8*)(w1r + 32 + 8 * fq); fW2[ts] = *(const bf16x8*)(sW2 + (16 * ts + fr) * PSt + 8 * fq); }
            __builtin_amdgcn_sched_barrier(0);
            f32x4 u[2];
#pragma unroll
            for (int ts = 0; ts < 2; ++ts) {
                f32x4 acc = MFMA_BF(fW1[ts][0], hb0, ((f32x4){0, 0, 0, 0}));
                acc = MFMA_BF(fW1[ts][1], hb1, acc);
                acc = MFMA_BF(fW2[ts], vb, acc);
                u[ts] = acc; }
            bf16x8 fRt[2][2], fMrk[2], fMrb[2];
#pragma unroll
            for (int ts = 0; ts < 2; ++ts) { const bf16_t* rtr = sRt + (16 * ts + fr) * RS;
                fRt[ts][0] = *(const bf16x8*)(rtr + 8 * fq); fRt[ts][1] = *(const bf16x8*)(rtr + 32 + 8 * fq);
                fMrk[ts] = *(const bf16x8*)(sMrk + (16 * ts + fr) * PSt + 8 * fq); fMrb[ts] = *(const bf16x8*)(sMrb + (16 * ts + fr) * PSt + 8 * fq); }
            __builtin_amdgcn_sched_barrier(0);
            const bf16x8 ub = pk8(u[0], u[1]);
#pragma unroll
            for (int ts = 0; ts < 2; ++ts) {
                f32x4 acc = MFMA_BF(fRt[ts][0], hb0, ((f32x4){0, 0, 0, 0}));
                acc = MFMA_BF(fRt[ts][1], hb1, acc);
                acc = MFMA_BF(fMrk[ts], vb, acc);
                acc = MFMA_BF(fMrb[ts], ub, acc);
#pragma unroll
                for (int e = 0; e < 4; ++e) sY[(16 * ts + 4 * fq + e) * YS + v0 + fr] = acc[e]; }
            bf16x8 fBP[4], fKP[4]; f32x4 fPL[4];
#pragma unroll
            for (int tc = 0; tc < 4; ++tc) { fBP[tc] = *(const bf16x8*)(sBPT + (16 * tc + fr) * PSt + 8 * fq); fKP[tc] = *(const bf16x8*)(sKPT + (16 * tc + fr) * PSt + 8 * fq); fPL[tc] = *(const f32x4*)(sPL + 16 * tc + 4 * fq); }
            __builtin_amdgcn_sched_barrier(0);
#pragma unroll
            for (int tc = 0; tc < 4; ++tc) {
                f32x4 acc = Hacc[tc] * fPL[tc];
                acc = MFMA_BF(fBP[tc], ub, acc);
                acc = MFMA_BF(fKP[tc], vb, acc);
                Hacc[tc] = acc; }
        }
        __syncthreads();
        {
            const f32x4 y4 = *(const f32x4*)(sY + ps * YS + c4); const f32x4 lng = *(const f32x4*)(sCst + 384 + c4), lnb = *(const f32x4*)(sCst + 448 + c4);
            const float mean = row16_sum((y4[0] + y4[1]) + (y4[2] + y4[3])) * (1.f / 64.f);
            float q = 0.f;
#pragma unroll
            for (int e = 0; e < 4; ++e) { const float d = y4[e] - mean; q += d * d; }
            const float rstd = __builtin_amdgcn_rsqf(row16_sum(q) * (1.f / 64.f) + 64e-5f);
            if (valid && t >= NMETA) {
                f16x4 o;
#pragma unroll
                for (int e = 0; e < 4; ++e) o[e] = (f16)((((y4[e] - mean) * rstd) * lng[e] + lnb[e] + bo * v4[e]) * g4[e]);
                *(f16x4*)(OB + (size_t)(b * SEQ + (t - NMETA)) * 512 + hc) = o;
            }
        }
    }
    __syncthreads();
}

constexpr int SCW = 8224;
__device__ __forceinline__ void dsa_item(const Params& p, int b, int g, unsigned char* lds) {
    int tid_ = threadIdx.x; asm volatile("" : "+v"(tid_));
    const int tid = tid_, lane = tid & 63, wave = __builtin_amdgcn_readfirstlane(tid >> 6);
    const f16* PB = (const f16*)(p.ws + WS_PB); const f16* CKV = (const f16*)(p.ws + WS_CKV); const f16* KIDX = (const f16*)(p.ws + WS_KIDX); const float* WIS = (const float*)(p.ws + WS_WIS);
    f16* OLAT = (f16*)(p.ws + WS_OLAT);
    float* sc = (float*)lds;
    unsigned* hist = (unsigned*)(lds + 4 * SCW * 4);
    unsigned short* sel = (unsigned short*)(lds + 4 * SCW * 4 + 4096);
    unsigned* misc = (unsigned*)(lds + 4 * SCW * 4 + 4096 + 2048);
    f16* sq = (f16*)(lds + 4 * SCW * 4 + 4096 + 2048 + 256);
    const int i0 = 4 * g, n_adm = 80 + 64 * (i0 >> 6), ntile = (n_adm + 31) >> 5;
    const int mq0 = b * SEQ + i0;
    {
        const int rho = lane & 31, q = rho >> 3, hd = rho & 7, hh = lane >> 5;
        const f16* qip = PB + (size_t)(mq0 + q) * N1 + C_QI + hd * 64 + 8 * hh;
        f16x8 af[4];
#pragma unroll
        for (int ks = 0; ks < 4; ++ks) af[ks] = *(const f16x8*)(qip + 16 * ks);
        float wsc[16];
#pragma unroll
        for (int j = 0; j < 16; ++j) wsc[j] = WIS[(size_t)(mq0 + (j >> 2)) * 8 + (j & 3) + 4 * hh];
        f16x8 bn[4];
        { const f16* kp = KIDX + (size_t)row_of(b, wave * 32 + (lane & 31)) * 64 + 8 * hh;
#pragma unroll
          for (int ks = 0; ks < 4; ++ks) bn[ks] = *(const f16x8*)(kp + 16 * ks); }
        for (int kt = wave; kt < ntile; kt += 8) {
            const int key = kt * 32 + (lane & 31);
            f16x8 bf[4];
#pragma unroll
            for (int ks = 0; ks < 4; ++ks) bf[ks] = bn[ks];
            { const int kn = (kt + 8 < ntile) ? kt + 8 : kt;
              const f16* kp = KIDX + (size_t)row_of(b, kn * 32 + (lane & 31)) * 64 + 8 * hh;
#pragma unroll
              for (int ks = 0; ks < 4; ++ks) bn[ks] = *(const f16x8*)(kp + 16 * ks); }
            f32x16 acc;
#pragma unroll
            for (int j = 0; j < 16; ++j) acc[j] = 0.f;
#pragma unroll
            for (int ks = 0; ks < 4; ++ks) acc = __builtin_amdgcn_mfma_f32_32x32x16_f16(af[ks], bf[ks], acc, 0, 0, 0);
            float s4[4];
#pragma unroll
            for (int qq = 0; qq < 4; ++qq) { float s = 0.f;
#pragma unroll
                for (int jj = 0; jj < 4; ++jj) s += wsc[4 * qq + jj] * fmaxf(acc[4 * qq + jj], 0.f);
                s += __shfl_xor(s, 32); s4[qq] = s; }
            if (lane < 32) {
#pragma unroll
                for (int qq = 0; qq < 4; ++qq) sc[qq * SCW + key] = s4[qq]; }
        }
        *(f16x8*)(sq + tid * 8) = *(const f16x8*)(PB + (size_t)(mq0 + (tid >> 7)) * N1 + C_QABS + (tid & 127) * 8);
    }
    __syncthreads();
    const int qs = tid >> 7, tl = tid & 127;
    int nsel;
    {
        const float* scq = sc + qs * SCW;
        if (n_adm <= 256) { for (int idx = tl; idx < n_adm; idx += 128) sel[qs * 256 + idx] = (unsigned short)idx; nsel = n_adm; }
        else {
            constexpr int NK = 65;
            unsigned kreg[NK];
            float lmin = INFINITY, lmax = -INFINITY;
#pragma unroll
            for (int i = 0; i < NK; ++i) { const int idx = tl + 128 * i; const float v = (idx < n_adm) ? scq[idx] : 0.f; kreg[i] = __float_as_uint(v); if (idx < n_adm) { lmin = fminf(lmin, v); lmax = fmaxf(lmax, v); } }
#pragma unroll
            for (int o = 1; o < 64; o <<= 1) { lmin = fminf(lmin, __shfl_xor(lmin, o)); lmax = fmaxf(lmax, __shfl_xor(lmax, o)); }
            float* mm = (float*)(misc + 32);
            if ((tid & 63) == 0) { mm[(qs * 2 + ((tid >> 6) & 1)) * 2] = lmin; mm[(qs * 2 + ((tid >> 6) & 1)) * 2 + 1] = lmax; }
            hist[qs * 256 + tl] = 0u; hist[qs * 256 + 128 + tl] = 0u;
            __syncthreads();
            const float lo = fminf(mm[qs * 4], mm[qs * 4 + 2]), hi = fmaxf(mm[qs * 4 + 1], mm[qs * 4 + 3]);
            const float scale = (hi > lo) ? 16777215.f / (hi - lo) : 0.f;
#pragma unroll
            for (int i = 0; i < NK; ++i) { const float v = __uint_as_float(kreg[i]); unsigned k = (unsigned)((v - lo) * scale); kreg[i] = k > 0xFFFFFFu ? 0xFFFFFFu : k; }
            unsigned prefix = 0u, mask = 0u; int kth = 256;
#pragma unroll
            for (int pass = 0; pass < 3; ++pass) {
                const int shift = 16 - 8 * pass;
#pragma unroll
                for (int i = 0; i < NK; ++i) { const int idx = tl + 128 * i; const unsigned u = kreg[i]; if (idx < n_adm && (u & mask) == prefix) atomicAdd(&hist[qs * 256 + ((u >> shift) & 255u)], 1u); }
                __syncthreads();
                if (tl < 64) {
                    const int c0 = (int)hist[qs * 256 + 4 * tl], c1 = (int)hist[qs * 256 + 4 * tl + 1], c2 = (int)hist[qs * 256 + 4 * tl + 2], c3 = (int)hist[qs * 256 + 4 * tl + 3];
                    const int tot = c0 + c1 + c2 + c3; int sfx = tot;
#pragma unroll
                    for (int off = 1; off < 64; off <<= 1) { const int tv = __shfl_down(sfx, off); if (tl + off < 64) sfx += tv; }
                    const int above = sfx - tot;
                    if (above < kth && kth <= sfx) { const int rem = kth - above; int bin, nk;
                        if (rem <= c3) { bin = 4 * tl + 3; nk = rem; } else if (rem <= c3 + c2) { bin = 4 * tl + 2; nk = rem - c3; }
                        else if (rem <= c3 + c2 + c1) { bin = 4 * tl + 1; nk = rem - c3 - c2; } else { bin = 4 * tl; nk = rem - c3 - c2 - c1; }
                        misc[qs * 8] = (unsigned)bin; misc[qs * 8 + 1] = (unsigned)nk; }
                }
                __syncthreads();
                prefix |= misc[qs * 8] << shift; mask |= 0xFFu << shift; kth = (int)misc[qs * 8 + 1];
                if (pass < 2) { hist[qs * 256 + tl] = 0u; hist[qs * 256 + 128 + tl] = 0u; }
                if (tl == 0 && pass == 2) { misc[qs * 8 + 2] = 0u; misc[qs * 8 + 3] = 0u; }
                __syncthreads();
            }
            const int lane_ = tid & 63;
#pragma unroll
            for (int i = 0; i < NK; ++i) { const int idx = tl + 128 * i; const unsigned u = kreg[i]; const bool ok = idx < n_adm;
                if (ok && u > prefix) { const unsigned long long m = __ballot(1); const int leader = __ffsll((long long)m) - 1; unsigned base = 0u;
                    if (lane_ == leader) base = atomicAdd(&misc[qs * 8 + 2], (unsigned)__popcll(m));
                    base = __shfl(base, leader);
                    sel[qs * 256 + base + __popcll(m & ((1ull << lane_) - 1ull))] = (unsigned short)idx; }
                else if (ok && u == prefix) { const unsigned e = atomicAdd(&misc[qs * 8 + 3], 1u); if ((int)e < kth) { const unsigned pos = atomicAdd(&misc[qs * 8 + 2], 1u); sel[qs * 256 + pos] = (unsigned short)idx; } } }
            nsel = 256;
        }
    }
    __syncthreads();
    {
        int lane_ = lane; asm volatile("" : "+v"(lane_));
        const int fr = lane_ & 15, fq = lane_ >> 4, aq = wave >> 1, rh = wave & 1;
        const unsigned short* selq = sel + aq * 256;
        f16x8 qf[4];
#pragma unroll
        for (int ks = 0; ks < 4; ++ks) { qf[ks] = *(const f16x8*)(sq + (aq * 8 + (fr & 7)) * 128 + 32 * ks + 8 * fq); if (fr >= 8) qf[ks] = (f16x8){(f16)0.f, (f16)0.f, (f16)0.f, (f16)0.f, (f16)0.f, (f16)0.f, (f16)0.f, (f16)0.f}; }
        f32x4 S[16];
#pragma unroll
        for (int g4 = 0; g4 < 4; ++g4) {
            f16x8 cf[4][4];
#pragma unroll
            for (int tq = 0; tq < 4; ++tq) { const int kk = 16 * (4 * g4 + tq) + fr; const int kidx = (kk < nsel) ? (int)selq[kk] : 0;
                const f16* cp = CKV + (size_t)row_of(b, kidx) * 128 + 8 * fq;
#pragma unroll
                for (int ks = 0; ks < 4; ++ks) cf[tq][ks] = *(const f16x8*)(cp + 32 * ks); }
            __builtin_amdgcn_sched_barrier(0);
#pragma unroll
            for (int tq = 0; tq < 4; ++tq) { f32x4 acc = {0.f, 0.f, 0.f, 0.f};
#pragma unroll
                for (int ks = 0; ks < 4; ++ks) acc = __builtin_amdgcn_mfma_f32_16x16x32_f16(cf[tq][ks], qf[ks], acc, 0, 0, 0);
                S[4 * g4 + tq] = acc; }
            __builtin_amdgcn_sched_barrier(0);
        }
        float mx = -INFINITY;
#pragma unroll
        for (int kt = 0; kt < 16; ++kt)
#pragma unroll
            for (int e = 0; e < 4; ++e) { const float v = (16 * kt + 4 * fq + e < nsel) ? S[kt][e] * 0.125f : -INFINITY; S[kt][e] = v; mx = fmaxf(mx, v); }
        mx = fmaxf(mx, __shfl_xor(mx, 16)); mx = fmaxf(mx, __shfl_xor(mx, 32));
        float sum = 0.f;
#pragma unroll
        for (int kt = 0; kt < 16; ++kt)
#pragma unroll
            for (int e = 0; e < 4; ++e) { const float pv = __expf(S[kt][e] - mx); S[kt][e] = pv; sum += pv; }
        sum += __shfl_xor(sum, 16); sum += __shfl_xor(sum, 32);
        const float inv = 1.f / sum;
        f16x8 Pf[8];
#pragma unroll
        for (int i = 0; i < 8; ++i) {
#pragma unroll
            for (int e = 0; e < 4; ++e) { Pf[i][e] = (f16)(S[2 * i][e] * inv); Pf[i][4 + e] = (f16)(S[2 * i + 1][e] * inv); } }
        f16x8 I0, I1;
#pragma unroll
        for (int j = 0; j < 8; ++j) { I0[j] = (8 * fq + j == fr) ? (f16)1.f : (f16)0.f; I1[j] = (8 * fq + j == 16 + fr) ? (f16)1.f : (f16)0.f; }
        f32x4 O[4];
#pragma unroll
        for (int j = 0; j < 4; ++j) O[j] = (f32x4){0.f, 0.f, 0.f, 0.f};
#pragma unroll
        for (int i2 = 0; i2 < 4; ++i2) {
            f16x8 ca[2][2], cb[2][2];
#pragma unroll
            for (int u = 0; u < 2; ++u) { const int ka = 32 * (2 * i2 + u) + fr, kb = ka + 16;
                const f16* pa = CKV + (size_t)row_of(b, (ka < nsel) ? (int)selq[ka] : 0) * 128 + 64 * rh + 8 * fq;
                const f16* pb = CKV + (size_t)row_of(b, (kb < nsel) ? (int)selq[kb] : 0) * 128 + 64 * rh + 8 * fq;
                ca[u][0] = *(const f16x8*)(pa); ca[u][1] = *(const f16x8*)(pa + 32); cb[u][0] = *(const f16x8*)(pb); cb[u][1] = *(const f16x8*)(pb + 32); }
            __builtin_amdgcn_sched_barrier(0);
#pragma unroll
            for (int u = 0; u < 2; ++u) {
#pragma unroll
                for (int j = 0; j < 4; ++j) {
                    const f32x4 z = {0.f, 0.f, 0.f, 0.f};
                    const f32x4 da = __builtin_amdgcn_mfma_f32_16x16x32_f16(ca[u][j >> 1], (j & 1) ? I1 : I0, z, 0, 0, 0);
                    const f32x4 db = __builtin_amdgcn_mfma_f32_16x16x32_f16(cb[u][j >> 1], (j & 1) ? I1 : I0, z, 0, 0, 0);
                    f16x8 bfr;
#pragma unroll
                    for (int e = 0; e < 4; ++e) { bfr[e] = (f16)da[e]; bfr[4 + e] = (f16)db[e]; }
                    O[j] = __builtin_amdgcn_mfma_f32_16x16x32_f16(Pf[2 * i2 + u], bfr, O[j], 0, 0, 0);
                }
            }
            __builtin_amdgcn_sched_barrier(0);
        }
        if (fq < 2) {
#pragma unroll
            for (int j = 0; j < 4; ++j)
#pragma unroll
                for (int e = 0; e < 4; ++e) OLAT[(size_t)(mq0 + aq) * 1024 + (4 * fq + e) * 128 + 64 * rh + 16 * j + fr] = (f16)O[j][e];
        }
    }
    __syncthreads();
}

__device__ __forceinline__ void phc2_mixers(const Params& p, unsigned char* lds, int rep) {
    unsigned* ctr = (unsigned*)(p.ws + WS_CTL) + 64 + 64 * rep;
    int* s_item = (int*)(lds + 150 * 1024 - 16);
    constexpr int NRW = 16, NDSA = 2 * (SEQ / 4);
    for (;;) {
        if (threadIdx.x == 0) *s_item = (int)atomicAdd(ctr, 1u);
        __syncthreads();
        const int item = *s_item;
        __syncthreads();
        if (item >= NRW + NDSA) break;
        if (item < NRW) rwkv_item(p, item >> 3, item & 7, lds);
        else { const int d = item - NRW; dsa_item(p, d & 1, (SEQ / 4 - 1) - (d >> 1), lds); }
    }
}

__device__ __forceinline__ void phd3_ln1(const Params& p) {
    const int tid = threadIdx.x, lane = tid & 63, wave = tid >> 6;
    const int gw = blockIdx.x * 8 + wave, NGW = gridDim.x * 8;
    f16* H1H = (f16*)(p.ws + WS_H1H);
    for (int m = gw; m < MREAL; m += NGW) {
        float* row = p.out + (size_t)m * D;
        f32x4 v[4]; float s = 0.f;
#pragma unroll
        for (int j = 0; j < 4; ++j) { v[j] = *(const f32x4*)(row + j * 256 + lane * 4); s += (v[j].x + v[j].y) + (v[j].z + v[j].w); }
        const float mean = wave_sum(s) * (1.f / D); float s2 = 0.f;
#pragma unroll
        for (int j = 0; j < 4; ++j) { v[j] = v[j] - mean; s2 += (v[j].x * v[j].x + v[j].y * v[j].y) + (v[j].z * v[j].z + v[j].w * v[j].w); }
        const float rstd = 1.f / sqrtf(wave_sum(s2) * (1.f / D) + LN_EPS);
#pragma unroll
        for (int j = 0; j < 4; ++j) { const f32x4 g = *(const f32x4*)(p.ln1_g + j * 256 + lane * 4), bb = *(const f32x4*)(p.ln1_b + j * 256 + lane * 4);
            const f32x4 o = v[j] * rstd * g + bb; *(f32x4*)(row + j * 256 + lane * 4) = o; *(f16x4*)(H1H + (size_t)m * D + j * 256 + lane * 4) = to_h4(o); }
    }
    f16* U16 = (f16*)(p.ws + WS_U16); f16* V16 = (f16*)(p.ws + WS_V16);
    const long gt = (long)blockIdx.x * NT + tid, NGT = (long)gridDim.x * NT;
    for (long e = gt; e < 16384L * 1024 / 4; e += NGT) {
        *(f16x4*)(U16 + e * 4) = to_h4(*(const f32x4*)(p.peer_u + e * 4));
        *(f16x4*)(V16 + e * 4) = to_h4(*(const f32x4*)(p.peer_v + e * 4));
    }
}

#define CSWAP(j) do { if (tv[j] > tv[j - 1]) { const int _t = tv[j]; tv[j] = tv[j - 1]; tv[j - 1] = _t; const int _i = ti[j]; ti[j] = ti[j - 1]; ti[j - 1] = _i; } } while (0)
#define CSWAP_ALL() do { CSWAP(15); CSWAP(14); CSWAP(13); CSWAP(12); CSWAP(11); CSWAP(10); CSWAP(9); CSWAP(8); CSWAP(7); CSWAP(6); CSWAP(5); CSWAP(4); CSWAP(3); CSWAP(2); CSWAP(1); } while (0)
__device__ __forceinline__ void top16_of_128(const unsigned short* src, int (&tv)[16], int (&ti)[16]) {
#pragma unroll
    for (int j = 0; j < 16; ++j) { tv[j] = -1; ti[j] = 0; }
    for (int c = 0; c < 16; ++c) {
        const u32x4 w = *(const u32x4*)(src + c * 8);
#pragma unroll
        for (int e = 0; e < 8; ++e) {
            const int x = (int)((w[e >> 1] >> (16 * (e & 1))) & 0xFFFFu);
            if (x > tv[15]) { tv[15] = x; ti[15] = c * 8 + e; CSWAP_ALL(); }
        }
    }
}
__device__ __forceinline__ void phd5_topk(const Params& p) {
    const unsigned short* SC = (const unsigned short*)(p.ws + WS_SC);
    unsigned short* EIDX = (unsigned short*)(p.ws + WS_EIDX); float* EGATE = (float*)(p.ws + WS_EGATE);
    const long gt = (long)blockIdx.x * NT + threadIdx.x, NGT = (long)gridDim.x * NT;
    for (long e = gt; e < (long)MREAL * 8; e += NGT) {
        const int m = (int)(e >> 3), h = (int)(e & 7);
        int av[16], bv[16]; int ai[16], bi[16];
        top16_of_128(SC + (size_t)m * 2048 + h * 256, av, ai);
        top16_of_128(SC + (size_t)m * 2048 + h * 256 + 128, bv, bi);
        int tv[16]; int ti[16];
#pragma unroll
        for (int j = 0; j < 16; ++j) { tv[j] = -1; ti[j] = 0; }
#pragma unroll
        for (int i = 0; i < 16; ++i)
#pragma unroll
            for (int j = 0; j < 16; ++j)
                if ((i + 1) * (j + 1) <= 16) {
                    const int x = av[i] + bv[j];
                    if (x > tv[15]) { tv[15] = x; ti[15] = ai[i] * 128 + bi[j]; CSWAP_ALL(); }
                }
        float sum = 0.f; float ex[16];
#pragma unroll
        for (int j = 0; j < 16; ++j) { ex[j] = __expf((float)(tv[j] - tv[0]) * (1.f / 8192.f)); sum += ex[j]; }
        const float inv = 1.f / sum;
#pragma unroll
        for (int j = 0; j < 16; ++j) { EIDX[(size_t)m * 128 + h * 16 + j] = (unsigned short)ti[j]; EGATE[(size_t)m * 128 + h * 16 + j] = ex[j] * inv; }
    }
}

__device__ __forceinline__ void phd6_gather(const Params& p) {
    const int tid = threadIdx.x, lane = tid & 63, wave = tid >> 6;
    const int gw = blockIdx.x * 8 + wave, NGW = gridDim.x * 8;
    const f16* U16 = (const f16*)(p.ws + WS_U16); const f16* V16 = (const f16*)(p.ws + WS_V16);
    const unsigned short* EIDX = (const unsigned short*)(p.ws + WS_EIDX); const float* EGATE = (const float*)(p.ws + WS_EGATE);
    for (int m = gw; m < MREAL; m += NGW) {
        float* row = p.out + (size_t)m * D;
        float hv[16];
#pragma unroll
        for (int sg = 0; sg < 2; ++sg)
#pragma unroll
            for (int q = 0; q < 2; ++q) { const f32x4 t = *(const f32x4*)(row + sg * 512 + lane * 8 + q * 4); hv[sg * 8 + q * 4] = t.x; hv[sg * 8 + q * 4 + 1] = t.y; hv[sg * 8 + q * 4 + 2] = t.z; hv[sg * 8 + q * 4 + 3] = t.w; }
        const int e_lo = (int)EIDX[(size_t)m * 128 + lane], e_hi = (int)EIDX[(size_t)m * 128 + 64 + lane];
        const float g_lo = EGATE[(size_t)m * 128 + lane], g_hi = EGATE[(size_t)m * 128 + 64 + lane];
        float hd_lo = 0.f, hd_hi = 0.f;
#pragma unroll 4
        for (int e = 0; e < 64; ++e) {
            const int id0 = __builtin_amdgcn_readlane(e_lo, e), id1 = __builtin_amdgcn_readlane(e_hi, e);
            const f16* u0 = U16 + (size_t)id0 * D + lane * 8; const f16* u1 = U16 + (size_t)id1 * D + lane * 8;
            const f16x8 a0 = *(const f16x8*)(u0), a1 = *(const f16x8*)(u0 + 512), b0 = *(const f16x8*)(u1), b1 = *(const f16x8*)(u1 + 512);
            float s0 = 0.f, s1 = 0.f;
#pragma unroll
            for (int j = 0; j < 8; ++j) { s0 += hv[j] * (float)a0[j]; s0 += hv[8 + j] * (float)a1[j]; s1 += hv[j] * (float)b0[j]; s1 += hv[8 + j] * (float)b1[j]; }
            s0 = wave_sum(s0); s1 = wave_sum(s1);
            if (lane == e) { hd_lo = s0; hd_hi = s1; }
        }
        const float c_lo = g_lo * 0.5f * hd_lo * (1.f + erff(hd_lo * 0.70710678118654752f));
        const float c_hi = g_hi * 0.5f * hd_hi * (1.f + erff(hd_hi * 0.70710678118654752f));
        float acc[16];
#pragma unroll
        for (int j = 0; j < 16; ++j) acc[j] = 0.f;
#pragma unroll 4
        for (int e = 0; e < 64; ++e) {
            const int id0 = __builtin_amdgcn_readlane(e_lo, e), id1 = __builtin_amdgcn_readlane(e_hi, e);
            const float cf0 = __builtin_bit_cast(float, __builtin_amdgcn_readlane(__builtin_bit_cast(int, c_lo), e)), cf1 = __builtin_bit_cast(float, __builtin_amdgcn_readlane(__builtin_bit_cast(int, c_hi), e));
            const f16* v0 = V16 + (size_t)id0 * D + lane * 8; const f16* v1 = V16 + (size_t)id1 * D + lane * 8;
            const f16x8 a0 = *(const f16x8*)(v0), a1 = *(const f16x8*)(v0 + 512), b0 = *(const f16x8*)(v1), b1 = *(const f16x8*)(v1 + 512);
#pragma unroll
            for (int j = 0; j < 8; ++j) { acc[j] += cf0 * (float)a0[j] + cf1 * (float)b0[j]; acc[8 + j] += cf0 * (float)a1[j] + cf1 * (float)b1[j]; }
        }
        float s = 0.f;
#pragma unroll
        for (int j = 0; j < 16; ++j) { acc[j] += ALPHA * hv[j]; s += acc[j]; }
        const float mean = wave_sum(s) * (1.f / D); float s2 = 0.f;
#pragma unroll
        for (int j = 0; j < 16; ++j) { acc[j] -= mean; s2 += acc[j] * acc[j]; }
        const float rstd = 1.f / sqrtf(wave_sum(s2) * (1.f / D) + LN_EPS);
#pragma unroll
        for (int sg = 0; sg < 2; ++sg)
#pragma unroll
            for (int q = 0; q < 2; ++q) { const int col = sg * 512 + lane * 8 + q * 4; const f32x4 g = *(const f32x4*)(p.ln2_g + col), bb = *(const f32x4*)(p.ln2_b + col);
                f32x4 o; o.x = acc[sg * 8 + q * 4] * rstd * g.x + bb.x; o.y = acc[sg * 8 + q * 4 + 1] * rstd * g.y + bb.y; o.z = acc[sg * 8 + q * 4 + 2] * rstd * g.z + bb.z; o.w = acc[sg * 8 + q * 4 + 3] * rstd * g.w + bb.w;
                *(f32x4*)(row + col) = o; }
    }
}

struct EpiLora {
    f16 *LW, *AA, *GG; const float *w0, *a0;
    __device__ __forceinline__ void operator()(const f32x4 (&acc)[2][2][4][2], const pg8::Unit& u, int wr, int wc, int fr, int fq) const {
        const int row0 = u.pm * 256 + wr * 64 + fr, col0 = (u.pn & 1) * 256 + wc * 32 + 4 * fq;
        if (u.pn < 2) {
#pragma unroll
            for (int bj = 0; bj < 2; ++bj)
#pragma unroll
                for (int n = 0; n < 2; ++n) { const int col = col0 + bj * 128 + n * 16; const f32x4 c = *(const f32x4*)(w0 + col);
#pragma unroll
                    for (int ai = 0; ai < 2; ++ai)
#pragma unroll
                        for (int m = 0; m < 4; ++m) { const f32x4 v = acc[ai][bj][m][n]; f16x4 o;
#pragma unroll
                            for (int e = 0; e < 4; ++e) { const float wl = -softplusf_(-(c[e] + v[e])) - 0.5f; o[e] = (f16)(-__expf(wl)); }
                            *(f16x4*)(LW + (size_t)(row0 + ai * 128 + m * 16) * 512 + col) = o; } }
        } else if (u.pn < 4) {
#pragma unroll
            for (int bj = 0; bj < 2; ++bj)
#pragma unroll
                for (int n = 0; n < 2; ++n) { const int col = col0 + bj * 128 + n * 16; const f32x4 c = *(const f32x4*)(a0 + col);
#pragma unroll
                    for (int ai = 0; ai < 2; ++ai)
#pragma unroll
                        for (int m = 0; m < 4; ++m) { const f32x4 v = acc[ai][bj][m][n]; f16x4 o;
#pragma unroll
                            for (int e = 0; e < 4; ++e) o[e] = (f16)sigmoidf_(c[e] + v[e]);
                            *(f16x4*)(AA + (size_t)(row0 + ai * 128 + m * 16) * 512 + col) = o; } }
        } else {
#pragma unroll
            for (int bj = 0; bj < 2; ++bj)
#pragma unroll
                for (int n = 0; n < 2; ++n) { const int col = col0 + bj * 128 + n * 16;
#pragma unroll
                    for (int ai = 0; ai < 2; ++ai)
#pragma unroll
                        for (int m = 0; m < 4; ++m) *(f16x4*)(GG + (size_t)(row0 + ai * 128 + m * 16) * 512 + col) = to_h4(acc[ai][bj][m][n]); }
        }
    }
};

#define XB_TMO      128
#define XB_XCNT(j)  (256  + 64 * (j))
#define XB_XSUB(j)  (1280 + 64 * (j))
#define XB_XGEN(j)  (2304 + 64 * (j))
#define XB_TOP      3328
#define XB_TOPGEN   3392
#define XCD_BAR_WORDS 3456
#define XB_SPIN_CAP (1u << 20)
__device__ __forceinline__ unsigned xb_ld(unsigned* p)              { return __hip_atomic_load(p, __ATOMIC_RELAXED, __HIP_MEMORY_SCOPE_AGENT); }
__device__ __forceinline__ unsigned xb_add(unsigned* p, unsigned v) { return __hip_atomic_fetch_add(p, v, __ATOMIC_RELAXED, __HIP_MEMORY_SCOPE_AGENT); }
__device__ __forceinline__ unsigned xb_xcc_id() { return (unsigned)__builtin_amdgcn_s_getreg((3 << 11) | 20) & 0xFu; }
#define XB_SPIN(cond, bar) do { unsigned _sp = 0; while (cond) { __builtin_amdgcn_s_sleep(1); \
    if ((++_sp & 255u) == 0u) { if (xb_ld(&(bar)[XB_TMO])) break; if (_sp > XB_SPIN_CAP) { atomicAdd(&(bar)[XB_TMO], 1u); break; } } } } while (0)
struct XcdBarrier { unsigned* bar; unsigned x; volatile LAS unsigned* st; };
__device__ __forceinline__ XcdBarrier xcd_barrier_post(unsigned* bar, volatile LAS unsigned* st) {
    XcdBarrier b; b.bar = bar; b.x = xb_xcc_id(); b.st = st;
    if (threadIdx.x == 0) (void)xb_add(&bar[XB_XCNT(b.x)], 1u);
    return b;
}
__device__ __forceinline__ void xcd_barrier_complete(unsigned* bar, unsigned x, unsigned& nloc, unsigned& nx) {
    const unsigned G = gridDim.x * gridDim.y * gridDim.z;
    unsigned sum, cnt, mine, sp = 0u;
    for (;;) {
        sum = 0u; cnt = 0u; mine = 0u;
#pragma unroll
        for (unsigned j = 0; j < 16; ++j) { const unsigned c = xb_ld(&bar[XB_XCNT(j)]); sum += c; cnt += (c > 0u) ? 1u : 0u; mine = (j == x) ? c : mine; }
        if (sum == G) break;
        __builtin_amdgcn_s_sleep(1);
        if ((++sp & 255u) == 0u) { if (xb_ld(&bar[XB_TMO])) break; if (sp > XB_SPIN_CAP) { atomicAdd(&bar[XB_TMO], 1u); break; } }
    }
    nloc = mine > 0u ? mine : 1u; nx = cnt > 0u ? cnt : 1u;
}
__device__ __forceinline__ void xcd_barrier(const XcdBarrier& b) {
    asm volatile("s_waitcnt vmcnt(0)" ::: "memory");
    __syncthreads();
    if (threadIdx.x == 0) {
        unsigned* bar = b.bar;
        __builtin_amdgcn_s_waitcnt(0);
        unsigned nloc = b.st[0], nx = b.st[1];
        if (nloc == 0u) { xcd_barrier_complete(bar, b.x, nloc, nx); b.st[0] = nloc; b.st[1] = nx; }
        const unsigned old = xb_add(&bar[XB_XSUB(b.x)], 1u);
        const unsigned gen = old / nloc;
        if (old + 1u == (gen + 1u) * nloc) {
            __builtin_amdgcn_fence(__ATOMIC_RELEASE, "agent");
            asm volatile("s_waitcnt vmcnt(0)" ::: "memory");
            const unsigned og = xb_add(&bar[XB_TOP], 1u);
            const unsigned tg = og / nx;
            if (og + 1u == (tg + 1u) * nx) xb_add(&bar[XB_TOPGEN], 1u);
            else XB_SPIN(xb_ld(&bar[XB_TOPGEN]) == tg, bar);
            __builtin_amdgcn_fence(__ATOMIC_ACQUIRE, "agent");
            xb_add(&bar[XB_XGEN(b.x)], 1u);
            asm volatile("s_waitcnt vmcnt(0)" ::: "memory");
        } else {
            XB_SPIN(xb_ld(&bar[XB_XGEN(b.x)]) == gen, bar);
            __builtin_amdgcn_fence(__ATOMIC_ACQUIRE, "agent");
            asm volatile("s_waitcnt vmcnt(0)" ::: "memory");
        }
    }
    __syncthreads();
}

constexpr int LDS_BYTES = 150 * 1024;
constexpr int REP0 = 1, REP1 = 1, REP4 = 1, REP5 = 1, REP8 = 1, REP9 = 1;
constexpr int NPHASE = 11;
__global__ void __launch_bounds__(NT) mk_fwd(Params p) {
    extern __shared__ __attribute__((aligned(16))) unsigned char lds[];
    cg::grid_group grid = cg::this_grid();
    unsigned char* ws = p.ws;
    const int lo = p.ph_lo, hi = p.ph_hi;
    volatile LAS unsigned* bst = (volatile LAS unsigned*)((LAS unsigned char*)lds + LDS_BYTES - 64);
    if (threadIdx.x < 2) bst[threadIdx.x] = 0u;
    __syncthreads();
    const XcdBarrier xbar = xcd_barrier_post((unsigned*)(ws + WS_CTL) + 4096, bst);
#define IN(k) (lo <= (k) && (k) < hi)
#define SEAM(k) do { if (IN(k) && IN((k) + 1)) { if ((k) == 0) grid.sync(); else xcd_barrier(xbar); } } while (0)
    if (IN(0)) ph0_prep(p, lds);
    SEAM(0);
    if (IN(1)) {
        f16* PB = (f16*)(ws + WS_PB);
        auto f = [=](int row, int col, f32x4 v) { *(f16x4*)(PB + (size_t)row * N1 + col) = to_h4(v); };
        pg8::run_gemm(lds, (const f16*)(ws + WS_H0), (const f16*)(ws + WS_W1T), MR, N1, D, f);
    }
    SEAM(1);
    if (IN(2)) phc1_rowprep(p);
    SEAM(2);
    if (IN(3)) {
        pg8::Gemm g{(const f16*)((unsigned char*)p.out + DO_LORAIN), (const f16*)(ws + WS_WLT), MR, 1536, 256}; pg8::StaticOrder S; S.init(MR, 1536, (int)gridDim.x, (int)blockIdx.x);
        EpiLora E{(f16*)((unsigned char*)p.out + DO_LW), (f16*)((unsigned char*)p.out + DO_AA), (f16*)((unsigned char*)p.out + DO_GG), p.b_w0, p.b_a0};
        pg8::gemm_phase<EpiLora>((PG8_LAS unsigned char*)lds, g, S, E);
        __syncthreads();
    }
    SEAM(3);
    if (IN(4)) for (int rep = 0; rep < REP4; ++rep) { if (rep) grid.sync(); phc2_mixers(p, lds, rep); }
    SEAM(4);
    if (IN(5)) {
        f16* MIX = (f16*)(ws + WS_MIXED); f16* TMP = (f16*)(ws + WS_TMP); const float* bg = p.b_gate;
        auto f1 = [=](int row, int col, f32x4 v) { const f32x4 c = *(const f32x4*)(bg + col); f16x4 o;
#pragma unroll
            for (int e = 0; e < 4; ++e) o[e] = (f16)sigmoidf_(v[e] + c[e]);
            *(f16x4*)(MIX + (size_t)row * D + col) = o; };
        pg8::run_gemm(lds, (const f16*)(ws + WS_H0), (const f16*)(ws + WS_WGT), MREAL, D, D, f1);
        auto f2 = [=](int row, int col, f32x4 v) { f16x4* q = (f16x4*)(MIX + (size_t)row * D + col); const f16x4 gq = *q; f16x4 o;
#pragma unroll
            for (int e = 0; e < 4; ++e) o[e] = (f16)((float)gq[e] * v[e]);
            *q = o; };
        pg8::run_gemm(lds, (const f16*)(ws + WS_OLAT), (const f16*)(ws + WS_WPAT), MREAL, D, D, f2);
        auto f3 = [=](int row, int col, f32x4 v) { const f32x4 c = *(const f32x4*)(bg + 1024 + col); f16x4 o;
#pragma unroll
            for (int e = 0; e < 4; ++e) o[e] = (f16)sigmoidf_(v[e] + c[e]);
            *(f16x4*)(TMP + (size_t)row * D + col) = o; };
        pg8::run_gemm(lds, (const f16*)(ws + WS_H0), (const f16*)(ws + WS_WGT) + (size_t)1024 * D, MREAL, D, D, f3);
        auto f4 = [=](int row, int col, f32x4 v) { f16x4* q = (f16x4*)(MIX + (size_t)row * D + col); const f16x4 m0 = *q; const f16x4 gq = *(const f16x4*)(TMP + (size_t)row * D + col); f16x4 o;
#pragma unroll
            for (int e = 0; e < 4; ++e) o[e] = (f16)((float)m0[e] + (float)gq[e] * v[e]);
            *q = o; };
        pg8::run_gemm(lds, (const f16*)(ws + WS_OB), (const f16*)(ws + WS_WPBT), MREAL, D, 512, f4);
    }
    SEAM(5);
    if (IN(6)) {
        const float* x = p.x; const float* STAT = (const float*)(ws + WS_STAT); const float* lg = p.ln_in_g; const float* lb = p.ln_in_b; float* out = p.out;
        auto f = [=](int row, int col, f32x4 v) { const f32x4 xv = *(const f32x4*)(x + (size_t)row * D + col); const float mean = STAT[2 * row], rstd = STAT[2 * row + 1];
            const f32x4 g = *(const f32x4*)(lg + col), bb = *(const f32x4*)(lb + col);
            *(f32x4*)(out + (size_t)row * D + col) = ((xv - mean) * rstd * g + bb) * ALPHA + v; };
        pg8::run_gemm(lds, (const f16*)(ws + WS_MIXED), (const f16*)(ws + WS_WOT), MREAL, D, D, f);
    }
    SEAM(6);
    if (IN(7)) phd3_ln1(p);
    SEAM(7);
    if (IN(8)) {
        unsigned short* SC = (unsigned short*)(ws + WS_SC);
        auto f = [=](int row, int col, f32x4 v) { u32x2 o; unsigned q[4];
#pragma unroll
            for (int e = 0; e < 4; ++e) q[e] = (unsigned)__float2int_rn(fminf(fmaxf((v[e] + 2.f) * 8192.f, 0.f), 65535.f));
            o.x = q[0] | (q[1] << 16); o.y = q[2] | (q[3] << 16); *(u32x2*)(SC + (size_t)row * 2048 + col) = o; };
        pg8::run_gemm(lds, (const f16*)(ws + WS_H1H), (const f16*)(ws + WS_WSKT), MREAL, 2048, D, f);
    }
    SEAM(8);
    if (IN(9)) phd5_topk(p);
    SEAM(9);
    if (IN(10)) phd6_gather(p);
#undef IN
#undef SEAM
}

extern "C" void kernel_launch(void* const* d_in, const int* in_sizes, int n_in, void* d_out, int out_size, void* d_ws, size_t ws_size, hipStream_t stream) {
    static int grid = 0;
    if (grid == 0) {
        int dev = 0, cus = 0, per_cu = 0;
        if (hipGetDevice(&dev) != hipSuccess || hipDeviceGetAttribute(&cus, hipDeviceAttributeMultiprocessorCount, dev) != hipSuccess) { fprintf(stderr, "kernel_launch: device query failed\n"); grid = -1; return; }
        if (hipFuncSetAttribute((const void*)mk_fwd, hipFuncAttributeMaxDynamicSharedMemorySize, LDS_BYTES) != hipSuccess) { fprintf(stderr, "kernel_launch: hipFuncSetAttribute failed\n"); grid = -1; return; }
        if (hipOccupancyMaxActiveBlocksPerMultiprocessor(&per_cu, (const void*)mk_fwd, NT, LDS_BYTES) != hipSuccess || per_cu < 1) { fprintf(stderr, "kernel_launch: occupancy query says %d\n", per_cu); grid = -1; return; }
        if (n_in != 33 || out_size != MREAL * D || ws_size < WS_END) { fprintf(stderr, "kernel_launch: unexpected shapes n_in %d out %d ws %zu\n", n_in, out_size, ws_size); grid = -1; return; }
        grid = cus;
    }
    if (grid < 0) return;
    (void)hipMemsetAsync((char*)d_ws + WS_CTL, 0, 1 * MiB, stream);
    Params p{};
    const float** pf = (const float**)&p;
    for (int i = 0; i < 33; ++i) pf[i] = (const float*)d_in[i];
    p.out = (float*)d_out; p.ws = (unsigned char*)d_ws; p.ph_lo = 0; p.ph_hi = NPHASE;
    void* args[] = {&p};
    hipError_t e = hipLaunchCooperativeKernel((void*)mk_fwd, dim3(grid), dim3(NT), args, LDS_BYTES, stream);
    if (e != hipSuccess) fprintf(stderr, "kernel_launch: cooperative launch failed: %s (grid %d)\n", hipGetErrorString(e), grid);
}
```

```cpp
#include <hip/hip_runtime.h>
#include <hip/hip_cooperative_groups.h>
#include <cstdio>
#include <cstdint>
namespace cg = cooperative_groups;

#define LAS __attribute__((address_space(3)))
typedef _Float16 f16;
typedef _Float16 f16x2 __attribute__((ext_vector_type(2)));
typedef _Float16 f16x4 __attribute__((ext_vector_type(4)));
typedef _Float16 f16x8 __attribute__((ext_vector_type(8)));
typedef float f32x2 __attribute__((ext_vector_type(2)));
typedef float f32x4 __attribute__((ext_vector_type(4)));
typedef float f32x16 __attribute__((ext_vector_type(16)));
typedef unsigned u32x4 __attribute__((ext_vector_type(4)));

constexpr int D = 1024, SEQ = 8192, NMETA = 16, TT = 8208;
constexpr int MREAL = 16384, MR = 16640;
constexpr int NIN = 5064;
constexpr int N1 = 3584;
constexpr int C_QABS = 0, C_QI = 1024, C_CKV = 1536, C_KI = 1664, C_WI = 1728, C_BC = 1792;
constexpr int NT = 512;
constexpr float LN_EPS = 1e-5f;
constexpr float ALPHA = 1.189207115002721f;

__device__ __forceinline__ int row_of(int b, int t) { return t < NMETA ? MREAL + b * NMETA + t : b * SEQ + (t - NMETA); }

constexpr size_t MiB = 1u << 20;
constexpr size_t WS_CTL = 0, WS_STAT = 1 * MiB, WS_WIS = 2 * MiB, WS_W1T = 3 * MiB, WS_WGT = 10 * MiB, WS_WPAT = 14 * MiB, WS_WPBT = 16 * MiB,
                 WS_WOT = 17 * MiB, WS_WSKT = 19 * MiB, WS_WLT = 23 * MiB, WS_CKV = 24 * MiB, WS_KIDX = 29 * MiB, WS_H0 = 32 * MiB,
                 WS_OLAT = 65 * MiB, WS_OB = 97 * MiB, WS_PB = 113 * MiB, WS_END = 227 * MiB;
constexpr size_t WS_MIXED = WS_PB, WS_H1H = WS_PB, WS_TMP = WS_PB + 32 * MiB, WS_SC = WS_PB + 32 * MiB, WS_EIDX = WS_PB + 96 * MiB, WS_EGATE = WS_PB + 100 * MiB;
constexpr size_t WS_U16 = WS_H0, WS_V16 = WS_OLAT;
constexpr size_t DO_LORAIN = 0, DO_LW = 9 * MiB, DO_AA = 26 * MiB, DO_GG = 43 * MiB;

struct Params {
    const float *x, *meta, *ln_in_g, *ln_in_b, *w_in, *b_gate, *a_kv_norm_g, *a_w_uk, *a_w_uv, *a_kidx_g, *a_kidx_b, *b_mu, *b_w0, *b_w2, *b_a0, *b_a2,
        *b_g2, *b_k_k, *b_k_a, *b_r_k, *b_lnx_g, *b_lnx_b, *w_pa, *w_pb, *w_o, *ln1_g, *ln1_b, *peer_wq, *peer_subkeys, *peer_u, *peer_v, *ln2_g, *ln2_b;
    float* out;
    unsigned char* ws;
    int ph_lo, ph_hi;
};

__device__ __forceinline__ float wave_sum(float v) {
#pragma unroll
    for (int o = 1; o < 64; o <<= 1) v += __shfl_xor(v, o);
    return v;
}
__device__ __forceinline__ float wave_max(float v) {
#pragma unroll
    for (int o = 1; o < 64; o <<= 1) v = fmaxf(v, __shfl_xor(v, o));
    return v;
}
#define DPP_F(v, ctrl) __builtin_bit_cast(float, __builtin_amdgcn_update_dpp(0, __builtin_bit_cast(int, (v)), (ctrl), 0xF, 0xF, true))
__device__ __forceinline__ float row16_sum(float v) {
    v += DPP_F(v, 0xB1);
    v += DPP_F(v, 0x4E);
    v += DPP_F(v, 0x141);
    v += DPP_F(v, 0x140);
    return v;
}
__device__ __forceinline__ float sigmoidf_(float x) { return __builtin_amdgcn_rcpf(1.f + __expf(-x)); }
__device__ __forceinline__ float softplusf_(float z) { return fmaxf(z, 0.f) + __logf(1.f + __expf(-fabsf(z))); }
__device__ __forceinline__ unsigned fkey(float f) { unsigned u = __float_as_uint(f); return u ^ ((u >> 31) ? 0xFFFFFFFFu : 0x80000000u); }

namespace pg8 {
#define PG8_LAS __attribute__((address_space(3)))
typedef short h16x8 __attribute__((ext_vector_type(8)));
constexpr int BM = 256, BK = 64, HALF = 128, HTB = HALF * BK * 2, STAGE_BYTES = 8 * HTB, NXCD = 8, WGM = 8;
__host__ __device__ __forceinline__ int lds_byte(int r, int c) { const int st = (r >> 4) * 2 + (c >> 5), rr = r & 15, cc = c & 31, ob = rr * 64 + cc * 2; return st * 1024 + (ob ^ (((ob >> 9) & 1) << 5)); }
__host__ __device__ __forceinline__ void stage_rc(int b, int& R, int& C) { const int st = b / 1024, sb = b % 1024, swz = sb ^ (((sb >> 9) & 1) << 5); R = (st >> 1) * 16 + swz / 64; C = (st & 1) * 32 + (swz % 64) / 2; }
struct Unit { int pm, pn; };
struct Gemm { const f16* A; const f16* Bt; int M, N, K; };
struct StaticOrder {
    int nM, nN, nwg, G, c;
    __host__ __device__ void init(int M, int N, int G_, int c_) { nM = M / BM; nN = N / BM; nwg = nM * nN; G = G_; c = c_; }
    __host__ __device__ bool next(int i, Unit& u) const {
        const long L = (long)i * G + c; if (L >= nwg) return false;
        int wgid = (int)L; { const int q = nwg / NXCD, r = nwg % NXCD, xcd = wgid % NXCD, off = wgid / NXCD; wgid = (xcd < r ? xcd * (q + 1) : r * (q + 1) + (xcd - r) * q) + off; }
        const int nig = WGM * nN, gid = wgid / nig, fm = gid * WGM, gsz = (nM - fm) < WGM ? (nM - fm) : WGM;
        u.pm = fm + ((wgid % nig) % gsz); u.pn = (wgid % nig) / gsz; return true;
    }
};
template <class F> struct EpiElem {
    F f;
    __device__ __forceinline__ void operator()(const f32x4 (&acc)[2][2][4][2], const Unit& u, int wr, int wc, int fr, int fq) const {
        const int row0 = u.pm * BM + wr * 64 + fr, col0 = u.pn * BM + wc * 32 + 4 * fq;
#pragma unroll
        for (int ai = 0; ai < 2; ++ai)
#pragma unroll
            for (int m = 0; m < 4; ++m)
#pragma unroll
                for (int bj = 0; bj < 2; ++bj)
#pragma unroll
                    for (int n = 0; n < 2; ++n) f(row0 + ai * HALF + m * 16, col0 + bj * HALF + n * 16, acc[ai][bj][m][n]);
    }
};
template <class Epi>
__device__ __forceinline__ void gemm_phase(PG8_LAS unsigned char* lds, const Gemm g, const StaticOrder& S, const Epi& E) {
    const int tid = threadIdx.x, wid = __builtin_amdgcn_readfirstlane(tid >> 6), lane = tid & 63, wr = wid >> 2, wc = wid & 3, fr = lane & 15, fq = lane >> 4;
    int K = g.K; asm volatile("" : "+s"(K));
    const int nt = K / BK;
    unsigned voffA[2], voffB[2];
#pragma unroll
    for (int i = 0; i < 2; ++i) { int R, C; stage_rc(tid * 16 + i * 8192, R, C); voffA[i] = (unsigned)(R * K + C) * 2u; voffB[i] = (unsigned)(R * K + C) * 2u; }
    const size_t kstep = (size_t)(BK * 2);
    const size_t hstep = (size_t)HALF * K * 2;
    const size_t tstep = 2 * hstep;
    const unsigned ldsw = (unsigned)wid * 1024u;
    const int aoff = lds_byte(wr * 64 + fr, fq * 8), boff = lds_byte(wc * 32 + fr, fq * 8);
#define PG8_SA(b, h) (((b) * 2 + (h)) * HTB)
#define PG8_SB(b, h) ((4 + (b) * 2 + (h)) * HTB)
#define PG8_STAGE(bufoff, gbase, voff) do { _Pragma("unroll") for (int _i = 0; _i < 2; ++_i) \
        __builtin_amdgcn_global_load_lds((const unsigned*)((const char*)(gbase) + (voff)[_i]), (PG8_LAS unsigned*)(lds + (bufoff) + ldsw + _i * 8192), 16, 0, 0); } while (0)
#define PG8_LDA(dst, b, h) do { _Pragma("unroll") for (int m = 0; m < 4; ++m) _Pragma("unroll") for (int k = 0; k < 2; ++k) dst[m][k] = *(const PG8_LAS h16x8*)(lds + PG8_SA(b, h) + aoff + m * 2048 + k * 1024); } while (0)
#define PG8_LDB(dst, b, h) do { _Pragma("unroll") for (int n = 0; n < 2; ++n) _Pragma("unroll") for (int k = 0; k < 2; ++k) dst[n][k] = *(const PG8_LAS h16x8*)(lds + PG8_SB(b, h) + boff + n * 2048 + k * 1024); } while (0)
#define PG8_MMA(ai, bj, At, Bt) do { __builtin_amdgcn_s_setprio(1); _Pragma("unroll") for (int m = 0; m < 4; ++m) _Pragma("unroll") for (int n = 0; n < 2; ++n) _Pragma("unroll") for (int k = 0; k < 2; ++k) \
        acc[ai][bj][m][n] = __builtin_amdgcn_mfma_f32_16x16x32_f16(__builtin_bit_cast(f16x8, Bt[n][k]), __builtin_bit_cast(f16x8, At[m][k]), acc[ai][bj][m][n], 0, 0, 0); __builtin_amdgcn_s_setprio(0); } while (0)
#define PG8_WAIT_V(n) asm volatile("s_waitcnt vmcnt(" #n ")" ::: "memory")
#define PG8_WAIT_L(n) asm volatile("s_waitcnt lgkmcnt(" #n ")" ::: "memory")
#define PG8_BAR __builtin_amdgcn_s_barrier()
#define PG8_SCHED __builtin_amdgcn_sched_barrier(0)
    Unit cur, nxt; int ui = 0;
    if (!S.next(0, cur)) return;
    f32x4 acc[2][2][4][2];
#pragma unroll
    for (int a = 0; a < 2; ++a)
#pragma unroll
        for (int b = 0; b < 2; ++b)
#pragma unroll
            for (int m = 0; m < 4; ++m)
#pragma unroll
                for (int n = 0; n < 2; ++n) acc[a][b][m][n] = (f32x4){0.f, 0.f, 0.f, 0.f};
    h16x8 At[4][2], B0[2][2], B1[2][2];
    const char* cA = (const char*)g.A + (size_t)cur.pm * tstep; const char* cB = (const char*)g.Bt + (size_t)cur.pn * tstep;
    PG8_STAGE(PG8_SB(0, 0), cB, voffB); PG8_STAGE(PG8_SA(0, 0), cA, voffA); PG8_STAGE(PG8_SB(0, 1), cB + hstep, voffB); PG8_STAGE(PG8_SA(0, 1), cA + hstep, voffA);
    if (wr == 1) PG8_BAR;
    PG8_WAIT_V(4); PG8_BAR;
    PG8_STAGE(PG8_SB(1, 0), cB + kstep, voffB); PG8_STAGE(PG8_SA(1, 0), cA + kstep, voffA); PG8_STAGE(PG8_SB(1, 1), cB + hstep + kstep, voffB);
    PG8_WAIT_V(6); PG8_BAR;
    for (;;) {
        const bool has_next = S.next(ui + 1, nxt);
        const char* nA = has_next ? (const char*)g.A + (size_t)nxt.pm * tstep : cA; const char* nB = has_next ? (const char*)g.Bt + (size_t)nxt.pn * tstep : cB;
        for (int t = 0; t < nt; t += 2) {
            const bool last = (t == nt - 2);
            const char* a1 = cA + (size_t)(t + 1) * kstep;
            const char* a2 = last ? nA : cA + (size_t)(t + 2) * kstep; const char* b2 = last ? nB : cB + (size_t)(t + 2) * kstep;
            const char* a3 = a2 + kstep; const char* b3 = b2 + kstep;
            PG8_LDB(B0, 0, 0); PG8_SCHED; PG8_LDA(At, 0, 0); PG8_STAGE(PG8_SA(1, 1), a1 + hstep, voffA);
            PG8_WAIT_L(8); PG8_BAR; PG8_WAIT_L(0); PG8_MMA(0, 0, At, B0); PG8_BAR; PG8_SCHED;
            PG8_LDB(B1, 0, 1); PG8_STAGE(PG8_SB(0, 0), b2, voffB);
            PG8_BAR; PG8_WAIT_L(0); PG8_MMA(0, 1, At, B1); PG8_BAR;
            PG8_LDA(At, 0, 1); PG8_STAGE(PG8_SA(0, 0), a2, voffA);
            PG8_BAR; PG8_WAIT_L(0); PG8_MMA(1, 0, At, B0); PG8_BAR; PG8_SCHED;
            PG8_STAGE(PG8_SB(0, 1), b2 + hstep, voffB);
            PG8_WAIT_V(6); PG8_BAR; PG8_MMA(1, 1, At, B1); PG8_BAR;
            PG8_LDB(B0, 1, 0); PG8_SCHED; PG8_LDA(At, 1, 0); PG8_STAGE(PG8_SA(0, 1), a2 + hstep, voffA);
            PG8_WAIT_L(8); PG8_BAR; PG8_WAIT_L(0); PG8_MMA(0, 0, At, B0); PG8_BAR; PG8_SCHED;
            PG8_LDB(B1, 1, 1); PG8_STAGE(PG8_SB(1, 0), b3, voffB);
            PG8_BAR; PG8_WAIT_L(0); PG8_MMA(0, 1, At, B1); PG8_BAR;
            PG8_LDA(At, 1, 1); PG8_STAGE(PG8_SA(1, 0), a3, voffA);
            PG8_BAR; PG8_WAIT_L(0); PG8_MMA(1, 0, At, B0); PG8_BAR; PG8_SCHED;
            PG8_STAGE(PG8_SB(1, 1), b3 + hstep, voffB);
            PG8_WAIT_V(6); PG8_BAR; PG8_MMA(1, 1, At, B1); PG8_BAR;
        }
        E(acc, cur, wr, wc, fr, fq);
        if (!has_next) break;
#pragma unroll
        for (int a = 0; a < 2; ++a)
#pragma unroll
            for (int b = 0; b < 2; ++b)
#pragma unroll
                for (int m = 0; m < 4; ++m)
#pragma unroll
                    for (int n = 0; n < 2; ++n) acc[a][b][m][n] = (f32x4){0.f, 0.f, 0.f, 0.f};
        cur = nxt; cA = nA; cB = nB; ++ui;
    }
    PG8_WAIT_V(0);
    if (wr == 0) PG8_BAR;
    PG8_BAR;
#undef PG8_SA
#undef PG8_SB
#undef PG8_STAGE
#undef PG8_LDA
#undef PG8_LDB
#undef PG8_MMA
#undef PG8_WAIT_V
#undef PG8_WAIT_L
#undef PG8_BAR
#undef PG8_SCHED
}
template <class F>
__device__ __forceinline__ void run_gemm(unsigned char* lds, const f16* A, const f16* Bt, int M, int N, int K, const F& f) {
    Gemm g{A, Bt, M, N, K}; StaticOrder S; S.init(M, N, (int)gridDim.x, (int)blockIdx.x);
    EpiElem<F> E{f};
    gemm_phase<EpiElem<F>>((PG8_LAS unsigned char*)lds, g, S, E);
    __syncthreads();
}
}

__device__ __forceinline__ f16x4 to_h4(f32x4 v) { f16x4 r; r.x = (f16)v.x; r.y = (f16)v.y; r.z = (f16)v.z; r.w = (f16)v.w; return r; }

__device__ __forceinline__ void tr_item(const float* W, int ldw, int col0, int nvalid, int K, f16* out, int nrow0, int item, int nblk, float* scr, int lane) {
    const int kb = item / nblk, nb = item % nblk, k0 = 64 * kb, n0 = 32 * nb;
#pragma unroll 8
    for (int i = 0; i < 32; ++i) { const int kk = 2 * i + (lane >> 5); const int j = n0 + (lane & 31);
        scr[kk * 33 + (lane & 31)] = (j < nvalid) ? W[(size_t)(k0 + kk) * ldw + col0 + j] : 0.f; }
    asm volatile("s_waitcnt vmcnt(0) lgkmcnt(0)" ::: "memory");
    const int c = lane & 7;
#pragma unroll
    for (int jj = 0; jj < 4; ++jj) { const int n = (lane >> 3) + 8 * jj; const float* s = scr + (8 * c) * 33 + n;
        f16x8 o;
#pragma unroll
        for (int e = 0; e < 8; ++e) o[e] = (f16)s[e * 33];
        *(f16x8*)(out + (size_t)(nrow0 + n0 + n) * K + k0 + 8 * c) = o; }
    asm volatile("s_waitcnt lgkmcnt(0)" ::: "memory");
}

__device__ __forceinline__ void ph0_prep(const Params& p, unsigned char* lds) {
    const int tid = threadIdx.x, lane = tid & 63, wave = tid >> 6;
    const int gw = blockIdx.x * 8 + wave, NGW = gridDim.x * 8;
    f16* H0 = (f16*)(p.ws + WS_H0); float* STAT = (float*)(p.ws + WS_STAT);
    for (int m = gw; m < MR; m += NGW) {
        f16* orow = H0 + (size_t)m * D;
        if (m >= MREAL + 2 * NMETA) {
#pragma unroll
            for (int j = 0; j < 4; ++j) *(f16x4*)(orow + j * 256 + lane * 4) = (f16x4){(f16)0.f, (f16)0.f, (f16)0.f, (f16)0.f};
            continue;
        }
        const float* src = (m < MREAL) ? p.x + (size_t)m * D : p.meta + (size_t)((m - MREAL) & 15) * D;
        f32x4 v[4]; float s = 0.f;
#pragma unroll
        for (int j = 0; j < 4; ++j) { v[j] = *(const f32x4*)(src + j * 256 + lane * 4); s += (v[j].x + v[j].y) + (v[j].z + v[j].w); }
        const float mean = wave_sum(s) * (1.f / D); float s2 = 0.f;
#pragma unroll
        for (int j = 0; j < 4; ++j) { v[j] = v[j] - mean; s2 += (v[j].x * v[j].x + v[j].y * v[j].y) + (v[j].z * v[j].z + v[j].w * v[j].w); }
        const float rstd = 1.f / sqrtf(wave_sum(s2) * (1.f / D) + LN_EPS);
        if (lane == 0) { STAT[2 * m] = mean; STAT[2 * m + 1] = rstd; }
#pragma unroll
        for (int j = 0; j < 4; ++j) { const f32x4 g = *(const f32x4*)(p.ln_in_g + j * 256 + lane * 4), bb = *(const f32x4*)(p.ln_in_b + j * 256 + lane * 4);
            *(f16x4*)(orow + j * 256 + lane * 4) = to_h4(v[j] * rstd * g + bb); }
    }
    float* scr = (float*)lds + wave * (64 * 33);
    f16* W1T = (f16*)(p.ws + WS_W1T); f16* WGT = (f16*)(p.ws + WS_WGT); f16* WPBT = (f16*)(p.ws + WS_WPBT); f16* WOT = (f16*)(p.ws + WS_WOT);
    constexpr int I_QI = 16 * 16, I_CKV = 4 * 16, I_KI = 4 * 16, I_BC = 56 * 16, I_G = 64 * 16, I_PB = 32 * 8, I_O = 32 * 16;
    constexpr int NITEMS = I_QI + I_CKV + I_KI + I_BC + I_G + I_PB + I_O;
    for (int it = gw; it < NITEMS; it += NGW) {
        int r = it;
        if (r < I_QI) { tr_item(p.w_in, NIN, 640, 512, D, W1T, C_QI, r, 16, scr, lane); continue; } r -= I_QI;
        if (r < I_CKV) { tr_item(p.w_in, NIN, 512, 128, D, W1T, C_CKV, r, 4, scr, lane); continue; } r -= I_CKV;
        if (r < I_KI) { tr_item(p.w_in, NIN, 1152, 72, D, W1T, C_KI, r, 4, scr, lane); continue; } r -= I_KI;
        if (r < I_BC) { tr_item(p.w_in, NIN, 1224, 1792, D, W1T, C_BC, r, 56, scr, lane); continue; } r -= I_BC;
        if (r < I_G) { tr_item(p.w_in, NIN, 3016, 2048, D, WGT, 0, r, 64, scr, lane); continue; } r -= I_G;
        if (r < I_PB) { tr_item(p.w_pb, D, 0, 1024, 512, WPBT, 0, r, 32, scr, lane); continue; } r -= I_PB;
        tr_item(p.w_o, D, 0, 1024, D, WOT, 0, r, 32, scr, lane);
    }
    {
        const int fr = lane & 15, fq = lane >> 4;
        constexpr int T_W1 = 8 * 8 * 64, T_SK = 16 * 8 * 64, T_PA = 8 * 8 * 64;
        f16* WPAT = (f16*)(p.ws + WS_WPAT); f16* WSKT = (f16*)(p.ws + WS_WSKT);
        for (int it = gw; it < T_W1 + T_SK + T_PA; it += NGW) {
            int r = it; int kind = 0; if (r >= T_W1) { r -= T_W1; kind = 1; if (r >= T_SK) { r -= T_SK; kind = 2; } }
            const int g = r >> 9, mt = (r >> 6) & 7, nt = r & 63;
            const int m = 16 * mt + fr, n = 16 * nt + fr;
            const int KK = (kind == 1) ? 128 : 64;
            f32x4 acc = {0.f, 0.f, 0.f, 0.f};
            for (int k0 = 0; k0 < KK; k0 += 32) {
                const int kb = k0 + 8 * fq;
                f16x8 af, bf;
                if (kind == 0) { const float* ap = p.a_w_uk + (size_t)(m * 8 + g) * 64 + kb; const float* bp = p.w_in + (size_t)n * NIN + g * 64 + kb;
                    const f32x4 a0 = *(const f32x4*)ap, a1 = *(const f32x4*)(ap + 4), b0 = *(const f32x4*)bp, b1 = *(const f32x4*)(bp + 4);
#pragma unroll
                    for (int e = 0; e < 4; ++e) { af[e] = (f16)a0[e]; af[4 + e] = (f16)a1[e]; bf[e] = (f16)b0[e]; bf[4 + e] = (f16)b1[e]; } }
                else if (kind == 1) { const float* ap = p.peer_subkeys + (size_t)(g * 128 + m) * 128 + kb; const float* bp = p.peer_wq + (size_t)n * 2048 + g * 128 + kb;
                    const f32x4 a0 = *(const f32x4*)ap, a1 = *(const f32x4*)(ap + 4), b0 = *(const f32x4*)bp, b1 = *(const f32x4*)(bp + 4);
#pragma unroll
                    for (int e = 0; e < 4; ++e) { af[e] = (f16)a0[e]; af[4 + e] = (f16)a1[e]; bf[e] = (f16)b0[e]; bf[4 + e] = (f16)b1[e]; } }
                else { const float* ap = p.a_w_uv + (size_t)(m * 8 + g) * 64 + kb; const float* bp = p.w_pa + (size_t)(g * 64 + kb) * D + n;
                    const f32x4 a0 = *(const f32x4*)ap, a1 = *(const f32x4*)(ap + 4);
#pragma unroll
                    for (int e = 0; e < 4; ++e) { af[e] = (f16)a0[e]; af[4 + e] = (f16)a1[e]; }
#pragma unroll
                    for (int e = 0; e < 8; ++e) bf[e] = (f16)bp[(size_t)e * D]; }
                acc = __builtin_amdgcn_mfma_f32_16x16x32_f16(af, bf, acc, 0, 0, 0);
            }
            if (kind == 2) { *(f16x4*)(WPAT + (size_t)n * D + g * 128 + 16 * mt + 4 * fq) = to_h4(acc); }
            else { f16* o = ((kind == 0) ? W1T : WSKT) + (size_t)(g * 128 + 16 * mt + 4 * fq) * D + n;
#pragma unroll
                for (int e = 0; e < 4; ++e) o[(size_t)e * D] = (f16)acc[e]; }
        }
    }
    const long gt = (long)blockIdx.x * NT + tid, NGT = (long)gridDim.x * NT;
    f16* WLT = (f16*)(p.ws + WS_WLT);
    for (long e = gt; e < 1536L * 256; e += NGT) { const int n = (int)(e >> 8), k = (int)(e & 255); float v = 0.f;
        if (n < 512) { if (k < 64) v = p.b_w2[(size_t)k * 512 + n]; }
        else if (n < 1024) { if (k >= 64 && k < 128) v = p.b_a2[(size_t)(k - 64) * 512 + (n - 512)]; }
        else { if (k >= 128) v = p.b_g2[(size_t)(k - 128) * 512 + (n - 1024)]; }
        WLT[e] = (f16)v; }
}

__device__ __forceinline__ void phc1_rowprep(const Params& p) {
    const int tid = threadIdx.x, lane = tid & 63, wave = tid >> 6;
    const int gw = blockIdx.x * 8 + wave, NGW = gridDim.x * 8;
    const f16* PB = (const f16*)(p.ws + WS_PB); f16* CKV = (f16*)(p.ws + WS_CKV); f16* KIDX = (f16*)(p.ws + WS_KIDX); float* WIS = (float*)(p.ws + WS_WIS);
    f16* LORAIN = (f16*)((unsigned char*)p.out + DO_LORAIN);
    for (int m = gw; m < MR; m += NGW) {
        if (m >= MREAL + 2 * NMETA) { *(f16x4*)(LORAIN + (size_t)m * 256 + lane * 4) = (f16x4){(f16)0.f, (f16)0.f, (f16)0.f, (f16)0.f}; continue; }
        const f16* pr = PB + (size_t)m * N1;
        { const f16x2 c2 = *(const f16x2*)(pr + C_CKV + 2 * lane); const float a = (float)c2.x, b = (float)c2.y;
          const float ss = wave_sum(a * a + b * b); const float r = 1.f / sqrtf(ss * (1.f / 128.f) + 1e-6f);
          f16x2 o; o.x = (f16)(a * r * p.a_kv_norm_g[2 * lane]); o.y = (f16)(b * r * p.a_kv_norm_g[2 * lane + 1]);
          *(f16x2*)(CKV + (size_t)m * 128 + 2 * lane) = o; }
        { const float a = (float)pr[C_KI + lane]; const float mu = wave_sum(a) * (1.f / 64.f); const float d = a - mu;
          const float var = wave_sum(d * d) * (1.f / 64.f);
          KIDX[(size_t)m * 64 + lane] = (f16)(d * (1.f / sqrtf(var + LN_EPS)) * p.a_kidx_g[lane] + p.a_kidx_b[lane]); }
        if (lane < 8) WIS[(size_t)m * 8 + lane] = (float)pr[C_WI + lane] * 0.04419417382415922f;
        { int b, t; if (m < MREAL) { b = m >> 13; t = NMETA + (m & 8191); } else { b = (m - MREAL) >> 4; t = (m - MREAL) & 15; }
          const f16x4 cur = *(const f16x4*)(pr + C_BC + 1536 + lane * 4);
          f16x4 prv = (f16x4){(f16)0.f, (f16)0.f, (f16)0.f, (f16)0.f};
          if (t > 0) prv = *(const f16x4*)(PB + (size_t)row_of(b, t - 1) * N1 + C_BC + 1536 + lane * 4);
          const f32x4 mu = *(const f32x4*)(p.b_mu + 1536 + lane * 4);
          f16x4 o;
#pragma unroll
          for (int e = 0; e < 4; ++e) { const float c = (float)cur[e], q = (float)prv[e]; float xs = c + (q - c) * mu[e];
              const int j = lane * 4 + e; if (j < 64) xs = tanhf(xs); else if (j >= 128) xs = sigmoidf_(xs); o[e] = (f16)xs; }
          *(f16x4*)(LORAIN + (size_t)m * 256 + lane * 4) = o; }
    }
}

typedef short bf16x8 __attribute__((ext_vector_type(8)));
typedef unsigned short bf16_t;
typedef unsigned u32x2 __attribute__((ext_vector_type(2)));
typedef __bf16 bf16x2_t __attribute__((ext_vector_type(2)));
__device__ __forceinline__ unsigned cvt_pk_bf16(float lo, float hi) { const f32x2 v = {lo, hi}; const bf16x2_t b = __builtin_convertvector(v, bf16x2_t); return __builtin_bit_cast(unsigned, b); }
__device__ __forceinline__ bf16_t f2bf(float f) { unsigned u = __float_as_uint(f); return (bf16_t)((u + 0x7fffu + ((u >> 16) & 1u)) >> 16); }
__device__ __forceinline__ u32x2 pk4(f32x4 v) { u32x2 r; r.x = cvt_pk_bf16(v[0], v[1]); r.y = cvt_pk_bf16(v[2], v[3]); return r; }
__device__ __forceinline__ bf16x8 pk8(f32x4 a, f32x4 b) { u32x4 r; r.x = cvt_pk_bf16(a[0], a[1]); r.y = cvt_pk_bf16(a[2], a[3]); r.z = cvt_pk_bf16(b[0], b[1]); r.w = cvt_pk_bf16(b[2], b[3]); return __builtin_bit_cast(bf16x8, r); }
#define MFMA_BF(a, b, c) __builtin_amdgcn_mfma_f32_16x16x32_bf16((a), (b), (c), 0, 0, 0)
constexpr int RS = 72, PSt = 40, FS = 36, YS = 68;
__device__ __forceinline__ void rwkv_item(const Params& p, int b, int h, unsigned char* lds) {
    int tid_ = threadIdx.x; asm volatile("" : "+v"(tid_));
    const int tid = tid_, lane = tid & 63, wave = __builtin_amdgcn_readfirstlane(tid >> 6), fr = lane & 15, fq = lane >> 4;
    const f16* PB = (const f16*)(p.ws + WS_PB);
    const f16* LW = (const f16*)((unsigned char*)p.out + DO_LW); const f16* AA = (const f16*)((unsigned char*)p.out + DO_AA); const f16* GG = (const f16*)((unsigned char*)p.out + DO_GG);
    f16* OB = (f16*)(p.ws + WS_OB);
    bf16_t* sAt = (bf16_t*)lds; bf16_t* sRt = sAt + 32 * RS; bf16_t* sBt = sRt + 32 * RS; bf16_t* sKt = sBt + 32 * RS;
    bf16_t* sBPT = sKt + 32 * RS; bf16_t* sKPT = sBPT + 64 * PSt; bf16_t* sVT = sKPT + 64 * PSt;
    bf16_t* sAak = sVT + 64 * PSt; bf16_t* sMrb = sAak + 32 * PSt; bf16_t* sMrk = sMrb + 32 * PSt; bf16_t* sT = sMrk + 32 * PSt; bf16_t* sAabB = sT + 32 * PSt;
    float* sAabT = (float*)(sAabB + 16 * PSt); float* sTot = sAabT + 2 * 16 * FS; float* sPL = sTot + 8 * 64; float* sY = sPL + 64;
    float* sEnd = sY + 32 * YS;
    float* sCst = sEnd;
    for (unsigned* z = (unsigned*)lds + tid; z < (unsigned*)sEnd; z += NT) *z = 0u;
    const int ps = tid >> 4, cg = tid & 15, c4 = cg * 4, hc = h * 64 + c4;
    const int chslot = 32 * (cg >> 3) + 8 * (cg & 3) + 4 * ((cg >> 2) & 1);
    const int pslot = 8 * ((ps & 15) >> 2) + 4 * (ps >> 4) + (ps & 3);
    if (tid < 64) { sCst[tid] = p.b_mu[h * 64 + tid]; sCst[64 + tid] = p.b_mu[512 + h * 64 + tid]; sCst[128 + tid] = p.b_mu[1024 + h * 64 + tid]; sCst[192 + tid] = p.b_k_k[h * 64 + tid];
        sCst[256 + tid] = p.b_k_a[h * 64 + tid]; sCst[320 + tid] = p.b_r_k[h * 64 + tid]; sCst[384 + tid] = p.b_lnx_g[h * 64 + tid]; sCst[448 + tid] = p.b_lnx_b[h * 64 + tid]; }
    f32x4 Hacc[4];
#pragma unroll
    for (int i = 0; i < 4; ++i) Hacc[i] = (f32x4){0.f, 0.f, 0.f, 0.f};
    const f16x4 hz = (f16x4){(f16)0.f, (f16)0.f, (f16)0.f, (f16)0.f};
    f16x4 n_cr = hz, n_ck = hz, n_cv = hz, n_qr = hz, n_qk = hz, n_qv = hz, n_lw = hz, n_aa = hz, n_gg = hz;
#define RW_PREFETCH(tt) do { const int _t = (tt); n_cr = hz; n_ck = hz; n_cv = hz; n_qr = hz; n_qk = hz; n_qv = hz; n_lw = hz; n_aa = hz; n_gg = hz; \
        if (_t < TT) { const int _m = row_of(b, _t); const f16* _pr = PB + (size_t)_m * N1 + C_BC + hc; n_cr = *(const f16x4*)(_pr); n_ck = *(const f16x4*)(_pr + 512); n_cv = *(const f16x4*)(_pr + 1024); \
            if (_t > 0) { const f16* _pp = PB + (size_t)row_of(b, _t - 1) * N1 + C_BC + hc; n_qr = *(const f16x4*)(_pp); n_qk = *(const f16x4*)(_pp + 512); n_qv = *(const f16x4*)(_pp + 1024); } \
            n_lw = *(const f16x4*)(LW + (size_t)_m * 512 + hc); n_aa = *(const f16x4*)(AA + (size_t)_m * 512 + hc); n_gg = *(const f16x4*)(GG + (size_t)_m * 512 + hc); } } while (0)
    RW_PREFETCH(ps);
    __syncthreads();
    f32x4 pv4 = {0, 0, 0, 0}, pg4 = pv4; float pbo = 0.f; int pt = -1;
    for (int t0 = 0; t0 < TT + 32; t0 += 32) {
        if (t0 > 0) {
            const f32x4 y4 = *(const f32x4*)(sY + ps * YS + c4); const f32x4 lng = *(const f32x4*)(sCst + 384 + c4), lnb = *(const f32x4*)(sCst + 448 + c4);
            const float mean = row16_sum((y4[0] + y4[1]) + (y4[2] + y4[3])) * (1.f / 64.f);
            float q = 0.f;
#pragma unroll
            for (int e = 0; e < 4; ++e) { const float d = y4[e] - mean; q += d * d; }
            const float rstd = __builtin_amdgcn_rsqf(row16_sum(q) * (1.f / 64.f) + 64e-5f);
            if (pt < TT && pt >= NMETA) {
                f16x4 o;
#pragma unroll
                for (int e = 0; e < 4; ++e) o[e] = (f16)((((y4[e] - mean) * rstd) * lng[e] + lnb[e] + pbo * pv4[e]) * pg4[e]);
                *(f16x4*)(OB + (size_t)(b * SEQ + (pt - NMETA)) * 512 + hc) = o;
            }
        }
        if (t0 >= TT) break;
        const int t = t0 + ps;
        f32x4 r4 = {0, 0, 0, 0}, k4 = r4, v4 = r4, kk4 = r4, a4 = r4, g4 = r4, lw4 = r4;
        f32x4 rkw;
        {
            const f16x4 cr = n_cr, ck = n_ck, cv = n_cv, qr = n_qr, qk = n_qk, qv = n_qv, lw = n_lw, aa = n_aa, gg = n_gg;
            RW_PREFETCH(t + 32);
            const f32x4 mu_r = *(const f32x4*)(sCst + c4), mu_k = *(const f32x4*)(sCst + 64 + c4), mu_v = *(const f32x4*)(sCst + 128 + c4), kkw = *(const f32x4*)(sCst + 192 + c4), kaw = *(const f32x4*)(sCst + 256 + c4);
            rkw = *(const f32x4*)(sCst + 320 + c4);
#pragma unroll
            for (int e = 0; e < 4; ++e) {
                const float c0 = (float)cr[e], c1 = (float)ck[e], c2 = (float)cv[e];
                r4[e] = c0 + ((float)qr[e] - c0) * mu_r[e];
                const float k0 = c1 + ((float)qk[e] - c1) * mu_k[e];
                v4[e] = c2 + ((float)qv[e] - c2) * mu_v[e];
                a4[e] = (float)aa[e]; lw4[e] = (float)lw[e]; g4[e] = (float)gg[e];
                kk4[e] = k0 * kkw[e];
                k4[e] = k0 * (1.f + (a4[e] - 1.f) * kaw[e]);
            }
        }
        float ss = kk4[0] * kk4[0] + kk4[1] * kk4[1] + kk4[2] * kk4[2] + kk4[3] * kk4[3];
        float bo = r4[0] * k4[0] * rkw[0] + r4[1] * k4[1] * rkw[1] + r4[2] * k4[2] * rkw[2] + r4[3] * k4[3] * rkw[3];
        ss = row16_sum(ss); bo = row16_sum(bo);
        pv4 = v4; pg4 = g4; pbo = bo; pt = t;
        const float rn = __builtin_amdgcn_rsqf(ss + 1e-12f);
        f32x4 bb4;
#pragma unroll
        for (int e = 0; e < 4; ++e) { kk4[e] *= rn; bb4[e] = kk4[e] * a4[e]; }
        f32x4 cum = lw4;
        { f32x4 u1;
#pragma unroll
          for (int e = 0; e < 4; ++e) u1[e] = __shfl_up(cum[e], 16);
          if (lane >= 16) cum += u1;
#pragma unroll
          for (int e = 0; e < 4; ++e) u1[e] = __shfl_up(cum[e], 32);
          if (lane >= 32) cum += u1; }
        if (lane >= 48) *(f32x4*)(sTot + wave * 64 + c4) = cum;
        __syncthreads();
        f32x4 tot = {0, 0, 0, 0};
        { f32x4 tw[8];
#pragma unroll
          for (int w = 0; w < 8; ++w) tw[w] = *(const f32x4*)(sTot + w * 64 + c4);
          __builtin_amdgcn_sched_barrier(0);
#pragma unroll
          for (int w = 0; w < 8; ++w) { tot += tw[w]; const float msk = (w < wave) ? 1.f : 0.f; cum += tw[w] * msk; } }
        {
            f32x4 xa, xb, xk, xr, xbp, xkp;
#pragma unroll
            for (int e = 0; e < 4; ++e) { const float e1 = __expf(cum[e]), e2 = __expf(-cum[e]), e3 = __expf(cum[e] - lw4[e]), e4 = __expf(tot[e] - cum[e]);
                xa[e] = -kk4[e] * e3; xb[e] = bb4[e] * e2; xk[e] = k4[e] * e2; xr[e] = r4[e] * e1; xbp[e] = bb4[e] * e4; xkp[e] = k4[e] * e4; }
            *(u32x2*)(sAt + ps * RS + chslot) = pk4(xa); *(u32x2*)(sBt + ps * RS + chslot) = pk4(xb); *(u32x2*)(sKt + ps * RS + chslot) = pk4(xk); *(u32x2*)(sRt + ps * RS + chslot) = pk4(xr);
#pragma unroll
            for (int e = 0; e < 4; ++e) { sBPT[(c4 + e) * PSt + pslot] = f2bf(xbp[e]); sKPT[(c4 + e) * PSt + pslot] = f2bf(xkp[e]); sVT[(c4 + e) * PSt + pslot] = f2bf(v4[e]); }
            if (ps == 0) { f32x4 pl;
#pragma unroll
                for (int e = 0; e < 4; ++e) pl[e] = __expf(tot[e]);
                *(f32x4*)(sPL + c4) = pl; }
        }
        __syncthreads();
        for (int jb = wave; jb < 12; jb += 8) {
            const bf16_t *Ab, *Bb; int ta, tb;
            if (jb < 2) { ta = jb; tb = jb; Ab = sAt; Bb = sBt; }
            else if (jb == 2) { ta = 0; tb = 1; Ab = sBt; Bb = sAt; }
            else { const int ti = (jb - 3) % 3, prod = (jb - 3) / 3; ta = (ti == 2) ? 1 : 0; tb = (ti >= 1) ? 1 : 0; Ab = (prod == 1) ? sBt : sKt; Bb = (prod == 0) ? sAt : sRt; }
            f32x4 acc = {0, 0, 0, 0};
#pragma unroll
            for (int ks = 0; ks < 2; ++ks) { const bf16x8 a = *(const bf16x8*)(Ab + (16 * ta + fr) * RS + 32 * ks + 8 * fq); const bf16x8 bq = *(const bf16x8*)(Bb + (16 * tb + fr) * RS + 32 * ks + 8 * fq); acc = MFMA_BF(a, bq, acc); }
            const int rloc = 4 * fq, cloc = fr;
            if (jb < 2) {
#pragma unroll
                for (int e = 0; e < 4; ++e) acc[e] = (cloc < rloc + e) ? acc[e] : 0.f;
                *(f32x4*)(sAabT + jb * 16 * FS + cloc * FS + rloc) = acc;
                asm volatile("s_waitcnt lgkmcnt(0)" ::: "memory");
                if (lane < 16) {
                    const int col = lane;
                    const float* At_ = sAabT + jb * 16 * FS;
                    float x[16];
#pragma unroll
                    for (int s2 = 0; s2 < 16; ++s2) x[s2] = (s2 == col) ? 1.f : 0.f;
#define RW_INV_BATCH(J0, J1) do { f32x4 cv_[(J1) - (J0)][4]; \
                    _Pragma("unroll") for (int j = (J0); j < (J1); ++j) _Pragma("unroll") for (int q4 = (j + 1) / 4; q4 < 4; ++q4) cv_[j - (J0)][q4] = *(const f32x4*)(At_ + j * FS + 4 * q4); \
                    __builtin_amdgcn_sched_barrier(0); \
                    _Pragma("unroll") for (int j = (J0); j < (J1); ++j) { const float xj = x[j]; \
                        _Pragma("unroll") for (int q4 = (j + 1) / 4; q4 < 4; ++q4) _Pragma("unroll") for (int e = 0; e < 4; ++e) if (4 * q4 + e > j) x[4 * q4 + e] += cv_[j - (J0)][q4][e] * xj; } \
                    __builtin_amdgcn_sched_barrier(0); } while (0)
                    RW_INV_BATCH(0, 3); RW_INV_BATCH(3, 7); RW_INV_BATCH(7, 15);
#pragma unroll
                    for (int s2 = 0; s2 < 16; ++s2) sT[(16 * jb + s2) * PSt + 8 * (col >> 2) + (col & 3)] = f2bf(x[s2]);
                }
            } else if (jb == 2) {
                *(u32x2*)(sAabB + cloc * PSt + 8 * fq) = pk4(acc);
            } else {
                const int prod = (jb - 3) / 3; const int jrow = 16 * ta + rloc, scol = 16 * tb + cloc;
                if (prod == 0) {
#pragma unroll
                    for (int e = 0; e < 4; ++e) acc[e] = (jrow + e < scol) ? acc[e] : 0.f;
                } else {
#pragma unroll
                    for (int e = 0; e < 4; ++e) acc[e] = (jrow + e <= scol) ? acc[e] : 0.f;
                }
                *(u32x2*)(((prod == 0) ? sAak : (prod == 1) ? sMrb : sMrk) + scol * PSt + 8 * fq + 4 * ta) = pk4(acc);
            }
        }
        __syncthreads();
        if (wave < 4) {
            const int v0 = 16 * wave;
            const f32x4 z4 = {0.f, 0.f, 0.f, 0.f};
            const bf16x8 hb0 = pk8(Hacc[0], Hacc[1]), hb1 = pk8(Hacc[2], Hacc[3]);
            const bf16x8 vb = *(const bf16x8*)(sVT + (v0 + fr) * PSt + 8 * fq);
            bf16x8 fAt[2][2], fAak[2], fT[2], fAabB;
#pragma unroll
            for (int ts = 0; ts < 2; ++ts) { const bf16_t* atr = sAt + (16 * ts + fr) * RS;
                fAt[ts][0] = *(const bf16x8*)(atr + 8 * fq); fAt[ts][1] = *(const bf16x8*)(atr + 32 + 8 * fq); fAak[ts] = *(const bf16x8*)(sAak + (16 * ts + fr) * PSt + 8 * fq); fT[ts] = *(const bf16x8*)(sT + (16 * ts + fr) * PSt + 8 * fq); }
            fAabB = *(const bf16x8*)(sAabB + fr * PSt + 8 * fq);
            __builtin_amdgcn_sched_barrier(0);
            f32x4 zt = MFMA_BF(fAt[0][0], hb0, z4); zt = MFMA_BF(fAt[0][1], hb1, zt); zt = MFMA_BF(fAak[0], vb, zt);
            f32x4 zb = MFMA_BF(fAt[1][0], hb0, z4); zb = MFMA_BF(fAt[1][1], hb1, zb); zb = MFMA_BF(fAak[1], vb, zb);
            bf16x8 fRt[2][2], fMrk[2], fMrb[2];
#pragma unroll
            for (int ts = 0; ts < 2; ++ts) { const bf16_t* rtr = sRt + (16 * ts + fr) * RS;
                fRt[ts][0] = *(const bf16x8*)(rtr + 8 * fq); fRt[ts][1] = *(const bf16x8*)(rtr + 32 + 8 * fq);
                fMrk[ts] = *(const bf16x8*)(sMrk + (16 * ts + fr) * PSt + 8 * fq); fMrb[ts] = *(const bf16x8*)(sMrb + (16 * ts + fr) * PSt + 8 * fq); }
            __builtin_amdgcn_sched_barrier(0);
            const f32x4 ut = MFMA_BF(fT[0], pk8(zt, z4), z4);
            zb = MFMA_BF(fAabB, pk8(ut, z4), zb);
            const f32x4 ubt = MFMA_BF(fT[1], pk8(zb, z4), z4);
            const bf16x8 ub = pk8(ut, ubt);
            bf16x8 fBP[4], fKP[4]; f32x4 fPL[4];
#pragma unroll
            for (int tc = 0; tc < 4; ++tc) { fBP[tc] = *(const bf16x8*)(sBPT + (16 * tc + fr) * PSt + 8 * fq); fKP[tc] = *(const bf16x8*)(sKPT + (16 * tc + fr) * PSt + 8 * fq); fPL[tc] = *(const f32x4*)(sPL + 16 * tc + 4 * fq); }
            __builtin_amdgcn_sched_barrier(0);
#pragma unroll
            for (int ts = 0; ts < 2; ++ts) {
                f32x4 acc = MFMA_BF(fRt[ts][0], hb0, z4);
                acc = MFMA_BF(fRt[ts][1], hb1, acc);
                acc = MFMA_BF(fMrk[ts], vb, acc);
                acc = MFMA_BF(fMrb[ts], ub, acc);
#pragma unroll
                for (int e = 0; e < 4; ++e) sY[(16 * ts + 4 * fq + e) * YS + v0 + fr] = acc[e]; }
#pragma unroll
            for (int tc = 0; tc < 4; ++tc) {
                f32x4 acc = Hacc[tc] * fPL[tc];
                acc = MFMA_BF(fBP[tc], ub, acc);
                acc = MFMA_BF(fKP[tc], vb, acc);
                Hacc[tc] = acc; }
        }
        __syncthreads();
    }
    __syncthreads();
}

constexpr int SCW = 8224;
__device__ __forceinline__ void dsa_item(const Params& p, int b, int g, unsigned char* lds) {
    int tid_ = threadIdx.x; asm volatile("" : "+v"(tid_));
    const int tid = tid_, lane = tid & 63, wave = __builtin_amdgcn_readfirstlane(tid >> 6);
    const f16* PB = (const f16*)(p.ws + WS_PB); const f16* CKV = (const f16*)(p.ws + WS_CKV); const f16* KIDX = (const f16*)(p.ws + WS_KIDX); const float* WIS = (const float*)(p.ws + WS_WIS);
    f16* OLAT = (f16*)(p.ws + WS_OLAT);
    float* sc = (float*)lds;
    unsigned* hist = (unsigned*)(lds + 4 * SCW * 4);
    unsigned short* sel = (unsigned short*)(lds + 4 * SCW * 4 + 4096);
    unsigned* misc = (unsigned*)(lds + 4 * SCW * 4 + 4096 + 2048);
    f16* sq = (f16*)(lds + 4 * SCW * 4 + 4096 + 2048 + 256);
    const int i0 = 4 * g, n_adm = 80 + 64 * (i0 >> 6), ntile = (n_adm + 31) >> 5;
    const int mq0 = b * SEQ + i0;
    {
        const int rho = lane & 31, q = rho >> 3, hd = rho & 7, hh = lane >> 5;
        const f16* qip = PB + (size_t)(mq0 + q) * N1 + C_QI + hd * 64 + 8 * hh;
        f16x8 af[4];
#pragma unroll
        for (int ks = 0; ks < 4; ++ks) af[ks] = *(const f16x8*)(qip + 16 * ks);
        float wsc[16];
#pragma unroll
        for (int j = 0; j < 16; ++j) wsc[j] = WIS[(size_t)(mq0 + (j >> 2)) * 8 + (j & 3) + 4 * hh];
        f16x8 bn[4];
        { const f16* kp = KIDX + (size_t)row_of(b, wave * 32 + (lane & 31)) * 64 + 8 * hh;
#pragma unroll
          for (int ks = 0; ks < 4; ++ks) bn[ks] = *(const f16x8*)(kp + 16 * ks); }
        for (int kt = wave; kt < ntile; kt += 8) {
            const int key = kt * 32 + (lane & 31);
            f16x8 bf[4];
#pragma unroll
            for (int ks = 0; ks < 4; ++ks) bf[ks] = bn[ks];
            { const int kn = (kt + 8 < ntile) ? kt + 8 : kt;
              const f16* kp = KIDX + (size_t)row_of(b, kn * 32 + (lane & 31)) * 64 + 8 * hh;
#pragma unroll
              for (int ks = 0; ks < 4; ++ks) bn[ks] = *(const f16x8*)(kp + 16 * ks); }
            f32x16 acc;
#pragma unroll
            for (int j = 0; j < 16; ++j) acc[j] = 0.f;
#pragma unroll
            for (int ks = 0; ks < 4; ++ks) acc = __builtin_amdgcn_mfma_f32_32x32x16_f16(af[ks], bf[ks], acc, 0, 0, 0);
            float s4[4];
#pragma unroll
            for (int qq = 0; qq < 4; ++qq) { float s = 0.f;
#pragma unroll
                for (int jj = 0; jj < 4; ++jj) s += wsc[4 * qq + jj] * fmaxf(acc[4 * qq + jj], 0.f);
                s += __shfl_xor(s, 32); s4[qq] = s; }
            if (lane < 32) {
#pragma unroll
                for (int qq = 0; qq < 4; ++qq) sc[qq * SCW + key] = s4[qq]; }
        }
        *(f16x8*)(sq + tid * 8) = *(const f16x8*)(PB + (size_t)(mq0 + (tid >> 7)) * N1 + C_QABS + (tid & 127) * 8);
    }
    __syncthreads();
    const int qs = tid >> 7, tl = tid & 127;
    int nsel;
    {
        const float* scq = sc + qs * SCW;
        if (n_adm <= 256) { for (int idx = tl; idx < n_adm; idx += 128) sel[qs * 256 + idx] = (unsigned short)idx; nsel = n_adm; }
        else {
            constexpr int NK = 65;
            unsigned kreg[NK];
            float lmin = INFINITY, lmax = -INFINITY;
#pragma unroll
            for (int i = 0; i < NK; ++i) { const int idx = tl + 128 * i; const float v = (idx < n_adm) ? scq[idx] : 0.f; kreg[i] = __float_as_uint(v); if (idx < n_adm) { lmin = fminf(lmin, v); lmax = fmaxf(lmax, v); } }
#pragma unroll
            for (int o = 1; o < 64; o <<= 1) { lmin = fminf(lmin, __shfl_xor(lmin, o)); lmax = fmaxf(lmax, __shfl_xor(lmax, o)); }
            float* mm = (float*)(misc + 32);
            if ((tid & 63) == 0) { mm[(qs * 2 + ((tid >> 6) & 1)) * 2] = lmin; mm[(qs * 2 + ((tid >> 6) & 1)) * 2 + 1] = lmax; }
            hist[qs * 256 + tl] = 0u; hist[qs * 256 + 128 + tl] = 0u;
            __syncthreads();
            const float lo = fminf(mm[qs * 4], mm[qs * 4 + 2]), hi = fmaxf(mm[qs * 4 + 1], mm[qs * 4 + 3]);
            const float scale = (hi > lo) ? 16777215.f / (hi - lo) : 0.f;
#pragma unroll
            for (int i = 0; i < NK; ++i) { const float v = __uint_as_float(kreg[i]); unsigned k = (unsigned)((v - lo) * scale); kreg[i] = k > 0xFFFFFFu ? 0xFFFFFFu : k; }
            unsigned prefix = 0u, mask = 0u; int kth = 256;
#pragma unroll
            for (int pass = 0; pass < 3; ++pass) {
                const int shift = 16 - 8 * pass;
#pragma unroll
                for (int i = 0; i < NK; ++i) { const int idx = tl + 128 * i; const unsigned u = kreg[i]; if (idx < n_adm && (u & mask) == prefix) atomicAdd(&hist[qs * 256 + ((u >> shift) & 255u)], 1u); }
                __syncthreads();
                if (tl < 64) {
                    const int c0 = (int)hist[qs * 256 + 4 * tl], c1 = (int)hist[qs * 256 + 4 * tl + 1], c2 = (int)hist[qs * 256 + 4 * tl + 2], c3 = (int)hist[qs * 256 + 4 * tl + 3];
                    const int tot = c0 + c1 + c2 + c3; int sfx = tot;
#pragma unroll
                    for (int off = 1; off < 64; off <<= 1) { const int tv = __shfl_down(sfx, off); if (tl + off < 64) sfx += tv; }
                    const int above = sfx - tot;
                    if (above < kth && kth <= sfx) { const int rem = kth - above; int bin, nk;
                        if (rem <= c3) { bin = 4 * tl + 3; nk = rem; } else if (rem <= c3 + c2) { bin = 4 * tl + 2; nk = rem - c3; }
                        else if (rem <= c3 + c2 + c1) { bin = 4 * tl + 1; nk = rem - c3 - c2; } else { bin = 4 * tl; nk = rem - c3 - c2 - c1; }
                        misc[qs * 8] = (unsigned)bin; misc[qs * 8 + 1] = (unsigned)nk; }
                }
                __syncthreads();
                prefix |= misc[qs * 8] << shift; mask |= 0xFFu << shift; kth = (int)misc[qs * 8 + 1];
                if (pass < 2) { hist[qs * 256 + tl] = 0u; hist[qs * 256 + 128 + tl] = 0u; }
                if (tl == 0 && pass == 2) { misc[qs * 8 + 2] = 0u; misc[qs * 8 + 3] = 0u; }
                __syncthreads();
            }
            const int lane_ = tid & 63;
#pragma unroll
            for (int i = 0; i < NK; ++i) { const int idx = tl + 128 * i; const unsigned u = kreg[i]; const bool ok = idx < n_adm;
                if (ok && u > prefix) { const unsigned long long m = __ballot(1); const int leader = __ffsll((long long)m) - 1; unsigned base = 0u;
                    if (lane_ == leader) base = atomicAdd(&misc[qs * 8 + 2], (unsigned)__popcll(m));
                    base = __shfl(base, leader);
                    sel[qs * 256 + base + __popcll(m & ((1ull << lane_) - 1ull))] = (unsigned short)idx; }
                else if (ok && u == prefix) { const unsigned e = atomicAdd(&misc[qs * 8 + 3], 1u); if ((int)e < kth) { const unsigned pos = atomicAdd(&misc[qs * 8 + 2], 1u); sel[qs * 256 + pos] = (unsigned short)idx; } } }
            nsel = 256;
        }
    }
    __syncthreads();
    {
        int lane_ = lane; asm volatile("" : "+v"(lane_));
        const int fr = lane_ & 15, fq = lane_ >> 4, aq = wave >> 1, rh = wave & 1;
        const unsigned short* selq = sel + aq * 256;
        f16x8 qf[4];
#pragma unroll
        for (int ks = 0; ks < 4; ++ks) { qf[ks] = *(const f16x8*)(sq + (aq * 8 + (fr & 7)) * 128 + 32 * ks + 8 * fq); if (fr >= 8) qf[ks] = (f16x8){(f16)0.f, (f16)0.f, (f16)0.f, (f16)0.f, (f16)0.f, (f16)0.f, (f16)0.f, (f16)0.f}; }
        f32x4 S[16];
#pragma unroll
        for (int g4 = 0; g4 < 4; ++g4) {
            f16x8 cf[4][4];
#pragma unroll
            for (int tq = 0; tq < 4; ++tq) { const int kk = 16 * (4 * g4 + tq) + fr; const int kidx = (kk < nsel) ? (int)selq[kk] : 0;
                const f16* cp = CKV + (size_t)row_of(b, kidx) * 128 + 8 * fq;
#pragma unroll
                for (int ks = 0; ks < 4; ++ks) cf[tq][ks] = *(const f16x8*)(cp + 32 * ks); }
            __builtin_amdgcn_sched_barrier(0);
#pragma unroll
            for (int tq = 0; tq < 4; ++tq) { f32x4 acc = {0.f, 0.f, 0.f, 0.f};
#pragma unroll
                for (int ks = 0; ks < 4; ++ks) acc = __builtin_amdgcn_mfma_f32_16x16x32_f16(cf[tq][ks], qf[ks], acc, 0, 0, 0);
                S[4 * g4 + tq] = acc; }
            __builtin_amdgcn_sched_barrier(0);
        }
        float mx = -INFINITY;
#pragma unroll
        for (int kt = 0; kt < 16; ++kt)
#pragma unroll
            for (int e = 0; e < 4; ++e) { const float v = (16 * kt + 4 * fq + e < nsel) ? S[kt][e] * 0.125f : -INFINITY; S[kt][e] = v; mx = fmaxf(mx, v); }
        mx = fmaxf(mx, __shfl_xor(mx, 16)); mx = fmaxf(mx, __shfl_xor(mx, 32));
        float sum = 0.f;
#pragma unroll
        for (int kt = 0; kt < 16; ++kt)
#pragma unroll
            for (int e = 0; e < 4; ++e) { const float pv = __expf(S[kt][e] - mx); S[kt][e] = pv; sum += pv; }
        sum += __shfl_xor(sum, 16); sum += __shfl_xor(sum, 32);
        const float inv = 1.f / sum;
        f16x8 Pf[8];
#pragma unroll
        for (int i = 0; i < 8; ++i) {
#pragma unroll
            for (int e = 0; e < 4; ++e) { Pf[i][e] = (f16)(S[2 * i][e] * inv); Pf[i][4 + e] = (f16)(S[2 * i + 1][e] * inv); } }
        f16x8 I0, I1;
#pragma unroll
        for (int j = 0; j < 8; ++j) { I0[j] = (8 * fq + j == fr) ? (f16)1.f : (f16)0.f; I1[j] = (8 * fq + j == 16 + fr) ? (f16)1.f : (f16)0.f; }
        f32x4 O[4];
#pragma unroll
        for (int j = 0; j < 4; ++j) O[j] = (f32x4){0.f, 0.f, 0.f, 0.f};
#pragma unroll
        for (int i2 = 0; i2 < 4; ++i2) {
            f16x8 ca[2][2], cb[2][2];
#pragma unroll
            for (int u = 0; u < 2; ++u) { const int ka = 32 * (2 * i2 + u) + fr, kb = ka + 16;
                const f16* pa = CKV + (size_t)row_of(b, (ka < nsel) ? (int)selq[ka] : 0) * 128 + 64 * rh + 8 * fq;
                const f16* pb = CKV + (size_t)row_of(b, (kb < nsel) ? (int)selq[kb] : 0) * 128 + 64 * rh + 8 * fq;
                ca[u][0] = *(const f16x8*)(pa); ca[u][1] = *(const f16x8*)(pa + 32); cb[u][0] = *(const f16x8*)(pb); cb[u][1] = *(const f16x8*)(pb + 32); }
            __builtin_amdgcn_sched_barrier(0);
#pragma unroll
            for (int u = 0; u < 2; ++u) {
#pragma unroll
                for (int j = 0; j < 4; ++j) {
                    const f32x4 z = {0.f, 0.f, 0.f, 0.f};
                    const f32x4 da = __builtin_amdgcn_mfma_f32_16x16x32_f16(ca[u][j >> 1], (j & 1) ? I1 : I0, z, 0, 0, 0);
                    const f32x4 db = __builtin_amdgcn_mfma_f32_16x16x32_f16(cb[u][j >> 1], (j & 1) ? I1 : I0, z, 0, 0, 0);
                    f16x8 bfr;
#pragma unroll
                    for (int e = 0; e < 4; ++e) { bfr[e] = (f16)da[e]; bfr[4 + e] = (f16)db[e]; }
                    O[j] = __builtin_amdgcn_mfma_f32_16x16x32_f16(Pf[2 * i2 + u], bfr, O[j], 0, 0, 0);
                }
            }
            __builtin_amdgcn_sched_barrier(0);
        }
        if (fq < 2) {
#pragma unroll
            for (int j = 0; j < 4; ++j)
#pragma unroll
                for (int e = 0; e < 4; ++e) OLAT[(size_t)(mq0 + aq) * 1024 + (4 * fq + e) * 128 + 64 * rh + 16 * j + fr] = (f16)O[j][e];
        }
    }
    __syncthreads();
}

__device__ __forceinline__ void phc2_mixers(const Params& p, unsigned char* lds, int rep) {
    unsigned* ctr = (unsigned*)(p.ws + WS_CTL) + 64 + 64 * rep;
    int* s_item = (int*)(lds + 150 * 1024 - 16);
    constexpr int NRW = 16, NDSA = 2 * (SEQ / 4);
    for (;;) {
        if (threadIdx.x == 0) *s_item = (int)atomicAdd(ctr, 1u);
        __syncthreads();
        const int item = *s_item;
        __syncthreads();
        if (item >= NRW + NDSA) break;
        if (item < NRW) rwkv_item(p, item >> 3, item & 7, lds);
        else { const int d = item - NRW; dsa_item(p, d & 1, (SEQ / 4 - 1) - (d >> 1), lds); }
    }
}

__device__ __forceinline__ void phd3_ln1(const Params& p) {
    const int tid = threadIdx.x, lane = tid & 63, wave = tid >> 6;
    const int gw = blockIdx.x * 8 + wave, NGW = gridDim.x * 8;
    f16* H1H = (f16*)(p.ws + WS_H1H);
    for (int m = gw; m < MREAL; m += NGW) {
        float* row = p.out + (size_t)m * D;
        f32x4 v[4]; float s = 0.f;
#pragma unroll
        for (int j = 0; j < 4; ++j) { v[j] = *(const f32x4*)(row + j * 256 + lane * 4); s += (v[j].x + v[j].y) + (v[j].z + v[j].w); }
        const float mean = wave_sum(s) * (1.f / D); float s2 = 0.f;
#pragma unroll
        for (int j = 0; j < 4; ++j) { v[j] = v[j] - mean; s2 += (v[j].x * v[j].x + v[j].y * v[j].y) + (v[j].z * v[j].z + v[j].w * v[j].w); }
        const float rstd = 1.f / sqrtf(wave_sum(s2) * (1.f / D) + LN_EPS);
#pragma unroll
        for (int j = 0; j < 4; ++j) { const f32x4 g = *(const f32x4*)(p.ln1_g + j * 256 + lane * 4), bb = *(const f32x4*)(p.ln1_b + j * 256 + lane * 4);
            const f32x4 o = v[j] * rstd * g + bb; *(f32x4*)(row + j * 256 + lane * 4) = o; *(f16x4*)(H1H + (size_t)m * D + j * 256 + lane * 4) = to_h4(o); }
    }
    unsigned char* U8 = p.ws + WS_U16; unsigned char* V8 = p.ws + WS_V16;
    const long gt = (long)blockIdx.x * NT + tid, NGT = (long)gridDim.x * NT;
    for (long e = gt; e < 16384L * 1024 / 16; e += NGT) {
        u32x4 ou, ov;
#pragma unroll
        for (int q = 0; q < 4; ++q) { const f32x4 a = *(const f32x4*)(p.peer_u + e * 16 + q * 4) * 256.f; const f32x4 c = *(const f32x4*)(p.peer_v + e * 16 + q * 4) * 16.f;
            int w = 0; w = __builtin_amdgcn_cvt_pk_fp8_f32(a[0], a[1], w, false); w = __builtin_amdgcn_cvt_pk_fp8_f32(a[2], a[3], w, true); ou[q] = (unsigned)w;
            int x = 0; x = __builtin_amdgcn_cvt_pk_fp8_f32(c[0], c[1], x, false); x = __builtin_amdgcn_cvt_pk_fp8_f32(c[2], c[3], x, true); ov[q] = (unsigned)x; }
        *(u32x4*)(U8 + e * 16) = ou; *(u32x4*)(V8 + e * 16) = ov;
    }
}

#define CSWAP(j) do { if (tv[j] > tv[j - 1]) { const int _t = tv[j]; tv[j] = tv[j - 1]; tv[j - 1] = _t; const int _i = ti[j]; ti[j] = ti[j - 1]; ti[j - 1] = _i; } } while (0)
#define CSWAP_ALL() do { CSWAP(15); CSWAP(14); CSWAP(13); CSWAP(12); CSWAP(11); CSWAP(10); CSWAP(9); CSWAP(8); CSWAP(7); CSWAP(6); CSWAP(5); CSWAP(4); CSWAP(3); CSWAP(2); CSWAP(1); } while (0)
__device__ __forceinline__ void top16_of_128(const unsigned short* src, int (&tv)[16], int (&ti)[16]) {
#pragma unroll
    for (int j = 0; j < 16; ++j) { tv[j] = -1; ti[j] = 0; }
    for (int c = 0; c < 16; ++c) {
        const u32x4 w = *(const u32x4*)(src + c * 8);
#pragma unroll
        for (int e = 0; e < 8; ++e) {
            const int x = (int)((w[e >> 1] >> (16 * (e & 1))) & 0xFFFFu);
            if (x > tv[15]) { tv[15] = x; ti[15] = c * 8 + e; CSWAP_ALL(); }
        }
    }
}
__device__ __forceinline__ void phd5_topk(const Params& p) {
    const unsigned short* SC = (const unsigned short*)(p.ws + WS_SC);
    unsigned short* EIDX = (unsigned short*)(p.ws + WS_EIDX); float* EGATE = (float*)(p.ws + WS_EGATE);
    const long gt = (long)blockIdx.x * NT + threadIdx.x, NGT = (long)gridDim.x * NT;
    for (long e = gt; e < (long)MREAL * 8; e += NGT) {
        const int m = (int)(e >> 3), h = (int)(e & 7);
        int av[16], bv[16]; int ai[16], bi[16];
        top16_of_128(SC + (size_t)m * 2048 + h * 256, av, ai);
        top16_of_128(SC + (size_t)m * 2048 + h * 256 + 128, bv, bi);
        int tv[16]; int ti[16];
#pragma unroll
        for (int j = 0; j < 16; ++j) { tv[j] = -1; ti[j] = 0; }
#pragma unroll
        for (int i = 0; i < 16; ++i)
#pragma unroll
            for (int j = 0; j < 16; ++j)
                if ((i + 1) * (j + 1) <= 16) {
                    const int x = av[i] + bv[j];
                    if (x > tv[15]) { tv[15] = x; ti[15] = ai[i] * 128 + bi[j]; CSWAP_ALL(); }
                }
        float sum = 0.f; float ex[16];
#pragma unroll
        for (int j = 0; j < 16; ++j) { ex[j] = __expf((float)(tv[j] - tv[0]) * (1.f / 8192.f)); sum += ex[j]; }
        const float inv = 1.f / sum;
#pragma unroll
        for (int j = 0; j < 16; ++j) { EIDX[(size_t)m * 128 + h * 16 + j] = (unsigned short)ti[j]; EGATE[(size_t)m * 128 + h * 16 + j] = ex[j] * inv; }
    }
}

__device__ __forceinline__ void dec16(const u32x4 w, float (&o)[16]) {
#pragma unroll
    for (int q = 0; q < 4; ++q) { const f32x2 lo = __builtin_amdgcn_cvt_pk_f32_fp8((int)w[q], false), hi = __builtin_amdgcn_cvt_pk_f32_fp8((int)w[q], true); o[4 * q] = lo.x; o[4 * q + 1] = lo.y; o[4 * q + 2] = hi.x; o[4 * q + 3] = hi.y; }
}
__device__ __forceinline__ float wave_sum_u(float v) {
    v = row16_sum(v);
    const float a = __builtin_bit_cast(float, __builtin_amdgcn_readlane(__builtin_bit_cast(int, v), 0)), b = __builtin_bit_cast(float, __builtin_amdgcn_readlane(__builtin_bit_cast(int, v), 16));
    const float c = __builtin_bit_cast(float, __builtin_amdgcn_readlane(__builtin_bit_cast(int, v), 32)), d = __builtin_bit_cast(float, __builtin_amdgcn_readlane(__builtin_bit_cast(int, v), 48));
    return (a + b) + (c + d);
}
__device__ __forceinline__ void phd6_gather(const Params& p) {
    const int tid = threadIdx.x, lane = tid & 63, wave = tid >> 6;
    const int gw = blockIdx.x * 8 + wave, NGW = gridDim.x * 8;
    const unsigned char* U8 = p.ws + WS_U16; const unsigned char* V8 = p.ws + WS_V16;
    const unsigned short* EIDX = (const unsigned short*)(p.ws + WS_EIDX); const float* EGATE = (const float*)(p.ws + WS_EGATE);
    for (int m = gw; m < MREAL; m += NGW) {
        float* row = p.out + (size_t)m * D + 16 * lane;
        float hv[16];
#pragma unroll
        for (int q = 0; q < 4; ++q) { const f32x4 t4 = *(const f32x4*)(row + 4 * q); hv[4 * q] = t4.x; hv[4 * q + 1] = t4.y; hv[4 * q + 2] = t4.z; hv[4 * q + 3] = t4.w; }
        const int e_lo = (int)EIDX[(size_t)m * 128 + lane], e_hi = (int)EIDX[(size_t)m * 128 + 64 + lane];
        const float g_lo = EGATE[(size_t)m * 128 + lane], g_hi = EGATE[(size_t)m * 128 + 64 + lane];
        float hd_lo = 0.f, hd_hi = 0.f;
#define G_LOAD(buf, g_, TAB) do { _Pragma("unroll") for (int i_ = 0; i_ < 8; ++i_) { const int e_ = 8 * (g_) + i_; \
            const int id_ = (e_ < 64) ? __builtin_amdgcn_readlane(e_lo, e_ & 63) : __builtin_amdgcn_readlane(e_hi, e_ & 63); \
            buf[i_] = *(const u32x4*)((TAB) + (size_t)id_ * D + 16 * lane); } } while (0)
#define U_PROC(buf, g_) do { _Pragma("unroll") for (int i_ = 0; i_ < 8; ++i_) { const int e_ = 8 * (g_) + i_; float uf[16]; dec16(buf[i_], uf); float s_ = 0.f; \
            _Pragma("unroll") for (int j_ = 0; j_ < 16; ++j_) s_ += hv[j_] * uf[j_]; s_ = wave_sum_u(s_); \
            if (e_ < 64) { if (lane == (e_ & 63)) hd_lo = s_; } else { if (lane == (e_ & 63)) hd_hi = s_; } } } while (0)
        {
            u32x4 b0[8], b1[8];
            G_LOAD(b0, 0, U8);
            for (int g2 = 0; g2 < 16; g2 += 2) {
                G_LOAD(b1, g2 + 1, U8); __builtin_amdgcn_sched_barrier(0);
                U_PROC(b0, g2); __builtin_amdgcn_sched_barrier(0);
                if (g2 + 2 < 16) { G_LOAD(b0, g2 + 2, U8); } __builtin_amdgcn_sched_barrier(0);
                U_PROC(b1, g2 + 1); __builtin_amdgcn_sched_barrier(0);
            }
        }
        hd_lo *= (1.f / 256.f); hd_hi *= (1.f / 256.f);
        const float c_lo = g_lo * 0.5f * hd_lo * (1.f + erff(hd_lo * 0.70710678118654752f)) * (1.f / 16.f);
        const float c_hi = g_hi * 0.5f * hd_hi * (1.f + erff(hd_hi * 0.70710678118654752f)) * (1.f / 16.f);
        float acc[16];
#pragma unroll
        for (int j = 0; j < 16; ++j) acc[j] = 0.f;
#define V_PROC(buf, g_) do { _Pragma("unroll") for (int i_ = 0; i_ < 8; ++i_) { const int e_ = 8 * (g_) + i_; float vf[16]; dec16(buf[i_], vf); \
            const float cf_ = (e_ < 64) ? __builtin_bit_cast(float, __builtin_amdgcn_readlane(__builtin_bit_cast(int, c_lo), e_ & 63)) : __builtin_bit_cast(float, __builtin_amdgcn_readlane(__builtin_bit_cast(int, c_hi), e_ & 63)); \
            _Pragma("unroll") for (int j_ = 0; j_ < 16; ++j_) acc[j_] += cf_ * vf[j_]; } } while (0)
        {
            u32x4 b0[8], b1[8];
            G_LOAD(b0, 0, V8);
            for (int g2 = 0; g2 < 16; g2 += 2) {
                G_LOAD(b1, g2 + 1, V8); __builtin_amdgcn_sched_barrier(0);
                V_PROC(b0, g2); __builtin_amdgcn_sched_barrier(0);
                if (g2 + 2 < 16) { G_LOAD(b0, g2 + 2, V8); } __builtin_amdgcn_sched_barrier(0);
                V_PROC(b1, g2 + 1); __builtin_amdgcn_sched_barrier(0);
            }
        }
        float sm = 0.f;
#pragma unroll
        for (int j = 0; j < 16; ++j) { acc[j] += ALPHA * hv[j]; sm += acc[j]; }
        const float mean = wave_sum_u(sm) * (1.f / D); float s2 = 0.f;
#pragma unroll
        for (int j = 0; j < 16; ++j) { acc[j] -= mean; s2 += acc[j] * acc[j]; }
        const float rstd = __builtin_amdgcn_rsqf(wave_sum_u(s2) * (1.f / D) + LN_EPS);
#pragma unroll
        for (int q = 0; q < 4; ++q) { const int col = 16 * lane + 4 * q; const f32x4 g = *(const f32x4*)(p.ln2_g + col), bb = *(const f32x4*)(p.ln2_b + col);
            f32x4 o; o.x = acc[4 * q] * rstd * g.x + bb.x; o.y = acc[4 * q + 1] * rstd * g.y + bb.y; o.z = acc[4 * q + 2] * rstd * g.z + bb.z; o.w = acc[4 * q + 3] * rstd * g.w + bb.w;
            *(f32x4*)(row + 4 * q) = o; }
    }
}

struct EpiLora {
    f16 *LW, *AA, *GG; const float *w0, *a0;
    __device__ __forceinline__ void operator()(const f32x4 (&acc)[2][2][4][2], const pg8::Unit& u, int wr, int wc, int fr, int fq) const {
        const int row0 = u.pm * 256 + wr * 64 + fr, col0 = (u.pn & 1) * 256 + wc * 32 + 4 * fq;
        if (u.pn < 2) {
#pragma unroll
            for (int bj = 0; bj < 2; ++bj)
#pragma unroll
                for (int n = 0; n < 2; ++n) { const int col = col0 + bj * 128 + n * 16; const f32x4 c = *(const f32x4*)(w0 + col);
#pragma unroll
                    for (int ai = 0; ai < 2; ++ai)
#pragma unroll
                        for (int m = 0; m < 4; ++m) { const f32x4 v = acc[ai][bj][m][n]; f16x4 o;
#pragma unroll
                            for (int e = 0; e < 4; ++e) { const float wl = -softplusf_(-(c[e] + v[e])) - 0.5f; o[e] = (f16)(-__expf(wl)); }
                            *(f16x4*)(LW + (size_t)(row0 + ai * 128 + m * 16) * 512 + col) = o; } }
        } else if (u.pn < 4) {
#pragma unroll
            for (int bj = 0; bj < 2; ++bj)
#pragma unroll
                for (int n = 0; n < 2; ++n) { const int col = col0 + bj * 128 + n * 16; const f32x4 c = *(const f32x4*)(a0 + col);
#pragma unroll
                    for (int ai = 0; ai < 2; ++ai)
#pragma unroll
                        for (int m = 0; m < 4; ++m) { const f32x4 v = acc[ai][bj][m][n]; f16x4 o;
#pragma unroll
                            for (int e = 0; e < 4; ++e) o[e] = (f16)sigmoidf_(c[e] + v[e]);
                            *(f16x4*)(AA + (size_t)(row0 + ai * 128 + m * 16) * 512 + col) = o; } }
        } else {
#pragma unroll
            for (int bj = 0; bj < 2; ++bj)
#pragma unroll
                for (int n = 0; n < 2; ++n) { const int col = col0 + bj * 128 + n * 16;
#pragma unroll
                    for (int ai = 0; ai < 2; ++ai)
#pragma unroll
                        for (int m = 0; m < 4; ++m) *(f16x4*)(GG + (size_t)(row0 + ai * 128 + m * 16) * 512 + col) = to_h4(acc[ai][bj][m][n]); }
        }
    }
};

#define XB_TMO      128
#define XB_XCNT(j)  (256  + 64 * (j))
#define XB_XSUB(j)  (1280 + 64 * (j))
#define XB_XGEN(j)  (2304 + 64 * (j))
#define XB_TOP      3328
#define XB_TOPGEN   3392
#define XCD_BAR_WORDS 3456
#define XB_SPIN_CAP (1u << 20)
__device__ __forceinline__ unsigned xb_ld(unsigned* p)              { return __hip_atomic_load(p, __ATOMIC_RELAXED, __HIP_MEMORY_SCOPE_AGENT); }
__device__ __forceinline__ unsigned xb_add(unsigned* p, unsigned v) { return __hip_atomic_fetch_add(p, v, __ATOMIC_RELAXED, __HIP_MEMORY_SCOPE_AGENT); }
__device__ __forceinline__ unsigned xb_xcc_id() { return (unsigned)__builtin_amdgcn_s_getreg((3 << 11) | 20) & 0xFu; }
#define XB_SPIN(cond, bar) do { unsigned _sp = 0; while (cond) { __builtin_amdgcn_s_sleep(1); \
    if ((++_sp & 255u) == 0u) { if (xb_ld(&(bar)[XB_TMO])) break; if (_sp > XB_SPIN_CAP) { atomicAdd(&(bar)[XB_TMO], 1u); break; } } } } while (0)
struct XcdBarrier { unsigned* bar; unsigned x; volatile LAS unsigned* st; };
__device__ __forceinline__ XcdBarrier xcd_barrier_post(unsigned* bar, volatile LAS unsigned* st) {
    XcdBarrier b; b.bar = bar; b.x = xb_xcc_id(); b.st = st;
    if (threadIdx.x == 0) (void)xb_add(&bar[XB_XCNT(b.x)], 1u);
    return b;
}
__device__ __forceinline__ void xcd_barrier_complete(unsigned* bar, unsigned x, unsigned& nloc, unsigned& nx) {
    const unsigned G = gridDim.x * gridDim.y * gridDim.z;
    unsigned sum, cnt, mine, sp = 0u;
    for (;;) {
        sum = 0u; cnt = 0u; mine = 0u;
#pragma unroll
        for (unsigned j = 0; j < 16; ++j) { const unsigned c = xb_ld(&bar[XB_XCNT(j)]); sum += c; cnt += (c > 0u) ? 1u : 0u; mine = (j == x) ? c : mine; }
        if (sum == G) break;
        __builtin_amdgcn_s_sleep(1);
        if ((++sp & 255u) == 0u) { if (xb_ld(&bar[XB_TMO])) break; if (sp > XB_SPIN_CAP) { atomicAdd(&bar[XB_TMO], 1u); break; } }
    }
    nloc = mine > 0u ? mine : 1u; nx = cnt > 0u ? cnt : 1u;
}
__device__ __forceinline__ void xcd_barrier(const XcdBarrier& b) {
    asm volatile("s_waitcnt vmcnt(0)" ::: "memory");
    __syncthreads();
    if (threadIdx.x == 0) {
        unsigned* bar = b.bar;
        __builtin_amdgcn_s_waitcnt(0);
        unsigned nloc = b.st[0], nx = b.st[1];
        if (nloc == 0u) { xcd_barrier_complete(bar, b.x, nloc, nx); b.st[0] = nloc; b.st[1] = nx; }
        const unsigned old = xb_add(&bar[XB_XSUB(b.x)], 1u);
        const unsigned gen = old / nloc;
        if (old + 1u == (gen + 1u) * nloc) {
            __builtin_amdgcn_fence(__ATOMIC_RELEASE, "agent");
            asm volatile("s_waitcnt vmcnt(0)" ::: "memory");
            const unsigned og = xb_add(&bar[XB_TOP], 1u);
            const unsigned tg = og / nx;
            if (og + 1u == (tg + 1u) * nx) xb_add(&bar[XB_TOPGEN], 1u);
            else XB_SPIN(xb_ld(&bar[XB_TOPGEN]) == tg, bar);
            __builtin_amdgcn_fence(__ATOMIC_ACQUIRE, "agent");
            xb_add(&bar[XB_XGEN(b.x)], 1u);
            asm volatile("s_waitcnt vmcnt(0)" ::: "memory");
        } else {
            XB_SPIN(xb_ld(&bar[XB_XGEN(b.x)]) == gen, bar);
            __builtin_amdgcn_fence(__ATOMIC_ACQUIRE, "agent");
            asm volatile("s_waitcnt vmcnt(0)" ::: "memory");
        }
    }
    __syncthreads();
}

constexpr int LDS_BYTES = 150 * 1024;
constexpr int REP0 = 1, REP1 = 1, REP4 = 1, REP5 = 1, REP8 = 1, REP9 = 1;
constexpr int NPHASE = 11;
__global__ void __launch_bounds__(NT) mk_fwd(Params p) {
    extern __shared__ __attribute__((aligned(16))) unsigned char lds[];
    cg::grid_group grid = cg::this_grid();
    unsigned char* ws = p.ws;
    const int lo = p.ph_lo, hi = p.ph_hi;
    volatile LAS unsigned* bst = (volatile LAS unsigned*)((LAS unsigned char*)lds + LDS_BYTES - 64);
    if (threadIdx.x < 2) bst[threadIdx.x] = 0u;
    __syncthreads();
    const XcdBarrier xbar = xcd_barrier_post((unsigned*)(ws + WS_CTL) + 4096, bst);
#define IN(k) (lo <= (k) && (k) < hi)
#define SEAM(k) do { if (IN(k) && IN((k) + 1)) { if ((k) == 0) grid.sync(); else xcd_barrier(xbar); } } while (0)
    if (IN(0)) ph0_prep(p, lds);
    SEAM(0);
    if (IN(1)) {
        f16* PB = (f16*)(ws + WS_PB);
        auto f = [=](int row, int col, f32x4 v) { *(f16x4*)(PB + (size_t)row * N1 + col) = to_h4(v); };
        pg8::run_gemm(lds, (const f16*)(ws + WS_H0), (const f16*)(ws + WS_W1T), MR, N1, D, f);
    }
    SEAM(1);
    if (IN(2)) phc1_rowprep(p);
    SEAM(2);
    if (IN(3)) {
        pg8::Gemm g{(const f16*)((unsigned char*)p.out + DO_LORAIN), (const f16*)(ws + WS_WLT), MR, 1536, 256}; pg8::StaticOrder S; S.init(MR, 1536, (int)gridDim.x, (int)blockIdx.x);
        EpiLora E{(f16*)((unsigned char*)p.out + DO_LW), (f16*)((unsigned char*)p.out + DO_AA), (f16*)((unsigned char*)p.out + DO_GG), p.b_w0, p.b_a0};
        pg8::gemm_phase<EpiLora>((PG8_LAS unsigned char*)lds, g, S, E);
        __syncthreads();
    }
    SEAM(3);
    if (IN(4)) for (int rep = 0; rep < REP4; ++rep) { if (rep) grid.sync(); phc2_mixers(p, lds, rep); }
    SEAM(4);
    if (IN(5)) {
        f16* MIX = (f16*)(ws + WS_MIXED); f16* TMP = (f16*)(ws + WS_TMP); const float* bg = p.b_gate;
        auto f1 = [=](int row, int col, f32x4 v) { const f32x4 c = *(const f32x4*)(bg + col); f16x4 o;
#pragma unroll
            for (int e = 0; e < 4; ++e) o[e] = (f16)sigmoidf_(v[e] + c[e]);
            *(f16x4*)(MIX + (size_t)row * D + col) = o; };
        pg8::run_gemm(lds, (const f16*)(ws + WS_H0), (const f16*)(ws + WS_WGT), MREAL, D, D, f1);
        auto f2 = [=](int row, int col, f32x4 v) { f16x4* q = (f16x4*)(MIX + (size_t)row * D + col); const f16x4 gq = *q; f16x4 o;
#pragma unroll
            for (int e = 0; e < 4; ++e) o[e] = (f16)((float)gq[e] * v[e]);
            *q = o; };
        pg8::run_gemm(lds, (const f16*)(ws + WS_OLAT), (const f16*)(ws + WS_WPAT), MREAL, D, D, f2);
        auto f3 = [=](int row, int col, f32x4 v) { const f32x4 c = *(const f32x4*)(bg + 1024 + col); f16x4 o;
#pragma unroll
            for (int e = 0; e < 4; ++e) o[e] = (f16)sigmoidf_(v[e] + c[e]);
            *(f16x4*)(TMP + (size_t)row * D + col) = o; };
        pg8::run_gemm(lds, (const f16*)(ws + WS_H0), (const f16*)(ws + WS_WGT) + (size_t)1024 * D, MREAL, D, D, f3);
        auto f4 = [=](int row, int col, f32x4 v) { f16x4* q = (f16x4*)(MIX + (size_t)row * D + col); const f16x4 m0 = *q; const f16x4 gq = *(const f16x4*)(TMP + (size_t)row * D + col); f16x4 o;
#pragma unroll
            for (int e = 0; e < 4; ++e) o[e] = (f16)((float)m0[e] + (float)gq[e] * v[e]);
            *q = o; };
        pg8::run_gemm(lds, (const f16*)(ws + WS_OB), (const f16*)(ws + WS_WPBT), MREAL, D, 512, f4);
    }
    SEAM(5);
    if (IN(6)) {
        const float* x = p.x; const float* STAT = (const float*)(ws + WS_STAT); const float* lg = p.ln_in_g; const float* lb = p.ln_in_b; float* out = p.out;
        auto f = [=](int row, int col, f32x4 v) { const f32x4 xv = *(const f32x4*)(x + (size_t)row * D + col); const float mean = STAT[2 * row], rstd = STAT[2 * row + 1];
            const f32x4 g = *(const f32x4*)(lg + col), bb = *(const f32x4*)(lb + col);
            *(f32x4*)(out + (size_t)row * D + col) = ((xv - mean) * rstd * g + bb) * ALPHA + v; };
        pg8::run_gemm(lds, (const f16*)(ws + WS_MIXED), (const f16*)(ws + WS_WOT), MREAL, D, D, f);
    }
    SEAM(6);
    if (IN(7)) phd3_ln1(p);
    SEAM(7);
    if (IN(8)) {
        unsigned short* SC = (unsigned short*)(ws + WS_SC);
        auto f = [=](int row, int col, f32x4 v) { u32x2 o; unsigned q[4];
#pragma unroll
            for (int e = 0; e < 4; ++e) q[e] = (unsigned)__float2int_rn(fminf(fmaxf((v[e] + 2.f) * 8192.f, 0.f), 65535.f));
            o.x = q[0] | (q[1] << 16); o.y = q[2] | (q[3] << 16); *(u32x2*)(SC + (size_t)row * 2048 + col) = o; };
        pg8::run_gemm(lds, (const f16*)(ws + WS_H1H), (const f16*)(ws + WS_WSKT), MREAL, 2048, D, f);
    }
    SEAM(8);
    if (IN(9)) phd5_topk(p);
    SEAM(9);
    if (IN(10)) phd6_gather(p);
#undef IN
#undef SEAM
}

extern "C" void kernel_launch(void* const* d_in, const int* in_sizes, int n_in, void* d_out, int out_size, void* d_ws, size_t ws_size, hipStream_t stream) {
    static int grid = 0;
    if (grid == 0) {
        int dev = 0, cus = 0, per_cu = 0;
        if (hipGetDevice(&dev) != hipSuccess || hipDeviceGetAttribute(&cus, hipDeviceAttributeMultiprocessorCount, dev) != hipSuccess) { fprintf(stderr, "kernel_launch: device query failed\n"); grid = -1; return; }
        if (hipFuncSetAttribute((const void*)mk_fwd, hipFuncAttributeMaxDynamicSharedMemorySize, LDS_BYTES) != hipSuccess) { fprintf(stderr, "kernel_launch: hipFuncSetAttribute failed\n"); grid = -1; return; }
        if (hipOccupancyMaxActiveBlocksPerMultiprocessor(&per_cu, (const void*)mk_fwd, NT, LDS_BYTES) != hipSuccess || per_cu < 1) { fprintf(stderr, "kernel_launch: occupancy query says %d\n", per_cu); grid = -1; return; }
        if (n_in != 33 || out_size != MREAL * D || ws_size < WS_END) { fprintf(stderr, "kernel_launch: unexpected shapes n_in %d out %d ws %zu\n", n_in, out_size, ws_size); grid = -1; return; }
        grid = cus;
    }
    if (grid < 0) return;
    (void)hipMemsetAsync((char*)d_ws + WS_CTL, 0, 1 * MiB, stream);
    Params p{};
    const float** pf = (const float**)&p;
    for (int i = 0; i < 33; ++i) pf[i] = (const float*)d_in[i];
    p.out = (float*)d_out; p.ws = (unsigned char*)d_ws; p.ph_lo = 0; p.ph_hi = NPHASE;
    void* args[] = {&p};
    hipError_t e = hipLaunchCooperativeKernel((void*)mk_fwd, dim3(grid), dim3(NT), args, LDS_BYTES, stream);
    if (e != hipSuccess) fprintf(stderr, "kernel_launch: cooperative launch failed: %s (grid %d)\n", hipGetErrorString(e), grid);
}
```

```cpp
#include <hip/hip_runtime.h>
#include <hip/hip_cooperative_groups.h>
#include <cstdio>
#include <cstdint>
namespace cg = cooperative_groups;

#define LAS __attribute__((address_space(3)))
typedef _Float16 f16;
typedef _Float16 f16x2 __attribute__((ext_vector_type(2)));
typedef _Float16 f16x4 __attribute__((ext_vector_type(4)));
typedef _Float16 f16x8 __attribute__((ext_vector_type(8)));
typedef float f32x2 __attribute__((ext_vector_type(2)));
typedef float f32x4 __attribute__((ext_vector_type(4)));
typedef float f32x16 __attribute__((ext_vector_type(16)));
typedef unsigned u32x4 __attribute__((ext_vector_type(4)));

constexpr int D = 1024, SEQ = 8192, NMETA = 16, TT = 8208;
constexpr int MREAL = 16384, MR = 16640;
constexpr int NIN = 5064;
constexpr int N1 = 3584;
constexpr int C_QABS = 0, C_QI = 1024, C_CKV = 1536, C_KI = 1664, C_WI = 1728, C_BC = 1792;
constexpr int NT = 512;
constexpr int KIDX_B = 264 * 2048;
constexpr float LN_EPS = 1e-5f;
constexpr float ALPHA = 1.189207115002721f;

__device__ __forceinline__ int row_of(int b, int t) { return t < NMETA ? MREAL + b * NMETA + t : b * SEQ + (t - NMETA); }

constexpr size_t MiB = 1u << 20;
constexpr size_t WS_CTL = 0, WS_STAT = 1 * MiB, WS_WIS = 2 * MiB, WS_W1T = 3 * MiB, WS_WGT = 10 * MiB, WS_WPAT = 14 * MiB, WS_WPBT = 16 * MiB,
                 WS_WOT = 17 * MiB, WS_WSKT = 19 * MiB, WS_WLT = 23 * MiB, WS_CKV = 24 * MiB, WS_KIDX = 29 * MiB, WS_H0 = 32 * MiB,
                 WS_OLAT = 65 * MiB, WS_OB = 97 * MiB, WS_PB = 113 * MiB, WS_END = 227 * MiB;
constexpr size_t WS_MIXED = WS_PB, WS_H1H = WS_PB, WS_TMP = WS_PB + 32 * MiB, WS_SC = WS_PB + 32 * MiB, WS_EIDX = WS_PB + 96 * MiB, WS_EGATE = WS_PB + 100 * MiB;
constexpr size_t WS_U16 = WS_H0, WS_V16 = WS_OLAT;
constexpr size_t DO_LORAIN = 0, DO_LW = 9 * MiB, DO_AA = 26 * MiB, DO_GG = 43 * MiB;

struct Params {
    const float *x, *meta, *ln_in_g, *ln_in_b, *w_in, *b_gate, *a_kv_norm_g, *a_w_uk, *a_w_uv, *a_kidx_g, *a_kidx_b, *b_mu, *b_w0, *b_w2, *b_a0, *b_a2,
        *b_g2, *b_k_k, *b_k_a, *b_r_k, *b_lnx_g, *b_lnx_b, *w_pa, *w_pb, *w_o, *ln1_g, *ln1_b, *peer_wq, *peer_subkeys, *peer_u, *peer_v, *ln2_g, *ln2_b;
    float* out;
    unsigned char* ws;
    int ph_lo, ph_hi;
};

__device__ __forceinline__ float wave_sum(float v) {
#pragma unroll
    for (int o = 1; o < 64; o <<= 1) v += __shfl_xor(v, o);
    return v;
}
__device__ __forceinline__ float wave_max(float v) {
#pragma unroll
    for (int o = 1; o < 64; o <<= 1) v = fmaxf(v, __shfl_xor(v, o));
    return v;
}
#define DPP_F(v, ctrl) __builtin_bit_cast(float, __builtin_amdgcn_update_dpp(0, __builtin_bit_cast(int, (v)), (ctrl), 0xF, 0xF, true))
__device__ __forceinline__ float row16_sum(float v) {
    v += DPP_F(v, 0xB1);
    v += DPP_F(v, 0x4E);
    v += DPP_F(v, 0x141);
    v += DPP_F(v, 0x140);
    return v;
}
__device__ __forceinline__ float sigmoidf_(float x) { return __builtin_amdgcn_rcpf(1.f + __expf(-x)); }
__device__ __forceinline__ float softplusf_(float z) { return fmaxf(z, 0.f) + __logf(1.f + __expf(-fabsf(z))); }
__device__ __forceinline__ unsigned fkey(float f) { unsigned u = __float_as_uint(f); return u ^ ((u >> 31) ? 0xFFFFFFFFu : 0x80000000u); }

namespace pg8 {
#define PG8_LAS __attribute__((address_space(3)))
typedef short h16x8 __attribute__((ext_vector_type(8)));
constexpr int BM = 256, BK = 64, HALF = 128, HTB = HALF * BK * 2, STAGE_BYTES = 8 * HTB, NXCD = 8, WGM = 8;
__host__ __device__ __forceinline__ int lds_byte(int r, int c) { const int st = (r >> 4) * 2 + (c >> 5), rr = r & 15, cc = c & 31, ob = rr * 64 + cc * 2; return st * 1024 + (ob ^ (((ob >> 9) & 1) << 5)); }
__host__ __device__ __forceinline__ void stage_rc(int b, int& R, int& C) { const int st = b / 1024, sb = b % 1024, swz = sb ^ (((sb >> 9) & 1) << 5); R = (st >> 1) * 16 + swz / 64; C = (st & 1) * 32 + (swz % 64) / 2; }
struct Unit { int pm, pn; };
struct Gemm { const f16* A; const f16* Bt; int M, N, K; };
struct StaticOrder {
    int nM, nN, nwg, G, c;
    __host__ __device__ void init(int M, int N, int G_, int c_) { nM = M / BM; nN = N / BM; nwg = nM * nN; G = G_; c = c_; }
    __host__ __device__ bool next(int i, Unit& u) const {
        const long L = (long)i * G + c; if (L >= nwg) return false;
        int wgid = (int)L; { const int q = nwg / NXCD, r = nwg % NXCD, xcd = wgid % NXCD, off = wgid / NXCD; wgid = (xcd < r ? xcd * (q + 1) : r * (q + 1) + (xcd - r) * q) + off; }
        const int nig = WGM * nN, gid = wgid / nig, fm = gid * WGM, gsz = (nM - fm) < WGM ? (nM - fm) : WGM;
        u.pm = fm + ((wgid % nig) % gsz); u.pn = (wgid % nig) / gsz; return true;
    }
};
template <class F> struct EpiElem {
    F f;
    __device__ __forceinline__ void operator()(const f32x4 (&acc)[2][2][4][2], const Unit& u, int wr, int wc, int fr, int fq) const {
        const int row0 = u.pm * BM + wr * 64 + fr, col0 = u.pn * BM + wc * 32 + 4 * fq;
#pragma unroll
        for (int ai = 0; ai < 2; ++ai)
#pragma unroll
            for (int m = 0; m < 4; ++m)
#pragma unroll
                for (int bj = 0; bj < 2; ++bj)
#pragma unroll
                    for (int n = 0; n < 2; ++n) f(row0 + ai * HALF + m * 16, col0 + bj * HALF + n * 16, acc[ai][bj][m][n]);
    }
};
template <class Epi>
__device__ __forceinline__ void gemm_phase(PG8_LAS unsigned char* lds, const Gemm g, const StaticOrder& S, const Epi& E) {
    const int tid = threadIdx.x, wid = __builtin_amdgcn_readfirstlane(tid >> 6), lane = tid & 63, wr = wid >> 2, wc = wid & 3, fr = lane & 15, fq = lane >> 4;
    int K = g.K; asm volatile("" : "+s"(K));
    const int nt = K / BK;
    unsigned voffA[2], voffB[2];
#pragma unroll
    for (int i = 0; i < 2; ++i) { int R, C; stage_rc(tid * 16 + i * 8192, R, C); voffA[i] = (unsigned)(R * K + C) * 2u; voffB[i] = (unsigned)(R * K + C) * 2u; }
    const size_t kstep = (size_t)(BK * 2);
    const size_t hstep = (size_t)HALF * K * 2;
    const size_t tstep = 2 * hstep;
    const unsigned ldsw = (unsigned)wid * 1024u;
    const int aoff = lds_byte(wr * 64 + fr, fq * 8), boff = lds_byte(wc * 32 + fr, fq * 8);
#define PG8_SA(b, h) (((b) * 2 + (h)) * HTB)
#define PG8_SB(b, h) ((4 + (b) * 2 + (h)) * HTB)
#define PG8_STAGE(bufoff, gbase, voff) do { _Pragma("unroll") for (int _i = 0; _i < 2; ++_i) \
        __builtin_amdgcn_global_load_lds((const unsigned*)((const char*)(gbase) + (voff)[_i]), (PG8_LAS unsigned*)(lds + (bufoff) + ldsw + _i * 8192), 16, 0, 0); } while (0)
#define PG8_LDA(dst, b, h) do { _Pragma("unroll") for (int m = 0; m < 4; ++m) _Pragma("unroll") for (int k = 0; k < 2; ++k) dst[m][k] = *(const PG8_LAS h16x8*)(lds + PG8_SA(b, h) + aoff + m * 2048 + k * 1024); } while (0)
#define PG8_LDB(dst, b, h) do { _Pragma("unroll") for (int n = 0; n < 2; ++n) _Pragma("unroll") for (int k = 0; k < 2; ++k) dst[n][k] = *(const PG8_LAS h16x8*)(lds + PG8_SB(b, h) + boff + n * 2048 + k * 1024); } while (0)
#define PG8_MMA(ai, bj, At, Bt) do { __builtin_amdgcn_s_setprio(1); _Pragma("unroll") for (int m = 0; m < 4; ++m) _Pragma("unroll") for (int n = 0; n < 2; ++n) _Pragma("unroll") for (int k = 0; k < 2; ++k) \
        acc[ai][bj][m][n] = __builtin_amdgcn_mfma_f32_16x16x32_f16(__builtin_bit_cast(f16x8, Bt[n][k]), __builtin_bit_cast(f16x8, At[m][k]), acc[ai][bj][m][n], 0, 0, 0); __builtin_amdgcn_s_setprio(0); } while (0)
#define PG8_WAIT_V(n) asm volatile("s_waitcnt vmcnt(" #n ")" ::: "memory")
#define PG8_WAIT_L(n) asm volatile("s_waitcnt lgkmcnt(" #n ")" ::: "memory")
#define PG8_BAR __builtin_amdgcn_s_barrier()
#define PG8_SCHED __builtin_amdgcn_sched_barrier(0)
    Unit cur, nxt; int ui = 0;
    if (!S.next(0, cur)) return;
    f32x4 acc[2][2][4][2];
#pragma unroll
    for (int a = 0; a < 2; ++a)
#pragma unroll
        for (int b = 0; b < 2; ++b)
#pragma unroll
            for (int m = 0; m < 4; ++m)
#pragma unroll
                for (int n = 0; n < 2; ++n) acc[a][b][m][n] = (f32x4){0.f, 0.f, 0.f, 0.f};
    h16x8 At[4][2], B0[2][2], B1[2][2];
    const char* cA = (const char*)g.A + (size_t)cur.pm * tstep; const char* cB = (const char*)g.Bt + (size_t)cur.pn * tstep;
    PG8_STAGE(PG8_SB(0, 0), cB, voffB); PG8_STAGE(PG8_SA(0, 0), cA, voffA); PG8_STAGE(PG8_SB(0, 1), cB + hstep, voffB); PG8_STAGE(PG8_SA(0, 1), cA + hstep, voffA);
    if (wr == 1) PG8_BAR;
    PG8_WAIT_V(4); PG8_BAR;
    PG8_STAGE(PG8_SB(1, 0), cB + kstep, voffB); PG8_STAGE(PG8_SA(1, 0), cA + kstep, voffA); PG8_STAGE(PG8_SB(1, 1), cB + hstep + kstep, voffB);
    PG8_WAIT_V(6); PG8_BAR;
    for (;;) {
        const bool has_next = S.next(ui + 1, nxt);
        const char* nA = has_next ? (const char*)g.A + (size_t)nxt.pm * tstep : cA; const char* nB = has_next ? (const char*)g.Bt + (size_t)nxt.pn * tstep : cB;
        for (int t = 0; t < nt; t += 2) {
            const bool last = (t == nt - 2);
            const char* a1 = cA + (size_t)(t + 1) * kstep;
            const char* a2 = last ? nA : cA + (size_t)(t + 2) * kstep; const char* b2 = last ? nB : cB + (size_t)(t + 2) * kstep;
            const char* a3 = a2 + kstep; const char* b3 = b2 + kstep;
            PG8_LDB(B0, 0, 0); PG8_SCHED; PG8_LDA(At, 0, 0); PG8_STAGE(PG8_SA(1, 1), a1 + hstep, voffA);
            PG8_WAIT_L(8); PG8_BAR; PG8_WAIT_L(0); PG8_MMA(0, 0, At, B0); PG8_BAR; PG8_SCHED;
            PG8_LDB(B1, 0, 1); PG8_STAGE(PG8_SB(0, 0), b2, voffB);
            PG8_BAR; PG8_WAIT_L(0); PG8_MMA(0, 1, At, B1); PG8_BAR;
            PG8_LDA(At, 0, 1); PG8_STAGE(PG8_SA(0, 0), a2, voffA);
            PG8_BAR; PG8_WAIT_L(0); PG8_MMA(1, 0, At, B0); PG8_BAR; PG8_SCHED;
            PG8_STAGE(PG8_SB(0, 1), b2 + hstep, voffB);
            PG8_WAIT_V(6); PG8_BAR; PG8_MMA(1, 1, At, B1); PG8_BAR;
            PG8_LDB(B0, 1, 0); PG8_SCHED; PG8_LDA(At, 1, 0); PG8_STAGE(PG8_SA(0, 1), a2 + hstep, voffA);
            PG8_WAIT_L(8); PG8_BAR; PG8_WAIT_L(0); PG8_MMA(0, 0, At, B0); PG8_BAR; PG8_SCHED;
            PG8_LDB(B1, 1, 1); PG8_STAGE(PG8_SB(1, 0), b3, voffB);
            PG8_BAR; PG8_WAIT_L(0); PG8_MMA(0, 1, At, B1); PG8_BAR;
            PG8_LDA(At, 1, 1); PG8_STAGE(PG8_SA(1, 0), a3, voffA);
            PG8_BAR; PG8_WAIT_L(0); PG8_MMA(1, 0, At, B0); PG8_BAR; PG8_SCHED;
            PG8_STAGE(PG8_SB(1, 1), b3 + hstep, voffB);
            PG8_WAIT_V(6); PG8_BAR; PG8_MMA(1, 1, At, B1); PG8_BAR;
        }
        E(acc, cur, wr, wc, fr, fq);
        if (!has_next) break;
#pragma unroll
        for (int a = 0; a < 2; ++a)
#pragma unroll
            for (int b = 0; b < 2; ++b)
#pragma unroll
                for (int m = 0; m < 4; ++m)
#pragma unroll
                    for (int n = 0; n < 2; ++n) acc[a][b][m][n] = (f32x4){0.f, 0.f, 0.f, 0.f};
        cur = nxt; cA = nA; cB = nB; ++ui;
    }
    PG8_WAIT_V(0);
    if (wr == 0) PG8_BAR;
    PG8_BAR;
#undef PG8_SA
#undef PG8_SB
#undef PG8_STAGE
#undef PG8_LDA
#undef PG8_LDB
#undef PG8_MMA
#undef PG8_WAIT_V
#undef PG8_WAIT_L
#undef PG8_BAR
#undef PG8_SCHED
}
template <class F>
__device__ __forceinline__ void run_gemm(unsigned char* lds, const f16* A, const f16* Bt, int M, int N, int K, const F& f) {
    Gemm g{A, Bt, M, N, K}; StaticOrder S; S.init(M, N, (int)gridDim.x, (int)blockIdx.x);
    EpiElem<F> E{f};
    gemm_phase<EpiElem<F>>((PG8_LAS unsigned char*)lds, g, S, E);
    __syncthreads();
}
}

__device__ __forceinline__ f16x4 to_h4(f32x4 v) { f16x4 r; r.x = (f16)v.x; r.y = (f16)v.y; r.z = (f16)v.z; r.w = (f16)v.w; return r; }

__device__ __forceinline__ void tr_item(const float* W, int ldw, int col0, int nvalid, int K, f16* out, int nrow0, int item, int nblk, float* scr, int lane) {
    const int kb = item / nblk, nb = item % nblk, k0 = 64 * kb, n0 = 32 * nb;
#pragma unroll 8
    for (int i = 0; i < 32; ++i) { const int kk = 2 * i + (lane >> 5); const int j = n0 + (lane & 31);
        scr[kk * 33 + (lane & 31)] = (j < nvalid) ? W[(size_t)(k0 + kk) * ldw + col0 + j] : 0.f; }
    asm volatile("s_waitcnt vmcnt(0) lgkmcnt(0)" ::: "memory");
    const int c = lane & 7;
#pragma unroll
    for (int jj = 0; jj < 4; ++jj) { const int n = (lane >> 3) + 8 * jj; const float* s = scr + (8 * c) * 33 + n;
        f16x8 o;
#pragma unroll
        for (int e = 0; e < 8; ++e) o[e] = (f16)s[e * 33];
        *(f16x8*)(out + (size_t)(nrow0 + n0 + n) * K + k0 + 8 * c) = o; }
    asm volatile("s_waitcnt lgkmcnt(0)" ::: "memory");
}

__device__ __forceinline__ void ph0_prep(const Params& p, unsigned char* lds) {
    const int tid = threadIdx.x, lane = tid & 63, wave = tid >> 6;
    const int gw = blockIdx.x * 8 + wave, NGW = gridDim.x * 8;
    f16* H0 = (f16*)(p.ws + WS_H0); float* STAT = (float*)(p.ws + WS_STAT);
    for (int m = gw; m < MR; m += NGW) {
        f16* orow = H0 + (size_t)m * D;
        if (m >= MREAL + 2 * NMETA) {
#pragma unroll
            for (int j = 0; j < 4; ++j) *(f16x4*)(orow + j * 256 + lane * 4) = (f16x4){(f16)0.f, (f16)0.f, (f16)0.f, (f16)0.f};
            continue;
        }
        const float* src = (m < MREAL) ? p.x + (size_t)m * D : p.meta + (size_t)((m - MREAL) & 15) * D;
        f32x4 v[4]; float s = 0.f;
#pragma unroll
        for (int j = 0; j < 4; ++j) { v[j] = *(const f32x4*)(src + j * 256 + lane * 4); s += (v[j].x + v[j].y) + (v[j].z + v[j].w); }
        const float mean = wave_sum(s) * (1.f / D); float s2 = 0.f;
#pragma unroll
        for (int j = 0; j < 4; ++j) { v[j] = v[j] - mean; s2 += (v[j].x * v[j].x + v[j].y * v[j].y) + (v[j].z * v[j].z + v[j].w * v[j].w); }
        const float rstd = 1.f / sqrtf(wave_sum(s2) * (1.f / D) + LN_EPS);
        if (lane == 0) { STAT[2 * m] = mean; STAT[2 * m + 1] = rstd; }
#pragma unroll
        for (int j = 0; j < 4; ++j) { const f32x4 g = *(const f32x4*)(p.ln_in_g + j * 256 + lane * 4), bb = *(const f32x4*)(p.ln_in_b + j * 256 + lane * 4);
            *(f16x4*)(orow + j * 256 + lane * 4) = to_h4(v[j] * rstd * g + bb); }
    }
    float* scr = (float*)lds + wave * (64 * 33);
    f16* W1T = (f16*)(p.ws + WS_W1T); f16* WGT = (f16*)(p.ws + WS_WGT); f16* WPBT = (f16*)(p.ws + WS_WPBT); f16* WOT = (f16*)(p.ws + WS_WOT);
    constexpr int I_QI = 16 * 16, I_CKV = 4 * 16, I_KI = 4 * 16, I_BC = 56 * 16, I_G = 64 * 16, I_PB = 32 * 8, I_O = 32 * 16;
    constexpr int NITEMS = I_QI + I_CKV + I_KI + I_BC + I_G + I_PB + I_O;
    for (int it = gw; it < NITEMS; it += NGW) {
        int r = it;
        if (r < I_QI) { tr_item(p.w_in, NIN, 640, 512, D, W1T, C_QI, r, 16, scr, lane); continue; } r -= I_QI;
        if (r < I_CKV) { tr_item(p.w_in, NIN, 512, 128, D, W1T, C_CKV, r, 4, scr, lane); continue; } r -= I_CKV;
        if (r < I_KI) { tr_item(p.w_in, NIN, 1152, 72, D, W1T, C_KI, r, 4, scr, lane); continue; } r -= I_KI;
        if (r < I_BC) { tr_item(p.w_in, NIN, 1224, 1792, D, W1T, C_BC, r, 56, scr, lane); continue; } r -= I_BC;
        if (r < I_G) { tr_item(p.w_in, NIN, 3016, 2048, D, WGT, 0, r, 64, scr, lane); continue; } r -= I_G;
        if (r < I_PB) { tr_item(p.w_pb, D, 0, 1024, 512, WPBT, 0, r, 32, scr, lane); continue; } r -= I_PB;
        tr_item(p.w_o, D, 0, 1024, D, WOT, 0, r, 32, scr, lane);
    }
    {
        const int fr = lane & 15, fq = lane >> 4;
        constexpr int T_W1 = 8 * 8 * 64, T_SK = 16 * 8 * 64, T_PA = 8 * 8 * 64;
        f16* WPAT = (f16*)(p.ws + WS_WPAT); f16* WSKT = (f16*)(p.ws + WS_WSKT);
        for (int it = gw; it < T_W1 + T_SK + T_PA; it += NGW) {
            int r = it; int kind = 0; if (r >= T_W1) { r -= T_W1; kind = 1; if (r >= T_SK) { r -= T_SK; kind = 2; } }
            const int g = r >> 9, mt = (r >> 6) & 7, nt = r & 63;
            const int m = 16 * mt + fr, n = 16 * nt + fr;
            const int KK = (kind == 1) ? 128 : 64;
            f32x4 acc = {0.f, 0.f, 0.f, 0.f};
            for (int k0 = 0; k0 < KK; k0 += 32) {
                const int kb = k0 + 8 * fq;
                f16x8 af, bf;
                if (kind == 0) { const float* ap = p.a_w_uk + (size_t)(m * 8 + g) * 64 + kb; const float* bp = p.w_in + (size_t)n * NIN + g * 64 + kb;
                    const f32x4 a0 = *(const f32x4*)ap, a1 = *(const f32x4*)(ap + 4), b0 = *(const f32x4*)bp, b1 = *(const f32x4*)(bp + 4);
#pragma unroll
                    for (int e = 0; e < 4; ++e) { af[e] = (f16)a0[e]; af[4 + e] = (f16)a1[e]; bf[e] = (f16)b0[e]; bf[4 + e] = (f16)b1[e]; } }
                else if (kind == 1) { const float* ap = p.peer_subkeys + (size_t)(g * 128 + m) * 128 + kb; const float* bp = p.peer_wq + (size_t)n * 2048 + g * 128 + kb;
                    const f32x4 a0 = *(const f32x4*)ap, a1 = *(const f32x4*)(ap + 4), b0 = *(const f32x4*)bp, b1 = *(const f32x4*)(bp + 4);
#pragma unroll
                    for (int e = 0; e < 4; ++e) { af[e] = (f16)a0[e]; af[4 + e] = (f16)a1[e]; bf[e] = (f16)b0[e]; bf[4 + e] = (f16)b1[e]; } }
                else { const float* ap = p.a_w_uv + (size_t)(m * 8 + g) * 64 + kb; const float* bp = p.w_pa + (size_t)(g * 64 + kb) * D + n;
                    const f32x4 a0 = *(const f32x4*)ap, a1 = *(const f32x4*)(ap + 4);
#pragma unroll
                    for (int e = 0; e < 4; ++e) { af[e] = (f16)a0[e]; af[4 + e] = (f16)a1[e]; }
#pragma unroll
                    for (int e = 0; e < 8; ++e) bf[e] = (f16)bp[(size_t)e * D]; }
                acc = __builtin_amdgcn_mfma_f32_16x16x32_f16(af, bf, acc, 0, 0, 0);
            }
            if (kind == 2) { *(f16x4*)(WPAT + (size_t)n * D + g * 128 + 16 * mt + 4 * fq) = to_h4(acc); }
            else { f16* o = ((kind == 0) ? W1T : WSKT) + (size_t)(g * 128 + 16 * mt + 4 * fq) * D + n;
#pragma unroll
                for (int e = 0; e < 4; ++e) o[(size_t)e * D] = (f16)acc[e]; }
        }
    }
    const long gt = (long)blockIdx.x * NT + tid, NGT = (long)gridDim.x * NT;
    f16* WLT = (f16*)(p.ws + WS_WLT);
    for (long e = gt; e < 1536L * 256; e += NGT) { const int n = (int)(e >> 8), k = (int)(e & 255); float v = 0.f;
        if (n < 512) { if (k < 64) v = p.b_w2[(size_t)k * 512 + n]; }
        else if (n < 1024) { if (k >= 64 && k < 128) v = p.b_a2[(size_t)(k - 64) * 512 + (n - 512)]; }
        else { if (k >= 128) v = p.b_g2[(size_t)(k - 128) * 512 + (n - 1024)]; }
        WLT[e] = (f16)v; }
}

__device__ __forceinline__ void phc1_rowprep(const Params& p) {
    const int tid = threadIdx.x, lane = tid & 63, wave = tid >> 6;
    const int gw = blockIdx.x * 8 + wave, NGW = gridDim.x * 8;
    const f16* PB = (const f16*)(p.ws + WS_PB); f16* CKV = (f16*)(p.ws + WS_CKV); f16* KIDX = (f16*)(p.ws + WS_KIDX); float* WIS = (float*)(p.ws + WS_WIS);
    f16* LORAIN = (f16*)((unsigned char*)p.out + DO_LORAIN);
    for (int m = gw; m < MR; m += NGW) {
        if (m >= MREAL + 2 * NMETA) { *(f16x4*)(LORAIN + (size_t)m * 256 + lane * 4) = (f16x4){(f16)0.f, (f16)0.f, (f16)0.f, (f16)0.f}; continue; }
        const f16* pr = PB + (size_t)m * N1;
        { const f16x2 c2 = *(const f16x2*)(pr + C_CKV + 2 * lane); const float a = (float)c2.x, b = (float)c2.y;
          const float ss = wave_sum(a * a + b * b); const float r = 1.f / sqrtf(ss * (1.f / 128.f) + 1e-6f);
          f16x2 o; o.x = (f16)(a * r * p.a_kv_norm_g[2 * lane]); o.y = (f16)(b * r * p.a_kv_norm_g[2 * lane + 1]);
          *(f16x2*)(CKV + (size_t)m * 128 + 2 * lane) = o; }
        { const float a = (float)pr[C_KI + lane]; const float mu = wave_sum(a) * (1.f / 64.f); const float d = a - mu;
          const float var = wave_sum(d * d) * (1.f / 64.f);
          int kb_, kt_; if (m < MREAL) { kb_ = m >> 13; kt_ = NMETA + (m & 8191); } else { kb_ = (m - MREAL) >> 4; kt_ = (m - MREAL) & 15; }
          KIDX[(size_t)kb_ * KIDX_B + (size_t)(kt_ >> 5) * 2048 + (lane >> 4) * 512 + ((lane >> 3) & 1) * 256 + (kt_ & 31) * 8 + (lane & 7)] = (f16)(d * (1.f / sqrtf(var + LN_EPS)) * p.a_kidx_g[lane] + p.a_kidx_b[lane]); }
        if (lane < 8) WIS[(size_t)m * 8 + lane] = (float)pr[C_WI + lane] * 0.04419417382415922f;
        { int b, t; if (m < MREAL) { b = m >> 13; t = NMETA + (m & 8191); } else { b = (m - MREAL) >> 4; t = (m - MREAL) & 15; }
          const f16x4 cur = *(const f16x4*)(pr + C_BC + 1536 + lane * 4);
          f16x4 prv = (f16x4){(f16)0.f, (f16)0.f, (f16)0.f, (f16)0.f};
          if (t > 0) prv = *(const f16x4*)(PB + (size_t)row_of(b, t - 1) * N1 + C_BC + 1536 + lane * 4);
          const f32x4 mu = *(const f32x4*)(p.b_mu + 1536 + lane * 4);
          f16x4 o;
#pragma unroll
          for (int e = 0; e < 4; ++e) { const float c = (float)cur[e], q = (float)prv[e]; float xs = c + (q - c) * mu[e];
              const int j = lane * 4 + e; if (j < 64) xs = tanhf(xs); else if (j >= 128) xs = sigmoidf_(xs); o[e] = (f16)xs; }
          *(f16x4*)(LORAIN + (size_t)m * 256 + lane * 4) = o; }
    }
}

typedef short bf16x8 __attribute__((ext_vector_type(8)));
typedef unsigned short bf16_t;
typedef unsigned u32x2 __attribute__((ext_vector_type(2)));
typedef __bf16 bf16x2_t __attribute__((ext_vector_type(2)));
__device__ __forceinline__ unsigned cvt_pk_bf16(float lo, float hi) { const f32x2 v = {lo, hi}; const bf16x2_t b = __builtin_convertvector(v, bf16x2_t); return __builtin_bit_cast(unsigned, b); }
__device__ __forceinline__ bf16_t f2bf(float f) { unsigned u = __float_as_uint(f); return (bf16_t)((u + 0x7fffu + ((u >> 16) & 1u)) >> 16); }
__device__ __forceinline__ u32x2 pk4(f32x4 v) { u32x2 r; r.x = cvt_pk_bf16(v[0], v[1]); r.y = cvt_pk_bf16(v[2], v[3]); return r; }
__device__ __forceinline__ bf16x8 pk8(f32x4 a, f32x4 b) { u32x4 r; r.x = cvt_pk_bf16(a[0], a[1]); r.y = cvt_pk_bf16(a[2], a[3]); r.z = cvt_pk_bf16(b[0], b[1]); r.w = cvt_pk_bf16(b[2], b[3]); return __builtin_bit_cast(bf16x8, r); }
#define MFMA_BF(a, b, c) __builtin_amdgcn_mfma_f32_16x16x32_bf16((a), (b), (c), 0, 0, 0)
constexpr int RS = 72, PSt = 40, FS = 36, YS = 68;
__device__ __forceinline__ void rwkv_item(const Params& p, int b, int h, unsigned char* lds) {
    int tid_ = threadIdx.x; asm volatile("" : "+v"(tid_));
    const int tid = tid_, lane = tid & 63, wave = __builtin_amdgcn_readfirstlane(tid >> 6), fr = lane & 15, fq = lane >> 4;
    const f16* PB = (const f16*)(p.ws + WS_PB);
    const f16* LW = (const f16*)((unsigned char*)p.out + DO_LW); const f16* AA = (const f16*)((unsigned char*)p.out + DO_AA); const f16* GG = (const f16*)((unsigned char*)p.out + DO_GG);
    f16* OB = (f16*)(p.ws + WS_OB);
    constexpr int SETB = 4 * 32 * RS * 2 + 3 * 64 * PSt * 2 + 256 + 4608 * 4;
#define RW_SET(par_) bf16_t* sAt = (bf16_t*)(lds + (par_) * SETB); bf16_t* sRt = sAt + 32 * RS; bf16_t* sBt = sRt + 32 * RS; bf16_t* sKt = sBt + 32 * RS; \
        bf16_t* sBPT = sKt + 32 * RS; bf16_t* sKPT = sBPT + 64 * PSt; bf16_t* sVT = sKPT + 64 * PSt; float* sPL = (float*)(sVT + 64 * PSt); float* sFst = sPL + 64; \
        (void)sAt; (void)sRt; (void)sBt; (void)sKt; (void)sBPT; (void)sKPT; (void)sVT; (void)sPL; (void)sFst
    bf16_t* sAak = (bf16_t*)(lds + 2 * SETB); bf16_t* sMrb = sAak + 32 * PSt; bf16_t* sMrk = sMrb + 32 * PSt; bf16_t* sT = sMrk + 32 * PSt; bf16_t* sAabB = sT + 32 * PSt;
    float* sAabT = (float*)(sAabB + 16 * PSt); float* sTot = sAabT + 2 * 16 * FS; float* sY = sTot + 8 * 64;
    float* sEnd = sY + 32 * YS;
    float* sCst = sEnd;
    for (unsigned* z = (unsigned*)lds + tid; z < (unsigned*)sEnd; z += NT) *z = 0u;
    const int ps = tid >> 4, cg = tid & 15, c4 = cg * 4, hc = h * 64 + c4;
    const int chslot = 32 * (cg >> 3) + 8 * (cg & 3) + 4 * ((cg >> 2) & 1);
    const int pslot = 8 * ((ps & 15) >> 2) + 4 * (ps >> 4) + (ps & 3);
#define PSWZ(row, slot) ((row) * PSt + ((((slot) >> 3) ^ (((row) >> 3) & 3)) << 3) + ((slot) & 7))
    if (tid < 64) { sCst[tid] = p.b_mu[h * 64 + tid]; sCst[64 + tid] = p.b_mu[512 + h * 64 + tid]; sCst[128 + tid] = p.b_mu[1024 + h * 64 + tid]; sCst[192 + tid] = p.b_k_k[h * 64 + tid];
        sCst[256 + tid] = p.b_k_a[h * 64 + tid]; sCst[320 + tid] = p.b_r_k[h * 64 + tid]; sCst[384 + tid] = p.b_lnx_g[h * 64 + tid]; sCst[448 + tid] = p.b_lnx_b[h * 64 + tid]; }
    f32x4 Hacc[4];
#pragma unroll
    for (int i = 0; i < 4; ++i) Hacc[i] = (f32x4){0.f, 0.f, 0.f, 0.f};
    const f16x4 hz = (f16x4){(f16)0.f, (f16)0.f, (f16)0.f, (f16)0.f};
    f16x4 n_cr = hz, n_ck = hz, n_cv = hz, n_qr = hz, n_qk = hz, n_qv = hz, n_lw = hz, n_aa = hz, n_gg = hz;
#define RW_PREFETCH(tt) do { const int _t = (tt); n_cr = hz; n_ck = hz; n_cv = hz; n_qr = hz; n_qk = hz; n_qv = hz; n_lw = hz; n_aa = hz; n_gg = hz; \
        if (_t < TT) { const int _m = row_of(b, _t); const f16* _pr = PB + (size_t)_m * N1 + C_BC + hc; n_cr = *(const f16x4*)(_pr); n_ck = *(const f16x4*)(_pr + 512); n_cv = *(const f16x4*)(_pr + 1024); \
            if (_t > 0) { const f16* _pp = PB + (size_t)row_of(b, _t - 1) * N1 + C_BC + hc; n_qr = *(const f16x4*)(_pp); n_qk = *(const f16x4*)(_pp + 512); n_qv = *(const f16x4*)(_pp + 1024); } \
            n_lw = *(const f16x4*)(LW + (size_t)_m * 512 + hc); n_aa = *(const f16x4*)(AA + (size_t)_m * 512 + hc); n_gg = *(const f16x4*)(GG + (size_t)_m * 512 + hc); } } while (0)
    RW_PREFETCH(ps);
    __syncthreads();
#define RW_SCAN_LOCAL(dst, lwv) do { dst = (f32x4){(float)(lwv)[0], (float)(lwv)[1], (float)(lwv)[2], (float)(lwv)[3]}; f32x4 u1_; \
        _Pragma("unroll") for (int e = 0; e < 4; ++e) u1_[e] = __shfl_up(dst[e], 16); if (lane >= 16) dst += u1_; \
        _Pragma("unroll") for (int e = 0; e < 4; ++e) u1_[e] = __shfl_up(dst[e], 32); if (lane >= 32) dst += u1_; \
        if (lane >= 48) *(f32x4*)(sTot + wave * 64 + c4) = dst; } while (0)
#define RW_SCAN_FINISH(dst, totv) do { totv = (f32x4){0.f, 0.f, 0.f, 0.f}; f32x4 tw_[8]; \
        _Pragma("unroll") for (int w = 0; w < 8; ++w) tw_[w] = *(const f32x4*)(sTot + w * 64 + c4); \
        __builtin_amdgcn_sched_barrier(0); \
        _Pragma("unroll") for (int w = 0; w < 8; ++w) { totv += tw_[w]; const float msk_ = (w < wave) ? 1.f : 0.f; dst += tw_[w] * msk_; } } while (0)
    f32x4 cumC, totC;
    RW_SCAN_LOCAL(cumC, n_lw);
    __syncthreads();
    RW_SCAN_FINISH(cumC, totC);
    __syncthreads();
    constexpr int NCH = (TT + 31) / 32;
    { RW_SET(0); const int t = ps;
        f32x4 r4 = {0, 0, 0, 0}, k4 = r4, v4 = r4, kk4 = r4, a4 = r4, g4 = r4, lw4 = r4;
        f32x4 rkw;
        {
            const f16x4 cr = n_cr, ck = n_ck, cv = n_cv, qr = n_qr, qk = n_qk, qv = n_qv, lw = n_lw, aa = n_aa, gg = n_gg;
            RW_PREFETCH(t + 32);
            const f32x4 mu_r = *(const f32x4*)(sCst + c4), mu_k = *(const f32x4*)(sCst + 64 + c4), mu_v = *(const f32x4*)(sCst + 128 + c4), kkw = *(const f32x4*)(sCst + 192 + c4), kaw = *(const f32x4*)(sCst + 256 + c4);
            rkw = *(const f32x4*)(sCst + 320 + c4);
#pragma unroll
            for (int e = 0; e < 4; ++e) {
                const float c0 = (float)cr[e], c1 = (float)ck[e], c2 = (float)cv[e];
                r4[e] = c0 + ((float)qr[e] - c0) * mu_r[e];
                const float k0 = c1 + ((float)qk[e] - c1) * mu_k[e];
                v4[e] = c2 + ((float)qv[e] - c2) * mu_v[e];
                a4[e] = (float)aa[e]; lw4[e] = (float)lw[e]; g4[e] = (float)gg[e];
                kk4[e] = k0 * kkw[e];
                k4[e] = k0 * (1.f + (a4[e] - 1.f) * kaw[e]);
            }
        }
        float ss = kk4[0] * kk4[0] + kk4[1] * kk4[1] + kk4[2] * kk4[2] + kk4[3] * kk4[3];
        float bo = r4[0] * k4[0] * rkw[0] + r4[1] * k4[1] * rkw[1] + r4[2] * k4[2] * rkw[2] + r4[3] * k4[3] * rkw[3];
        ss = row16_sum(ss); bo = row16_sum(bo);
        *(f32x4*)(sFst + tid * 4) = v4; *(f32x4*)(sFst + 2048 + tid * 4) = g4; sFst[4096 + tid] = bo;
        const float rn = __builtin_amdgcn_rsqf(ss + 1e-12f);
        f32x4 bb4;
#pragma unroll
        for (int e = 0; e < 4; ++e) { kk4[e] *= rn; bb4[e] = kk4[e] * a4[e]; }
        const f32x4 cum = cumC, tot = totC;
        {
            f32x4 xa, xb, xk, xr, xbp, xkp;
#pragma unroll
            for (int e = 0; e < 4; ++e) { const float e1 = __expf(cum[e]), e2 = __expf(-cum[e]), e3 = __expf(cum[e] - lw4[e]), e4 = __expf(tot[e] - cum[e]);
                xa[e] = -kk4[e] * e3; xb[e] = bb4[e] * e2; xk[e] = k4[e] * e2; xr[e] = r4[e] * e1; xbp[e] = bb4[e] * e4; xkp[e] = k4[e] * e4; }
            *(u32x2*)(sAt + ps * RS + chslot) = pk4(xa); *(u32x2*)(sBt + ps * RS + chslot) = pk4(xb); *(u32x2*)(sKt + ps * RS + chslot) = pk4(xk); *(u32x2*)(sRt + ps * RS + chslot) = pk4(xr);
#pragma unroll
            for (int e = 0; e < 4; e += 2) { const unsigned pb_ = cvt_pk_bf16(xbp[e], xbp[e + 1]), pk_ = cvt_pk_bf16(xkp[e], xkp[e + 1]), pv_ = cvt_pk_bf16(v4[e], v4[e + 1]);
                sBPT[PSWZ(c4 + e, pslot)] = (bf16_t)pb_; sBPT[PSWZ(c4 + e + 1, pslot)] = (bf16_t)(pb_ >> 16); sKPT[PSWZ(c4 + e, pslot)] = (bf16_t)pk_; sKPT[PSWZ(c4 + e + 1, pslot)] = (bf16_t)(pk_ >> 16);
                sVT[PSWZ(c4 + e, pslot)] = (bf16_t)pv_; sVT[PSWZ(c4 + e + 1, pslot)] = (bf16_t)(pv_ >> 16); }
            if (ps == 0) { f32x4 pl;
#pragma unroll
                for (int e = 0; e < 4; ++e) pl[e] = __expf(tot[e]);
                *(f32x4*)(sPL + c4) = pl; }
        }
    }
    __syncthreads();
    { RW_SET(0);
        for (int jb = (wave < 2) ? wave : wave, jn = 0; jb < 12 && !(wave < 2 && jn > 0); jb += 6, ++jn) {
            const bf16_t *Ab, *Bb; int ta, tb;
            if (jb < 2) { ta = jb; tb = jb; Ab = sAt; Bb = sBt; }
            else if (jb == 2) { ta = 0; tb = 1; Ab = sBt; Bb = sAt; }
            else { const int ti = (jb - 3) % 3, prod = (jb - 3) / 3; ta = (ti == 2) ? 1 : 0; tb = (ti >= 1) ? 1 : 0; Ab = (prod == 1) ? sBt : sKt; Bb = (prod == 0) ? sAt : sRt; }
            f32x4 acc = {0, 0, 0, 0};
#pragma unroll
            for (int ks = 0; ks < 2; ++ks) { const bf16x8 a = *(const bf16x8*)(Ab + (16 * ta + fr) * RS + 32 * ks + 8 * fq); const bf16x8 bq = *(const bf16x8*)(Bb + (16 * tb + fr) * RS + 32 * ks + 8 * fq); acc = MFMA_BF(a, bq, acc); }
            const int rloc = 4 * fq, cloc = fr;
            if (jb < 2) {
#pragma unroll
                for (int e = 0; e < 4; ++e) acc[e] = (cloc < rloc + e) ? acc[e] : 0.f;
                *(f32x4*)(sAabT + jb * 16 * FS + cloc * FS + rloc) = acc;
                asm volatile("s_waitcnt lgkmcnt(0)" ::: "memory");
                if (lane < 16) {
                    const int col = lane;
                    const float* At_ = sAabT + jb * 16 * FS;
                    float x[16];
#pragma unroll
                    for (int s2 = 0; s2 < 16; ++s2) x[s2] = (s2 == col) ? 1.f : 0.f;
#define RW_INV_BATCH(J0, J1) do { f32x4 cv_[(J1) - (J0)][4]; \
                    _Pragma("unroll") for (int j = (J0); j < (J1); ++j) _Pragma("unroll") for (int q4 = (j + 1) / 4; q4 < 4; ++q4) cv_[j - (J0)][q4] = *(const f32x4*)(At_ + j * FS + 4 * q4); \
                    __builtin_amdgcn_sched_barrier(0); \
                    _Pragma("unroll") for (int j = (J0); j < (J1); ++j) { const float xj = x[j]; \
                        _Pragma("unroll") for (int q4 = (j + 1) / 4; q4 < 4; ++q4) _Pragma("unroll") for (int e = 0; e < 4; ++e) if (4 * q4 + e > j) x[4 * q4 + e] += cv_[j - (J0)][q4][e] * xj; } \
                    __builtin_amdgcn_sched_barrier(0); } while (0)
                    RW_INV_BATCH(0, 3); RW_INV_BATCH(3, 7); RW_INV_BATCH(7, 15);
#pragma unroll
                    for (int s2 = 0; s2 < 16; ++s2) sT[(16 * jb + s2) * PSt + 8 * (col >> 2) + (col & 3)] = f2bf(x[s2]);
                }
            } else if (jb == 2) {
                *(u32x2*)(sAabB + cloc * PSt + 8 * fq) = pk4(acc);
            } else {
                const int prod = (jb - 3) / 3; const int jrow = 16 * ta + rloc, scol = 16 * tb + cloc;
                if (prod == 0) {
#pragma unroll
                    for (int e = 0; e < 4; ++e) acc[e] = (jrow + e < scol) ? acc[e] : 0.f;
                } else {
#pragma unroll
                    for (int e = 0; e < 4; ++e) acc[e] = (jrow + e <= scol) ? acc[e] : 0.f;
                }
                *(u32x2*)(((prod == 0) ? sAak : (prod == 1) ? sMrb : sMrk) + scol * PSt + 8 * fq + 4 * ta) = pk4(acc);
            }
        }
    }
    { f32x4 cumN, totN; RW_SCAN_LOCAL(cumN, n_lw); __syncthreads(); RW_SCAN_FINISH(cumN, totN); cumC = cumN; totC = totN; }
    for (int c = 0; c < NCH; ++c) {
        const int par = c & 1; const bool more = (c + 1 < NCH);
        { RW_SET(par);
        if (wave < 4) {
            const int v0 = 16 * wave;
            const f32x4 z4 = {0.f, 0.f, 0.f, 0.f};
            const bf16x8 hb0 = pk8(Hacc[0], Hacc[1]), hb1 = pk8(Hacc[2], Hacc[3]);
            const bf16x8 vb = *(const bf16x8*)(sVT + PSWZ(v0 + fr, 8 * fq));
            bf16x8 fAt[2][2], fAak[2], fT[2], fAabB;
#pragma unroll
            for (int ts = 0; ts < 2; ++ts) { const bf16_t* atr = sAt + (16 * ts + fr) * RS;
                fAt[ts][0] = *(const bf16x8*)(atr + 8 * fq); fAt[ts][1] = *(const bf16x8*)(atr + 32 + 8 * fq); fAak[ts] = *(const bf16x8*)(sAak + (16 * ts + fr) * PSt + 8 * fq); fT[ts] = *(const bf16x8*)(sT + (16 * ts + fr) * PSt + 8 * fq); }
            fAabB = *(const bf16x8*)(sAabB + fr * PSt + 8 * fq);
            __builtin_amdgcn_sched_barrier(0);
            f32x4 zt = MFMA_BF(fAt[0][0], hb0, z4); f32x4 zb = MFMA_BF(fAt[1][0], hb0, z4);
            zt = MFMA_BF(fAt[0][1], hb1, zt); zb = MFMA_BF(fAt[1][1], hb1, zb);
            zt = MFMA_BF(fAak[0], vb, zt); zb = MFMA_BF(fAak[1], vb, zb);
            bf16x8 fRt[2][2], fMrk[2], fMrb[2];
#pragma unroll
            for (int ts = 0; ts < 2; ++ts) { const bf16_t* rtr = sRt + (16 * ts + fr) * RS;
                fRt[ts][0] = *(const bf16x8*)(rtr + 8 * fq); fRt[ts][1] = *(const bf16x8*)(rtr + 32 + 8 * fq);
                fMrk[ts] = *(const bf16x8*)(sMrk + (16 * ts + fr) * PSt + 8 * fq); fMrb[ts] = *(const bf16x8*)(sMrb + (16 * ts + fr) * PSt + 8 * fq); }
            __builtin_amdgcn_sched_barrier(0);
            const f32x4 ut = MFMA_BF(fT[0], pk8(zt, z4), z4);
            f32x4 y0 = MFMA_BF(fRt[0][0], hb0, z4); f32x4 y1 = MFMA_BF(fRt[1][0], hb0, z4);
            y0 = MFMA_BF(fRt[0][1], hb1, y0); y1 = MFMA_BF(fRt[1][1], hb1, y1);
            zb = MFMA_BF(fAabB, pk8(ut, z4), zb);
            y0 = MFMA_BF(fMrk[0], vb, y0); y1 = MFMA_BF(fMrk[1], vb, y1);
            const f32x4 ubt = MFMA_BF(fT[1], pk8(zb, z4), z4);
            const bf16x8 ub = pk8(ut, ubt);
            y0 = MFMA_BF(fMrb[0], ub, y0); y1 = MFMA_BF(fMrb[1], ub, y1);
#pragma unroll
            for (int e = 0; e < 4; ++e) { sY[(4 * fq + e) * YS + v0 + fr] = y0[e]; sY[(16 + 4 * fq + e) * YS + v0 + fr] = y1[e]; }
            __builtin_amdgcn_sched_barrier(0);
            bf16x8 fBP[4], fKP[4]; f32x4 fPL[4];
#pragma unroll
            for (int tc = 0; tc < 4; ++tc) { fBP[tc] = *(const bf16x8*)(sBPT + PSWZ(16 * tc + fr, 8 * fq)); fKP[tc] = *(const bf16x8*)(sKPT + PSWZ(16 * tc + fr, 8 * fq)); fPL[tc] = *(const f32x4*)(sPL + 16 * tc + 4 * fq); }
            __builtin_amdgcn_sched_barrier(0);
#pragma unroll
            for (int tc = 0; tc < 4; ++tc) {
                f32x4 acc = Hacc[tc] * fPL[tc];
                acc = MFMA_BF(fBP[tc], ub, acc);
                acc = MFMA_BF(fKP[tc], vb, acc);
                Hacc[tc] = acc; }
        }
        }
        if (more) { RW_SET(par ^ 1); const int t = 32 * (c + 1) + ps;
        f32x4 r4 = {0, 0, 0, 0}, k4 = r4, v4 = r4, kk4 = r4, a4 = r4, g4 = r4, lw4 = r4;
        f32x4 rkw;
        {
            const f16x4 cr = n_cr, ck = n_ck, cv = n_cv, qr = n_qr, qk = n_qk, qv = n_qv, lw = n_lw, aa = n_aa, gg = n_gg;
            RW_PREFETCH(t + 32);
            const f32x4 mu_r = *(const f32x4*)(sCst + c4), mu_k = *(const f32x4*)(sCst + 64 + c4), mu_v = *(const f32x4*)(sCst + 128 + c4), kkw = *(const f32x4*)(sCst + 192 + c4), kaw = *(const f32x4*)(sCst + 256 + c4);
            rkw = *(const f32x4*)(sCst + 320 + c4);
#pragma unroll
            for (int e = 0; e < 4; ++e) {
                const float c0 = (float)cr[e], c1 = (float)ck[e], c2 = (float)cv[e];
                r4[e] = c0 + ((float)qr[e] - c0) * mu_r[e];
                const float k0 = c1 + ((float)qk[e] - c1) * mu_k[e];
                v4[e] = c2 + ((float)qv[e] - c2) * mu_v[e];
                a4[e] = (float)aa[e]; lw4[e] = (float)lw[e]; g4[e] = (float)gg[e];
                kk4[e] = k0 * kkw[e];
                k4[e] = k0 * (1.f + (a4[e] - 1.f) * kaw[e]);
            }
        }
        float ss = kk4[0] * kk4[0] + kk4[1] * kk4[1] + kk4[2] * kk4[2] + kk4[3] * kk4[3];
        float bo = r4[0] * k4[0] * rkw[0] + r4[1] * k4[1] * rkw[1] + r4[2] * k4[2] * rkw[2] + r4[3] * k4[3] * rkw[3];
        ss = row16_sum(ss); bo = row16_sum(bo);
        *(f32x4*)(sFst + tid * 4) = v4; *(f32x4*)(sFst + 2048 + tid * 4) = g4; sFst[4096 + tid] = bo;
        const float rn = __builtin_amdgcn_rsqf(ss + 1e-12f);
        f32x4 bb4;
#pragma unroll
        for (int e = 0; e < 4; ++e) { kk4[e] *= rn; bb4[e] = kk4[e] * a4[e]; }
        const f32x4 cum = cumC, tot = totC;
        {
            f32x4 xa, xb, xk, xr, xbp, xkp;
#pragma unroll
            for (int e = 0; e < 4; ++e) { const float e1 = __expf(cum[e]), e2 = __expf(-cum[e]), e3 = __expf(cum[e] - lw4[e]), e4 = __expf(tot[e] - cum[e]);
                xa[e] = -kk4[e] * e3; xb[e] = bb4[e] * e2; xk[e] = k4[e] * e2; xr[e] = r4[e] * e1; xbp[e] = bb4[e] * e4; xkp[e] = k4[e] * e4; }
            *(u32x2*)(sAt + ps * RS + chslot) = pk4(xa); *(u32x2*)(sBt + ps * RS + chslot) = pk4(xb); *(u32x2*)(sKt + ps * RS + chslot) = pk4(xk); *(u32x2*)(sRt + ps * RS + chslot) = pk4(xr);
#pragma unroll
            for (int e = 0; e < 4; e += 2) { const unsigned pb_ = cvt_pk_bf16(xbp[e], xbp[e + 1]), pk_ = cvt_pk_bf16(xkp[e], xkp[e + 1]), pv_ = cvt_pk_bf16(v4[e], v4[e + 1]);
                sBPT[PSWZ(c4 + e, pslot)] = (bf16_t)pb_; sBPT[PSWZ(c4 + e + 1, pslot)] = (bf16_t)(pb_ >> 16); sKPT[PSWZ(c4 + e, pslot)] = (bf16_t)pk_; sKPT[PSWZ(c4 + e + 1, pslot)] = (bf16_t)(pk_ >> 16);
                sVT[PSWZ(c4 + e, pslot)] = (bf16_t)pv_; sVT[PSWZ(c4 + e + 1, pslot)] = (bf16_t)(pv_ >> 16); }
            if (ps == 0) { f32x4 pl;
#pragma unroll
                for (int e = 0; e < 4; ++e) pl[e] = __expf(tot[e]);
                *(f32x4*)(sPL + c4) = pl; }
        }
        }
        __syncthreads();
        { RW_SET(par); const int tF = 32 * c + ps;
        {
            const f32x4 y4 = *(const f32x4*)(sY + ps * YS + c4); const f32x4 lng = *(const f32x4*)(sCst + 384 + c4), lnb = *(const f32x4*)(sCst + 448 + c4);
            const f32x4 pv4 = *(const f32x4*)(sFst + tid * 4), pg4 = *(const f32x4*)(sFst + 2048 + tid * 4); const float pbo = sFst[4096 + tid];
            const float mean = row16_sum((y4[0] + y4[1]) + (y4[2] + y4[3])) * (1.f / 64.f);
            float q = 0.f;
#pragma unroll
            for (int e = 0; e < 4; ++e) { const float d = y4[e] - mean; q += d * d; }
            const float rstd = __builtin_amdgcn_rsqf(row16_sum(q) * (1.f / 64.f) + 64e-5f);
            if (tF < TT && tF >= NMETA) {
                f16x4 o;
#pragma unroll
                for (int e = 0; e < 4; ++e) o[e] = (f16)((((y4[e] - mean) * rstd) * lng[e] + lnb[e] + pbo * pv4[e]) * pg4[e]);
                *(f16x4*)(OB + (size_t)(b * SEQ + (tF - NMETA)) * 512 + hc) = o;
            }
        }
        }
        f32x4 cumN = {0.f, 0.f, 0.f, 0.f}, totN = cumN;
        if (more) { RW_SET(par ^ 1);
        for (int jb = (wave < 2) ? wave : wave, jn = 0; jb < 12 && !(wave < 2 && jn > 0); jb += 6, ++jn) {
            const bf16_t *Ab, *Bb; int ta, tb;
            if (jb < 2) { ta = jb; tb = jb; Ab = sAt; Bb = sBt; }
            else if (jb == 2) { ta = 0; tb = 1; Ab = sBt; Bb = sAt; }
            else { const int ti = (jb - 3) % 3, prod = (jb - 3) / 3; ta = (ti == 2) ? 1 : 0; tb = (ti >= 1) ? 1 : 0; Ab = (prod == 1) ? sBt : sKt; Bb = (prod == 0) ? sAt : sRt; }
            f32x4 acc = {0, 0, 0, 0};
#pragma unroll
            for (int ks = 0; ks < 2; ++ks) { const bf16x8 a = *(const bf16x8*)(Ab + (16 * ta + fr) * RS + 32 * ks + 8 * fq); const bf16x8 bq = *(const bf16x8*)(Bb + (16 * tb + fr) * RS + 32 * ks + 8 * fq); acc = MFMA_BF(a, bq, acc); }
            const int rloc = 4 * fq, cloc = fr;
            if (jb < 2) {
#pragma unroll
                for (int e = 0; e < 4; ++e) acc[e] = (cloc < rloc + e) ? acc[e] : 0.f;
                *(f32x4*)(sAabT + jb * 16 * FS + cloc * FS + rloc) = acc;
                asm volatile("s_waitcnt lgkmcnt(0)" ::: "memory");
                if (lane < 16) {
                    const int col = lane;
                    const float* At_ = sAabT + jb * 16 * FS;
                    float x[16];
#pragma unroll
                    for (int s2 = 0; s2 < 16; ++s2) x[s2] = (s2 == col) ? 1.f : 0.f;
#define RW_INV_BATCH(J0, J1) do { f32x4 cv_[(J1) - (J0)][4]; \
                    _Pragma("unroll") for (int j = (J0); j < (J1); ++j) _Pragma("unroll") for (int q4 = (j + 1) / 4; q4 < 4; ++q4) cv_[j - (J0)][q4] = *(const f32x4*)(At_ + j * FS + 4 * q4); \
                    __builtin_amdgcn_sched_barrier(0); \
                    _Pragma("unroll") for (int j = (J0); j < (J1); ++j) { const float xj = x[j]; \
                        _Pragma("unroll") for (int q4 = (j + 1) / 4; q4 < 4; ++q4) _Pragma("unroll") for (int e = 0; e < 4; ++e) if (4 * q4 + e > j) x[4 * q4 + e] += cv_[j - (J0)][q4][e] * xj; } \
                    __builtin_amdgcn_sched_barrier(0); } while (0)
                    RW_INV_BATCH(0, 3); RW_INV_BATCH(3, 7); RW_INV_BATCH(7, 15);
#pragma unroll
                    for (int s2 = 0; s2 < 16; ++s2) sT[(16 * jb + s2) * PSt + 8 * (col >> 2) + (col & 3)] = f2bf(x[s2]);
                }
            } else if (jb == 2) {
                *(u32x2*)(sAabB + cloc * PSt + 8 * fq) = pk4(acc);
            } else {
                const int prod = (jb - 3) / 3; const int jrow = 16 * ta + rloc, scol = 16 * tb + cloc;
                if (prod == 0) {
#pragma unroll
                    for (int e = 0; e < 4; ++e) acc[e] = (jrow + e < scol) ? acc[e] : 0.f;
                } else {
#pragma unroll
                    for (int e = 0; e < 4; ++e) acc[e] = (jrow + e <= scol) ? acc[e] : 0.f;
                }
                *(u32x2*)(((prod == 0) ? sAak : (prod == 1) ? sMrb : sMrk) + scol * PSt + 8 * fq + 4 * ta) = pk4(acc);
            }
        }
            RW_SCAN_LOCAL(cumN, n_lw);
        }
        __syncthreads();
        if (more) { RW_SCAN_FINISH(cumN, totN); cumC = cumN; totC = totN; }
    }
    __syncthreads();
}

constexpr int SCW = 8224;
__device__ __forceinline__ void dsa_item(const Params& p, int b, int g, unsigned char* lds) {
    int tid_ = threadIdx.x; asm volatile("" : "+v"(tid_));
    const int tid = tid_, lane = tid & 63, wave = __builtin_amdgcn_readfirstlane(tid >> 6);
    const f16* PB = (const f16*)(p.ws + WS_PB); const f16* CKV = (const f16*)(p.ws + WS_CKV); const f16* KIDX = (const f16*)(p.ws + WS_KIDX); const float* WIS = (const float*)(p.ws + WS_WIS);
    f16* OLAT = (f16*)(p.ws + WS_OLAT);
    float* sc = (float*)lds;
    unsigned* hist = (unsigned*)(lds + 4 * SCW * 4);
    unsigned short* sel = (unsigned short*)(lds + 4 * SCW * 4 + 4096);
    unsigned* misc = (unsigned*)(lds + 4 * SCW * 4 + 4096 + 2048);
    f16* sq = (f16*)(lds + 4 * SCW * 4 + 4096 + 2048 + 512);
    const int i0 = 4 * g, n_adm = 80 + 64 * (i0 >> 6), ntile = (n_adm + 31) >> 5;
    const int mq0 = b * SEQ + i0;
    {
        const int rho = lane & 31, hh = lane >> 5;
        const int q = 2 * ((rho >> 2) & 1) + (rho >> 4), hd = 4 * ((rho >> 3) & 1) + (rho & 3);
        const f16* qip = PB + (size_t)(mq0 + q) * N1 + C_QI + hd * 64 + 8 * hh;
        f16x8 af[4];
#pragma unroll
        for (int ks = 0; ks < 4; ++ks) af[ks] = *(const f16x8*)(qip + 16 * ks);
        float wsc[16];
#pragma unroll
        for (int j = 0; j < 16; ++j) wsc[j] = WIS[(size_t)(mq0 + 2 * hh + (j >> 3)) * 8 + (j & 7)];
        float mn0 = INFINITY, mx0 = -INFINITY, mn1 = INFINITY, mx1 = -INFINITY;
        f16x8 bn[2][4];
#pragma unroll
        for (int u = 0; u < 2; ++u) { const f16* kp = KIDX + (size_t)b * KIDX_B + (size_t)(wave + 8 * u) * 2048 + hh * 256 + (lane & 31) * 8;
#pragma unroll
          for (int ks = 0; ks < 4; ++ks) bn[u][ks] = *(const f16x8*)(kp + 512 * ks); }
        for (int kt = wave; kt < ntile; kt += 16) {
            f16x8 bf[2][4];
#pragma unroll
            for (int u = 0; u < 2; ++u)
#pragma unroll
                for (int ks = 0; ks < 4; ++ks) bf[u][ks] = bn[u][ks];
#pragma unroll
            for (int u = 0; u < 2; ++u) { int kn = kt + 16 + 8 * u; kn = (kn < ntile) ? kn : kt;
                const f16* kp = KIDX + (size_t)b * KIDX_B + (size_t)kn * 2048 + hh * 256 + (lane & 31) * 8;
#pragma unroll
                for (int ks = 0; ks < 4; ++ks) bn[u][ks] = *(const f16x8*)(kp + 512 * ks); }
            f32x16 acc0, acc1;
#pragma unroll
            for (int j = 0; j < 16; ++j) { acc0[j] = 0.f; acc1[j] = 0.f; }
#pragma unroll
            for (int ks = 0; ks < 4; ++ks) { acc0 = __builtin_amdgcn_mfma_f32_32x32x16_f16(af[ks], bf[0][ks], acc0, 0, 0, 0); acc1 = __builtin_amdgcn_mfma_f32_32x32x16_f16(af[ks], bf[1][ks], acc1, 0, 0, 0); }
            float sa0 = 0.f, sb0 = 0.f, sa1 = 0.f, sb1 = 0.f;
#pragma unroll
            for (int jj = 0; jj < 8; ++jj) { sa0 += wsc[jj] * fmaxf(acc0[jj], 0.f); sb0 += wsc[8 + jj] * fmaxf(acc0[8 + jj], 0.f); sa1 += wsc[jj] * fmaxf(acc1[jj], 0.f); sb1 += wsc[8 + jj] * fmaxf(acc1[8 + jj], 0.f); }
            const int key0 = kt * 32 + (lane & 31), key1 = key0 + 256;
            sc[(2 * hh) * SCW + key0] = sa0; sc[(2 * hh + 1) * SCW + key0] = sb0;
            if (key0 < n_adm) { mn0 = fminf(mn0, sa0); mx0 = fmaxf(mx0, sa0); mn1 = fminf(mn1, sb0); mx1 = fmaxf(mx1, sb0); }
            if (kt + 8 < ntile) { sc[(2 * hh) * SCW + key1] = sa1; sc[(2 * hh + 1) * SCW + key1] = sb1;
                if (key1 < n_adm) { mn0 = fminf(mn0, sa1); mx0 = fmaxf(mx0, sa1); mn1 = fminf(mn1, sb1); mx1 = fmaxf(mx1, sb1); } }
        }
#pragma unroll
        for (int o = 1; o < 32; o <<= 1) { mn0 = fminf(mn0, __shfl_xor(mn0, o)); mx0 = fmaxf(mx0, __shfl_xor(mx0, o)); mn1 = fminf(mn1, __shfl_xor(mn1, o)); mx1 = fmaxf(mx1, __shfl_xor(mx1, o)); }
        float* mm = (float*)(misc + 64);
        if ((lane & 31) == 0) { mm[((2 * hh) * 8 + wave) * 2] = mn0; mm[((2 * hh) * 8 + wave) * 2 + 1] = mx0; mm[((2 * hh + 1) * 8 + wave) * 2] = mn1; mm[((2 * hh + 1) * 8 + wave) * 2 + 1] = mx1; }
        *(f16x8*)(sq + tid * 8) = *(const f16x8*)(PB + (size_t)(mq0 + (tid >> 7)) * N1 + C_QABS + (tid & 127) * 8);
    }
    const int qs = tid >> 7, tl = tid & 127;
    if (n_adm > 256) { hist[qs * 256 + tl] = 0u; hist[qs * 256 + 128 + tl] = 0u; if (tl < 4) misc[qs * 8 + 2 + tl] = 0u; }
    __syncthreads();
    int nsel;
    {
        const float* scq = sc + qs * SCW;
        if (n_adm <= 256) { for (int idx = tl; idx < n_adm; idx += 128) sel[qs * 256 + idx] = (unsigned short)idx; nsel = n_adm; }
        else {
            constexpr int NK = 65;
            const float* mm = (const float*)(misc + 64);
            float lo = INFINITY, hi = -INFINITY;
#pragma unroll
            for (int w = 0; w < 8; ++w) { lo = fminf(lo, mm[(qs * 8 + w) * 2]); hi = fmaxf(hi, mm[(qs * 8 + w) * 2 + 1]); }
            const float scale = (hi > lo) ? 16777215.f / (hi - lo) : 0.f;
            unsigned kreg[NK];
#pragma unroll
            for (int i = 0; i < NK; ++i) { const int idx = tl + 128 * i; const float v = (idx < n_adm) ? scq[idx] : lo; unsigned k = (unsigned)((v - lo) * scale); k = k > 0xFFFFFFu ? 0xFFFFFFu : k; kreg[i] = k;
                if (idx < n_adm) atomicAdd(&hist[qs * 256 + (k >> 16)], 1u); }
            __syncthreads();
            if (tl < 64) {
                const int c0 = (int)hist[qs * 256 + 4 * tl], c1 = (int)hist[qs * 256 + 4 * tl + 1], c2 = (int)hist[qs * 256 + 4 * tl + 2], c3 = (int)hist[qs * 256 + 4 * tl + 3];
                const int tot = c0 + c1 + c2 + c3; int sfx = tot;
#pragma unroll
                for (int off = 1; off < 64; off <<= 1) { const int tv = __shfl_down(sfx, off); if (tl + off < 64) sfx += tv; }
                const int above = sfx - tot;
                if (above < 256 && 256 <= sfx) { const int rem = 256 - above; int bin, nk;
                    if (rem <= c3) { bin = 4 * tl + 3; nk = rem; } else if (rem <= c3 + c2) { bin = 4 * tl + 2; nk = rem - c3; }
                    else if (rem <= c3 + c2 + c1) { bin = 4 * tl + 1; nk = rem - c3 - c2; } else { bin = 4 * tl; nk = rem - c3 - c2 - c1; }
                    misc[qs * 8] = (unsigned)bin; misc[qs * 8 + 1] = (unsigned)nk; }
            }
            __syncthreads();
            const unsigned bin = misc[qs * 8]; const int need = (int)misc[qs * 8 + 1];
            unsigned* cand = (unsigned*)(sc + qs * SCW) + 0;
            const int lane_ = tid & 63;
            __syncthreads();
#pragma unroll
            for (int i = 0; i < NK; ++i) { const int idx = tl + 128 * i; const unsigned u = kreg[i]; const bool ok = idx < n_adm; const unsigned tb = u >> 16;
                if (ok && tb > bin) { const unsigned long long m = __ballot(1); const int leader = __ffsll((long long)m) - 1; unsigned base = 0u;
                    if (lane_ == leader) base = atomicAdd(&misc[qs * 8 + 2], (unsigned)__popcll(m));
                    base = __shfl(base, leader);
                    sel[qs * 256 + base + __popcll(m & ((1ull << lane_) - 1ull))] = (unsigned short)idx; }
                else if (ok && tb == bin) { const unsigned e = atomicAdd(&misc[qs * 8 + 3], 1u); if (e < 4096u) { cand[2 * e] = u; cand[2 * e + 1] = (unsigned)idx; } } }
            __syncthreads();
            { const int m = min((int)misc[qs * 8 + 3], 4096); const int base = (int)misc[qs * 8 + 2];
              for (int i = tl; i < m; i += 128) { const unsigned ku = cand[2 * i]; const unsigned ki = cand[2 * i + 1]; int rank = 0;
                  for (int j = 0; j < m; ++j) { const unsigned kj = cand[2 * j]; const unsigned ij = cand[2 * j + 1]; rank += (kj > ku || (kj == ku && ij < ki)) ? 1 : 0; }
                  if (rank < need) sel[qs * 256 + base + rank] = (unsigned short)ki; } }
            nsel = 256;
        }
    }
    __syncthreads();
    {
        int lane_ = lane; asm volatile("" : "+v"(lane_));
        const int fr = lane_ & 15, fq = lane_ >> 4, aq = wave >> 1, rh = wave & 1;
        const unsigned short* selq = sel + aq * 256;
        f16x8 qf[4];
#pragma unroll
        for (int ks = 0; ks < 4; ++ks) { qf[ks] = *(const f16x8*)(sq + (aq * 8 + (fr & 7)) * 128 + 32 * ks + 8 * fq); if (fr >= 8) qf[ks] = (f16x8){(f16)0.f, (f16)0.f, (f16)0.f, (f16)0.f, (f16)0.f, (f16)0.f, (f16)0.f, (f16)0.f}; }
        f32x4 S[16];
#define ATT_LOAD1(buf, g_) do { _Pragma("unroll") for (int tq = 0; tq < 2; ++tq) { const int kk = 16 * (2 * (g_) + tq) + fr; const int kidx = (kk < nsel) ? (int)selq[kk] : 0; \
            const f16* cp = CKV + (size_t)row_of(b, kidx) * 128 + 8 * fq; \
            _Pragma("unroll") for (int ks = 0; ks < 4; ++ks) buf[tq][ks] = *(const f16x8*)(cp + 32 * ks); } } while (0)
#define ATT_MUL1(buf, g_) do { _Pragma("unroll") for (int tq = 0; tq < 2; ++tq) { f32x4 acc = {0.f, 0.f, 0.f, 0.f}; \
            _Pragma("unroll") for (int ks = 0; ks < 4; ++ks) acc = __builtin_amdgcn_mfma_f32_16x16x32_f16(buf[tq][ks], qf[ks], acc, 0, 0, 0); S[2 * (g_) + tq] = acc; } } while (0)
#pragma unroll
        for (int hb = 0; hb < 2; ++hb) {
            f16x8 cfa[4][2][4];
#pragma unroll
            for (int gq = 0; gq < 4; ++gq) ATT_LOAD1(cfa[gq], 4 * hb + gq);
            __builtin_amdgcn_sched_barrier(0);
#pragma unroll
            for (int gq = 0; gq < 4; ++gq) ATT_MUL1(cfa[gq], 4 * hb + gq);
            __builtin_amdgcn_sched_barrier(0);
        }
        float mx = -INFINITY;
#pragma unroll
        for (int kt = 0; kt < 16; ++kt)
#pragma unroll
            for (int e = 0; e < 4; ++e) { const float v = (16 * kt + 4 * fq + e < nsel) ? S[kt][e] * 0.125f : -INFINITY; S[kt][e] = v; mx = fmaxf(mx, v); }
        mx = fmaxf(mx, __shfl_xor(mx, 16)); mx = fmaxf(mx, __shfl_xor(mx, 32));
        float sum = 0.f;
#pragma unroll
        for (int kt = 0; kt < 16; ++kt)
#pragma unroll
            for (int e = 0; e < 4; ++e) { const float pv = __expf(S[kt][e] - mx); S[kt][e] = pv; sum += pv; }
        sum += __shfl_xor(sum, 16); sum += __shfl_xor(sum, 32);
        const float inv = 1.f / sum;
        f16x8 Pf[8];
#pragma unroll
        for (int i = 0; i < 8; ++i) {
#pragma unroll
            for (int e = 0; e < 4; ++e) { Pf[i][e] = (f16)(S[2 * i][e] * inv); Pf[i][4 + e] = (f16)(S[2 * i + 1][e] * inv); } }
        f16x8 I0, I1;
#pragma unroll
        for (int j = 0; j < 8; ++j) { I0[j] = (8 * fq + j == fr) ? (f16)1.f : (f16)0.f; I1[j] = (8 * fq + j == 16 + fr) ? (f16)1.f : (f16)0.f; }
        f32x4 O[4];
#pragma unroll
        for (int j = 0; j < 4; ++j) O[j] = (f32x4){0.f, 0.f, 0.f, 0.f};
#define ATT_LOAD2(bufa, bufb, i_) do { const int ka = 32 * (i_) + fr, kb = ka + 16; \
            const f16* pa = CKV + (size_t)row_of(b, (ka < nsel) ? (int)selq[ka] : 0) * 128 + 64 * rh + 8 * fq; \
            const f16* pb = CKV + (size_t)row_of(b, (kb < nsel) ? (int)selq[kb] : 0) * 128 + 64 * rh + 8 * fq; \
            bufa[0] = *(const f16x8*)(pa); bufa[1] = *(const f16x8*)(pa + 32); bufb[0] = *(const f16x8*)(pb); bufb[1] = *(const f16x8*)(pb + 32); } while (0)
#define ATT_MUL2(bufa, bufb, i_) do { _Pragma("unroll") for (int j = 0; j < 4; ++j) { const f32x4 z = {0.f, 0.f, 0.f, 0.f}; \
            const f32x4 da = __builtin_amdgcn_mfma_f32_16x16x32_f16(bufa[j >> 1], (j & 1) ? I1 : I0, z, 0, 0, 0); \
            const f32x4 db = __builtin_amdgcn_mfma_f32_16x16x32_f16(bufb[j >> 1], (j & 1) ? I1 : I0, z, 0, 0, 0); \
            f16x8 bfr; _Pragma("unroll") for (int e = 0; e < 4; ++e) { bfr[e] = (f16)da[e]; bfr[4 + e] = (f16)db[e]; } \
            O[j] = __builtin_amdgcn_mfma_f32_16x16x32_f16(Pf[(i_)], bfr, O[j], 0, 0, 0); } } while (0)
#pragma unroll
        for (int hb = 0; hb < 2; ++hb) {
            f16x8 xa[4][2], xb[4][2];
#pragma unroll
            for (int iq = 0; iq < 4; ++iq) ATT_LOAD2(xa[iq], xb[iq], 4 * hb + iq);
            __builtin_amdgcn_sched_barrier(0);
#pragma unroll
            for (int iq = 0; iq < 4; ++iq) ATT_MUL2(xa[iq], xb[iq], 4 * hb + iq);
            __builtin_amdgcn_sched_barrier(0);
        }
        if (fq < 2) {
#pragma unroll
            for (int j = 0; j < 4; ++j)
#pragma unroll
                for (int e = 0; e < 4; ++e) OLAT[(size_t)(mq0 + aq) * 1024 + (4 * fq + e) * 128 + 64 * rh + 16 * j + fr] = (f16)O[j][e];
        }
    }
    __syncthreads();
}

__device__ __forceinline__ void phc2_mixers(const Params& p, unsigned char* lds, int rep) {
    unsigned* ctr = (unsigned*)(p.ws + WS_CTL) + 64 + 64 * rep;
    int* s_item = (int*)(lds + 150 * 1024 - 16);
    constexpr int NRW = 16, NDSA = 2 * (SEQ / 4);
    for (;;) {
        if (threadIdx.x == 0) *s_item = (int)atomicAdd(ctr, 1u);
        __syncthreads();
        const int item = *s_item;
        __syncthreads();
        if (item >= NRW + NDSA) break;
        if (item < NRW) rwkv_item(p, item >> 3, item & 7, lds);
        else { const int d = item - NRW; dsa_item(p, d & 1, (SEQ / 4 - 1) - (d >> 1), lds); }
    }
}

__device__ __forceinline__ void phd3_ln1(const Params& p) {
    const int tid = threadIdx.x, lane = tid & 63, wave = tid >> 6;
    const int gw = blockIdx.x * 8 + wave, NGW = gridDim.x * 8;
    f16* H1H = (f16*)(p.ws + WS_H1H);
    for (int m = gw; m < MREAL; m += NGW) {
        float* row = p.out + (size_t)m * D;
        f32x4 v[4]; float s = 0.f;
#pragma unroll
        for (int j = 0; j < 4; ++j) { v[j] = *(const f32x4*)(row + j * 256 + lane * 4); s += (v[j].x + v[j].y) + (v[j].z + v[j].w); }
        const float mean = wave_sum(s) * (1.f / D); float s2 = 0.f;
#pragma unroll
        for (int j = 0; j < 4; ++j) { v[j] = v[j] - mean; s2 += (v[j].x * v[j].x + v[j].y * v[j].y) + (v[j].z * v[j].z + v[j].w * v[j].w); }
        const float rstd = 1.f / sqrtf(wave_sum(s2) * (1.f / D) + LN_EPS);
#pragma unroll
        for (int j = 0; j < 4; ++j) { const f32x4 g = *(const f32x4*)(p.ln1_g + j * 256 + lane * 4), bb = *(const f32x4*)(p.ln1_b + j * 256 + lane * 4);
            const f32x4 o = v[j] * rstd * g + bb; *(f32x4*)(row + j * 256 + lane * 4) = o; *(f16x4*)(H1H + (size_t)m * D + j * 256 + lane * 4) = to_h4(o); }
    }
    unsigned char* U8 = p.ws + WS_U16; unsigned char* V8 = p.ws + WS_V16;
    const long gt = (long)blockIdx.x * NT + tid, NGT = (long)gridDim.x * NT;
    for (long e = gt; e < 16384L * 1024 / 16; e += NGT) {
        u32x4 ou, ov;
#pragma unroll
        for (int q = 0; q < 4; ++q) { const f32x4 a = *(const f32x4*)(p.peer_u + e * 16 + q * 4) * 256.f; const f32x4 c = *(const f32x4*)(p.peer_v + e * 16 + q * 4) * 16.f;
            int w = 0; w = __builtin_amdgcn_cvt_pk_fp8_f32(a[0], a[1], w, false); w = __builtin_amdgcn_cvt_pk_fp8_f32(a[2], a[3], w, true); ou[q] = (unsigned)w;
            int x = 0; x = __builtin_amdgcn_cvt_pk_fp8_f32(c[0], c[1], x, false); x = __builtin_amdgcn_cvt_pk_fp8_f32(c[2], c[3], x, true); ov[q] = (unsigned)x; }
        *(u32x4*)(U8 + e * 16) = ou; *(u32x4*)(V8 + e * 16) = ov;
    }
}

#define CSWAP(j) do { if (tv[j] > tv[j - 1]) { const int _t = tv[j]; tv[j] = tv[j - 1]; tv[j - 1] = _t; const int _i = ti[j]; ti[j] = ti[j - 1]; ti[j - 1] = _i; } } while (0)
#define CSWAP_ALL() do { CSWAP(15); CSWAP(14); CSWAP(13); CSWAP(12); CSWAP(11); CSWAP(10); CSWAP(9); CSWAP(8); CSWAP(7); CSWAP(6); CSWAP(5); CSWAP(4); CSWAP(3); CSWAP(2); CSWAP(1); } while (0)
__device__ __forceinline__ void top16_of_128(const unsigned short* src, int (&tv)[16], int (&ti)[16]) {
#pragma unroll
    for (int j = 0; j < 16; ++j) { tv[j] = -1; ti[j] = 0; }
    for (int c = 0; c < 16; ++c) {
        const u32x4 w = *(const u32x4*)(src + c * 8);
#pragma unroll
        for (int e = 0; e < 8; ++e) {
            const int x = (int)((w[e >> 1] >> (16 * (e & 1))) & 0xFFFFu);
            if (x > tv[15]) { tv[15] = x; ti[15] = c * 8 + e; CSWAP_ALL(); }
        }
    }
}
__device__ __forceinline__ void phd5_topk(const Params& p) {
    const unsigned short* SC = (const unsigned short*)(p.ws + WS_SC);
    unsigned short* EIDX = (unsigned short*)(p.ws + WS_EIDX); float* EGATE = (float*)(p.ws + WS_EGATE);
    const long gt = (long)blockIdx.x * NT + threadIdx.x, NGT = (long)gridDim.x * NT;
    for (long e = gt; e < (long)MREAL * 8; e += NGT) {
        const int m = (int)(e >> 3), h = (int)(e & 7);
        int av[16], bv[16]; int ai[16], bi[16];
        top16_of_128(SC + (size_t)m * 2048 + h * 256, av, ai);
        top16_of_128(SC + (size_t)m * 2048 + h * 256 + 128, bv, bi);
        int tv[16]; int ti[16];
#pragma unroll
        for (int j = 0; j < 16; ++j) { tv[j] = -1; ti[j] = 0; }
#pragma unroll
        for (int i = 0; i < 16; ++i)
#pragma unroll
            for (int j = 0; j < 16; ++j)
                if ((i + 1) * (j + 1) <= 16) {
                    const int x = av[i] + bv[j];
                    if (x > tv[15]) { tv[15] = x; ti[15] = ai[i] * 128 + bi[j]; CSWAP_ALL(); }
                }
        float sum = 0.f; float ex[16];
#pragma unroll
        for (int j = 0; j < 16; ++j) { ex[j] = __expf((float)(tv[j] - tv[0]) * (1.f / 8192.f)); sum += ex[j]; }
        const float inv = 1.f / sum;
#pragma unroll
        for (int j = 0; j < 16; ++j) { EIDX[(size_t)m * 128 + h * 16 + j] = (unsigned short)ti[j]; EGATE[(size_t)m * 128 + h * 16 + j] = ex[j] * inv; }
    }
}

__device__ __forceinline__ void dec16(const u32x4 w, float (&o)[16]) {
#pragma unroll
    for (int q = 0; q < 4; ++q) { const f32x2 lo = __builtin_amdgcn_cvt_pk_f32_fp8((int)w[q], false), hi = __builtin_amdgcn_cvt_pk_f32_fp8((int)w[q], true); o[4 * q] = lo.x; o[4 * q + 1] = lo.y; o[4 * q + 2] = hi.x; o[4 * q + 3] = hi.y; }
}
__device__ __forceinline__ float wave_sum_u(float v) {
    v = row16_sum(v);
    const float a = __builtin_bit_cast(float, __builtin_amdgcn_readlane(__builtin_bit_cast(int, v), 0)), b = __builtin_bit_cast(float, __builtin_amdgcn_readlane(__builtin_bit_cast(int, v), 16));
    const float c = __builtin_bit_cast(float, __builtin_amdgcn_readlane(__builtin_bit_cast(int, v), 32)), d = __builtin_bit_cast(float, __builtin_amdgcn_readlane(__builtin_bit_cast(int, v), 48));
    return (a + b) + (c + d);
}
__device__ __forceinline__ void phd6_gather(const Params& p) {
    const int tid = threadIdx.x, lane = tid & 63, wave = tid >> 6;
    const int gw = blockIdx.x * 8 + wave, NGW = gridDim.x * 8;
    const unsigned char* U8 = p.ws + WS_U16; const unsigned char* V8 = p.ws + WS_V16;
    const unsigned short* EIDX = (const unsigned short*)(p.ws + WS_EIDX); const float* EGATE = (const float*)(p.ws + WS_EGATE);
    for (int m = gw; m < MREAL; m += NGW) {
        float* row = p.out + (size_t)m * D + 16 * lane;
        float hv[16];
#pragma unroll
        for (int q = 0; q < 4; ++q) { const f32x4 t4 = *(const f32x4*)(row + 4 * q); hv[4 * q] = t4.x; hv[4 * q + 1] = t4.y; hv[4 * q + 2] = t4.z; hv[4 * q + 3] = t4.w; }
        const int e_lo = (int)EIDX[(size_t)m * 128 + lane], e_hi = (int)EIDX[(size_t)m * 128 + 64 + lane];
        const float g_lo = EGATE[(size_t)m * 128 + lane], g_hi = EGATE[(size_t)m * 128 + 64 + lane];
        float hd_lo = 0.f, hd_hi = 0.f;
#define G_LOAD(buf, g_, TAB) do { _Pragma("unroll") for (int i_ = 0; i_ < 8; ++i_) { const int e_ = 8 * (g_) + i_; \
            const int id_ = (e_ < 64) ? __builtin_amdgcn_readlane(e_lo, e_ & 63) : __builtin_amdgcn_readlane(e_hi, e_ & 63); \
            buf[i_] = *(const u32x4*)((TAB) + (size_t)id_ * D + 16 * lane); } } while (0)
#define U_PROC(buf, g_) do { _Pragma("unroll") for (int i_ = 0; i_ < 8; ++i_) { const int e_ = 8 * (g_) + i_; float uf[16]; dec16(buf[i_], uf); float s_ = 0.f; \
            _Pragma("unroll") for (int j_ = 0; j_ < 16; ++j_) s_ += hv[j_] * uf[j_]; s_ = wave_sum_u(s_); \
            if (e_ < 64) { if (lane == (e_ & 63)) hd_lo = s_; } else { if (lane == (e_ & 63)) hd_hi = s_; } } } while (0)
        {
            u32x4 b0[8], b1[8];
            G_LOAD(b0, 0, U8);
            for (int g2 = 0; g2 < 16; g2 += 2) {
                G_LOAD(b1, g2 + 1, U8); __builtin_amdgcn_sched_barrier(0);
                U_PROC(b0, g2); __builtin_amdgcn_sched_barrier(0);
                if (g2 + 2 < 16) { G_LOAD(b0, g2 + 2, U8); } __builtin_amdgcn_sched_barrier(0);
                U_PROC(b1, g2 + 1); __builtin_amdgcn_sched_barrier(0);
            }
        }
        hd_lo *= (1.f / 256.f); hd_hi *= (1.f / 256.f);
        const float c_lo = g_lo * 0.5f * hd_lo * (1.f + erff(hd_lo * 0.70710678118654752f)) * (1.f / 16.f);
        const float c_hi = g_hi * 0.5f * hd_hi * (1.f + erff(hd_hi * 0.70710678118654752f)) * (1.f / 16.f);
        float acc[16];
#pragma unroll
        for (int j = 0; j < 16; ++j) acc[j] = 0.f;
#define V_PROC(buf, g_) do { _Pragma("unroll") for (int i_ = 0; i_ < 8; ++i_) { const int e_ = 8 * (g_) + i_; float vf[16]; dec16(buf[i_], vf); \
            const float cf_ = (e_ < 64) ? __builtin_bit_cast(float, __builtin_amdgcn_readlane(__builtin_bit_cast(int, c_lo), e_ & 63)) : __builtin_bit_cast(float, __builtin_amdgcn_readlane(__builtin_bit_cast(int, c_hi), e_ & 63)); \
            _Pragma("unroll") for (int j_ = 0; j_ < 16; ++j_) acc[j_] += cf_ * vf[j_]; } } while (0)
        {
            u32x4 b0[8], b1[8];
            G_LOAD(b0, 0, V8);
            for (int g2 = 0; g2 < 16; g2 += 2) {
                G_LOAD(b1, g2 + 1, V8); __builtin_amdgcn_sched_barrier(0);
                V_PROC(b0, g2); __builtin_amdgcn_sched_barrier(0);
                if (g2 + 2 < 16) { G_LOAD(b0, g2 + 2, V8); } __builtin_amdgcn_sched_barrier(0);
                V_PROC(b1, g2 + 1); __builtin_amdgcn_sched_barrier(0);
            }
        }
        float sm = 0.f;
#pragma unroll
        for (int j = 0; j < 16; ++j) { acc[j] += ALPHA * hv[j]; sm += acc[j]; }
        const float mean = wave_sum_u(sm) * (1.f / D); float s2 = 0.f;
#pragma unroll
        for (int j = 0; j < 16; ++j) { acc[j] -= mean; s2 += acc[j] * acc[j]; }
        const float rstd = __builtin_amdgcn_rsqf(wave_sum_u(s2) * (1.f / D) + LN_EPS);
#pragma unroll
        for (int q = 0; q < 4; ++q) { const int col = 16 * lane + 4 * q; const f32x4 g = *(const f32x4*)(p.ln2_g + col), bb = *(const f32x4*)(p.ln2_b + col);
            f32x4 o; o.x = acc[4 * q] * rstd * g.x + bb.x; o.y = acc[4 * q + 1] * rstd * g.y + bb.y; o.z = acc[4 * q + 2] * rstd * g.z + bb.z; o.w = acc[4 * q + 3] * rstd * g.w + bb.w;
            *(f32x4*)(row + 4 * q) = o; }
    }
}

struct EpiLora {
    f16 *LW, *AA, *GG; const float *w0, *a0;
    __device__ __forceinline__ void operator()(const f32x4 (&acc)[2][2][4][2], const pg8::Unit& u, int wr, int wc, int fr, int fq) const {
        const int row0 = u.pm * 256 + wr * 64 + fr, col0 = (u.pn & 1) * 256 + wc * 32 + 4 * fq;
        if (u.pn < 2) {
#pragma unroll
            for (int bj = 0; bj < 2; ++bj)
#pragma unroll
                for (int n = 0; n < 2; ++n) { const int col = col0 + bj * 128 + n * 16; const f32x4 c = *(const f32x4*)(w0 + col);
#pragma unroll
                    for (int ai = 0; ai < 2; ++ai)
#pragma unroll
                        for (int m = 0; m < 4; ++m) { const f32x4 v = acc[ai][bj][m][n]; f16x4 o;
#pragma unroll
                            for (int e = 0; e < 4; ++e) { const float wl = -softplusf_(-(c[e] + v[e])) - 0.5f; o[e] = (f16)(-__expf(wl)); }
                            *(f16x4*)(LW + (size_t)(row0 + ai * 128 + m * 16) * 512 + col) = o; } }
        } else if (u.pn < 4) {
#pragma unroll
            for (int bj = 0; bj < 2; ++bj)
#pragma unroll
                for (int n = 0; n < 2; ++n) { const int col = col0 + bj * 128 + n * 16; const f32x4 c = *(const f32x4*)(a0 + col);
#pragma unroll
                    for (int ai = 0; ai < 2; ++ai)
#pragma unroll
                        for (int m = 0; m < 4; ++m) { const f32x4 v = acc[ai][bj][m][n]; f16x4 o;
#pragma unroll
                            for (int e = 0; e < 4; ++e) o[e] = (f16)sigmoidf_(c[e] + v[e]);
                            *(f16x4*)(AA + (size_t)(row0 + ai * 128 + m * 16) * 512 + col) = o; } }
        } else {
#pragma unroll
            for (int bj = 0; bj < 2; ++bj)
#pragma unroll
                for (int n = 0; n < 2; ++n) { const int col = col0 + bj * 128 + n * 16;
#pragma unroll
                    for (int ai = 0; ai < 2; ++ai)
#pragma unroll
                        for (int m = 0; m < 4; ++m) *(f16x4*)(GG + (size_t)(row0 + ai * 128 + m * 16) * 512 + col) = to_h4(acc[ai][bj][m][n]); }
        }
    }
};

#define XB_TMO      128
#define XB_XCNT(j)  (256  + 64 * (j))
#define XB_XSUB(j)  (1280 + 64 * (j))
#define XB_XGEN(j)  (2304 + 64 * (j))
#define XB_TOP      3328
#define XB_TOPGEN   3392
#define XCD_BAR_WORDS 3456
#define XB_SPIN_CAP (1u << 20)
__device__ __forceinline__ unsigned xb_ld(unsigned* p)              { return __hip_atomic_load(p, __ATOMIC_RELAXED, __HIP_MEMORY_SCOPE_AGENT); }
__device__ __forceinline__ unsigned xb_add(unsigned* p, unsigned v) { return __hip_atomic_fetch_add(p, v, __ATOMIC_RELAXED, __HIP_MEMORY_SCOPE_AGENT); }
__device__ __forceinline__ unsigned xb_xcc_id() { return (unsigned)__builtin_amdgcn_s_getreg((3 << 11) | 20) & 0xFu; }
#define XB_SPIN(cond, bar) do { unsigned _sp = 0; while (cond) { __builtin_amdgcn_s_sleep(1); \
    if ((++_sp & 255u) == 0u) { if (xb_ld(&(bar)[XB_TMO])) break; if (_sp > XB_SPIN_CAP) { atomicAdd(&(bar)[XB_TMO], 1u); break; } } } } while (0)
struct XcdBarrier { unsigned* bar; unsigned x; volatile LAS unsigned* st; };
__device__ __forceinline__ XcdBarrier xcd_barrier_post(unsigned* bar, volatile LAS unsigned* st) {
    XcdBarrier b; b.bar = bar; b.x = xb_xcc_id(); b.st = st;
    if (threadIdx.x == 0) (void)xb_add(&bar[XB_XCNT(b.x)], 1u);
    return b;
}
__device__ __forceinline__ void xcd_barrier_complete(unsigned* bar, unsigned x, unsigned& nloc, unsigned& nx) {
    const unsigned G = gridDim.x * gridDim.y * gridDim.z;
    unsigned sum, cnt, mine, sp = 0u;
    for (;;) {
        sum = 0u; cnt = 0u; mine = 0u;
#pragma unroll
        for (unsigned j = 0; j < 16; ++j) { const unsigned c = xb_ld(&bar[XB_XCNT(j)]); sum += c; cnt += (c > 0u) ? 1u : 0u; mine = (j == x) ? c : mine; }
        if (sum == G) break;
        __builtin_amdgcn_s_sleep(1);
        if ((++sp & 255u) == 0u) { if (xb_ld(&bar[XB_TMO])) break; if (sp > XB_SPIN_CAP) { atomicAdd(&bar[XB_TMO], 1u); break; } }
    }
    nloc = mine > 0u ? mine : 1u; nx = cnt > 0u ? cnt : 1u;
}
__device__ __forceinline__ void xcd_barrier(const XcdBarrier& b) {
    asm volatile("s_waitcnt vmcnt(0)" ::: "memory");
    __syncthreads();
    if (threadIdx.x == 0) {
        unsigned* bar = b.bar;
        __builtin_amdgcn_s_waitcnt(0);
        unsigned nloc = b.st[0], nx = b.st[1];
        if (nloc == 0u) { xcd_barrier_complete(bar, b.x, nloc, nx); b.st[0] = nloc; b.st[1] = nx; }
        const unsigned old = xb_add(&bar[XB_XSUB(b.x)], 1u);
        const unsigned gen = old / nloc;
        if (old + 1u == (gen + 1u) * nloc) {
            __builtin_amdgcn_fence(__ATOMIC_RELEASE, "agent");
            asm volatile("s_waitcnt vmcnt(0)" ::: "memory");
            const unsigned og = xb_add(&bar[XB_TOP], 1u);
            const unsigned tg = og / nx;
            if (og + 1u == (tg + 1u) * nx) xb_add(&bar[XB_TOPGEN], 1u);
            else XB_SPIN(xb_ld(&bar[XB_TOPGEN]) == tg, bar);
            __builtin_amdgcn_fence(__ATOMIC_ACQUIRE, "agent");
            xb_add(&bar[XB_XGEN(b.x)], 1u);
            asm volatile("s_waitcnt vmcnt(0)" ::: "memory");
        } else {
            XB_SPIN(xb_ld(&bar[XB_XGEN(b.x)]) == gen, bar);
            __builtin_amdgcn_fence(__ATOMIC_ACQUIRE, "agent");
            asm volatile("s_waitcnt vmcnt(0)" ::: "memory");
        }
    }
    __syncthreads();
}

constexpr int LDS_BYTES = 150 * 1024;
constexpr int REP0 = 1, REP1 = 1, REP4 = 1, REP5 = 1, REP8 = 1, REP9 = 1;
constexpr int NPHASE = 11;
__global__ void __launch_bounds__(NT) mk_fwd(Params p) {
    extern __shared__ __attribute__((aligned(16))) unsigned char lds[];
    cg::grid_group grid = cg::this_grid();
    unsigned char* ws = p.ws;
    const int lo = p.ph_lo, hi = p.ph_hi;
    volatile LAS unsigned* bst = (volatile LAS unsigned*)((LAS unsigned char*)lds + LDS_BYTES - 64);
    if (threadIdx.x < 2) bst[threadIdx.x] = 0u;
    __syncthreads();
    const XcdBarrier xbar = xcd_barrier_post((unsigned*)(ws + WS_CTL) + 4096, bst);
#define IN(k) (lo <= (k) && (k) < hi)
#define SEAM(k) do { if (IN(k) && IN((k) + 1)) { if ((k) == 0) grid.sync(); else xcd_barrier(xbar); } } while (0)
    if (IN(0)) ph0_prep(p, lds);
    SEAM(0);
    if (IN(1)) {
        f16* PB = (f16*)(ws + WS_PB);
        auto f = [=](int row, int col, f32x4 v) { *(f16x4*)(PB + (size_t)row * N1 + col) = to_h4(v); };
        pg8::run_gemm(lds, (const f16*)(ws + WS_H0), (const f16*)(ws + WS_W1T), MR, N1, D, f);
    }
    SEAM(1);
    if (IN(2)) phc1_rowprep(p);
    SEAM(2);
    if (IN(3)) {
        pg8::Gemm g{(const f16*)((unsigned char*)p.out + DO_LORAIN), (const f16*)(ws + WS_WLT), MR, 1536, 256}; pg8::StaticOrder S; S.init(MR, 1536, (int)gridDim.x, (int)blockIdx.x);
        EpiLora E{(f16*)((unsigned char*)p.out + DO_LW), (f16*)((unsigned char*)p.out + DO_AA), (f16*)((unsigned char*)p.out + DO_GG), p.b_w0, p.b_a0};
        pg8::gemm_phase<EpiLora>((PG8_LAS unsigned char*)lds, g, S, E);
        __syncthreads();
    }
    SEAM(3);
    if (IN(4)) for (int rep = 0; rep < REP4; ++rep) { if (rep) grid.sync(); phc2_mixers(p, lds, rep); }
    SEAM(4);
    if (IN(5)) {
        f16* MIX = (f16*)(ws + WS_MIXED); f16* TMP = (f16*)(ws + WS_TMP); const float* bg = p.b_gate;
        auto f1 = [=](int row, int col, f32x4 v) { const f32x4 c = *(const f32x4*)(bg + col); f16x4 o;
#pragma unroll
            for (int e = 0; e < 4; ++e) o[e] = (f16)sigmoidf_(v[e] + c[e]);
            *(f16x4*)(MIX + (size_t)row * D + col) = o; };
        pg8::run_gemm(lds, (const f16*)(ws + WS_H0), (const f16*)(ws + WS_WGT), MREAL, D, D, f1);
        auto f2 = [=](int row, int col, f32x4 v) { f16x4* q = (f16x4*)(MIX + (size_t)row * D + col); const f16x4 gq = *q; f16x4 o;
#pragma unroll
            for (int e = 0; e < 4; ++e) o[e] = (f16)((float)gq[e] * v[e]);
            *q = o; };
        pg8::run_gemm(lds, (const f16*)(ws + WS_OLAT), (const f16*)(ws + WS_WPAT), MREAL, D, D, f2);
        auto f3 = [=](int row, int col, f32x4 v) { const f32x4 c = *(const f32x4*)(bg + 1024 + col); f16x4 o;
#pragma unroll
            for (int e = 0; e < 4; ++e) o[e] = (f16)sigmoidf_(v[e] + c[e]);
            *(f16x4*)(TMP + (size_t)row * D + col) = o; };
        pg8::run_gemm(lds, (const f16*)(ws + WS_H0), (const f16*)(ws + WS_WGT) + (size_t)1024 * D, MREAL, D, D, f3);
        auto f4 = [=](int row, int col, f32x4 v) { f16x4* q = (f16x4*)(MIX + (size_t)row * D + col); const f16x4 m0 = *q; const f16x4 gq = *(const f16x4*)(TMP + (size_t)row * D + col); f16x4 o;
#pragma unroll
            for (int e = 0; e < 4; ++e) o[e] = (f16)((float)m0[e] + (float)gq[e] * v[e]);
            *q = o; };
        pg8::run_gemm(lds, (const f16*)(ws + WS_OB), (const f16*)(ws + WS_WPBT), MREAL, D, 512, f4);
    }
    SEAM(5);
    if (IN(6)) {
        const float* x = p.x; const float* STAT = (const float*)(ws + WS_STAT); const float* lg = p.ln_in_g; const float* lb = p.ln_in_b; float* out = p.out;
        auto f = [=](int row, int col, f32x4 v) { const f32x4 xv = *(const f32x4*)(x + (size_t)row * D + col); const float mean = STAT[2 * row], rstd = STAT[2 * row + 1];
            const f32x4 g = *(const f32x4*)(lg + col), bb = *(const f32x4*)(lb + col);
            *(f32x4*)(out + (size_t)row * D + col) = ((xv - mean) * rstd * g + bb) * ALPHA + v; };
        pg8::run_gemm(lds, (const f16*)(ws + WS_MIXED), (const f16*)(ws + WS_WOT), MREAL, D, D, f);
    }
    SEAM(6);
    if (IN(7)) phd3_ln1(p);
    SEAM(7);
    if (IN(8)) {
        unsigned short* SC = (unsigned short*)(ws + WS_SC);
        auto f = [=](int row, int col, f32x4 v) { u32x2 o; unsigned q[4];
#pragma unroll
            for (int e = 0; e < 4; ++e) q[e] = (unsigned)__float2int_rn(fminf(fmaxf((v[e] + 2.f) * 8192.f, 0.f), 65535.f));
            o.x = q[0] | (q[1] << 16); o.y = q[2] | (q[3] << 16); *(u32x2*)(SC + (size_t)row * 2048 + col) = o; };
        pg8::run_gemm(lds, (const f16*)(ws + WS_H1H), (const f16*)(ws + WS_WSKT), MREAL, 2048, D, f);
    }
    SEAM(8);
    if (IN(9)) phd5_topk(p);
    SEAM(9);
    if (IN(10)) phd6_gather(p);
#undef IN
#undef SEAM
}

extern "C" void kernel_launch(void* const* d_in, const int* in_sizes, int n_in, void* d_out, int out_size, void* d_ws, size_t ws_size, hipStream_t stream) {
    static int grid = 0;
    if (grid == 0) {
        int dev = 0, cus = 0, per_cu = 0;
        if (hipGetDevice(&dev) != hipSuccess || hipDeviceGetAttribute(&cus, hipDeviceAttributeMultiprocessorCount, dev) != hipSuccess) { fprintf(stderr, "kernel_launch: device query failed\n"); grid = -1; return; }
        if (hipFuncSetAttribute((const void*)mk_fwd, hipFuncAttributeMaxDynamicSharedMemorySize, LDS_BYTES) != hipSuccess) { fprintf(stderr, "kernel_launch: hipFuncSetAttribute failed\n"); grid = -1; return; }
        if (hipOccupancyMaxActiveBlocksPerMultiprocessor(&per_cu, (const void*)mk_fwd, NT, LDS_BYTES) != hipSuccess || per_cu < 1) { fprintf(stderr, "kernel_launch: occupancy query says %d\n", per_cu); grid = -1; return; }
        if (n_in != 33 || out_size != MREAL * D || ws_size < WS_END) { fprintf(stderr, "kernel_launch: unexpected shapes n_in %d out %d ws %zu\n", n_in, out_size, ws_size); grid = -1; return; }
        grid = cus;
    }
    if (grid < 0) return;
    (void)hipMemsetAsync((char*)d_ws + WS_CTL, 0, 1 * MiB, stream);
    Params p{};
    const float** pf = (const float**)&p;
    for (int i = 0; i < 33; ++i) pf[i] = (const float*)d_in[i];
    p.out = (float*)d_out; p.ws = (unsigned char*)d_ws; p.ph_lo = 0; p.ph_hi = NPHASE;
    void* args[] = {&p};
    hipError_t e = hipLaunchCooperativeKernel((void*)mk_fwd, dim3(grid), dim3(NT), args, LDS_BYTES, stream);
    if (e != hipSuccess) fprintf(stderr, "kernel_launch: cooperative launch failed: %s (grid %d)\n", hipGetErrorString(e), grid);
}
```

```cpp
#include <hip/hip_runtime.h>
#include <hip/hip_cooperative_groups.h>
#include <cstdio>
#include <cstdint>
namespace cg = cooperative_groups;

#define LAS __attribute__((address_space(3)))
typedef _Float16 f16;
typedef _Float16 f16x2 __attribute__((ext_vector_type(2)));
typedef _Float16 f16x4 __attribute__((ext_vector_type(4)));
typedef _Float16 f16x8 __attribute__((ext_vector_type(8)));
typedef float f32x2 __attribute__((ext_vector_type(2)));
typedef float f32x4 __attribute__((ext_vector_type(4)));
typedef float f32x16 __attribute__((ext_vector_type(16)));
typedef unsigned u32x4 __attribute__((ext_vector_type(4)));

constexpr int D = 1024, SEQ = 8192, NMETA = 16, TT = 8208;
constexpr int MREAL = 16384, MR = 16640;
constexpr int NIN = 5064;
constexpr int N1 = 3584;
constexpr int C_QABS = 0, C_QI = 1024, C_CKV = 1536, C_KI = 1664, C_WI = 1728, C_BC = 1792;
constexpr int NT = 512;
constexpr int KIDX_B = 264 * 2048;
constexpr float LN_EPS = 1e-5f;
constexpr float ALPHA = 1.189207115002721f;

__device__ __forceinline__ int row_of(int b, int t) { return t < NMETA ? MREAL + b * NMETA + t : b * SEQ + (t - NMETA); }

constexpr size_t MiB = 1u << 20;
constexpr size_t WS_CTL = 0, WS_STAT = 1 * MiB, WS_WIS = 2 * MiB, WS_W1T = 3 * MiB, WS_WGT = 10 * MiB, WS_WPAT = 14 * MiB, WS_WPBT = 16 * MiB,
                 WS_WOT = 17 * MiB, WS_WSKT = 19 * MiB, WS_WLT = 23 * MiB, WS_CKV = 24 * MiB, WS_KIDX = 29 * MiB, WS_H0 = 32 * MiB,
                 WS_OLAT = 65 * MiB, WS_OB = 97 * MiB, WS_PB = 113 * MiB, WS_U8 = 227 * MiB, WS_V8A = 243 * MiB, WS_V8B = 3 * MiB, WS_END = 256 * MiB;
constexpr int V8A_ROWS = 13312;
constexpr size_t WS_MIXED = WS_PB, WS_H1H = WS_PB, WS_TMP = WS_PB + 32 * MiB, WS_SC = WS_PB + 32 * MiB, WS_EIDX = WS_PB + 96 * MiB, WS_EGATE = WS_PB + 100 * MiB;
constexpr size_t DO_LORAIN = 0, DO_LW = 9 * MiB, DO_AA = 26 * MiB, DO_GG = 43 * MiB;

struct Params {
    const float *x, *meta, *ln_in_g, *ln_in_b, *w_in, *b_gate, *a_kv_norm_g, *a_w_uk, *a_w_uv, *a_kidx_g, *a_kidx_b, *b_mu, *b_w0, *b_w2, *b_a0, *b_a2,
        *b_g2, *b_k_k, *b_k_a, *b_r_k, *b_lnx_g, *b_lnx_b, *w_pa, *w_pb, *w_o, *ln1_g, *ln1_b, *peer_wq, *peer_subkeys, *peer_u, *peer_v, *ln2_g, *ln2_b;
    float* out;
    unsigned char* ws;
    int ph_lo, ph_hi;
};

__device__ __forceinline__ float wave_sum(float v) {
#pragma unroll
    for (int o = 1; o < 64; o <<= 1) v += __shfl_xor(v, o);
    return v;
}
__device__ __forceinline__ float wave_max(float v) {
#pragma unroll
    for (int o = 1; o < 64; o <<= 1) v = fmaxf(v, __shfl_xor(v, o));
    return v;
}
#define DPP_F(v, ctrl) __builtin_bit_cast(float, __builtin_amdgcn_update_dpp(0, __builtin_bit_cast(int, (v)), (ctrl), 0xF, 0xF, true))
__device__ __forceinline__ float row16_sum(float v) {
    v += DPP_F(v, 0xB1);
    v += DPP_F(v, 0x4E);
    v += DPP_F(v, 0x141);
    v += DPP_F(v, 0x140);
    return v;
}
__device__ __forceinline__ float sigmoidf_(float x) { return __builtin_amdgcn_rcpf(1.f + __expf(-x)); }
__device__ __forceinline__ float softplusf_(float z) { return fmaxf(z, 0.f) + __logf(1.f + __expf(-fabsf(z))); }
__device__ __forceinline__ unsigned fkey(float f) { unsigned u = __float_as_uint(f); return u ^ ((u >> 31) ? 0xFFFFFFFFu : 0x80000000u); }

namespace pg8 {
#define PG8_LAS __attribute__((address_space(3)))
typedef short h16x8 __attribute__((ext_vector_type(8)));
constexpr int BM = 256, BK = 64, HALF = 128, HTB = HALF * BK * 2, STAGE_BYTES = 8 * HTB, NXCD = 8, WGM = 8;
__host__ __device__ __forceinline__ int lds_byte(int r, int c) { const int st = (r >> 4) * 2 + (c >> 5), rr = r & 15, cc = c & 31, ob = rr * 64 + cc * 2; return st * 1024 + (ob ^ (((ob >> 9) & 1) << 5)); }
__host__ __device__ __forceinline__ void stage_rc(int b, int& R, int& C) { const int st = b / 1024, sb = b % 1024, swz = sb ^ (((sb >> 9) & 1) << 5); R = (st >> 1) * 16 + swz / 64; C = (st & 1) * 32 + (swz % 64) / 2; }
struct Unit { int pm, pn; };
struct Gemm { const f16* A; const f16* Bt; int M, N, K; };
struct StaticOrder {
    int nM, nN, nwg, G, c;
    __host__ __device__ void init(int M, int N, int G_, int c_) { nM = M / BM; nN = N / BM; nwg = nM * nN; G = G_; c = c_; }
    __host__ __device__ bool next(int i, Unit& u) const {
        const long L = (long)i * G + c; if (L >= nwg) return false;
        int wgid = (int)L; { const int q = nwg / NXCD, r = nwg % NXCD, xcd = wgid % NXCD, off = wgid / NXCD; wgid = (xcd < r ? xcd * (q + 1) : r * (q + 1) + (xcd - r) * q) + off; }
        const int nig = WGM * nN, gid = wgid / nig, fm = gid * WGM, gsz = (nM - fm) < WGM ? (nM - fm) : WGM;
        u.pm = fm + ((wgid % nig) % gsz); u.pn = (wgid % nig) / gsz; return true;
    }
};
template <class F> struct EpiElem {
    F f;
    __device__ __forceinline__ void operator()(const f32x4 (&acc)[2][2][4][2], const Unit& u, int wr, int wc, int fr, int fq) const {
        const int row0 = u.pm * BM + wr * 64 + fr, col0 = u.pn * BM + wc * 32 + 4 * fq;
#pragma unroll
        for (int ai = 0; ai < 2; ++ai)
#pragma unroll
            for (int m = 0; m < 4; ++m)
#pragma unroll
                for (int bj = 0; bj < 2; ++bj)
#pragma unroll
                    for (int n = 0; n < 2; ++n) f(row0 + ai * HALF + m * 16, col0 + bj * HALF + n * 16, acc[ai][bj][m][n]);
    }
};
template <class Epi>
__device__ __forceinline__ void gemm_phase(PG8_LAS unsigned char* lds, const Gemm g, const StaticOrder& S, const Epi& E) {
    const int tid = threadIdx.x, wid = __builtin_amdgcn_readfirstlane(tid >> 6), lane = tid & 63, wr = wid >> 2, wc = wid & 3, fr = lane & 15, fq = lane >> 4;
    int K = g.K; asm volatile("" : "+s"(K));
    const int nt = K / BK;
    unsigned voffA[2], voffB[2];
#pragma unroll
    for (int i = 0; i < 2; ++i) { int R, C; stage_rc(tid * 16 + i * 8192, R, C); voffA[i] = (unsigned)(R * K + C) * 2u; voffB[i] = (unsigned)(R * K + C) * 2u; }
    const size_t kstep = (size_t)(BK * 2);
    const size_t hstep = (size_t)HALF * K * 2;
    const size_t tstep = 2 * hstep;
    const unsigned ldsw = (unsigned)wid * 1024u;
    const int aoff = lds_byte(wr * 64 + fr, fq * 8), boff = lds_byte(wc * 32 + fr, fq * 8);
#define PG8_SA(b, h) (((b) * 2 + (h)) * HTB)
#define PG8_SB(b, h) ((4 + (b) * 2 + (h)) * HTB)
#define PG8_STAGE(bufoff, gbase, voff) do { _Pragma("unroll") for (int _i = 0; _i < 2; ++_i) \
        __builtin_amdgcn_global_load_lds((const unsigned*)((const char*)(gbase) + (voff)[_i]), (PG8_LAS unsigned*)(lds + (bufoff) + ldsw + _i * 8192), 16, 0, 0); } while (0)
#define PG8_LDA(dst, b, h) do { _Pragma("unroll") for (int m = 0; m < 4; ++m) _Pragma("unroll") for (int k = 0; k < 2; ++k) dst[m][k] = *(const PG8_LAS h16x8*)(lds + PG8_SA(b, h) + aoff + m * 2048 + k * 1024); } while (0)
#define PG8_LDB(dst, b, h) do { _Pragma("unroll") for (int n = 0; n < 2; ++n) _Pragma("unroll") for (int k = 0; k < 2; ++k) dst[n][k] = *(const PG8_LAS h16x8*)(lds + PG8_SB(b, h) + boff + n * 2048 + k * 1024); } while (0)
#define PG8_MMA(ai, bj, At, Bt) do { __builtin_amdgcn_s_setprio(1); _Pragma("unroll") for (int m = 0; m < 4; ++m) _Pragma("unroll") for (int n = 0; n < 2; ++n) _Pragma("unroll") for (int k = 0; k < 2; ++k) \
        acc[ai][bj][m][n] = __builtin_amdgcn_mfma_f32_16x16x32_f16(__builtin_bit_cast(f16x8, Bt[n][k]), __builtin_bit_cast(f16x8, At[m][k]), acc[ai][bj][m][n], 0, 0, 0); __builtin_amdgcn_s_setprio(0); } while (0)
#define PG8_WAIT_V(n) asm volatile("s_waitcnt vmcnt(" #n ")" ::: "memory")
#define PG8_WAIT_L(n) asm volatile("s_waitcnt lgkmcnt(" #n ")" ::: "memory")
#define PG8_BAR __builtin_amdgcn_s_barrier()
#define PG8_SCHED __builtin_amdgcn_sched_barrier(0)
    Unit cur, nxt; int ui = 0;
    if (!S.next(0, cur)) return;
    f32x4 acc[2][2][4][2];
#pragma unroll
    for (int a = 0; a < 2; ++a)
#pragma unroll
        for (int b = 0; b < 2; ++b)
#pragma unroll
            for (int m = 0; m < 4; ++m)
#pragma unroll
                for (int n = 0; n < 2; ++n) acc[a][b][m][n] = (f32x4){0.f, 0.f, 0.f, 0.f};
    h16x8 At[4][2], B0[2][2], B1[2][2];
    const char* cA = (const char*)g.A + (size_t)cur.pm * tstep; const char* cB = (const char*)g.Bt + (size_t)cur.pn * tstep;
    PG8_STAGE(PG8_SB(0, 0), cB, voffB); PG8_STAGE(PG8_SA(0, 0), cA, voffA); PG8_STAGE(PG8_SB(0, 1), cB + hstep, voffB); PG8_STAGE(PG8_SA(0, 1), cA + hstep, voffA);
    if (wr == 1) PG8_BAR;
    PG8_WAIT_V(4); PG8_BAR;
    PG8_STAGE(PG8_SB(1, 0), cB + kstep, voffB); PG8_STAGE(PG8_SA(1, 0), cA + kstep, voffA); PG8_STAGE(PG8_SB(1, 1), cB + hstep + kstep, voffB);
    PG8_WAIT_V(6); PG8_BAR;
    for (;;) {
        const bool has_next = S.next(ui + 1, nxt);
        const char* nA = has_next ? (const char*)g.A + (size_t)nxt.pm * tstep : cA; const char* nB = has_next ? (const char*)g.Bt + (size_t)nxt.pn * tstep : cB;
        for (int t = 0; t < nt; t += 2) {
            const bool last = (t == nt - 2);
            const char* a1 = cA + (size_t)(t + 1) * kstep;
            const char* a2 = last ? nA : cA + (size_t)(t + 2) * kstep; const char* b2 = last ? nB : cB + (size_t)(t + 2) * kstep;
            const char* a3 = a2 + kstep; const char* b3 = b2 + kstep;
            PG8_LDB(B0, 0, 0); PG8_SCHED; PG8_LDA(At, 0, 0); PG8_STAGE(PG8_SA(1, 1), a1 + hstep, voffA);
            PG8_WAIT_L(8); PG8_BAR; PG8_WAIT_L(0); PG8_MMA(0, 0, At, B0); PG8_BAR; PG8_SCHED;
            PG8_LDB(B1, 0, 1); PG8_STAGE(PG8_SB(0, 0), b2, voffB);
            PG8_BAR; PG8_WAIT_L(0); PG8_MMA(0, 1, At, B1); PG8_BAR;
            PG8_LDA(At, 0, 1); PG8_STAGE(PG8_SA(0, 0), a2, voffA);
            PG8_BAR; PG8_WAIT_L(0); PG8_MMA(1, 0, At, B0); PG8_BAR; PG8_SCHED;
            PG8_STAGE(PG8_SB(0, 1), b2 + hstep, voffB);
            PG8_WAIT_V(6); PG8_BAR; PG8_MMA(1, 1, At, B1); PG8_BAR;
            PG8_LDB(B0, 1, 0); PG8_SCHED; PG8_LDA(At, 1, 0); PG8_STAGE(PG8_SA(0, 1), a2 + hstep, voffA);
            PG8_WAIT_L(8); PG8_BAR; PG8_WAIT_L(0); PG8_MMA(0, 0, At, B0); PG8_BAR; PG8_SCHED;
            PG8_LDB(B1, 1, 1); PG8_STAGE(PG8_SB(1, 0), b3, voffB);
            PG8_BAR; PG8_WAIT_L(0); PG8_MMA(0, 1, At, B1); PG8_BAR;
            PG8_LDA(At, 1, 1); PG8_STAGE(PG8_SA(1, 0), a3, voffA);
            PG8_BAR; PG8_WAIT_L(0); PG8_MMA(1, 0, At, B0); PG8_BAR; PG8_SCHED;
            PG8_STAGE(PG8_SB(1, 1), b3 + hstep, voffB);
            PG8_WAIT_V(6); PG8_BAR; PG8_MMA(1, 1, At, B1); PG8_BAR;
        }
        E(acc, cur, wr, wc, fr, fq);
        if (!has_next) break;
#pragma unroll
        for (int a = 0; a < 2; ++a)
#pragma unroll
            for (int b = 0; b < 2; ++b)
#pragma unroll
                for (int m = 0; m < 4; ++m)
#pragma unroll
                    for (int n = 0; n < 2; ++n) acc[a][b][m][n] = (f32x4){0.f, 0.f, 0.f, 0.f};
        cur = nxt; cA = nA; cB = nB; ++ui;
    }
    PG8_WAIT_V(0);
    if (wr == 0) PG8_BAR;
    PG8_BAR;
#undef PG8_SA
#undef PG8_SB
#undef PG8_STAGE
#undef PG8_LDA
#undef PG8_LDB
#undef PG8_MMA
#undef PG8_WAIT_V
#undef PG8_WAIT_L
#undef PG8_BAR
#undef PG8_SCHED
}
template <class F>
__device__ __forceinline__ void run_gemm(unsigned char* lds, const f16* A, const f16* Bt, int M, int N, int K, const F& f) {
    Gemm g{A, Bt, M, N, K}; StaticOrder S; S.init(M, N, (int)gridDim.x, (int)blockIdx.x);
    EpiElem<F> E{f};
    gemm_phase<EpiElem<F>>((PG8_LAS unsigned char*)lds, g, S, E);
    __syncthreads();
}
}

__device__ __forceinline__ f16x4 to_h4(f32x4 v) { f16x4 r; r.x = (f16)v.x; r.y = (f16)v.y; r.z = (f16)v.z; r.w = (f16)v.w; return r; }

__device__ __forceinline__ void tr_item(const float* W, int ldw, int col0, int nvalid, int K, f16* out, int nrow0, int item, int nblk, float* scr, int lane) {
    const int kb = item / nblk, nb = item % nblk, k0 = 64 * kb, n0 = 32 * nb;
#pragma unroll 8
    for (int i = 0; i < 32; ++i) { const int kk = 2 * i + (lane >> 5); const int j = n0 + (lane & 31);
        scr[kk * 33 + (lane & 31)] = (j < nvalid) ? W[(size_t)(k0 + kk) * ldw + col0 + j] : 0.f; }
    asm volatile("s_waitcnt vmcnt(0) lgkmcnt(0)" ::: "memory");
    const int c = lane & 7;
#pragma unroll
    for (int jj = 0; jj < 4; ++jj) { const int n = (lane >> 3) + 8 * jj; const float* s = scr + (8 * c) * 33 + n;
        f16x8 o;
#pragma unroll
        for (int e = 0; e < 8; ++e) o[e] = (f16)s[e * 33];
        *(f16x8*)(out + (size_t)(nrow0 + n0 + n) * K + k0 + 8 * c) = o; }
    asm volatile("s_waitcnt lgkmcnt(0)" ::: "memory");
}

template <bool LATE>
__device__ __forceinline__ void ph0_prep(const Params& p, unsigned char* lds, int vwg, int nvwg) {
    int tid_ = threadIdx.x; asm volatile("" : "+v"(tid_));
    const int tid = tid_, lane = tid & 63, wave = tid >> 6;
    const int gw = vwg * 8 + wave, NGW = nvwg * 8;
    f16* H0 = (f16*)(p.ws + WS_H0); float* STAT = (float*)(p.ws + WS_STAT);
    for (int m = gw; m < (LATE ? 0 : MR); m += NGW) {
        f16* orow = H0 + (size_t)m * D;
        if (m >= MREAL + 2 * NMETA) {
#pragma unroll
            for (int j = 0; j < 4; ++j) *(f16x4*)(orow + j * 256 + lane * 4) = (f16x4){(f16)0.f, (f16)0.f, (f16)0.f, (f16)0.f};
            continue;
        }
        const float* src = (m < MREAL) ? p.x + (size_t)m * D : p.meta + (size_t)((m - MREAL) & 15) * D;
        f32x4 v[4]; float s = 0.f;
#pragma unroll
        for (int j = 0; j < 4; ++j) { v[j] = *(const f32x4*)(src + j * 256 + lane * 4); s += (v[j].x + v[j].y) + (v[j].z + v[j].w); }
        const float mean = wave_sum(s) * (1.f / D); float s2 = 0.f;
#pragma unroll
        for (int j = 0; j < 4; ++j) { v[j] = v[j] - mean; s2 += (v[j].x * v[j].x + v[j].y * v[j].y) + (v[j].z * v[j].z + v[j].w * v[j].w); }
        const float rstd = 1.f / sqrtf(wave_sum(s2) * (1.f / D) + LN_EPS);
        if (lane == 0) { STAT[2 * m] = mean; STAT[2 * m + 1] = rstd; }
#pragma unroll
        for (int j = 0; j < 4; ++j) { const f32x4 g = *(const f32x4*)(p.ln_in_g + j * 256 + lane * 4), bb = *(const f32x4*)(p.ln_in_b + j * 256 + lane * 4);
            *(f16x4*)(orow + j * 256 + lane * 4) = to_h4(v[j] * rstd * g + bb); }
    }
    float* scr = (float*)lds + wave * (64 * 33);
    f16* W1T = (f16*)(p.ws + WS_W1T); f16* WGT = (f16*)(p.ws + WS_WGT); f16* WPBT = (f16*)(p.ws + WS_WPBT); f16* WOT = (f16*)(p.ws + WS_WOT);
    constexpr int I_QI = 16 * 16, I_CKV = 4 * 16, I_KI = 4 * 16, I_BC = 56 * 16, I_G = 64 * 16, I_PB = 32 * 8, I_O = 32 * 16;
    constexpr int NITEMS = I_QI + I_CKV + I_KI + I_BC + I_G + I_PB + I_O;
    for (int it = gw + (LATE ? I_QI + I_CKV + I_KI + I_BC : 0); it < (LATE ? NITEMS : I_QI + I_CKV + I_KI + I_BC); it += NGW) {
        int r = it;
        if (r < I_QI) { tr_item(p.w_in, NIN, 640, 512, D, W1T, C_QI, r, 16, scr, lane); continue; } r -= I_QI;
        if (r < I_CKV) { tr_item(p.w_in, NIN, 512, 128, D, W1T, C_CKV, r, 4, scr, lane); continue; } r -= I_CKV;
        if (r < I_KI) { tr_item(p.w_in, NIN, 1152, 72, D, W1T, C_KI, r, 4, scr, lane); continue; } r -= I_KI;
        if (r < I_BC) { tr_item(p.w_in, NIN, 1224, 1792, D, W1T, C_BC, r, 56, scr, lane); continue; } r -= I_BC;
        if (r < I_G) { tr_item(p.w_in, NIN, 3016, 2048, D, WGT, 0, r, 64, scr, lane); continue; } r -= I_G;
        if (r < I_PB) { tr_item(p.w_pb, D, 0, 1024, 512, WPBT, 0, r, 32, scr, lane); continue; } r -= I_PB;
        tr_item(p.w_o, D, 0, 1024, D, WOT, 0, r, 32, scr, lane);
    }
    {
        const int fr = lane & 15, fq = lane >> 4;
        constexpr int T_W1 = 8 * 8 * 64, T_SK = 16 * 8 * 64, T_PA = 8 * 8 * 64;
        f16* WPAT = (f16*)(p.ws + WS_WPAT); f16* WSKT = (f16*)(p.ws + WS_WSKT);
        for (int it = gw + (LATE ? T_W1 : 0); it < (LATE ? T_W1 + T_SK + T_PA : T_W1); it += NGW) {
            int r = it; int kind = 0; if (r >= T_W1) { r -= T_W1; kind = 1; if (r >= T_SK) { r -= T_SK; kind = 2; } }
            const int g = r >> 9, mt = (r >> 6) & 7, nt = r & 63;
            const int m = 16 * mt + fr, n = 16 * nt + fr;
            const int KK = (kind == 1) ? 128 : 64;
            f32x4 acc = {0.f, 0.f, 0.f, 0.f};
            for (int k0 = 0; k0 < KK; k0 += 32) {
                const int kb = k0 + 8 * fq;
                f16x8 af, bf;
                if (kind == 0) { const float* ap = p.a_w_uk + (size_t)(m * 8 + g) * 64 + kb; const float* bp = p.w_in + (size_t)n * NIN + g * 64 + kb;
                    const f32x4 a0 = *(const f32x4*)ap, a1 = *(const f32x4*)(ap + 4), b0 = *(const f32x4*)bp, b1 = *(const f32x4*)(bp + 4);
#pragma unroll
                    for (int e = 0; e < 4; ++e) { af[e] = (f16)a0[e]; af[4 + e] = (f16)a1[e]; bf[e] = (f16)b0[e]; bf[4 + e] = (f16)b1[e]; } }
                else if (kind == 1) { const float* ap = p.peer_subkeys + (size_t)(g * 128 + m) * 128 + kb; const float* bp = p.peer_wq + (size_t)n * 2048 + g * 128 + kb;
                    const f32x4 a0 = *(const f32x4*)ap, a1 = *(const f32x4*)(ap + 4), b0 = *(const f32x4*)bp, b1 = *(const f32x4*)(bp + 4);
#pragma unroll
                    for (int e = 0; e < 4; ++e) { af[e] = (f16)a0[e]; af[4 + e] = (f16)a1[e]; bf[e] = (f16)b0[e]; bf[4 + e] = (f16)b1[e]; } }
                else { const float* ap = p.a_w_uv + (size_t)(m * 8 + g) * 64 + kb; const float* bp = p.w_pa + (size_t)(g * 64 + kb) * D + n;
                    const f32x4 a0 = *(const f32x4*)ap, a1 = *(const f32x4*)(ap + 4);
#pragma unroll
                    for (int e = 0; e < 4; ++e) { af[e] = (f16)a0[e]; af[4 + e] = (f16)a1[e]; }
#pragma unroll
                    for (int e = 0; e < 8; ++e) bf[e] = (f16)bp[(size_t)e * D]; }
                acc = __builtin_amdgcn_mfma_f32_16x16x32_f16(af, bf, acc, 0, 0, 0);
            }
            if (kind == 2) { *(f16x4*)(WPAT + (size_t)n * D + g * 128 + 16 * mt + 4 * fq) = to_h4(acc); }
            else { f16* o = ((kind == 0) ? W1T : WSKT) + (size_t)(g * 128 + 16 * mt + 4 * fq) * D + n;
#pragma unroll
                for (int e = 0; e < 4; ++e) o[(size_t)e * D] = (f16)acc[e]; }
        }
    }
    const long gt = (long)vwg * NT + tid, NGT = (long)nvwg * NT;
    f16* WLT = (f16*)(p.ws + WS_WLT);
    for (long e = gt; e < (LATE ? 0L : 1536L * 256); e += NGT) { const int n = (int)(e >> 8), k = (int)(e & 255); float v = 0.f;
        if (n < 512) { if (k < 64) v = p.b_w2[(size_t)k * 512 + n]; }
        else if (n < 1024) { if (k >= 64 && k < 128) v = p.b_a2[(size_t)(k - 64) * 512 + (n - 512)]; }
        else { if (k >= 128) v = p.b_g2[(size_t)(k - 128) * 512 + (n - 1024)]; }
        WLT[e] = (f16)v; }
    if (LATE) {
        unsigned char* U8 = p.ws + WS_U8;
        for (long e = gt; e < 16384L * 1024 / 16; e += NGT) {
            u32x4 ou, ov;
#pragma unroll
            for (int q = 0; q < 4; ++q) { const f32x4 a = *(const f32x4*)(p.peer_u + e * 16 + q * 4) * 256.f; const f32x4 c = *(const f32x4*)(p.peer_v + e * 16 + q * 4) * 16.f;
                int w = 0; w = __builtin_amdgcn_cvt_pk_fp8_f32(a[0], a[1], w, false); w = __builtin_amdgcn_cvt_pk_fp8_f32(a[2], a[3], w, true); ou[q] = (unsigned)w;
                int x = 0; x = __builtin_amdgcn_cvt_pk_fp8_f32(c[0], c[1], x, false); x = __builtin_amdgcn_cvt_pk_fp8_f32(c[2], c[3], x, true); ov[q] = (unsigned)x; }
            const long row = e >> 6;
            unsigned char* vdst = (row < V8A_ROWS) ? p.ws + WS_V8A + e * 16 : p.ws + WS_V8B + (e - (long)V8A_ROWS * 64) * 16;
            *(u32x4*)(U8 + e * 16) = ou; *(u32x4*)vdst = ov;
        }
    }
}

__device__ __forceinline__ void phc1_rowprep(const Params& p) {
    const int tid = threadIdx.x, lane = tid & 63, wave = tid >> 6;
    const int gw = blockIdx.x * 8 + wave, NGW = gridDim.x * 8;
    const f16* PB = (const f16*)(p.ws + WS_PB); f16* CKV = (f16*)(p.ws + WS_CKV); f16* KIDX = (f16*)(p.ws + WS_KIDX); float* WIS = (float*)(p.ws + WS_WIS);
    f16* LORAIN = (f16*)((unsigned char*)p.out + DO_LORAIN);
    for (int m = gw; m < MR; m += NGW) {
        if (m >= MREAL + 2 * NMETA) { *(f16x4*)(LORAIN + (size_t)m * 256 + lane * 4) = (f16x4){(f16)0.f, (f16)0.f, (f16)0.f, (f16)0.f}; continue; }
        const f16* pr = PB + (size_t)m * N1;
        { const f16x2 c2 = *(const f16x2*)(pr + C_CKV + 2 * lane); const float a = (float)c2.x, b = (float)c2.y;
          const float ss = wave_sum(a * a + b * b); const float r = 1.f / sqrtf(ss * (1.f / 128.f) + 1e-6f);
          f16x2 o; o.x = (f16)(a * r * p.a_kv_norm_g[2 * lane]); o.y = (f16)(b * r * p.a_kv_norm_g[2 * lane + 1]);
          *(f16x2*)(CKV + (size_t)m * 128 + 2 * lane) = o; }
        { const float a = (float)pr[C_KI + lane]; const float mu = wave_sum(a) * (1.f / 64.f); const float d = a - mu;
          const float var = wave_sum(d * d) * (1.f / 64.f);
          int kb_, kt_; if (m < MREAL) { kb_ = m >> 13; kt_ = NMETA + (m & 8191); } else { kb_ = (m - MREAL) >> 4; kt_ = (m - MREAL) & 15; }
          KIDX[(size_t)kb_ * KIDX_B + (size_t)(kt_ >> 5) * 2048 + (lane >> 4) * 512 + ((lane >> 3) & 1) * 256 + (kt_ & 31) * 8 + (lane & 7)] = (f16)(d * (1.f / sqrtf(var + LN_EPS)) * p.a_kidx_g[lane] + p.a_kidx_b[lane]); }
        if (lane < 8) WIS[(size_t)m * 8 + lane] = (float)pr[C_WI + lane] * 0.04419417382415922f;
        { int b, t; if (m < MREAL) { b = m >> 13; t = NMETA + (m & 8191); } else { b = (m - MREAL) >> 4; t = (m - MREAL) & 15; }
          const f16x4 cur = *(const f16x4*)(pr + C_BC + 1536 + lane * 4);
          f16x4 prv = (f16x4){(f16)0.f, (f16)0.f, (f16)0.f, (f16)0.f};
          if (t > 0) prv = *(const f16x4*)(PB + (size_t)row_of(b, t - 1) * N1 + C_BC + 1536 + lane * 4);
          const f32x4 mu = *(const f32x4*)(p.b_mu + 1536 + lane * 4);
          f16x4 o;
#pragma unroll
          for (int e = 0; e < 4; ++e) { const float c = (float)cur[e], q = (float)prv[e]; float xs = c + (q - c) * mu[e];
              const int j = lane * 4 + e; if (j < 64) xs = tanhf(xs); else if (j >= 128) xs = sigmoidf_(xs); o[e] = (f16)xs; }
          *(f16x4*)(LORAIN + (size_t)m * 256 + lane * 4) = o; }
    }
}

typedef short bf16x8 __attribute__((ext_vector_type(8)));
typedef unsigned short bf16_t;
typedef unsigned u32x2 __attribute__((ext_vector_type(2)));
typedef __bf16 bf16x2_t __attribute__((ext_vector_type(2)));
__device__ __forceinline__ unsigned cvt_pk_bf16(float lo, float hi) { const f32x2 v = {lo, hi}; const bf16x2_t b = __builtin_convertvector(v, bf16x2_t); return __builtin_bit_cast(unsigned, b); }
__device__ __forceinline__ bf16_t f2bf(float f) { unsigned u = __float_as_uint(f); return (bf16_t)((u + 0x7fffu + ((u >> 16) & 1u)) >> 16); }
__device__ __forceinline__ u32x2 pk4(f32x4 v) { u32x2 r; r.x = cvt_pk_bf16(v[0], v[1]); r.y = cvt_pk_bf16(v[2], v[3]); return r; }
__device__ __forceinline__ bf16x8 pk8(f32x4 a, f32x4 b) { u32x4 r; r.x = cvt_pk_bf16(a[0], a[1]); r.y = cvt_pk_bf16(a[2], a[3]); r.z = cvt_pk_bf16(b[0], b[1]); r.w = cvt_pk_bf16(b[2], b[3]); return __builtin_bit_cast(bf16x8, r); }
#define MFMA_BF(a, b, c) __builtin_amdgcn_mfma_f32_16x16x32_bf16((a), (b), (c), 0, 0, 0)
constexpr int RS = 72, PSt = 40, FS = 36, YS = 68;
__device__ __forceinline__ void rwkv_item(const Params& p, int b, int h, unsigned char* lds) {
    int tid_ = threadIdx.x; asm volatile("" : "+v"(tid_));
    const int tid = tid_, lane = tid & 63, wave = __builtin_amdgcn_readfirstlane(tid >> 6), fr = lane & 15, fq = lane >> 4;
    const f16* PB = (const f16*)(p.ws + WS_PB);
    const f16* LW = (const f16*)((unsigned char*)p.out + DO_LW); const f16* AA = (const f16*)((unsigned char*)p.out + DO_AA); const f16* GG = (const f16*)((unsigned char*)p.out + DO_GG);
    f16* OB = (f16*)(p.ws + WS_OB);
    constexpr int SETB = 4 * 32 * RS * 2 + 3 * 64 * PSt * 2 + 256 + 4608 * 4;
#define RW_SET(par_) bf16_t* sAt = (bf16_t*)(lds + (par_) * SETB); bf16_t* sRt = sAt + 32 * RS; bf16_t* sBt = sRt + 32 * RS; bf16_t* sKt = sBt + 32 * RS; \
        bf16_t* sBPT = sKt + 32 * RS; bf16_t* sKPT = sBPT + 64 * PSt; bf16_t* sVT = sKPT + 64 * PSt; float* sPL = (float*)(sVT + 64 * PSt); float* sFst = sPL + 64; \
        (void)sAt; (void)sRt; (void)sBt; (void)sKt; (void)sBPT; (void)sKPT; (void)sVT; (void)sPL; (void)sFst
    bf16_t* sAak = (bf16_t*)(lds + 2 * SETB); bf16_t* sMrb = sAak + 32 * PSt; bf16_t* sMrk = sMrb + 32 * PSt; bf16_t* sT = sMrk + 32 * PSt; bf16_t* sAabB = sT + 32 * PSt;
    float* sAabT = (float*)(sAabB + 16 * PSt); float* sTot = sAabT + 2 * 16 * FS; float* sY = sTot + 8 * 64;
    float* sEnd = sY + 32 * YS;
    float* sCst = sEnd;
    for (unsigned* z = (unsigned*)lds + tid; z < (unsigned*)sEnd; z += NT) *z = 0u;
    const int ps = tid >> 4, cg = tid & 15, c4 = cg * 4, hc = h * 64 + c4;
    const int chslot = 32 * (cg >> 3) + 8 * (cg & 3) + 4 * ((cg >> 2) & 1);
    const int pslot = 8 * ((ps & 15) >> 2) + 4 * (ps >> 4) + (ps & 3);
#define PSWZ(row, slot) ((row) * PSt + ((((slot) >> 3) ^ (((row) >> 3) & 3)) << 3) + ((slot) & 7))
    if (tid < 64) { sCst[tid] = p.b_mu[h * 64 + tid]; sCst[64 + tid] = p.b_mu[512 + h * 64 + tid]; sCst[128 + tid] = p.b_mu[1024 + h * 64 + tid]; sCst[192 + tid] = p.b_k_k[h * 64 + tid];
        sCst[256 + tid] = p.b_k_a[h * 64 + tid]; sCst[320 + tid] = p.b_r_k[h * 64 + tid]; sCst[384 + tid] = p.b_lnx_g[h * 64 + tid]; sCst[448 + tid] = p.b_lnx_b[h * 64 + tid]; }
    f32x4 Hacc[4];
#pragma unroll
    for (int i = 0; i < 4; ++i) Hacc[i] = (f32x4){0.f, 0.f, 0.f, 0.f};
    const f16x4 hz = (f16x4){(f16)0.f, (f16)0.f, (f16)0.f, (f16)0.f};
    f16x4 n_cr = hz, n_ck = hz, n_cv = hz, n_qr = hz, n_qk = hz, n_qv = hz, n_lw = hz, n_aa = hz, n_gg = hz;
#define RW_PREFETCH(tt) do { const int _t = (tt); n_cr = hz; n_ck = hz; n_cv = hz; n_qr = hz; n_qk = hz; n_qv = hz; n_lw = hz; n_aa = hz; n_gg = hz; \
        if (_t < TT) { const int _m = row_of(b, _t); const f16* _pr = PB + (size_t)_m * N1 + C_BC + hc; n_cr = *(const f16x4*)(_pr); n_ck = *(const f16x4*)(_pr + 512); n_cv = *(const f16x4*)(_pr + 1024); \
            if (_t > 0) { const f16* _pp = PB + (size_t)row_of(b, _t - 1) * N1 + C_BC + hc; n_qr = *(const f16x4*)(_pp); n_qk = *(const f16x4*)(_pp + 512); n_qv = *(const f16x4*)(_pp + 1024); } \
            n_lw = *(const f16x4*)(LW + (size_t)_m * 512 + hc); n_aa = *(const f16x4*)(AA + (size_t)_m * 512 + hc); n_gg = *(const f16x4*)(GG + (size_t)_m * 512 + hc); } } while (0)
    RW_PREFETCH(ps);
    __syncthreads();
#define RW_SCAN_LOCAL(dst, lwv) do { dst = (f32x4){(float)(lwv)[0], (float)(lwv)[1], (float)(lwv)[2], (float)(lwv)[3]}; f32x4 u1_; \
        _Pragma("unroll") for (int e = 0; e < 4; ++e) u1_[e] = __shfl_up(dst[e], 16); if (lane >= 16) dst += u1_; \
        _Pragma("unroll") for (int e = 0; e < 4; ++e) u1_[e] = __shfl_up(dst[e], 32); if (lane >= 32) dst += u1_; \
        if (lane >= 48) *(f32x4*)(sTot + wave * 64 + c4) = dst; } while (0)
#define RW_SCAN_FINISH(dst, totv) do { totv = (f32x4){0.f, 0.f, 0.f, 0.f}; f32x4 tw_[8]; \
        _Pragma("unroll") for (int w = 0; w < 8; ++w) tw_[w] = *(const f32x4*)(sTot + w * 64 + c4); \
        __builtin_amdgcn_sched_barrier(0); \
        _Pragma("unroll") for (int w = 0; w < 8; ++w) { totv += tw_[w]; const float msk_ = (w < wave) ? 1.f : 0.f; dst += tw_[w] * msk_; } } while (0)
    f32x4 cumC, totC;
    RW_SCAN_LOCAL(cumC, n_lw);
    __syncthreads();
    RW_SCAN_FINISH(cumC, totC);
    __syncthreads();
    constexpr int NCH = (TT + 31) / 32;
    { RW_SET(0); const int t = ps;
        f32x4 r4 = {0, 0, 0, 0}, k4 = r4, v4 = r4, kk4 = r4, a4 = r4, g4 = r4, lw4 = r4;
        f32x4 rkw;
        {
            const f16x4 cr = n_cr, ck = n_ck, cv = n_cv, qr = n_qr, qk = n_qk, qv = n_qv, lw = n_lw, aa = n_aa, gg = n_gg;
            RW_PREFETCH(t + 32);
            const f32x4 mu_r = *(const f32x4*)(sCst + c4), mu_k = *(const f32x4*)(sCst + 64 + c4), mu_v = *(const f32x4*)(sCst + 128 + c4), kkw = *(const f32x4*)(sCst + 192 + c4), kaw = *(const f32x4*)(sCst + 256 + c4);
            rkw = *(const f32x4*)(sCst + 320 + c4);
#pragma unroll
            for (int e = 0; e < 4; ++e) {
                const float c0 = (float)cr[e], c1 = (float)ck[e], c2 = (float)cv[e];
                r4[e] = c0 + ((float)qr[e] - c0) * mu_r[e];
                const float k0 = c1 + ((float)qk[e] - c1) * mu_k[e];
                v4[e] = c2 + ((float)qv[e] - c2) * mu_v[e];
                a4[e] = (float)aa[e]; lw4[e] = (float)lw[e]; g4[e] = (float)gg[e];
                kk4[e] = k0 * kkw[e];
                k4[e] = k0 * (1.f + (a4[e] - 1.f) * kaw[e]);
            }
        }
        float ss = kk4[0] * kk4[0] + kk4[1] * kk4[1] + kk4[2] * kk4[2] + kk4[3] * kk4[3];
        float bo = r4[0] * k4[0] * rkw[0] + r4[1] * k4[1] * rkw[1] + r4[2] * k4[2] * rkw[2] + r4[3] * k4[3] * rkw[3];
        ss = row16_sum(ss); bo = row16_sum(bo);
        *(f32x4*)(sFst + tid * 4) = v4; *(f32x4*)(sFst + 2048 + tid * 4) = g4; sFst[4096 + tid] = bo;
        const float rn = __builtin_amdgcn_rsqf(ss + 1e-12f);
        f32x4 bb4;
#pragma unroll
        for (int e = 0; e < 4; ++e) { kk4[e] *= rn; bb4[e] = kk4[e] * a4[e]; }
        const f32x4 cum = cumC, tot = totC;
        {
            f32x4 xa, xb, xk, xr, xbp, xkp;
#pragma unroll
            for (int e = 0; e < 4; ++e) { const float e1 = __expf(cum[e]), e2 = __expf(-cum[e]), e3 = __expf(cum[e] - lw4[e]), e4 = __expf(tot[e] - cum[e]);
                xa[e] = -kk4[e] * e3; xb[e] = bb4[e] * e2; xk[e] = k4[e] * e2; xr[e] = r4[e] * e1; xbp[e] = bb4[e] * e4; xkp[e] = k4[e] * e4; }
            *(u32x2*)(sAt + ps * RS + chslot) = pk4(xa); *(u32x2*)(sBt + ps * RS + chslot) = pk4(xb); *(u32x2*)(sKt + ps * RS + chslot) = pk4(xk); *(u32x2*)(sRt + ps * RS + chslot) = pk4(xr);
#pragma unroll
            for (int e = 0; e < 4; e += 2) { const unsigned pb_ = cvt_pk_bf16(xbp[e], xbp[e + 1]), pk_ = cvt_pk_bf16(xkp[e], xkp[e + 1]), pv_ = cvt_pk_bf16(v4[e], v4[e + 1]);
                sBPT[PSWZ(c4 + e, pslot)] = (bf16_t)pb_; sBPT[PSWZ(c4 + e + 1, pslot)] = (bf16_t)(pb_ >> 16); sKPT[PSWZ(c4 + e, pslot)] = (bf16_t)pk_; sKPT[PSWZ(c4 + e + 1, pslot)] = (bf16_t)(pk_ >> 16);
                sVT[PSWZ(c4 + e, pslot)] = (bf16_t)pv_; sVT[PSWZ(c4 + e + 1, pslot)] = (bf16_t)(pv_ >> 16); }
            if (ps == 0) { f32x4 pl;
#pragma unroll
                for (int e = 0; e < 4; ++e) pl[e] = __expf(tot[e]);
                *(f32x4*)(sPL + c4) = pl; }
        }
    }
    __syncthreads();
    { RW_SET(0);
        for (int jb = (wave < 2) ? wave : wave, jn = 0; jb < 12 && !(wave < 2 && jn > 0); jb += 6, ++jn) {
            const bf16_t *Ab, *Bb; int ta, tb;
            if (jb < 2) { ta = jb; tb = jb; Ab = sAt; Bb = sBt; }
            else if (jb == 2) { ta = 0; tb = 1; Ab = sBt; Bb = sAt; }
            else { const int ti = (jb - 3) % 3, prod = (jb - 3) / 3; ta = (ti == 2) ? 1 : 0; tb = (ti >= 1) ? 1 : 0; Ab = (prod == 1) ? sBt : sKt; Bb = (prod == 0) ? sAt : sRt; }
            f32x4 acc = {0, 0, 0, 0};
#pragma unroll
            for (int ks = 0; ks < 2; ++ks) { const bf16x8 a = *(const bf16x8*)(Ab + (16 * ta + fr) * RS + 32 * ks + 8 * fq); const bf16x8 bq = *(const bf16x8*)(Bb + (16 * tb + fr) * RS + 32 * ks + 8 * fq); acc = MFMA_BF(a, bq, acc); }
            const int rloc = 4 * fq, cloc = fr;
            if (jb < 2) {
#pragma unroll
                for (int e = 0; e < 4; ++e) acc[e] = (cloc < rloc + e) ? acc[e] : 0.f;
                *(f32x4*)(sAabT + jb * 16 * FS + cloc * FS + rloc) = acc;
                asm volatile("s_waitcnt lgkmcnt(0)" ::: "memory");
                if (lane < 16) {
                    const int col = lane;
                    const float* At_ = sAabT + jb * 16 * FS;
                    float x[16];
#pragma unroll
                    for (int s2 = 0; s2 < 16; ++s2) x[s2] = (s2 == col) ? 1.f : 0.f;
#define RW_INV_BATCH(J0, J1) do { f32x4 cv_[(J1) - (J0)][4]; \
                    _Pragma("unroll") for (int j = (J0); j < (J1); ++j) _Pragma("unroll") for (int q4 = (j + 1) / 4; q4 < 4; ++q4) cv_[j - (J0)][q4] = *(const f32x4*)(At_ + j * FS + 4 * q4); \
                    __builtin_amdgcn_sched_barrier(0); \
                    _Pragma("unroll") for (int j = (J0); j < (J1); ++j) { const float xj = x[j]; \
                        _Pragma("unroll") for (int q4 = (j + 1) / 4; q4 < 4; ++q4) _Pragma("unroll") for (int e = 0; e < 4; ++e) if (4 * q4 + e > j) x[4 * q4 + e] += cv_[j - (J0)][q4][e] * xj; } \
                    __builtin_amdgcn_sched_barrier(0); } while (0)
                    RW_INV_BATCH(0, 3); RW_INV_BATCH(3, 7); RW_INV_BATCH(7, 15);
#pragma unroll
                    for (int s2 = 0; s2 < 16; ++s2) sT[(16 * jb + s2) * PSt + 8 * (col >> 2) + (col & 3)] = f2bf(x[s2]);
                }
            } else if (jb == 2) {
                *(u32x2*)(sAabB + cloc * PSt + 8 * fq) = pk4(acc);
            } else {
                const int prod = (jb - 3) / 3; const int jrow = 16 * ta + rloc, scol = 16 * tb + cloc;
                if (prod == 0) {
#pragma unroll
                    for (int e = 0; e < 4; ++e) acc[e] = (jrow + e < scol) ? acc[e] : 0.f;
                } else {
#pragma unroll
                    for (int e = 0; e < 4; ++e) acc[e] = (jrow + e <= scol) ? acc[e] : 0.f;
                }
                *(u32x2*)(((prod == 0) ? sAak : (prod == 1) ? sMrb : sMrk) + scol * PSt + 8 * fq + 4 * ta) = pk4(acc);
            }
        }
    }
    { f32x4 cumN, totN; RW_SCAN_LOCAL(cumN, n_lw); __syncthreads(); RW_SCAN_FINISH(cumN, totN); cumC = cumN; totC = totN; }
    for (int c = 0; c < NCH; ++c) {
        const int par = c & 1; const bool more = (c + 1 < NCH);
        { RW_SET(par);
        if (wave < 4) {
            const int v0 = 16 * wave;
            const f32x4 z4 = {0.f, 0.f, 0.f, 0.f};
            const bf16x8 hb0 = pk8(Hacc[0], Hacc[1]), hb1 = pk8(Hacc[2], Hacc[3]);
            const bf16x8 vb = *(const bf16x8*)(sVT + PSWZ(v0 + fr, 8 * fq));
            bf16x8 fAt[2][2], fAak[2], fT[2], fAabB;
#pragma unroll
            for (int ts = 0; ts < 2; ++ts) { const bf16_t* atr = sAt + (16 * ts + fr) * RS;
                fAt[ts][0] = *(const bf16x8*)(atr + 8 * fq); fAt[ts][1] = *(const bf16x8*)(atr + 32 + 8 * fq); fAak[ts] = *(const bf16x8*)(sAak + (16 * ts + fr) * PSt + 8 * fq); fT[ts] = *(const bf16x8*)(sT + (16 * ts + fr) * PSt + 8 * fq); }
            fAabB = *(const bf16x8*)(sAabB + fr * PSt + 8 * fq);
            __builtin_amdgcn_sched_barrier(0);
            f32x4 zt = MFMA_BF(fAt[0][0], hb0, z4); f32x4 zb = MFMA_BF(fAt[1][0], hb0, z4);
            zt = MFMA_BF(fAt[0][1], hb1, zt); zb = MFMA_BF(fAt[1][1], hb1, zb);
            zt = MFMA_BF(fAak[0], vb, zt); zb = MFMA_BF(fAak[1], vb, zb);
            bf16x8 fRt[2][2], fMrk[2], fMrb[2];
#pragma unroll
            for (int ts = 0; ts < 2; ++ts) { const bf16_t* rtr = sRt + (16 * ts + fr) * RS;
                fRt[ts][0] = *(const bf16x8*)(rtr + 8 * fq); fRt[ts][1] = *(const bf16x8*)(rtr + 32 + 8 * fq);
                fMrk[ts] = *(const bf16x8*)(sMrk + (16 * ts + fr) * PSt + 8 * fq); fMrb[ts] = *(const bf16x8*)(sMrb + (16 * ts + fr) * PSt + 8 * fq); }
            __builtin_amdgcn_sched_barrier(0);
            const f32x4 ut = MFMA_BF(fT[0], pk8(zt, z4), z4);
            f32x4 y0 = MFMA_BF(fRt[0][0], hb0, z4); f32x4 y1 = MFMA_BF(fRt[1][0], hb0, z4);
            y0 = MFMA_BF(fRt[0][1], hb1, y0); y1 = MFMA_BF(fRt[1][1], hb1, y1);
            zb = MFMA_BF(fAabB, pk8(ut, z4), zb);
            y0 = MFMA_BF(fMrk[0], vb, y0); y1 = MFMA_BF(fMrk[1], vb, y1);
            const f32x4 ubt = MFMA_BF(fT[1], pk8(zb, z4), z4);
            const bf16x8 ub = pk8(ut, ubt);
            y0 = MFMA_BF(fMrb[0], ub, y0); y1 = MFMA_BF(fMrb[1], ub, y1);
#pragma unroll
            for (int e = 0; e < 4; ++e) { sY[(4 * fq + e) * YS + v0 + fr] = y0[e]; sY[(16 + 4 * fq + e) * YS + v0 + fr] = y1[e]; }
            __builtin_amdgcn_sched_barrier(0);
            bf16x8 fBP[4], fKP[4]; f32x4 fPL[4];
#pragma unroll
            for (int tc = 0; tc < 4; ++tc) { fBP[tc] = *(const bf16x8*)(sBPT + PSWZ(16 * tc + fr, 8 * fq)); fKP[tc] = *(const bf16x8*)(sKPT + PSWZ(16 * tc + fr, 8 * fq)); fPL[tc] = *(const f32x4*)(sPL + 16 * tc + 4 * fq); }
            __builtin_amdgcn_sched_barrier(0);
#pragma unroll
            for (int tc = 0; tc < 4; ++tc) {
                f32x4 acc = Hacc[tc] * fPL[tc];
                acc = MFMA_BF(fBP[tc], ub, acc);
                acc = MFMA_BF(fKP[tc], vb, acc);
                Hacc[tc] = acc; }
        }
        }
        if (more) { RW_SET(par ^ 1); const int t = 32 * (c + 1) + ps;
        f32x4 r4 = {0, 0, 0, 0}, k4 = r4, v4 = r4, kk4 = r4, a4 = r4, g4 = r4, lw4 = r4;
        f32x4 rkw;
        {
            const f16x4 cr = n_cr, ck = n_ck, cv = n_cv, qr = n_qr, qk = n_qk, qv = n_qv, lw = n_lw, aa = n_aa, gg = n_gg;
            RW_PREFETCH(t + 32);
            const f32x4 mu_r = *(const f32x4*)(sCst + c4), mu_k = *(const f32x4*)(sCst + 64 + c4), mu_v = *(const f32x4*)(sCst + 128 + c4), kkw = *(const f32x4*)(sCst + 192 + c4), kaw = *(const f32x4*)(sCst + 256 + c4);
            rkw = *(const f32x4*)(sCst + 320 + c4);
#pragma unroll
            for (int e = 0; e < 4; ++e) {
                const float c0 = (float)cr[e], c1 = (float)ck[e], c2 = (float)cv[e];
                r4[e] = c0 + ((float)qr[e] - c0) * mu_r[e];
                const float k0 = c1 + ((float)qk[e] - c1) * mu_k[e];
                v4[e] = c2 + ((float)qv[e] - c2) * mu_v[e];
                a4[e] = (float)aa[e]; lw4[e] = (float)lw[e]; g4[e] = (float)gg[e];
                kk4[e] = k0 * kkw[e];
                k4[e] = k0 * (1.f + (a4[e] - 1.f) * kaw[e]);
            }
        }
        float ss = kk4[0] * kk4[0] + kk4[1] * kk4[1] + kk4[2] * kk4[2] + kk4[3] * kk4[3];
        float bo = r4[0] * k4[0] * rkw[0] + r4[1] * k4[1] * rkw[1] + r4[2] * k4[2] * rkw[2] + r4[3] * k4[3] * rkw[3];
        ss = row16_sum(ss); bo = row16_sum(bo);
        *(f32x4*)(sFst + tid * 4) = v4; *(f32x4*)(sFst + 2048 + tid * 4) = g4; sFst[4096 + tid] = bo;
        const float rn = __builtin_amdgcn_rsqf(ss + 1e-12f);
        f32x4 bb4;
#pragma unroll
        for (int e = 0; e < 4; ++e) { kk4[e] *= rn; bb4[e] = kk4[e] * a4[e]; }
        const f32x4 cum = cumC, tot = totC;
        {
            f32x4 xa, xb, xk, xr, xbp, xkp;
#pragma unroll
            for (int e = 0; e < 4; ++e) { const float e1 = __expf(cum[e]), e2 = __expf(-cum[e]), e3 = __expf(cum[e] - lw4[e]), e4 = __expf(tot[e] - cum[e]);
                xa[e] = -kk4[e] * e3; xb[e] = bb4[e] * e2; xk[e] = k4[e] * e2; xr[e] = r4[e] * e1; xbp[e] = bb4[e] * e4; xkp[e] = k4[e] * e4; }
            *(u32x2*)(sAt + ps * RS + chslot) = pk4(xa); *(u32x2*)(sBt + ps * RS + chslot) = pk4(xb); *(u32x2*)(sKt + ps * RS + chslot) = pk4(xk); *(u32x2*)(sRt + ps * RS + chslot) = pk4(xr);
#pragma unroll
            for (int e = 0; e < 4; e += 2) { const unsigned pb_ = cvt_pk_bf16(xbp[e], xbp[e + 1]), pk_ = cvt_pk_bf16(xkp[e], xkp[e + 1]), pv_ = cvt_pk_bf16(v4[e], v4[e + 1]);
                sBPT[PSWZ(c4 + e, pslot)] = (bf16_t)pb_; sBPT[PSWZ(c4 + e + 1, pslot)] = (bf16_t)(pb_ >> 16); sKPT[PSWZ(c4 + e, pslot)] = (bf16_t)pk_; sKPT[PSWZ(c4 + e + 1, pslot)] = (bf16_t)(pk_ >> 16);
                sVT[PSWZ(c4 + e, pslot)] = (bf16_t)pv_; sVT[PSWZ(c4 + e + 1, pslot)] = (bf16_t)(pv_ >> 16); }
            if (ps == 0) { f32x4 pl;
#pragma unroll
                for (int e = 0; e < 4; ++e) pl[e] = __expf(tot[e]);
                *(f32x4*)(sPL + c4) = pl; }
        }
        }
        __syncthreads();
        { RW_SET(par); const int tF = 32 * c + ps;
        {
            const f32x4 y4 = *(const f32x4*)(sY + ps * YS + c4); const f32x4 lng = *(const f32x4*)(sCst + 384 + c4), lnb = *(const f32x4*)(sCst + 448 + c4);
            const f32x4 pv4 = *(const f32x4*)(sFst + tid * 4), pg4 = *(const f32x4*)(sFst + 2048 + tid * 4); const float pbo = sFst[4096 + tid];
            const float mean = row16_sum((y4[0] + y4[1]) + (y4[2] + y4[3])) * (1.f / 64.f);
            float q = 0.f;
#pragma unroll
            for (int e = 0; e < 4; ++e) { const float d = y4[e] - mean; q += d * d; }
            const float rstd = __builtin_amdgcn_rsqf(row16_sum(q) * (1.f / 64.f) + 64e-5f);
            if (tF < TT && tF >= NMETA) {
                f16x4 o;
#pragma unroll
                for (int e = 0; e < 4; ++e) o[e] = (f16)((((y4[e] - mean) * rstd) * lng[e] + lnb[e] + pbo * pv4[e]) * pg4[e]);
                *(f16x4*)(OB + (size_t)(b * SEQ + (tF - NMETA)) * 512 + hc) = o;
            }
        }
        }
        f32x4 cumN = {0.f, 0.f, 0.f, 0.f}, totN = cumN;
        if (more) { RW_SET(par ^ 1);
        for (int jb = (wave < 2) ? wave : wave, jn = 0; jb < 12 && !(wave < 2 && jn > 0); jb += 6, ++jn) {
            const bf16_t *Ab, *Bb; int ta, tb;
            if (jb < 2) { ta = jb; tb = jb; Ab = sAt; Bb = sBt; }
            else if (jb == 2) { ta = 0; tb = 1; Ab = sBt; Bb = sAt; }
            else { const int ti = (jb - 3) % 3, prod = (jb - 3) / 3; ta = (ti == 2) ? 1 : 0; tb = (ti >= 1) ? 1 : 0; Ab = (prod == 1) ? sBt : sKt; Bb = (prod == 0) ? sAt : sRt; }
            f32x4 acc = {0, 0, 0, 0};
#pragma unroll
            for (int ks = 0; ks < 2; ++ks) { const bf16x8 a = *(const bf16x8*)(Ab + (16 * ta + fr) * RS + 32 * ks + 8 * fq); const bf16x8 bq = *(const bf16x8*)(Bb + (16 * tb + fr) * RS + 32 * ks + 8 * fq); acc = MFMA_BF(a, bq, acc); }
            const int rloc = 4 * fq, cloc = fr;
            if (jb < 2) {
#pragma unroll
                for (int e = 0; e < 4; ++e) acc[e] = (cloc < rloc + e) ? acc[e] : 0.f;
                *(f32x4*)(sAabT + jb * 16 * FS + cloc * FS + rloc) = acc;
                asm volatile("s_waitcnt lgkmcnt(0)" ::: "memory");
                if (lane < 16) {
                    const int col = lane;
                    const float* At_ = sAabT + jb * 16 * FS;
                    float x[16];
#pragma unroll
                    for (int s2 = 0; s2 < 16; ++s2) x[s2] = (s2 == col) ? 1.f : 0.f;
#define RW_INV_BATCH(J0, J1) do { f32x4 cv_[(J1) - (J0)][4]; \
                    _Pragma("unroll") for (int j = (J0); j < (J1); ++j) _Pragma("unroll") for (int q4 = (j + 1) / 4; q4 < 4; ++q4) cv_[j - (J0)][q4] = *(const f32x4*)(At_ + j * FS + 4 * q4); \
                    __builtin_amdgcn_sched_barrier(0); \
                    _Pragma("unroll") for (int j = (J0); j < (J1); ++j) { const float xj = x[j]; \
                        _Pragma("unroll") for (int q4 = (j + 1) / 4; q4 < 4; ++q4) _Pragma("unroll") for (int e = 0; e < 4; ++e) if (4 * q4 + e > j) x[4 * q4 + e] += cv_[j - (J0)][q4][e] * xj; } \
                    __builtin_amdgcn_sched_barrier(0); } while (0)
                    RW_INV_BATCH(0, 3); RW_INV_BATCH(3, 7); RW_INV_BATCH(7, 15);
#pragma unroll
                    for (int s2 = 0; s2 < 16; ++s2) sT[(16 * jb + s2) * PSt + 8 * (col >> 2) + (col & 3)] = f2bf(x[s2]);
                }
            } else if (jb == 2) {
                *(u32x2*)(sAabB + cloc * PSt + 8 * fq) = pk4(acc);
            } else {
                const int prod = (jb - 3) / 3; const int jrow = 16 * ta + rloc, scol = 16 * tb + cloc;
                if (prod == 0) {
#pragma unroll
                    for (int e = 0; e < 4; ++e) acc[e] = (jrow + e < scol) ? acc[e] : 0.f;
                } else {
#pragma unroll
                    for (int e = 0; e < 4; ++e) acc[e] = (jrow + e <= scol) ? acc[e] : 0.f;
                }
                *(u32x2*)(((prod == 0) ? sAak : (prod == 1) ? sMrb : sMrk) + scol * PSt + 8 * fq + 4 * ta) = pk4(acc);
            }
        }
            RW_SCAN_LOCAL(cumN, n_lw);
        }
        __syncthreads();
        if (more) { RW_SCAN_FINISH(cumN, totN); cumC = cumN; totC = totN; }
    }
    __syncthreads();
}

constexpr int SCW = 8224;
__device__ __forceinline__ void dsa_item(const Params& p, int b, int g, unsigned char* lds) {
    int tid_ = threadIdx.x; asm volatile("" : "+v"(tid_));
    const int tid = tid_, lane = tid & 63, wave = __builtin_amdgcn_readfirstlane(tid >> 6);
    const f16* PB = (const f16*)(p.ws + WS_PB); const f16* CKV = (const f16*)(p.ws + WS_CKV); const f16* KIDX = (const f16*)(p.ws + WS_KIDX); const float* WIS = (const float*)(p.ws + WS_WIS);
    f16* OLAT = (f16*)(p.ws + WS_OLAT);
    float* sc = (float*)lds;
    unsigned* hist = (unsigned*)(lds + 4 * SCW * 4);
    unsigned short* sel = (unsigned short*)(lds + 4 * SCW * 4 + 4096);
    unsigned* misc = (unsigned*)(lds + 4 * SCW * 4 + 4096 + 2048);
    f16* sq = (f16*)(lds + 4 * SCW * 4 + 4096 + 2048 + 512);
    const int i0 = 4 * g, n_adm = 80 + 64 * (i0 >> 6), ntile = (n_adm + 31) >> 5;
    const int mq0 = b * SEQ + i0;
    {
        const int rho = lane & 31, hh = lane >> 5;
        const int q = 2 * ((rho >> 2) & 1) + (rho >> 4), hd = 4 * ((rho >> 3) & 1) + (rho & 3);
        const f16* qip = PB + (size_t)(mq0 + q) * N1 + C_QI + hd * 64 + 8 * hh;
        f16x8 af[4];
#pragma unroll
        for (int ks = 0; ks < 4; ++ks) af[ks] = *(const f16x8*)(qip + 16 * ks);
        float wsc[16];
#pragma unroll
        for (int j = 0; j < 16; ++j) wsc[j] = WIS[(size_t)(mq0 + 2 * hh + (j >> 3)) * 8 + (j & 7)];
        float mn0 = INFINITY, mx0 = -INFINITY, mn1 = INFINITY, mx1 = -INFINITY;
        f16x8 bn[2][4];
#pragma unroll
        for (int u = 0; u < 2; ++u) { const f16* kp = KIDX + (size_t)b * KIDX_B + (size_t)(wave + 8 * u) * 2048 + hh * 256 + (lane & 31) * 8;
#pragma unroll
          for (int ks = 0; ks < 4; ++ks) bn[u][ks] = *(const f16x8*)(kp + 512 * ks); }
        for (int kt = wave; kt < ntile; kt += 16) {
            f16x8 bf[2][4];
#pragma unroll
            for (int u = 0; u < 2; ++u)
#pragma unroll
                for (int ks = 0; ks < 4; ++ks) bf[u][ks] = bn[u][ks];
#pragma unroll
            for (int u = 0; u < 2; ++u) { int kn = kt + 16 + 8 * u; kn = (kn < ntile) ? kn : kt;
                const f16* kp = KIDX + (size_t)b * KIDX_B + (size_t)kn * 2048 + hh * 256 + (lane & 31) * 8;
#pragma unroll
                for (int ks = 0; ks < 4; ++ks) bn[u][ks] = *(const f16x8*)(kp + 512 * ks); }
            f32x16 acc0, acc1;
#pragma unroll
            for (int j = 0; j < 16; ++j) { acc0[j] = 0.f; acc1[j] = 0.f; }
#pragma unroll
            for (int ks = 0; ks < 4; ++ks) { acc0 = __builtin_amdgcn_mfma_f32_32x32x16_f16(af[ks], bf[0][ks], acc0, 0, 0, 0); acc1 = __builtin_amdgcn_mfma_f32_32x32x16_f16(af[ks], bf[1][ks], acc1, 0, 0, 0); }
            float sa0 = 0.f, sb0 = 0.f, sa1 = 0.f, sb1 = 0.f;
#pragma unroll
            for (int jj = 0; jj < 8; ++jj) { sa0 += wsc[jj] * fmaxf(acc0[jj], 0.f); sb0 += wsc[8 + jj] * fmaxf(acc0[8 + jj], 0.f); sa1 += wsc[jj] * fmaxf(acc1[jj], 0.f); sb1 += wsc[8 + jj] * fmaxf(acc1[8 + jj], 0.f); }
            const int key0 = kt * 32 + (lane & 31), key1 = key0 + 256;
            sc[(2 * hh) * SCW + key0] = sa0; sc[(2 * hh + 1) * SCW + key0] = sb0;
            if (key0 < n_adm) { mn0 = fminf(mn0, sa0); mx0 = fmaxf(mx0, sa0); mn1 = fminf(mn1, sb0); mx1 = fmaxf(mx1, sb0); }
            if (kt + 8 < ntile) { sc[(2 * hh) * SCW + key1] = sa1; sc[(2 * hh + 1) * SCW + key1] = sb1;
                if (key1 < n_adm) { mn0 = fminf(mn0, sa1); mx0 = fmaxf(mx0, sa1); mn1 = fminf(mn1, sb1); mx1 = fmaxf(mx1, sb1); } }
        }
#pragma unroll
        for (int o = 1; o < 32; o <<= 1) { mn0 = fminf(mn0, __shfl_xor(mn0, o)); mx0 = fmaxf(mx0, __shfl_xor(mx0, o)); mn1 = fminf(mn1, __shfl_xor(mn1, o)); mx1 = fmaxf(mx1, __shfl_xor(mx1, o)); }
        float* mm = (float*)(misc + 64);
        if ((lane & 31) == 0) { mm[((2 * hh) * 8 + wave) * 2] = mn0; mm[((2 * hh) * 8 + wave) * 2 + 1] = mx0; mm[((2 * hh + 1) * 8 + wave) * 2] = mn1; mm[((2 * hh + 1) * 8 + wave) * 2 + 1] = mx1; }
        *(f16x8*)(sq + tid * 8) = *(const f16x8*)(PB + (size_t)(mq0 + (tid >> 7)) * N1 + C_QABS + (tid & 127) * 8);
    }
    const int qs = tid >> 7, tl = tid & 127;
    if (n_adm > 256) { hist[qs * 256 + tl] = 0u; hist[qs * 256 + 128 + tl] = 0u; if (tl < 4) misc[qs * 8 + 2 + tl] = 0u; }
    __syncthreads();
    int nsel;
    {
        const float* scq = sc + qs * SCW;
        if (n_adm <= 256) { for (int idx = tl; idx < n_adm; idx += 128) sel[qs * 256 + idx] = (unsigned short)idx; nsel = n_adm; }
        else {
            constexpr int NK = 65;
            const float* mm = (const float*)(misc + 64);
            float lo = INFINITY, hi = -INFINITY;
#pragma unroll
            for (int w = 0; w < 8; ++w) { lo = fminf(lo, mm[(qs * 8 + w) * 2]); hi = fmaxf(hi, mm[(qs * 8 + w) * 2 + 1]); }
            const float scale = (hi > lo) ? 16777215.f / (hi - lo) : 0.f;
            unsigned kreg[NK];
#pragma unroll
            for (int i = 0; i < NK; ++i) { const int idx = tl + 128 * i; const float v = (idx < n_adm) ? scq[idx] : lo; unsigned k = (unsigned)((v - lo) * scale); k = k > 0xFFFFFFu ? 0xFFFFFFu : k; kreg[i] = k;
                if (idx < n_adm) atomicAdd(&hist[qs * 256 + (k >> 16)], 1u); }
            __syncthreads();
            if (tl < 64) {
                const int c0 = (int)hist[qs * 256 + 4 * tl], c1 = (int)hist[qs * 256 + 4 * tl + 1], c2 = (int)hist[qs * 256 + 4 * tl + 2], c3 = (int)hist[qs * 256 + 4 * tl + 3];
                const int tot = c0 + c1 + c2 + c3; int sfx = tot;
#pragma unroll
                for (int off = 1; off < 64; off <<= 1) { const int tv = __shfl_down(sfx, off); if (tl + off < 64) sfx += tv; }
                const int above = sfx - tot;
                if (above < 256 && 256 <= sfx) { const int rem = 256 - above; int bin, nk;
                    if (rem <= c3) { bin = 4 * tl + 3; nk = rem; } else if (rem <= c3 + c2) { bin = 4 * tl + 2; nk = rem - c3; }
                    else if (rem <= c3 + c2 + c1) { bin = 4 * tl + 1; nk = rem - c3 - c2; } else { bin = 4 * tl; nk = rem - c3 - c2 - c1; }
                    misc[qs * 8] = (unsigned)bin; misc[qs * 8 + 1] = (unsigned)nk; }
            }
            __syncthreads();
            const unsigned bin = misc[qs * 8]; const int need = (int)misc[qs * 8 + 1];
            unsigned* cand = (unsigned*)(sc + qs * SCW) + 0;
            const int lane_ = tid & 63;
            __syncthreads();
#pragma unroll
            for (int i = 0; i < NK; ++i) { const int idx = tl + 128 * i; const unsigned u = kreg[i]; const bool ok = idx < n_adm; const unsigned tb = u >> 16;
                if (ok && tb > bin) { const unsigned long long m = __ballot(1); const int leader = __ffsll((long long)m) - 1; unsigned base = 0u;
                    if (lane_ == leader) base = atomicAdd(&misc[qs * 8 + 2], (unsigned)__popcll(m));
                    base = __shfl(base, leader);
                    sel[qs * 256 + base + __popcll(m & ((1ull << lane_) - 1ull))] = (unsigned short)idx; }
                else if (ok && tb == bin) { const unsigned e = atomicAdd(&misc[qs * 8 + 3], 1u); if (e < 4096u) { cand[2 * e] = u; cand[2 * e + 1] = (unsigned)idx; } } }
            __syncthreads();
            { const int m = min((int)misc[qs * 8 + 3], 4096); const int base = (int)misc[qs * 8 + 2];
              for (int i = tl; i < m; i += 128) { const unsigned ku = cand[2 * i]; const unsigned ki = cand[2 * i + 1]; int rank = 0;
                  for (int j = 0; j < m; ++j) { const unsigned kj = cand[2 * j]; const unsigned ij = cand[2 * j + 1]; rank += (kj > ku || (kj == ku && ij < ki)) ? 1 : 0; }
                  if (rank < need) sel[qs * 256 + base + rank] = (unsigned short)ki; } }
            nsel = 256;
        }
    }
    __syncthreads();
    {
        int lane_ = lane; asm volatile("" : "+v"(lane_));
        const int fr = lane_ & 15, fq = lane_ >> 4, aq = wave >> 1, rh = wave & 1;
        const unsigned short* selq = sel + aq * 256;
        unsigned char* cq = lds + aq * 32768;
        f16x8 qf[4];
#pragma unroll
        for (int ks = 0; ks < 4; ++ks) { qf[ks] = *(const f16x8*)(sq + (aq * 8 + (fr & 7)) * 128 + 32 * ks + 8 * fq); if (fr >= 8) qf[ks] = (f16x8){(f16)0.f, (f16)0.f, (f16)0.f, (f16)0.f, (f16)0.f, (f16)0.f, (f16)0.f, (f16)0.f}; }
        f16x8 I0, I1;
#pragma unroll
        for (int j = 0; j < 8; ++j) { I0[j] = (8 * fq + j == fr) ? (f16)1.f : (f16)0.f; I1[j] = (8 * fq + j == 16 + fr) ? (f16)1.f : (f16)0.f; }
        f32x4 O[4];
#pragma unroll
        for (int j = 0; j < 4; ++j) O[j] = (f32x4){0.f, 0.f, 0.f, 0.f};
        float m_run = -1e30f, l_run = 0.f;
        for (int kb = 0; kb < 2; ++kb) {
            {
                f16x8 g[16];
#pragma unroll
                for (int i = 0; i < 16; ++i) { const int rl = 64 * rh + 4 * i + fq; const int kk = 128 * kb + rl; const int kidx = (kk < nsel) ? (int)selq[kk] : 0;
                    g[i] = *(const f16x8*)(CKV + (size_t)row_of(b, kidx) * 128 + fr * 8); }
                __builtin_amdgcn_sched_barrier(0);
#pragma unroll
                for (int i = 0; i < 16; ++i) { const int rl = 64 * rh + 4 * i + fq; *(f16x8*)(cq + rl * 256 + ((fr ^ (rl & 15)) << 4)) = g[i]; }
            }
            __syncthreads();
            f32x4 S[8];
#pragma unroll
            for (int kt = 0; kt < 8; ++kt) { const int rl = 16 * kt + fr; f16x8 a[4];
#pragma unroll
                for (int ks = 0; ks < 4; ++ks) a[ks] = *(const f16x8*)(cq + rl * 256 + (((4 * ks + fq) ^ fr) << 4));
                f32x4 acc = {0.f, 0.f, 0.f, 0.f};
#pragma unroll
                for (int ks = 0; ks < 4; ++ks) acc = __builtin_amdgcn_mfma_f32_16x16x32_f16(a[ks], qf[ks], acc, 0, 0, 0);
                S[kt] = acc; }
            float mx = -1e30f;
#pragma unroll
            for (int kt = 0; kt < 8; ++kt)
#pragma unroll
                for (int e = 0; e < 4; ++e) { const float v = (128 * kb + 16 * kt + 4 * fq + e < nsel) ? S[kt][e] * 0.125f : -1e30f; S[kt][e] = v; mx = fmaxf(mx, v); }
            mx = fmaxf(mx, __shfl_xor(mx, 16)); mx = fmaxf(mx, __shfl_xor(mx, 32));
            const float m_new = fmaxf(m_run, mx);
            const float alpha = __expf(m_run - m_new);
            float sum = 0.f;
#pragma unroll
            for (int kt = 0; kt < 8; ++kt)
#pragma unroll
                for (int e = 0; e < 4; ++e) { const float pv = (S[kt][e] > -1e29f) ? __expf(S[kt][e] - m_new) : 0.f; S[kt][e] = pv; sum += pv; }
            sum += __shfl_xor(sum, 16); sum += __shfl_xor(sum, 32);
            l_run = l_run * alpha + sum; m_run = m_new;
#pragma unroll
            for (int e = 0; e < 4; ++e) { const float al = __shfl(alpha, 4 * fq + e);
#pragma unroll
                for (int j = 0; j < 4; ++j) O[j][e] *= al; }
            f16x8 Pf[4];
#pragma unroll
            for (int i = 0; i < 4; ++i)
#pragma unroll
                for (int e = 0; e < 4; ++e) { Pf[i][e] = (f16)S[2 * i][e]; Pf[i][4 + e] = (f16)S[2 * i + 1][e]; }
#pragma unroll
            for (int i = 0; i < 4; ++i) {
                const int ra = 32 * i + fr, rb = ra + 16;
                f16x8 xa[2], xb[2];
#pragma unroll
                for (int u = 0; u < 2; ++u) { xa[u] = *(const f16x8*)(cq + ra * 256 + (((4 * (2 * rh + u) + fq) ^ fr) << 4)); xb[u] = *(const f16x8*)(cq + rb * 256 + (((4 * (2 * rh + u) + fq) ^ fr) << 4)); }
#pragma unroll
                for (int j = 0; j < 4; ++j) {
                    const f32x4 z = {0.f, 0.f, 0.f, 0.f};
                    const f32x4 da = __builtin_amdgcn_mfma_f32_16x16x32_f16(xa[j >> 1], (j & 1) ? I1 : I0, z, 0, 0, 0);
                    const f32x4 db = __builtin_amdgcn_mfma_f32_16x16x32_f16(xb[j >> 1], (j & 1) ? I1 : I0, z, 0, 0, 0);
                    f16x8 bfr;
#pragma unroll
                    for (int e = 0; e < 4; ++e) { bfr[e] = (f16)da[e]; bfr[4 + e] = (f16)db[e]; }
                    O[j] = __builtin_amdgcn_mfma_f32_16x16x32_f16(Pf[i], bfr, O[j], 0, 0, 0);
                }
            }
            __syncthreads();
        }
        const float inv = 1.f / l_run;
        if (fq < 2) {
#pragma unroll
            for (int e = 0; e < 4; ++e) { const float il = __shfl(inv, 4 * fq + e);
#pragma unroll
                for (int j = 0; j < 4; ++j) OLAT[(size_t)(mq0 + aq) * 1024 + (4 * fq + e) * 128 + 64 * rh + 16 * j + fr] = (f16)(O[j][e] * il); }
        }
    }
    __syncthreads();
}

__device__ __forceinline__ void phc2_mixers(const Params& p, unsigned char* lds, int rep) {
    unsigned* ctr = (unsigned*)(p.ws + WS_CTL) + 64 + 64 * rep;
    int* s_item = (int*)(lds + 150 * 1024 - 16);
    constexpr int NRW = 16, NDSA = 2 * (SEQ / 4), NFILL = 512;
    for (;;) {
        if (threadIdx.x == 0) *s_item = (int)atomicAdd(ctr, 1u);
        __syncthreads();
        const int item = *s_item;
        __syncthreads();
        if (item >= NRW + NDSA + NFILL) break;
        if (item >= NRW + NDSA) { ph0_prep<true>(p, lds, item - (NRW + NDSA), NFILL); __syncthreads(); continue; }
        if (item < NRW) rwkv_item(p, item >> 3, item & 7, lds);
        else { const int d = item - NRW; dsa_item(p, d & 1, (SEQ / 4 - 1) - (d >> 1), lds); }
    }
}

__device__ __forceinline__ void phd3_ln1(const Params& p) {
    const int tid = threadIdx.x, lane = tid & 63, wave = tid >> 6;
    const int gw = blockIdx.x * 8 + wave, NGW = gridDim.x * 8;
    f16* H1H = (f16*)(p.ws + WS_H1H);
    for (int m = gw; m < MREAL; m += NGW) {
        float* row = p.out + (size_t)m * D;
        f32x4 v[4]; float s = 0.f;
#pragma unroll
        for (int j = 0; j < 4; ++j) { v[j] = *(const f32x4*)(row + j * 256 + lane * 4); s += (v[j].x + v[j].y) + (v[j].z + v[j].w); }
        const float mean = wave_sum(s) * (1.f / D); float s2 = 0.f;
#pragma unroll
        for (int j = 0; j < 4; ++j) { v[j] = v[j] - mean; s2 += (v[j].x * v[j].x + v[j].y * v[j].y) + (v[j].z * v[j].z + v[j].w * v[j].w); }
        const float rstd = 1.f / sqrtf(wave_sum(s2) * (1.f / D) + LN_EPS);
#pragma unroll
        for (int j = 0; j < 4; ++j) { const f32x4 g = *(const f32x4*)(p.ln1_g + j * 256 + lane * 4), bb = *(const f32x4*)(p.ln1_b + j * 256 + lane * 4);
            const f32x4 o = v[j] * rstd * g + bb; *(f32x4*)(row + j * 256 + lane * 4) = o; *(f16x4*)(H1H + (size_t)m * D + j * 256 + lane * 4) = to_h4(o); }
    }
}

#define INS16(L, x_) do { unsigned x__ = (x_); _Pragma("unroll") for (int j_ = 0; j_ < 16; ++j_) { const unsigned hi_ = max(L[j_], x__); x__ = min(L[j_], x__); L[j_] = hi_; } } while (0)
__device__ __forceinline__ void top16_of_128(const unsigned short* src, unsigned (&L)[16]) {
#pragma unroll
    for (int j = 0; j < 16; ++j) L[j] = 0u;
#pragma unroll 1
    for (int hb = 0; hb < 2; ++hb) {
        u32x4 w[8];
#pragma unroll
        for (int c = 0; c < 8; ++c) w[c] = *(const u32x4*)(src + hb * 64 + c * 8);
        __builtin_amdgcn_sched_barrier(0);
#pragma unroll
        for (int c = 0; c < 8; ++c)
#pragma unroll
            for (int e = 0; e < 8; ++e) {
                const unsigned sc16 = (w[c][e >> 1] >> (16 * (e & 1))) & 0xFFFFu;
                const unsigned key = (sc16 << 16) | (unsigned)(127 - (hb * 64 + c * 8 + e));
                INS16(L, key);
            }
    }
}
__device__ __forceinline__ void phd5_topk(const Params& p) {
    const unsigned short* SC = (const unsigned short*)(p.ws + WS_SC);
    unsigned short* EIDX = (unsigned short*)(p.ws + WS_EIDX); float* EGATE = (float*)(p.ws + WS_EGATE);
    const long gt = (long)blockIdx.x * NT + threadIdx.x, NGT = (long)gridDim.x * NT;
    for (long e = gt; e < (long)MREAL * 8; e += NGT) {
        const int m = (int)(e >> 3), h = (int)(e & 7);
        unsigned A[16], B[16];
        top16_of_128(SC + (size_t)m * 2048 + h * 256, A);
        top16_of_128(SC + (size_t)m * 2048 + h * 256 + 128, B);
        unsigned T[16];
#pragma unroll
        for (int j = 0; j < 16; ++j) T[j] = 0u;
#pragma unroll
        for (int i = 0; i < 16; ++i)
#pragma unroll
            for (int j = 0; j < 16; ++j)
                if ((i + 1) * (j + 1) <= 16) {
                    const unsigned sum = (A[i] >> 16) + (B[j] >> 16);
                    const unsigned eid = (127u - (A[i] & 0xFFFFu)) * 128u + (127u - (B[j] & 0xFFFFu));
                    INS16(T, (sum << 14) | eid);
                }
        float sumf = 0.f; float ex[16];
        const int s0 = (int)(T[0] >> 14);
#pragma unroll
        for (int j = 0; j < 16; ++j) { ex[j] = __expf((float)((int)(T[j] >> 14) - s0) * (1.f / 8192.f)); sumf += ex[j]; }
        const float inv = 1.f / sumf;
#pragma unroll
        for (int j = 0; j < 16; ++j) { EIDX[(size_t)m * 128 + h * 16 + j] = (unsigned short)(T[j] & 0x3FFFu); EGATE[(size_t)m * 128 + h * 16 + j] = ex[j] * inv; }
    }
}

__device__ __forceinline__ void dec16(const u32x4 w, float (&o)[16]) {
#pragma unroll
    for (int q = 0; q < 4; ++q) { const f32x2 lo = __builtin_amdgcn_cvt_pk_f32_fp8((int)w[q], false), hi = __builtin_amdgcn_cvt_pk_f32_fp8((int)w[q], true); o[4 * q] = lo.x; o[4 * q + 1] = lo.y; o[4 * q + 2] = hi.x; o[4 * q + 3] = hi.y; }
}
__device__ __forceinline__ float wave_sum_u(float v) {
    v = row16_sum(v);
    const float a = __builtin_bit_cast(float, __builtin_amdgcn_readlane(__builtin_bit_cast(int, v), 0)), b = __builtin_bit_cast(float, __builtin_amdgcn_readlane(__builtin_bit_cast(int, v), 16));
    const float c = __builtin_bit_cast(float, __builtin_amdgcn_readlane(__builtin_bit_cast(int, v), 32)), d = __builtin_bit_cast(float, __builtin_amdgcn_readlane(__builtin_bit_cast(int, v), 48));
    return (a + b) + (c + d);
}
__device__ __forceinline__ void phd6_gather(const Params& p) {
    const int tid = threadIdx.x, lane = tid & 63, wave = tid >> 6;
    const int gw = blockIdx.x * 8 + wave, NGW = gridDim.x * 8;
    const unsigned char* U8 = p.ws + WS_U8; const unsigned char* V8A = p.ws + WS_V8A; const unsigned char* V8B = p.ws + WS_V8B - (size_t)V8A_ROWS * D;
    const unsigned short* EIDX = (const unsigned short*)(p.ws + WS_EIDX); const float* EGATE = (const float*)(p.ws + WS_EGATE);
    for (int m = gw; m < MREAL; m += NGW) {
        float* row = p.out + (size_t)m * D + 16 * lane;
        float hv[16];
#pragma unroll
        for (int q = 0; q < 4; ++q) { const f32x4 t4 = *(const f32x4*)(row + 4 * q); hv[4 * q] = t4.x; hv[4 * q + 1] = t4.y; hv[4 * q + 2] = t4.z; hv[4 * q + 3] = t4.w; }
        const int e_lo = (int)EIDX[(size_t)m * 128 + lane], e_hi = (int)EIDX[(size_t)m * 128 + 64 + lane];
        const float g_lo = EGATE[(size_t)m * 128 + lane], g_hi = EGATE[(size_t)m * 128 + 64 + lane];
        float hd_lo = 0.f, hd_hi = 0.f;
#define G_LOAD(buf, g_, TAB) do { _Pragma("unroll") for (int i_ = 0; i_ < 8; ++i_) { const int e_ = 8 * (g_) + i_; \
            const int id_ = (e_ < 64) ? __builtin_amdgcn_readlane(e_lo, e_ & 63) : __builtin_amdgcn_readlane(e_hi, e_ & 63); \
            buf[i_] = *(const u32x4*)(((TAB) ? ((id_ < V8A_ROWS) ? V8A : V8B) : U8) + (size_t)id_ * D + 16 * lane); } } while (0)
#define U_PROC(buf, g_) do { _Pragma("unroll") for (int i_ = 0; i_ < 8; ++i_) { const int e_ = 8 * (g_) + i_; float uf[16]; dec16(buf[i_], uf); float s_ = 0.f; \
            _Pragma("unroll") for (int j_ = 0; j_ < 16; ++j_) s_ += hv[j_] * uf[j_]; s_ = wave_sum_u(s_); \
            if (e_ < 64) { if (lane == (e_ & 63)) hd_lo = s_; } else { if (lane == (e_ & 63)) hd_hi = s_; } } } while (0)
        {
            u32x4 b0[8], b1[8];
            G_LOAD(b0, 0, 0);
            for (int g2 = 0; g2 < 16; g2 += 2) {
                G_LOAD(b1, g2 + 1, 0); __builtin_amdgcn_sched_barrier(0);
                U_PROC(b0, g2); __builtin_amdgcn_sched_barrier(0);
                if (g2 + 2 < 16) { G_LOAD(b0, g2 + 2, 0); } __builtin_amdgcn_sched_barrier(0);
                U_PROC(b1, g2 + 1); __builtin_amdgcn_sched_barrier(0);
            }
        }
        hd_lo *= (1.f / 256.f); hd_hi *= (1.f / 256.f);
        const float c_lo = g_lo * 0.5f * hd_lo * (1.f + erff(hd_lo * 0.70710678118654752f)) * (1.f / 16.f);
        const float c_hi = g_hi * 0.5f * hd_hi * (1.f + erff(hd_hi * 0.70710678118654752f)) * (1.f / 16.f);
        float acc[16];
#pragma unroll
        for (int j = 0; j < 16; ++j) acc[j] = 0.f;
#define V_PROC(buf, g_) do { _Pragma("unroll") for (int i_ = 0; i_ < 8; ++i_) { const int e_ = 8 * (g_) + i_; float vf[16]; dec16(buf[i_], vf); \
            const float cf_ = (e_ < 64) ? __builtin_bit_cast(float, __builtin_amdgcn_readlane(__builtin_bit_cast(int, c_lo), e_ & 63)) : __builtin_bit_cast(float, __builtin_amdgcn_readlane(__builtin_bit_cast(int, c_hi), e_ & 63)); \
            _Pragma("unroll") for (int j_ = 0; j_ < 16; ++j_) acc[j_] += cf_ * vf[j_]; } } while (0)
        {
            u32x4 b0[8], b1[8];
            G_LOAD(b0, 0, 1);
            for (int g2 = 0; g2 < 16; g2 += 2) {
                G_LOAD(b1, g2 + 1, 1); __builtin_amdgcn_sched_barrier(0);
                V_PROC(b0, g2); __builtin_amdgcn_sched_barrier(0);
                if (g2 + 2 < 16) { G_LOAD(b0, g2 + 2, 1); } __builtin_amdgcn_sched_barrier(0);
                V_PROC(b1, g2 + 1); __builtin_amdgcn_sched_barrier(0);
            }
        }
        float sm = 0.f;
#pragma unroll
        for (int j = 0; j < 16; ++j) { acc[j] += ALPHA * hv[j]; sm += acc[j]; }
        const float mean = wave_sum_u(sm) * (1.f / D); float s2 = 0.f;
#pragma unroll
        for (int j = 0; j < 16; ++j) { acc[j] -= mean; s2 += acc[j] * acc[j]; }
        const float rstd = __builtin_amdgcn_rsqf(wave_sum_u(s2) * (1.f / D) + LN_EPS);
#pragma unroll
        for (int q = 0; q < 4; ++q) { const int col = 16 * lane + 4 * q; const f32x4 g = *(const f32x4*)(p.ln2_g + col), bb = *(const f32x4*)(p.ln2_b + col);
            f32x4 o; o.x = acc[4 * q] * rstd * g.x + bb.x; o.y = acc[4 * q + 1] * rstd * g.y + bb.y; o.z = acc[4 * q + 2] * rstd * g.z + bb.z; o.w = acc[4 * q + 3] * rstd * g.w + bb.w;
            *(f32x4*)(row + 4 * q) = o; }
    }
}

struct EpiLora {
    f16 *LW, *AA, *GG; const float *w0, *a0;
    __device__ __forceinline__ void operator()(const f32x4 (&acc)[2][2][4][2], const pg8::Unit& u, int wr, int wc, int fr, int fq) const {
        const int row0 = u.pm * 256 + wr * 64 + fr, col0 = (u.pn & 1) * 256 + wc * 32 + 4 * fq;
        if (u.pn < 2) {
#pragma unroll
            for (int bj = 0; bj < 2; ++bj)
#pragma unroll
                for (int n = 0; n < 2; ++n) { const int col = col0 + bj * 128 + n * 16; const f32x4 c = *(const f32x4*)(w0 + col);
#pragma unroll
                    for (int ai = 0; ai < 2; ++ai)
#pragma unroll
                        for (int m = 0; m < 4; ++m) { const f32x4 v = acc[ai][bj][m][n]; f16x4 o;
#pragma unroll
                            for (int e = 0; e < 4; ++e) { const float wl = -softplusf_(-(c[e] + v[e])) - 0.5f; o[e] = (f16)(-__expf(wl)); }
                            *(f16x4*)(LW + (size_t)(row0 + ai * 128 + m * 16) * 512 + col) = o; } }
        } else if (u.pn < 4) {
#pragma unroll
            for (int bj = 0; bj < 2; ++bj)
#pragma unroll
                for (int n = 0; n < 2; ++n) { const int col = col0 + bj * 128 + n * 16; const f32x4 c = *(const f32x4*)(a0 + col);
#pragma unroll
                    for (int ai = 0; ai < 2; ++ai)
#pragma unroll
                        for (int m = 0; m < 4; ++m) { const f32x4 v = acc[ai][bj][m][n]; f16x4 o;
#pragma unroll
                            for (int e = 0; e < 4; ++e) o[e] = (f16)sigmoidf_(c[e] + v[e]);
                            *(f16x4*)(AA + (size_t)(row0 + ai * 128 + m * 16) * 512 + col) = o; } }
        } else {
#pragma unroll
            for (int bj = 0; bj < 2; ++bj)
#pragma unroll
                for (int n = 0; n < 2; ++n) { const int col = col0 + bj * 128 + n * 16;
#pragma unroll
                    for (int ai = 0; ai < 2; ++ai)
#pragma unroll
                        for (int m = 0; m < 4; ++m) *(f16x4*)(GG + (size_t)(row0 + ai * 128 + m * 16) * 512 + col) = to_h4(acc[ai][bj][m][n]); }
        }
    }
};

#define XB_TMO      128
#define XB_XCNT(j)  (256  + 64 * (j))
#define XB_XSUB(j)  (1280 + 64 * (j))
#define XB_XGEN(j)  (2304 + 64 * (j))
#define XB_TOP      3328
#define XB_TOPGEN   3392
#define XCD_BAR_WORDS 3456
#define XB_SPIN_CAP (1u << 20)
__device__ __forceinline__ unsigned xb_ld(unsigned* p)              { return __hip_atomic_load(p, __ATOMIC_RELAXED, __HIP_MEMORY_SCOPE_AGENT); }
__device__ __forceinline__ unsigned xb_add(unsigned* p, unsigned v) { return __hip_atomic_fetch_add(p, v, __ATOMIC_RELAXED, __HIP_MEMORY_SCOPE_AGENT); }
__device__ __forceinline__ unsigned xb_xcc_id() { return (unsigned)__builtin_amdgcn_s_getreg((3 << 11) | 20) & 0xFu; }
#define XB_SPIN(cond, bar) do { unsigned _sp = 0; while (cond) { __builtin_amdgcn_s_sleep(1); \
    if ((++_sp & 255u) == 0u) { if (xb_ld(&(bar)[XB_TMO])) break; if (_sp > XB_SPIN_CAP) { atomicAdd(&(bar)[XB_TMO], 1u); break; } } } } while (0)
struct XcdBarrier { unsigned* bar; unsigned x; volatile LAS unsigned* st; };
__device__ __forceinline__ XcdBarrier xcd_barrier_post(unsigned* bar, volatile LAS unsigned* st) {
    XcdBarrier b; b.bar = bar; b.x = xb_xcc_id(); b.st = st;
    if (threadIdx.x == 0) (void)xb_add(&bar[XB_XCNT(b.x)], 1u);
    return b;
}
__device__ __forceinline__ void xcd_barrier_complete(unsigned* bar, unsigned x, unsigned& nloc, unsigned& nx) {
    const unsigned G = gridDim.x * gridDim.y * gridDim.z;
    unsigned sum, cnt, mine, sp = 0u;
    for (;;) {
        sum = 0u; cnt = 0u; mine = 0u;
#pragma unroll
        for (unsigned j = 0; j < 16; ++j) { const unsigned c = xb_ld(&bar[XB_XCNT(j)]); sum += c; cnt += (c > 0u) ? 1u : 0u; mine = (j == x) ? c : mine; }
        if (sum == G) break;
        __builtin_amdgcn_s_sleep(1);
        if ((++sp & 255u) == 0u) { if (xb_ld(&bar[XB_TMO])) break; if (sp > XB_SPIN_CAP) { atomicAdd(&bar[XB_TMO], 1u); break; } }
    }
    nloc = mine > 0u ? mine : 1u; nx = cnt > 0u ? cnt : 1u;
}
__device__ __forceinline__ void xcd_barrier(const XcdBarrier& b) {
    asm volatile("s_waitcnt vmcnt(0)" ::: "memory");
    __syncthreads();
    if (threadIdx.x == 0) {
        unsigned* bar = b.bar;
        __builtin_amdgcn_s_waitcnt(0);
        unsigned nloc = b.st[0], nx = b.st[1];
        if (nloc == 0u) { xcd_barrier_complete(bar, b.x, nloc, nx); b.st[0] = nloc; b.st[1] = nx; }
        const unsigned old = xb_add(&bar[XB_XSUB(b.x)], 1u);
        const unsigned gen = old / nloc;
        if (old + 1u == (gen + 1u) * nloc) {
            __builtin_amdgcn_fence(__ATOMIC_RELEASE, "agent");
            asm volatile("s_waitcnt vmcnt(0)" ::: "memory");
            const unsigned og = xb_add(&bar[XB_TOP], 1u);
            const unsigned tg = og / nx;
            if (og + 1u == (tg + 1u) * nx) xb_add(&bar[XB_TOPGEN], 1u);
            else XB_SPIN(xb_ld(&bar[XB_TOPGEN]) == tg, bar);
            __builtin_amdgcn_fence(__ATOMIC_ACQUIRE, "agent");
            xb_add(&bar[XB_XGEN(b.x)], 1u);
            asm volatile("s_waitcnt vmcnt(0)" ::: "memory");
        } else {
            XB_SPIN(xb_ld(&bar[XB_XGEN(b.x)]) == gen, bar);
            __builtin_amdgcn_fence(__ATOMIC_ACQUIRE, "agent");
            asm volatile("s_waitcnt vmcnt(0)" ::: "memory");
        }
    }
    __syncthreads();
}

constexpr int LDS_BYTES = 150 * 1024;
constexpr int REP0 = 1, REP1 = 1, REP4 = 1, REP5 = 1, REP8 = 1, REP9 = 1;
constexpr int NPHASE = 11;
__global__ void __launch_bounds__(NT) mk_fwd(Params p) {
    extern __shared__ __attribute__((aligned(16))) unsigned char lds[];
    cg::grid_group grid = cg::this_grid();
    unsigned char* ws = p.ws;
    const int lo = p.ph_lo, hi = p.ph_hi;
    volatile LAS unsigned* bst = (volatile LAS unsigned*)((LAS unsigned char*)lds + LDS_BYTES - 64);
    if (threadIdx.x < 2) bst[threadIdx.x] = 0u;
    __syncthreads();
    const XcdBarrier xbar = xcd_barrier_post((unsigned*)(ws + WS_CTL) + 4096, bst);
#define IN(k) (lo <= (k) && (k) < hi)
#define SEAM(k) do { if (IN(k) && IN((k) + 1)) { if ((k) == 0) grid.sync(); else xcd_barrier(xbar); } } while (0)
    if (IN(0)) ph0_prep<false>(p, lds, (int)blockIdx.x, (int)gridDim.x);
    SEAM(0);
    if (IN(1)) {
        f16* PB = (f16*)(ws + WS_PB);
        auto f = [=](int row, int col, f32x4 v) { *(f16x4*)(PB + (size_t)row * N1 + col) = to_h4(v); };
        pg8::run_gemm(lds, (const f16*)(ws + WS_H0), (const f16*)(ws + WS_W1T), MR, N1, D, f);
    }
    SEAM(1);
    if (IN(2)) phc1_rowprep(p);
    SEAM(2);
    if (IN(3)) {
        pg8::Gemm g{(const f16*)((unsigned char*)p.out + DO_LORAIN), (const f16*)(ws + WS_WLT), MR, 1536, 256}; pg8::StaticOrder S; S.init(MR, 1536, (int)gridDim.x, (int)blockIdx.x);
        EpiLora E{(f16*)((unsigned char*)p.out + DO_LW), (f16*)((unsigned char*)p.out + DO_AA), (f16*)((unsigned char*)p.out + DO_GG), p.b_w0, p.b_a0};
        pg8::gemm_phase<EpiLora>((PG8_LAS unsigned char*)lds, g, S, E);
        __syncthreads();
    }
    SEAM(3);
    if (IN(4)) for (int rep = 0; rep < REP4; ++rep) { if (rep) grid.sync(); phc2_mixers(p, lds, rep); }
    SEAM(4);
    if (IN(5)) {
        f16* MIX = (f16*)(ws + WS_MIXED); f16* TMP = (f16*)(ws + WS_TMP); const float* bg = p.b_gate;
        auto f1 = [=](int row, int col, f32x4 v) { const f32x4 c = *(const f32x4*)(bg + col); f16x4 o;
#pragma unroll
            for (int e = 0; e < 4; ++e) o[e] = (f16)sigmoidf_(v[e] + c[e]);
            *(f16x4*)(MIX + (size_t)row * D + col) = o; };
        pg8::run_gemm(lds, (const f16*)(ws + WS_H0), (const f16*)(ws + WS_WGT), MREAL, D, D, f1);
        auto f2 = [=](int row, int col, f32x4 v) { f16x4* q = (f16x4*)(MIX + (size_t)row * D + col); const f16x4 gq = *q; f16x4 o;
#pragma unroll
            for (int e = 0; e < 4; ++e) o[e] = (f16)((float)gq[e] * v[e]);
            *q = o; };
        pg8::run_gemm(lds, (const f16*)(ws + WS_OLAT), (const f16*)(ws + WS_WPAT), MREAL, D, D, f2);
        auto f3 = [=](int row, int col, f32x4 v) { const f32x4 c = *(const f32x4*)(bg + 1024 + col); f16x4 o;
#pragma unroll
            for (int e = 0; e < 4; ++e) o[e] = (f16)sigmoidf_(v[e] + c[e]);
            *(f16x4*)(TMP + (size_t)row * D + col) = o; };
        pg8::run_gemm(lds, (const f16*)(ws + WS_H0), (const f16*)(ws + WS_WGT) + (size_t)1024 * D, MREAL, D, D, f3);
        auto f4 = [=](int row, int col, f32x4 v) { f16x4* q = (f16x4*)(MIX + (size_t)row * D + col); const f16x4 m0 = *q; const f16x4 gq = *(const f16x4*)(TMP + (size_t)row * D + col); f16x4 o;
#pragma unroll
            for (int e = 0; e < 4; ++e) o[e] = (f16)((float)m0[e] + (float)gq[e] * v[e]);
            *q = o; };
        pg8::run_gemm(lds, (const f16*)(ws + WS_OB), (const f16*)(ws + WS_WPBT), MREAL, D, 512, f4);
    }
    SEAM(5);
    if (IN(6)) {
        const float* x = p.x; const float* STAT = (const float*)(ws + WS_STAT); const float* lg = p.ln_in_g; const float* lb = p.ln_in_b; float* out = p.out;
        auto f = [=](int row, int col, f32x4 v) { const f32x4 xv = *(const f32x4*)(x + (size_t)row * D + col); const float mean = STAT[2 * row], rstd = STAT[2 * row + 1];
            const f32x4 g = *(const f32x4*)(lg + col), bb = *(const f32x4*)(lb + col);
            *(f32x4*)(out + (size_t)row * D + col) = ((xv - mean) * rstd * g + bb) * ALPHA + v; };
        pg8::run_gemm(lds, (const f16*)(ws + WS_MIXED), (const f16*)(ws + WS_WOT), MREAL, D, D, f);
    }
    SEAM(6);
    if (IN(7)) phd3_ln1(p);
    SEAM(7);
    if (IN(8)) {
        unsigned short* SC = (unsigned short*)(ws + WS_SC);
        auto f = [=](int row, int col, f32x4 v) { u32x2 o; unsigned q[4];
#pragma unroll
            for (int e = 0; e < 4; ++e) q[e] = (unsigned)__float2int_rn(fminf(fmaxf((v[e] + 2.f) * 8192.f, 0.f), 65535.f));
            o.x = q[0] | (q[1] << 16); o.y = q[2] | (q[3] << 16); *(u32x2*)(SC + (size_t)row * 2048 + col) = o; };
        pg8::run_gemm(lds, (const f16*)(ws + WS_H1H), (const f16*)(ws + WS_WSKT), MREAL, 2048, D, f);
    }
    SEAM(8);
    if (IN(9)) phd5_topk(p);
    SEAM(9);
    if (IN(10)) phd6_gather(p);
#undef IN
#undef SEAM
}

extern "C" void kernel_launch(void* const* d_in, const int* in_sizes, int n_in, void* d_out, int out_size, void* d_ws, size_t ws_size, hipStream_t stream) {
    static int grid = 0;
    if (grid == 0) {
        int dev = 0, cus = 0, per_cu = 0;
        if (hipGetDevice(&dev) != hipSuccess || hipDeviceGetAttribute(&cus, hipDeviceAttributeMultiprocessorCount, dev) != hipSuccess) { fprintf(stderr, "kernel_launch: device query failed\n"); grid = -1; return; }
        if (hipFuncSetAttribute((const void*)mk_fwd, hipFuncAttributeMaxDynamicSharedMemorySize, LDS_BYTES) != hipSuccess) { fprintf(stderr, "kernel_launch: hipFuncSetAttribute failed\n"); grid = -1; return; }
        if (hipOccupancyMaxActiveBlocksPerMultiprocessor(&per_cu, (const void*)mk_fwd, NT, LDS_BYTES) != hipSuccess || per_cu < 1) { fprintf(stderr, "kernel_launch: occupancy query says %d\n", per_cu); grid = -1; return; }
        if (n_in != 33 || out_size != MREAL * D || ws_size < WS_END) { fprintf(stderr, "kernel_launch: unexpected shapes n_in %d out %d ws %zu\n", n_in, out_size, ws_size); grid = -1; return; }
        grid = cus;
    }
    if (grid < 0) return;
    (void)hipMemsetAsync((char*)d_ws + WS_CTL, 0, 1 * MiB, stream);
    Params p{};
    const float** pf = (const float**)&p;
    for (int i = 0; i < 33; ++i) pf[i] = (const float*)d_in[i];
    p.out = (float*)d_out; p.ws = (unsigned char*)d_ws; p.ph_lo = 0; p.ph_hi = NPHASE;
    void* args[] = {&p};
    hipError_t e = hipLaunchCooperativeKernel((void*)mk_fwd, dim3(grid), dim3(NT), args, LDS_BYTES, stream);
    if (e != hipSuccess) fprintf(stderr, "kernel_launch: cooperative launch failed: %s (grid %d)\n", hipGetErrorString(e), grid);
}
```

```cpp
#include <hip/hip_runtime.h>
#include <hip/hip_cooperative_groups.h>
#include <cstdio>
#include <cstdint>
namespace cg = cooperative_groups;

#define LAS __attribute__((address_space(3)))
typedef _Float16 f16;
typedef _Float16 f16x2 __attribute__((ext_vector_type(2)));
typedef _Float16 f16x4 __attribute__((ext_vector_type(4)));
typedef _Float16 f16x8 __attribute__((ext_vector_type(8)));
typedef float f32x2 __attribute__((ext_vector_type(2)));
typedef float f32x4 __attribute__((ext_vector_type(4)));
typedef float f32x16 __attribute__((ext_vector_type(16)));
typedef unsigned u32x4 __attribute__((ext_vector_type(4)));

constexpr int D = 1024, SEQ = 8192, NMETA = 16, TT = 8208;
constexpr int MREAL = 16384, MR = 16640;
constexpr int NIN = 5064;
constexpr int N1 = 3584;
constexpr int C_QABS = 0, C_QI = 1024, C_CKV = 1536, C_KI = 1664, C_WI = 1728, C_BC = 1792;
constexpr int NT = 512;
constexpr int KIDX_B = 264 * 2048;
constexpr float LN_EPS = 1e-5f;
constexpr float ALPHA = 1.189207115002721f;

__device__ __forceinline__ int row_of(int b, int t) { return t < NMETA ? MREAL + b * NMETA + t : b * SEQ + (t - NMETA); }

constexpr size_t MiB = 1u << 20;
constexpr size_t WS_CTL = 0, WS_STAT = 1 * MiB, WS_WIS = 2 * MiB, WS_W1T = 3 * MiB, WS_WGT = 10 * MiB, WS_WPAT = 14 * MiB, WS_WPBT = 16 * MiB,
                 WS_WOT = 17 * MiB, WS_WSKT = 19 * MiB, WS_WLT = 23 * MiB, WS_CKV = 24 * MiB, WS_KIDX = 29 * MiB, WS_H0 = 32 * MiB,
                 WS_OLAT = 65 * MiB, WS_OB = 97 * MiB, WS_PB = 113 * MiB, WS_U8 = 227 * MiB, WS_V8A = 243 * MiB, WS_V8B = 3 * MiB, WS_END = 256 * MiB;
constexpr int V8A_ROWS = 13312;
constexpr size_t WS_MIXED = WS_PB, WS_H1H = WS_PB, WS_TMP = WS_PB + 32 * MiB, WS_SC = WS_PB + 32 * MiB, WS_EIDX = WS_PB + 96 * MiB, WS_EGATE = WS_PB + 100 * MiB;
constexpr size_t DO_LORAIN = 0, DO_LW = 9 * MiB, DO_AA = 26 * MiB, DO_GG = 43 * MiB;

struct Params {
    const float *x, *meta, *ln_in_g, *ln_in_b, *w_in, *b_gate, *a_kv_norm_g, *a_w_uk, *a_w_uv, *a_kidx_g, *a_kidx_b, *b_mu, *b_w0, *b_w2, *b_a0, *b_a2,
        *b_g2, *b_k_k, *b_k_a, *b_r_k, *b_lnx_g, *b_lnx_b, *w_pa, *w_pb, *w_o, *ln1_g, *ln1_b, *peer_wq, *peer_subkeys, *peer_u, *peer_v, *ln2_g, *ln2_b;
    float* out;
    unsigned char* ws;
    int ph_lo, ph_hi;
};

__device__ __forceinline__ float wave_sum(float v) {
#pragma unroll
    for (int o = 1; o < 64; o <<= 1) v += __shfl_xor(v, o);
    return v;
}
__device__ __forceinline__ float wave_max(float v) {
#pragma unroll
    for (int o = 1; o < 64; o <<= 1) v = fmaxf(v, __shfl_xor(v, o));
    return v;
}
#define DPP_F(v, ctrl) __builtin_bit_cast(float, __builtin_amdgcn_update_dpp(0, __builtin_bit_cast(int, (v)), (ctrl), 0xF, 0xF, true))
__device__ __forceinline__ float row16_sum(float v) {
    v += DPP_F(v, 0xB1);
    v += DPP_F(v, 0x4E);
    v += DPP_F(v, 0x141);
    v += DPP_F(v, 0x140);
    return v;
}
__device__ __forceinline__ float sigmoidf_(float x) { return __builtin_amdgcn_rcpf(1.f + __expf(-x)); }
__device__ __forceinline__ float softplusf_(float z) { return fmaxf(z, 0.f) + __logf(1.f + __expf(-fabsf(z))); }
__device__ __forceinline__ unsigned fkey(float f) { unsigned u = __float_as_uint(f); return u ^ ((u >> 31) ? 0xFFFFFFFFu : 0x80000000u); }

namespace pg8 {
#define PG8_LAS __attribute__((address_space(3)))
typedef short h16x8 __attribute__((ext_vector_type(8)));
constexpr int BM = 256, BK = 64, HALF = 128, HTB = HALF * BK * 2, STAGE_BYTES = 8 * HTB, NXCD = 8, WGM = 8;
__host__ __device__ __forceinline__ int lds_byte(int r, int c) { const int st = (r >> 4) * 2 + (c >> 5), rr = r & 15, cc = c & 31, ob = rr * 64 + cc * 2; return st * 1024 + (ob ^ (((ob >> 9) & 1) << 5)); }
__host__ __device__ __forceinline__ void stage_rc(int b, int& R, int& C) { const int st = b / 1024, sb = b % 1024, swz = sb ^ (((sb >> 9) & 1) << 5); R = (st >> 1) * 16 + swz / 64; C = (st & 1) * 32 + (swz % 64) / 2; }
struct Unit { int pm, pn; };
struct Gemm { const f16* A; const f16* Bt; int M, N, K; };
struct StaticOrder {
    int nM, nN, nwg, G, c;
    __host__ __device__ void init(int M, int N, int G_, int c_) { nM = M / BM; nN = N / BM; nwg = nM * nN; G = G_; c = c_; }
    __host__ __device__ bool next(int i, Unit& u) const {
        const long L = (long)i * G + c; if (L >= nwg) return false;
        int wgid = (int)L; { const int q = nwg / NXCD, r = nwg % NXCD, xcd = wgid % NXCD, off = wgid / NXCD; wgid = (xcd < r ? xcd * (q + 1) : r * (q + 1) + (xcd - r) * q) + off; }
        const int nig = WGM * nN, gid = wgid / nig, fm = gid * WGM, gsz = (nM - fm) < WGM ? (nM - fm) : WGM;
        u.pm = fm + ((wgid % nig) % gsz); u.pn = (wgid % nig) / gsz; return true;
    }
};
template <class F> struct EpiElem {
    F f;
    __device__ __forceinline__ void operator()(const f32x4 (&acc)[2][2][4][2], const Unit& u, int wr, int wc, int fr, int fq) const {
        const int row0 = u.pm * BM + wr * 64 + fr, col0 = u.pn * BM + wc * 32 + 4 * fq;
#pragma unroll
        for (int ai = 0; ai < 2; ++ai)
#pragma unroll
            for (int m = 0; m < 4; ++m)
#pragma unroll
                for (int bj = 0; bj < 2; ++bj)
#pragma unroll
                    for (int n = 0; n < 2; ++n) f(row0 + ai * HALF + m * 16, col0 + bj * HALF + n * 16, acc[ai][bj][m][n]);
    }
};
template <class Epi>
__device__ __forceinline__ void gemm_phase(PG8_LAS unsigned char* lds, const Gemm g, const StaticOrder& S, const Epi& E) {
    const int tid = threadIdx.x, wid = __builtin_amdgcn_readfirstlane(tid >> 6), lane = tid & 63, wr = wid >> 2, wc = wid & 3, fr = lane & 15, fq = lane >> 4;
    int K = g.K; asm volatile("" : "+s"(K));
    const int nt = K / BK;
    unsigned voffA[2], voffB[2];
#pragma unroll
    for (int i = 0; i < 2; ++i) { int R, C; stage_rc(tid * 16 + i * 8192, R, C); voffA[i] = (unsigned)(R * K + C) * 2u; voffB[i] = (unsigned)(R * K + C) * 2u; }
    const size_t kstep = (size_t)(BK * 2);
    const size_t hstep = (size_t)HALF * K * 2;
    const size_t tstep = 2 * hstep;
    const unsigned ldsw = (unsigned)wid * 1024u;
    const int aoff = lds_byte(wr * 64 + fr, fq * 8), boff = lds_byte(wc * 32 + fr, fq * 8);
#define PG8_SA(b, h) (((b) * 2 + (h)) * HTB)
#define PG8_SB(b, h) ((4 + (b) * 2 + (h)) * HTB)
#define PG8_STAGE(bufoff, gbase, voff) do { _Pragma("unroll") for (int _i = 0; _i < 2; ++_i) \
        __builtin_amdgcn_global_load_lds((const unsigned*)((const char*)(gbase) + (voff)[_i]), (PG8_LAS unsigned*)(lds + (bufoff) + ldsw + _i * 8192), 16, 0, 0); } while (0)
#define PG8_LDA(dst, b, h) do { _Pragma("unroll") for (int m = 0; m < 4; ++m) _Pragma("unroll") for (int k = 0; k < 2; ++k) dst[m][k] = *(const PG8_LAS h16x8*)(lds + PG8_SA(b, h) + aoff + m * 2048 + k * 1024); } while (0)
#define PG8_LDB(dst, b, h) do { _Pragma("unroll") for (int n = 0; n < 2; ++n) _Pragma("unroll") for (int k = 0; k < 2; ++k) dst[n][k] = *(const PG8_LAS h16x8*)(lds + PG8_SB(b, h) + boff + n * 2048 + k * 1024); } while (0)
#define PG8_MMA(ai, bj, At, Bt) do { __builtin_amdgcn_s_setprio(1); _Pragma("unroll") for (int m = 0; m < 4; ++m) _Pragma("unroll") for (int n = 0; n < 2; ++n) _Pragma("unroll") for (int k = 0; k < 2; ++k) \
        acc[ai][bj][m][n] = __builtin_amdgcn_mfma_f32_16x16x32_f16(__builtin_bit_cast(f16x8, Bt[n][k]), __builtin_bit_cast(f16x8, At[m][k]), acc[ai][bj][m][n], 0, 0, 0); __builtin_amdgcn_s_setprio(0); } while (0)
#define PG8_WAIT_V(n) asm volatile("s_waitcnt vmcnt(" #n ")" ::: "memory")
#define PG8_WAIT_L(n) asm volatile("s_waitcnt lgkmcnt(" #n ")" ::: "memory")
#define PG8_BAR __builtin_amdgcn_s_barrier()
#define PG8_SCHED __builtin_amdgcn_sched_barrier(0)
    Unit cur, nxt; int ui = 0;
    if (!S.next(0, cur)) return;
    f32x4 acc[2][2][4][2];
#pragma unroll
    for (int a = 0; a < 2; ++a)
#pragma unroll
        for (int b = 0; b < 2; ++b)
#pragma unroll
            for (int m = 0; m < 4; ++m)
#pragma unroll
                for (int n = 0; n < 2; ++n) acc[a][b][m][n] = (f32x4){0.f, 0.f, 0.f, 0.f};
    h16x8 At[4][2], B0[2][2], B1[2][2];
    const char* cA = (const char*)g.A + (size_t)cur.pm * tstep; const char* cB = (const char*)g.Bt + (size_t)cur.pn * tstep;
    PG8_STAGE(PG8_SB(0, 0), cB, voffB); PG8_STAGE(PG8_SA(0, 0), cA, voffA); PG8_STAGE(PG8_SB(0, 1), cB + hstep, voffB); PG8_STAGE(PG8_SA(0, 1), cA + hstep, voffA);
    if (wr == 1) PG8_BAR;
    PG8_WAIT_V(4); PG8_BAR;
    PG8_STAGE(PG8_SB(1, 0), cB + kstep, voffB); PG8_STAGE(PG8_SA(1, 0), cA + kstep, voffA); PG8_STAGE(PG8_SB(1, 1), cB + hstep + kstep, voffB);
    PG8_WAIT_V(6); PG8_BAR;
    for (;;) {
        const bool has_next = S.next(ui + 1, nxt);
        const char* nA = has_next ? (const char*)g.A + (size_t)nxt.pm * tstep : cA; const char* nB = has_next ? (const char*)g.Bt + (size_t)nxt.pn * tstep : cB;
        for (int t = 0; t < nt; t += 2) {
            const bool last = (t == nt - 2);
            const char* a1 = cA + (size_t)(t + 1) * kstep;
            const char* a2 = last ? nA : cA + (size_t)(t + 2) * kstep; const char* b2 = last ? nB : cB + (size_t)(t + 2) * kstep;
            const char* a3 = a2 + kstep; const char* b3 = b2 + kstep;
            PG8_LDB(B0, 0, 0); PG8_SCHED; PG8_LDA(At, 0, 0); PG8_STAGE(PG8_SA(1, 1), a1 + hstep, voffA);
            PG8_WAIT_L(8); PG8_BAR; PG8_WAIT_L(0); PG8_MMA(0, 0, At, B0); PG8_BAR; PG8_SCHED;
            PG8_LDB(B1, 0, 1); PG8_STAGE(PG8_SB(0, 0), b2, voffB);
            PG8_BAR; PG8_WAIT_L(0); PG8_MMA(0, 1, At, B1); PG8_BAR;
            PG8_LDA(At, 0, 1); PG8_STAGE(PG8_SA(0, 0), a2, voffA);
            PG8_BAR; PG8_WAIT_L(0); PG8_MMA(1, 0, At, B0); PG8_BAR; PG8_SCHED;
            PG8_STAGE(PG8_SB(0, 1), b2 + hstep, voffB);
            PG8_WAIT_V(6); PG8_BAR; PG8_MMA(1, 1, At, B1); PG8_BAR;
            PG8_LDB(B0, 1, 0); PG8_SCHED; PG8_LDA(At, 1, 0); PG8_STAGE(PG8_SA(0, 1), a2 + hstep, voffA);
            PG8_WAIT_L(8); PG8_BAR; PG8_WAIT_L(0); PG8_MMA(0, 0, At, B0); PG8_BAR; PG8_SCHED;
            PG8_LDB(B1, 1, 1); PG8_STAGE(PG8_SB(1, 0), b3, voffB);
            PG8_BAR; PG8_WAIT_L(0); PG8_MMA(0, 1, At, B1); PG8_BAR;
            PG8_LDA(At, 1, 1); PG8_STAGE(PG8_SA(1, 0), a3, voffA);
            PG8_BAR; PG8_WAIT_L(0); PG8_MMA(1, 0, At, B0); PG8_BAR; PG8_SCHED;
            PG8_STAGE(PG8_SB(1, 1), b3 + hstep, voffB);
            PG8_WAIT_V(6); PG8_BAR; PG8_MMA(1, 1, At, B1); PG8_BAR;
        }
        E(acc, cur, wr, wc, fr, fq);
        if (!has_next) break;
#pragma unroll
        for (int a = 0; a < 2; ++a)
#pragma unroll
            for (int b = 0; b < 2; ++b)
#pragma unroll
                for (int m = 0; m < 4; ++m)
#pragma unroll
                    for (int n = 0; n < 2; ++n) acc[a][b][m][n] = (f32x4){0.f, 0.f, 0.f, 0.f};
        cur = nxt; cA = nA; cB = nB; ++ui;
    }
    PG8_WAIT_V(0);
    if (wr == 0) PG8_BAR;
    PG8_BAR;
#undef PG8_SA
#undef PG8_SB
#undef PG8_STAGE
#undef PG8_LDA
#undef PG8_LDB
#undef PG8_MMA
#undef PG8_WAIT_V
#undef PG8_WAIT_L
#undef PG8_BAR
#undef PG8_SCHED
}
template <class F>
__device__ __forceinline__ void run_gemm(unsigned char* lds, const f16* A, const f16* Bt, int M, int N, int K, const F& f) {
    Gemm g{A, Bt, M, N, K}; StaticOrder S; S.init(M, N, (int)gridDim.x, (int)blockIdx.x);
    EpiElem<F> E{f};
    gemm_phase<EpiElem<F>>((PG8_LAS unsigned char*)lds, g, S, E);
    __syncthreads();
}
}

__device__ __forceinline__ f16x4 to_h4(f32x4 v) { f16x4 r; r.x = (f16)v.x; r.y = (f16)v.y; r.z = (f16)v.z; r.w = (f16)v.w; return r; }

__device__ __forceinline__ void tr_item(const float* W, int ldw, int col0, int nvalid, int K, f16* out, int nrow0, int item, int nblk, float* scr, int lane) {
    const int kb = item / nblk, nb = item % nblk, k0 = 64 * kb, n0 = 32 * nb;
#pragma unroll 8
    for (int i = 0; i < 32; ++i) { const int kk = 2 * i + (lane >> 5); const int j = n0 + (lane & 31);
        scr[kk * 33 + (lane & 31)] = (j < nvalid) ? W[(size_t)(k0 + kk) * ldw + col0 + j] : 0.f; }
    asm volatile("s_waitcnt vmcnt(0) lgkmcnt(0)" ::: "memory");
    const int c = lane & 7;
#pragma unroll
    for (int jj = 0; jj < 4; ++jj) { const int n = (lane >> 3) + 8 * jj; const float* s = scr + (8 * c) * 33 + n;
        f16x8 o;
#pragma unroll
        for (int e = 0; e < 8; ++e) o[e] = (f16)s[e * 33];
        *(f16x8*)(out + (size_t)(nrow0 + n0 + n) * K + k0 + 8 * c) = o; }
    asm volatile("s_waitcnt lgkmcnt(0)" ::: "memory");
}

template <bool LATE>
__device__ __forceinline__ void ph0_prep(const Params& p, unsigned char* lds, int vwg, int nvwg) {
    int tid_ = threadIdx.x; asm volatile("" : "+v"(tid_));
    const int tid = tid_, lane = tid & 63, wave = tid >> 6;
    const int gw = vwg * 8 + wave, NGW = nvwg * 8;
    f16* H0 = (f16*)(p.ws + WS_H0); float* STAT = (float*)(p.ws + WS_STAT);
    for (int m = gw; m < (LATE ? 0 : MR); m += NGW) {
        f16* orow = H0 + (size_t)m * D;
        if (m >= MREAL + 2 * NMETA) {
#pragma unroll
            for (int j = 0; j < 4; ++j) *(f16x4*)(orow + j * 256 + lane * 4) = (f16x4){(f16)0.f, (f16)0.f, (f16)0.f, (f16)0.f};
            continue;
        }
        const float* src = (m < MREAL) ? p.x + (size_t)m * D : p.meta + (size_t)((m - MREAL) & 15) * D;
        f32x4 v[4]; float s = 0.f;
#pragma unroll
        for (int j = 0; j < 4; ++j) { v[j] = *(const f32x4*)(src + j * 256 + lane * 4); s += (v[j].x + v[j].y) + (v[j].z + v[j].w); }
        const float mean = wave_sum(s) * (1.f / D); float s2 = 0.f;
#pragma unroll
        for (int j = 0; j < 4; ++j) { v[j] = v[j] - mean; s2 += (v[j].x * v[j].x + v[j].y * v[j].y) + (v[j].z * v[j].z + v[j].w * v[j].w); }
        const float rstd = 1.f / sqrtf(wave_sum(s2) * (1.f / D) + LN_EPS);
        if (lane == 0) { STAT[2 * m] = mean; STAT[2 * m + 1] = rstd; }
#pragma unroll
        for (int j = 0; j < 4; ++j) { const f32x4 g = *(const f32x4*)(p.ln_in_g + j * 256 + lane * 4), bb = *(const f32x4*)(p.ln_in_b + j * 256 + lane * 4);
            *(f16x4*)(orow + j * 256 + lane * 4) = to_h4(v[j] * rstd * g + bb); }
    }
    float* scr = (float*)lds + wave * (64 * 33);
    f16* W1T = (f16*)(p.ws + WS_W1T); f16* WGT = (f16*)(p.ws + WS_WGT); f16* WPBT = (f16*)(p.ws + WS_WPBT); f16* WOT = (f16*)(p.ws + WS_WOT);
    constexpr int I_QI = 16 * 16, I_CKV = 4 * 16, I_KI = 4 * 16, I_BC = 56 * 16, I_G = 64 * 16, I_PB = 32 * 8, I_O = 32 * 16;
    constexpr int NITEMS = I_QI + I_CKV + I_KI + I_BC + I_G + I_PB + I_O;
    for (int it = gw + (LATE ? I_QI + I_CKV + I_KI + I_BC : 0); it < (LATE ? NITEMS : I_QI + I_CKV + I_KI + I_BC); it += NGW) {
        int r = it;
        if (r < I_QI) { tr_item(p.w_in, NIN, 640, 512, D, W1T, C_QI, r, 16, scr, lane); continue; } r -= I_QI;
        if (r < I_CKV) { tr_item(p.w_in, NIN, 512, 128, D, W1T, C_CKV, r, 4, scr, lane); continue; } r -= I_CKV;
        if (r < I_KI) { tr_item(p.w_in, NIN, 1152, 72, D, W1T, C_KI, r, 4, scr, lane); continue; } r -= I_KI;
        if (r < I_BC) { tr_item(p.w_in, NIN, 1224, 1792, D, W1T, C_BC, r, 56, scr, lane); continue; } r -= I_BC;
        if (r < I_G) { tr_item(p.w_in, NIN, 3016, 2048, D, WGT, 0, r, 64, scr, lane); continue; } r -= I_G;
        if (r < I_PB) { tr_item(p.w_pb, D, 0, 1024, 512, WPBT, 0, r, 32, scr, lane); continue; } r -= I_PB;
        tr_item(p.w_o, D, 0, 1024, D, WOT, 0, r, 32, scr, lane);
    }
    {
        const int fr = lane & 15, fq = lane >> 4;
        constexpr int T_W1 = 8 * 8 * 64, T_SK = 16 * 8 * 64, T_PA = 8 * 8 * 64;
        f16* WPAT = (f16*)(p.ws + WS_WPAT); f16* WSKT = (f16*)(p.ws + WS_WSKT);
        for (int it = gw + (LATE ? T_W1 : 0); it < (LATE ? T_W1 + T_SK + T_PA : T_W1); it += NGW) {
            int r = it; int kind = 0; if (r >= T_W1) { r -= T_W1; kind = 1; if (r >= T_SK) { r -= T_SK; kind = 2; } }
            const int g = r >> 9, mt = (r >> 6) & 7, nt = r & 63;
            const int m = 16 * mt + fr, n = 16 * nt + fr;
            const int KK = (kind == 1) ? 128 : 64;
            f32x4 acc = {0.f, 0.f, 0.f, 0.f};
            for (int k0 = 0; k0 < KK; k0 += 32) {
                const int kb = k0 + 8 * fq;
                f16x8 af, bf;
                if (kind == 0) { const float* ap = p.a_w_uk + (size_t)(m * 8 + g) * 64 + kb; const float* bp = p.w_in + (size_t)n * NIN + g * 64 + kb;
                    const f32x4 a0 = *(const f32x4*)ap, a1 = *(const f32x4*)(ap + 4), b0 = *(const f32x4*)bp, b1 = *(const f32x4*)(bp + 4);
#pragma unroll
                    for (int e = 0; e < 4; ++e) { af[e] = (f16)a0[e]; af[4 + e] = (f16)a1[e]; bf[e] = (f16)b0[e]; bf[4 + e] = (f16)b1[e]; } }
                else if (kind == 1) { const float* ap = p.peer_subkeys + (size_t)(g * 128 + m) * 128 + kb; const float* bp = p.peer_wq + (size_t)n * 2048 + g * 128 + kb;
                    const f32x4 a0 = *(const f32x4*)ap, a1 = *(const f32x4*)(ap + 4), b0 = *(const f32x4*)bp, b1 = *(const f32x4*)(bp + 4);
#pragma unroll
                    for (int e = 0; e < 4; ++e) { af[e] = (f16)a0[e]; af[4 + e] = (f16)a1[e]; bf[e] = (f16)b0[e]; bf[4 + e] = (f16)b1[e]; } }
                else { const float* ap = p.a_w_uv + (size_t)(m * 8 + g) * 64 + kb; const float* bp = p.w_pa + (size_t)(g * 64 + kb) * D + n;
                    const f32x4 a0 = *(const f32x4*)ap, a1 = *(const f32x4*)(ap + 4);
#pragma unroll
                    for (int e = 0; e < 4; ++e) { af[e] = (f16)a0[e]; af[4 + e] = (f16)a1[e]; }
#pragma unroll
                    for (int e = 0; e < 8; ++e) bf[e] = (f16)bp[(size_t)e * D]; }
                acc = __builtin_amdgcn_mfma_f32_16x16x32_f16(af, bf, acc, 0, 0, 0);
            }
            if (kind == 2) { *(f16x4*)(WPAT + (size_t)n * D + g * 128 + 16 * mt + 4 * fq) = to_h4(acc); }
            else { f16* o = ((kind == 0) ? W1T : WSKT) + (size_t)(g * 128 + 16 * mt + 4 * fq) * D + n;
#pragma unroll
                for (int e = 0; e < 4; ++e) o[(size_t)e * D] = (f16)acc[e]; }
        }
    }
    const long gt = (long)vwg * NT + tid, NGT = (long)nvwg * NT;
    f16* WLT = (f16*)(p.ws + WS_WLT);
    for (long e = gt; e < (LATE ? 0L : 1536L * 256); e += NGT) { const int n = (int)(e >> 8), k = (int)(e & 255); float v = 0.f;
        if (n < 512) { if (k < 64) v = p.b_w2[(size_t)k * 512 + n]; }
        else if (n < 1024) { if (k >= 64 && k < 128) v = p.b_a2[(size_t)(k - 64) * 512 + (n - 512)]; }
        else { if (k >= 128) v = p.b_g2[(size_t)(k - 128) * 512 + (n - 1024)]; }
        WLT[e] = (f16)v; }
    if (LATE) {
        unsigned char* U8 = p.ws + WS_U8;
        for (long e = gt; e < 16384L * 1024 / 16; e += NGT) {
            u32x4 ou, ov;
#pragma unroll
            for (int q = 0; q < 4; ++q) { const f32x4 a = *(const f32x4*)(p.peer_u + e * 16 + q * 4) * 256.f; const f32x4 c = *(const f32x4*)(p.peer_v + e * 16 + q * 4) * 16.f;
                int w = 0; w = __builtin_amdgcn_cvt_pk_fp8_f32(a[0], a[1], w, false); w = __builtin_amdgcn_cvt_pk_fp8_f32(a[2], a[3], w, true); ou[q] = (unsigned)w;
                int x = 0; x = __builtin_amdgcn_cvt_pk_fp8_f32(c[0], c[1], x, false); x = __builtin_amdgcn_cvt_pk_fp8_f32(c[2], c[3], x, true); ov[q] = (unsigned)x; }
            const long row = e >> 6;
            unsigned char* vdst = (row < V8A_ROWS) ? p.ws + WS_V8A + e * 16 : p.ws + WS_V8B + (e - (long)V8A_ROWS * 64) * 16;
            *(u32x4*)(U8 + e * 16) = ou; *(u32x4*)vdst = ov;
        }
    }
}

__device__ __forceinline__ void phc1_rowprep(const Params& p) {
    const int tid = threadIdx.x, lane = tid & 63, wave = tid >> 6;
    const int gw = blockIdx.x * 8 + wave, NGW = gridDim.x * 8;
    const f16* PB = (const f16*)(p.ws + WS_PB); f16* CKV = (f16*)(p.ws + WS_CKV); f16* KIDX = (f16*)(p.ws + WS_KIDX); float* WIS = (float*)(p.ws + WS_WIS);
    f16* LORAIN = (f16*)((unsigned char*)p.out + DO_LORAIN);
    for (int m = gw; m < MR; m += NGW) {
        if (m >= MREAL + 2 * NMETA) { *(f16x4*)(LORAIN + (size_t)m * 256 + lane * 4) = (f16x4){(f16)0.f, (f16)0.f, (f16)0.f, (f16)0.f}; continue; }
        const f16* pr = PB + (size_t)m * N1;
        { const f16x2 c2 = *(const f16x2*)(pr + C_CKV + 2 * lane); const float a = (float)c2.x, b = (float)c2.y;
          const float ss = wave_sum(a * a + b * b); const float r = 1.f / sqrtf(ss * (1.f / 128.f) + 1e-6f);
          f16x2 o; o.x = (f16)(a * r * p.a_kv_norm_g[2 * lane]); o.y = (f16)(b * r * p.a_kv_norm_g[2 * lane + 1]);
          *(f16x2*)(CKV + (size_t)m * 128 + 2 * lane) = o; }
        { const float a = (float)pr[C_KI + lane]; const float mu = wave_sum(a) * (1.f / 64.f); const float d = a - mu;
          const float var = wave_sum(d * d) * (1.f / 64.f);
          int kb_, kt_; if (m < MREAL) { kb_ = m >> 13; kt_ = NMETA + (m & 8191); } else { kb_ = (m - MREAL) >> 4; kt_ = (m - MREAL) & 15; }
          KIDX[(size_t)kb_ * KIDX_B + (size_t)(kt_ >> 5) * 2048 + (lane >> 4) * 512 + ((lane >> 3) & 1) * 256 + (kt_ & 31) * 8 + (lane & 7)] = (f16)(d * (1.f / sqrtf(var + LN_EPS)) * p.a_kidx_g[lane] + p.a_kidx_b[lane]); }
        if (lane < 8) WIS[(size_t)m * 8 + lane] = (float)pr[C_WI + lane] * 0.04419417382415922f;
        { int b, t; if (m < MREAL) { b = m >> 13; t = NMETA + (m & 8191); } else { b = (m - MREAL) >> 4; t = (m - MREAL) & 15; }
          const f16x4 cur = *(const f16x4*)(pr + C_BC + 1536 + lane * 4);
          f16x4 prv = (f16x4){(f16)0.f, (f16)0.f, (f16)0.f, (f16)0.f};
          if (t > 0) prv = *(const f16x4*)(PB + (size_t)row_of(b, t - 1) * N1 + C_BC + 1536 + lane * 4);
          const f32x4 mu = *(const f32x4*)(p.b_mu + 1536 + lane * 4);
          f16x4 o;
#pragma unroll
          for (int e = 0; e < 4; ++e) { const float c = (float)cur[e], q = (float)prv[e]; float xs = c + (q - c) * mu[e];
              const int j = lane * 4 + e; if (j < 64) xs = tanhf(xs); else if (j >= 128) xs = sigmoidf_(xs); o[e] = (f16)xs; }
          *(f16x4*)(LORAIN + (size_t)m * 256 + lane * 4) = o; }
    }
}

typedef short bf16x8 __attribute__((ext_vector_type(8)));
typedef unsigned short bf16_t;
typedef unsigned u32x2 __attribute__((ext_vector_type(2)));
typedef __bf16 bf16x2_t __attribute__((ext_vector_type(2)));
__device__ __forceinline__ unsigned cvt_pk_bf16(float lo, float hi) { const f32x2 v = {lo, hi}; const bf16x2_t b = __builtin_convertvector(v, bf16x2_t); return __builtin_bit_cast(unsigned, b); }
__device__ __forceinline__ bf16_t f2bf(float f) { unsigned u = __float_as_uint(f); return (bf16_t)((u + 0x7fffu + ((u >> 16) & 1u)) >> 16); }
__device__ __forceinline__ u32x2 pk4(f32x4 v) { u32x2 r; r.x = cvt_pk_bf16(v[0], v[1]); r.y = cvt_pk_bf16(v[2], v[3]); return r; }
__device__ __forceinline__ bf16x8 pk8(f32x4 a, f32x4 b) { u32x4 r; r.x = cvt_pk_bf16(a[0], a[1]); r.y = cvt_pk_bf16(a[2], a[3]); r.z = cvt_pk_bf16(b[0], b[1]); r.w = cvt_pk_bf16(b[2], b[3]); return __builtin_bit_cast(bf16x8, r); }
#define MFMA_BF(a, b, c) __builtin_amdgcn_mfma_f32_16x16x32_bf16((a), (b), (c), 0, 0, 0)
constexpr int RS = 72, PSt = 40, FS = 36, YS = 68;
__device__ __forceinline__ void rwkv_item(const Params& p, int b, int h, unsigned char* lds) {
    int tid_ = threadIdx.x; asm volatile("" : "+v"(tid_));
    const int tid = tid_, lane = tid & 63, wave = __builtin_amdgcn_readfirstlane(tid >> 6), fr = lane & 15, fq = lane >> 4;
    const f16* PB = (const f16*)(p.ws + WS_PB);
    const f16* LW = (const f16*)((unsigned char*)p.out + DO_LW); const f16* AA = (const f16*)((unsigned char*)p.out + DO_AA); const f16* GG = (const f16*)((unsigned char*)p.out + DO_GG);
    f16* OB = (f16*)(p.ws + WS_OB);
    constexpr int SETB = 4 * 32 * RS * 2 + 3 * 64 * PSt * 2 + 256 + 4608 * 4;
#define RW_SET(par_) bf16_t* sAt = (bf16_t*)(lds + (par_) * SETB); bf16_t* sRt = sAt + 32 * RS; bf16_t* sBt = sRt + 32 * RS; bf16_t* sKt = sBt + 32 * RS; \
        bf16_t* sBPT = sKt + 32 * RS; bf16_t* sKPT = sBPT + 64 * PSt; bf16_t* sVT = sKPT + 64 * PSt; float* sPL = (float*)(sVT + 64 * PSt); float* sFst = sPL + 64; \
        (void)sAt; (void)sRt; (void)sBt; (void)sKt; (void)sBPT; (void)sKPT; (void)sVT; (void)sPL; (void)sFst
    bf16_t* sAak = (bf16_t*)(lds + 2 * SETB); bf16_t* sMrb = sAak + 32 * PSt; bf16_t* sMrk = sMrb + 32 * PSt; bf16_t* sT = sMrk + 32 * PSt; bf16_t* sAabB = sT + 32 * PSt;
    float* sAabT = (float*)(sAabB + 16 * PSt); float* sTot = sAabT + 2 * 16 * FS; float* sY = sTot + 8 * 64;
    float* sEnd = sY + 32 * YS;
    float* sCst = sEnd;
    for (unsigned* z = (unsigned*)lds + tid; z < (unsigned*)sEnd; z += NT) *z = 0u;
    const int ps = tid >> 4, cg = tid & 15, c4 = cg * 4, hc = h * 64 + c4;
    const int chslot = 32 * (cg >> 3) + 8 * (cg & 3) + 4 * ((cg >> 2) & 1);
    const int pslot = 8 * ((ps & 15) >> 2) + 4 * (ps >> 4) + (ps & 3);
#define PSWZ(row, slot) ((row) * PSt + ((((slot) >> 3) ^ (((row) >> 3) & 3)) << 3) + ((slot) & 7))
    if (tid < 64) { sCst[tid] = p.b_mu[h * 64 + tid]; sCst[64 + tid] = p.b_mu[512 + h * 64 + tid]; sCst[128 + tid] = p.b_mu[1024 + h * 64 + tid]; sCst[192 + tid] = p.b_k_k[h * 64 + tid];
        sCst[256 + tid] = p.b_k_a[h * 64 + tid]; sCst[320 + tid] = p.b_r_k[h * 64 + tid]; sCst[384 + tid] = p.b_lnx_g[h * 64 + tid]; sCst[448 + tid] = p.b_lnx_b[h * 64 + tid]; }
    f32x4 Hacc[4];
#pragma unroll
    for (int i = 0; i < 4; ++i) Hacc[i] = (f32x4){0.f, 0.f, 0.f, 0.f};
    const f16x4 hz = (f16x4){(f16)0.f, (f16)0.f, (f16)0.f, (f16)0.f};
    f16x4 n_cr = hz, n_ck = hz, n_cv = hz, n_qr = hz, n_qk = hz, n_qv = hz, n_lw = hz, n_aa = hz, n_gg = hz;
#define RW_PREFETCH(tt) do { const int _t = (tt); n_cr = hz; n_ck = hz; n_cv = hz; n_qr = hz; n_qk = hz; n_qv = hz; n_lw = hz; n_aa = hz; n_gg = hz; \
        if (_t < TT) { const int _m = row_of(b, _t); const f16* _pr = PB + (size_t)_m * N1 + C_BC + hc; n_cr = *(const f16x4*)(_pr); n_ck = *(const f16x4*)(_pr + 512); n_cv = *(const f16x4*)(_pr + 1024); \
            if (_t > 0) { const f16* _pp = PB + (size_t)row_of(b, _t - 1) * N1 + C_BC + hc; n_qr = *(const f16x4*)(_pp); n_qk = *(const f16x4*)(_pp + 512); n_qv = *(const f16x4*)(_pp + 1024); } \
            n_lw = *(const f16x4*)(LW + (size_t)_m * 512 + hc); n_aa = *(const f16x4*)(AA + (size_t)_m * 512 + hc); n_gg = *(const f16x4*)(GG + (size_t)_m * 512 + hc); } } while (0)
    const f16* pf_pb = PB + (size_t)(b * SEQ + 32 - NMETA + ps) * N1 + C_BC + hc;
    size_t pf_lo = (size_t)(b * SEQ + 32 - NMETA + ps) * 512 + hc; int pf_t = 32 + ps;
#define RW_PREFETCH_INC() do { n_cr = hz; n_ck = hz; n_cv = hz; n_qr = hz; n_qk = hz; n_qv = hz; n_lw = hz; n_aa = hz; n_gg = hz; \
        if (pf_t < TT) { n_cr = *(const f16x4*)(pf_pb); n_ck = *(const f16x4*)(pf_pb + 512); n_cv = *(const f16x4*)(pf_pb + 1024); \
            n_qr = *(const f16x4*)(pf_pb - N1); n_qk = *(const f16x4*)(pf_pb - N1 + 512); n_qv = *(const f16x4*)(pf_pb - N1 + 1024); \
            n_lw = *(const f16x4*)(LW + pf_lo); n_aa = *(const f16x4*)(AA + pf_lo); n_gg = *(const f16x4*)(GG + pf_lo); } \
        pf_pb += 32 * N1; pf_lo += 32 * 512; pf_t += 32; } while (0)
    RW_PREFETCH(ps);
    __syncthreads();
#define RW_SCAN_LOCAL(dst, lwv) do { dst = (f32x4){(float)(lwv)[0], (float)(lwv)[1], (float)(lwv)[2], (float)(lwv)[3]}; f32x4 u1_; \
        _Pragma("unroll") for (int e = 0; e < 4; ++e) u1_[e] = __shfl_up(dst[e], 16); if (lane >= 16) dst += u1_; \
        _Pragma("unroll") for (int e = 0; e < 4; ++e) u1_[e] = __shfl_up(dst[e], 32); if (lane >= 32) dst += u1_; \
        if (lane >= 48) *(f32x4*)(sTot + wave * 64 + c4) = dst; } while (0)
#define RW_SCAN_FINISH(dst, totv) do { totv = (f32x4){0.f, 0.f, 0.f, 0.f}; f32x4 tw_[8]; \
        _Pragma("unroll") for (int w = 0; w < 8; ++w) tw_[w] = *(const f32x4*)(sTot + w * 64 + c4); \
        __builtin_amdgcn_sched_barrier(0); \
        _Pragma("unroll") for (int w = 0; w < 8; ++w) { totv += tw_[w]; const float msk_ = (w < wave) ? 1.f : 0.f; dst += tw_[w] * msk_; } } while (0)
    f32x4 cumC, totC;
    RW_SCAN_LOCAL(cumC, n_lw);
    __syncthreads();
    RW_SCAN_FINISH(cumC, totC);
    __syncthreads();
    constexpr int NCH = (TT + 31) / 32;
    { RW_SET(0); const int t = ps;
        f32x4 r4 = {0, 0, 0, 0}, k4 = r4, v4 = r4, kk4 = r4, a4 = r4, g4 = r4, lw4 = r4;
        f32x4 rkw;
        {
            const f16x4 cr = n_cr, ck = n_ck, cv = n_cv, qr = n_qr, qk = n_qk, qv = n_qv, lw = n_lw, aa = n_aa, gg = n_gg;
            RW_PREFETCH_INC();
            const f32x4 mu_r = *(const f32x4*)(sCst + c4), mu_k = *(const f32x4*)(sCst + 64 + c4), mu_v = *(const f32x4*)(sCst + 128 + c4), kkw = *(const f32x4*)(sCst + 192 + c4), kaw = *(const f32x4*)(sCst + 256 + c4);
            rkw = *(const f32x4*)(sCst + 320 + c4);
#pragma unroll
            for (int e = 0; e < 4; ++e) {
                const float c0 = (float)cr[e], c1 = (float)ck[e], c2 = (float)cv[e];
                r4[e] = c0 + ((float)qr[e] - c0) * mu_r[e];
                const float k0 = c1 + ((float)qk[e] - c1) * mu_k[e];
                v4[e] = c2 + ((float)qv[e] - c2) * mu_v[e];
                a4[e] = (float)aa[e]; lw4[e] = (float)lw[e]; g4[e] = (float)gg[e];
                kk4[e] = k0 * kkw[e];
                k4[e] = k0 * (1.f + (a4[e] - 1.f) * kaw[e]);
            }
        }
        float ss = kk4[0] * kk4[0] + kk4[1] * kk4[1] + kk4[2] * kk4[2] + kk4[3] * kk4[3];
        float bo = r4[0] * k4[0] * rkw[0] + r4[1] * k4[1] * rkw[1] + r4[2] * k4[2] * rkw[2] + r4[3] * k4[3] * rkw[3];
        ss = row16_sum(ss); bo = row16_sum(bo);
        *(f32x4*)(sFst + tid * 4) = v4; *(f32x4*)(sFst + 2048 + tid * 4) = g4; sFst[4096 + tid] = bo;
        const float rn = __builtin_amdgcn_rsqf(ss + 1e-12f);
        f32x4 bb4;
#pragma unroll
        for (int e = 0; e < 4; ++e) { kk4[e] *= rn; bb4[e] = kk4[e] * a4[e]; }
        const f32x4 cum = cumC, tot = totC;
        {
            f32x4 xa, xb, xk, xr, xbp, xkp;
#pragma unroll
            for (int e = 0; e < 4; ++e) { const float e1 = __expf(cum[e]), e2 = __expf(-cum[e]), e3 = __expf(cum[e] - lw4[e]), e4 = __expf(tot[e] - cum[e]);
                xa[e] = -kk4[e] * e3; xb[e] = bb4[e] * e2; xk[e] = k4[e] * e2; xr[e] = r4[e] * e1; xbp[e] = bb4[e] * e4; xkp[e] = k4[e] * e4; }
            *(u32x2*)(sAt + ps * RS + chslot) = pk4(xa); *(u32x2*)(sBt + ps * RS + chslot) = pk4(xb); *(u32x2*)(sKt + ps * RS + chslot) = pk4(xk); *(u32x2*)(sRt + ps * RS + chslot) = pk4(xr);
#pragma unroll
            for (int e = 0; e < 4; e += 2) { const unsigned pb_ = cvt_pk_bf16(xbp[e], xbp[e + 1]), pk_ = cvt_pk_bf16(xkp[e], xkp[e + 1]), pv_ = cvt_pk_bf16(v4[e], v4[e + 1]);
                sBPT[PSWZ(c4 + e, pslot)] = (bf16_t)pb_; sBPT[PSWZ(c4 + e + 1, pslot)] = (bf16_t)(pb_ >> 16); sKPT[PSWZ(c4 + e, pslot)] = (bf16_t)pk_; sKPT[PSWZ(c4 + e + 1, pslot)] = (bf16_t)(pk_ >> 16);
                sVT[PSWZ(c4 + e, pslot)] = (bf16_t)pv_; sVT[PSWZ(c4 + e + 1, pslot)] = (bf16_t)(pv_ >> 16); }
            if (ps == 0) { f32x4 pl;
#pragma unroll
                for (int e = 0; e < 4; ++e) pl[e] = __expf(tot[e]);
                *(f32x4*)(sPL + c4) = pl; }
        }
    }
    __syncthreads();
    { RW_SET(0);
        for (int jb = (wave < 2) ? wave : wave, jn = 0; jb < 12 && !(wave < 2 && jn > 0); jb += 6, ++jn) {
            const bf16_t *Ab, *Bb; int ta, tb;
            if (jb < 2) { ta = jb; tb = jb; Ab = sAt; Bb = sBt; }
            else if (jb == 2) { ta = 0; tb = 1; Ab = sBt; Bb = sAt; }
            else { const int ti = (jb - 3) % 3, prod = (jb - 3) / 3; ta = (ti == 2) ? 1 : 0; tb = (ti >= 1) ? 1 : 0; Ab = (prod == 1) ? sBt : sKt; Bb = (prod == 0) ? sAt : sRt; }
            f32x4 acc = {0, 0, 0, 0};
#pragma unroll
            for (int ks = 0; ks < 2; ++ks) { const bf16x8 a = *(const bf16x8*)(Ab + (16 * ta + fr) * RS + 32 * ks + 8 * fq); const bf16x8 bq = *(const bf16x8*)(Bb + (16 * tb + fr) * RS + 32 * ks + 8 * fq); acc = MFMA_BF(a, bq, acc); }
            const int rloc = 4 * fq, cloc = fr;
            if (jb < 2) {
#pragma unroll
                for (int e = 0; e < 4; ++e) acc[e] = (cloc < rloc + e) ? acc[e] : 0.f;
                *(f32x4*)(sAabT + jb * 16 * FS + cloc * FS + rloc) = acc;
                asm volatile("s_waitcnt lgkmcnt(0)" ::: "memory");
                if (lane < 16) {
                    const int col = lane;
                    const float* At_ = sAabT + jb * 16 * FS;
                    float x[16];
#pragma unroll
                    for (int s2 = 0; s2 < 16; ++s2) x[s2] = (s2 == col) ? 1.f : 0.f;
#define RW_INV_BATCH(J0, J1) do { f32x4 cv_[(J1) - (J0)][4]; \
                    _Pragma("unroll") for (int j = (J0); j < (J1); ++j) _Pragma("unroll") for (int q4 = (j + 1) / 4; q4 < 4; ++q4) cv_[j - (J0)][q4] = *(const f32x4*)(At_ + j * FS + 4 * q4); \
                    __builtin_amdgcn_sched_barrier(0); \
                    _Pragma("unroll") for (int j = (J0); j < (J1); ++j) { const float xj = x[j]; \
                        _Pragma("unroll") for (int q4 = (j + 1) / 4; q4 < 4; ++q4) _Pragma("unroll") for (int e = 0; e < 4; ++e) if (4 * q4 + e > j) x[4 * q4 + e] += cv_[j - (J0)][q4][e] * xj; } \
                    __builtin_amdgcn_sched_barrier(0); } while (0)
                    RW_INV_BATCH(0, 3); RW_INV_BATCH(3, 7); RW_INV_BATCH(7, 15);
#pragma unroll
                    for (int s2 = 0; s2 < 16; ++s2) sT[(16 * jb + s2) * PSt + 8 * (col >> 2) + (col & 3)] = f2bf(x[s2]);
                }
            } else if (jb == 2) {
                *(u32x2*)(sAabB + cloc * PSt + 8 * fq) = pk4(acc);
            } else {
                const int prod = (jb - 3) / 3; const int jrow = 16 * ta + rloc, scol = 16 * tb + cloc;
                if (prod == 0) {
#pragma unroll
                    for (int e = 0; e < 4; ++e) acc[e] = (jrow + e < scol) ? acc[e] : 0.f;
                } else {
#pragma unroll
                    for (int e = 0; e < 4; ++e) acc[e] = (jrow + e <= scol) ? acc[e] : 0.f;
                }
                *(u32x2*)(((prod == 0) ? sAak : (prod == 1) ? sMrb : sMrk) + scol * PSt + 8 * fq + 4 * ta) = pk4(acc);
            }
        }
    }
    { f32x4 cumN, totN; RW_SCAN_LOCAL(cumN, n_lw); __syncthreads(); RW_SCAN_FINISH(cumN, totN); cumC = cumN; totC = totN; }
    for (int c = 0; c < NCH; ++c) {
        const int par = c & 1; const bool more = (c + 1 < NCH);
        { RW_SET(par);
        if (wave < 4) {
            const int v0 = 16 * wave;
            const f32x4 z4 = {0.f, 0.f, 0.f, 0.f};
            const bf16x8 hb0 = pk8(Hacc[0], Hacc[1]), hb1 = pk8(Hacc[2], Hacc[3]);
            const bf16x8 vb = *(const bf16x8*)(sVT + PSWZ(v0 + fr, 8 * fq));
            bf16x8 fAt[2][2], fAak[2], fT[2], fAabB;
#pragma unroll
            for (int ts = 0; ts < 2; ++ts) { const bf16_t* atr = sAt + (16 * ts + fr) * RS;
                fAt[ts][0] = *(const bf16x8*)(atr + 8 * fq); fAt[ts][1] = *(const bf16x8*)(atr + 32 + 8 * fq); fAak[ts] = *(const bf16x8*)(sAak + (16 * ts + fr) * PSt + 8 * fq); fT[ts] = *(const bf16x8*)(sT + (16 * ts + fr) * PSt + 8 * fq); }
            fAabB = *(const bf16x8*)(sAabB + fr * PSt + 8 * fq);
            __builtin_amdgcn_sched_barrier(0);
            f32x4 zt = MFMA_BF(fAt[0][0], hb0, z4); f32x4 zb = MFMA_BF(fAt[1][0], hb0, z4);
            zt = MFMA_BF(fAt[0][1], hb1, zt); zb = MFMA_BF(fAt[1][1], hb1, zb);
            zt = MFMA_BF(fAak[0], vb, zt); zb = MFMA_BF(fAak[1], vb, zb);
            bf16x8 fRt[2][2], fMrk[2], fMrb[2];
#pragma unroll
            for (int ts = 0; ts < 2; ++ts) { const bf16_t* rtr = sRt + (16 * ts + fr) * RS;
                fRt[ts][0] = *(const bf16x8*)(rtr + 8 * fq); fRt[ts][1] = *(const bf16x8*)(rtr + 32 + 8 * fq);
                fMrk[ts] = *(const bf16x8*)(sMrk + (16 * ts + fr) * PSt + 8 * fq); fMrb[ts] = *(const bf16x8*)(sMrb + (16 * ts + fr) * PSt + 8 * fq); }
            __builtin_amdgcn_sched_barrier(0);
            const f32x4 ut = MFMA_BF(fT[0], pk8(zt, z4), z4);
            f32x4 y0 = MFMA_BF(fRt[0][0], hb0, z4); f32x4 y1 = MFMA_BF(fRt[1][0], hb0, z4);
            y0 = MFMA_BF(fRt[0][1], hb1, y0); y1 = MFMA_BF(fRt[1][1], hb1, y1);
            zb = MFMA_BF(fAabB, pk8(ut, z4), zb);
            y0 = MFMA_BF(fMrk[0], vb, y0); y1 = MFMA_BF(fMrk[1], vb, y1);
            const f32x4 ubt = MFMA_BF(fT[1], pk8(zb, z4), z4);
            const bf16x8 ub = pk8(ut, ubt);
            y0 = MFMA_BF(fMrb[0], ub, y0); y1 = MFMA_BF(fMrb[1], ub, y1);
#pragma unroll
            for (int e = 0; e < 4; ++e) { sY[(4 * fq + e) * YS + v0 + fr] = y0[e]; sY[(16 + 4 * fq + e) * YS + v0 + fr] = y1[e]; }
            __builtin_amdgcn_sched_barrier(0);
            bf16x8 fBP[4], fKP[4]; f32x4 fPL[4];
#pragma unroll
            for (int tc = 0; tc < 4; ++tc) { fBP[tc] = *(const bf16x8*)(sBPT + PSWZ(16 * tc + fr, 8 * fq)); fKP[tc] = *(const bf16x8*)(sKPT + PSWZ(16 * tc + fr, 8 * fq)); fPL[tc] = *(const f32x4*)(sPL + 16 * tc + 4 * fq); }
            __builtin_amdgcn_sched_barrier(0);
#pragma unroll
            for (int tc = 0; tc < 4; ++tc) {
                f32x4 acc = Hacc[tc] * fPL[tc];
                acc = MFMA_BF(fBP[tc], ub, acc);
                acc = MFMA_BF(fKP[tc], vb, acc);
                Hacc[tc] = acc; }
        }
        }
        if (more) { RW_SET(par ^ 1); const int t = 32 * (c + 1) + ps;
        f32x4 r4 = {0, 0, 0, 0}, k4 = r4, v4 = r4, kk4 = r4, a4 = r4, g4 = r4, lw4 = r4;
        f32x4 rkw;
        {
            const f16x4 cr = n_cr, ck = n_ck, cv = n_cv, qr = n_qr, qk = n_qk, qv = n_qv, lw = n_lw, aa = n_aa, gg = n_gg;
            RW_PREFETCH_INC();
            const f32x4 mu_r = *(const f32x4*)(sCst + c4), mu_k = *(const f32x4*)(sCst + 64 + c4), mu_v = *(const f32x4*)(sCst + 128 + c4), kkw = *(const f32x4*)(sCst + 192 + c4), kaw = *(const f32x4*)(sCst + 256 + c4);
            rkw = *(const f32x4*)(sCst + 320 + c4);
#pragma unroll
            for (int e = 0; e < 4; ++e) {
                const float c0 = (float)cr[e], c1 = (float)ck[e], c2 = (float)cv[e];
                r4[e] = c0 + ((float)qr[e] - c0) * mu_r[e];
                const float k0 = c1 + ((float)qk[e] - c1) * mu_k[e];
                v4[e] = c2 + ((float)qv[e] - c2) * mu_v[e];
                a4[e] = (float)aa[e]; lw4[e] = (float)lw[e]; g4[e] = (float)gg[e];
                kk4[e] = k0 * kkw[e];
                k4[e] = k0 * (1.f + (a4[e] - 1.f) * kaw[e]);
            }
        }
        float ss = kk4[0] * kk4[0] + kk4[1] * kk4[1] + kk4[2] * kk4[2] + kk4[3] * kk4[3];
        float bo = r4[0] * k4[0] * rkw[0] + r4[1] * k4[1] * rkw[1] + r4[2] * k4[2] * rkw[2] + r4[3] * k4[3] * rkw[3];
        ss = row16_sum(ss); bo = row16_sum(bo);
        *(f32x4*)(sFst + tid * 4) = v4; *(f32x4*)(sFst + 2048 + tid * 4) = g4; sFst[4096 + tid] = bo;
        const float rn = __builtin_amdgcn_rsqf(ss + 1e-12f);
        f32x4 bb4;
#pragma unroll
        for (int e = 0; e < 4; ++e) { kk4[e] *= rn; bb4[e] = kk4[e] * a4[e]; }
        const f32x4 cum = cumC, tot = totC;
        {
            f32x4 xa, xb, xk, xr, xbp, xkp;
#pragma unroll
            for (int e = 0; e < 4; ++e) { const float e1 = __expf(cum[e]), e2 = __expf(-cum[e]), e3 = __expf(cum[e] - lw4[e]), e4 = __expf(tot[e] - cum[e]);
                xa[e] = -kk4[e] * e3; xb[e] = bb4[e] * e2; xk[e] = k4[e] * e2; xr[e] = r4[e] * e1; xbp[e] = bb4[e] * e4; xkp[e] = k4[e] * e4; }
            *(u32x2*)(sAt + ps * RS + chslot) = pk4(xa); *(u32x2*)(sBt + ps * RS + chslot) = pk4(xb); *(u32x2*)(sKt + ps * RS + chslot) = pk4(xk); *(u32x2*)(sRt + ps * RS + chslot) = pk4(xr);
#pragma unroll
            for (int e = 0; e < 4; e += 2) { const unsigned pb_ = cvt_pk_bf16(xbp[e], xbp[e + 1]), pk_ = cvt_pk_bf16(xkp[e], xkp[e + 1]), pv_ = cvt_pk_bf16(v4[e], v4[e + 1]);
                sBPT[PSWZ(c4 + e, pslot)] = (bf16_t)pb_; sBPT[PSWZ(c4 + e + 1, pslot)] = (bf16_t)(pb_ >> 16); sKPT[PSWZ(c4 + e, pslot)] = (bf16_t)pk_; sKPT[PSWZ(c4 + e + 1, pslot)] = (bf16_t)(pk_ >> 16);
                sVT[PSWZ(c4 + e, pslot)] = (bf16_t)pv_; sVT[PSWZ(c4 + e + 1, pslot)] = (bf16_t)(pv_ >> 16); }
            if (ps == 0) { f32x4 pl;
#pragma unroll
                for (int e = 0; e < 4; ++e) pl[e] = __expf(tot[e]);
                *(f32x4*)(sPL + c4) = pl; }
        }
        }
        __syncthreads();
        { RW_SET(par);
#pragma unroll
          for (int rr = 0; rr < 2; ++rr) {
            const int vt = rr ? tid - 384 : tid; const bool act = rr ? (wave >= 6) : (wave >= 2);
            if (act) {
                const int psv = vt >> 4, tF = 32 * c + psv;
                const f32x4 y4 = *(const f32x4*)(sY + psv * YS + c4); const f32x4 lng = *(const f32x4*)(sCst + 384 + c4), lnb = *(const f32x4*)(sCst + 448 + c4);
                const f32x4 pv4 = *(const f32x4*)(sFst + vt * 4), pg4 = *(const f32x4*)(sFst + 2048 + vt * 4); const float pbo = sFst[4096 + vt];
                const float mean = row16_sum((y4[0] + y4[1]) + (y4[2] + y4[3])) * (1.f / 64.f);
                float q = 0.f;
#pragma unroll
                for (int e = 0; e < 4; ++e) { const float d = y4[e] - mean; q += d * d; }
                const float rstd = __builtin_amdgcn_rsqf(row16_sum(q) * (1.f / 64.f) + 64e-5f);
                if (tF < TT && tF >= NMETA) {
                    f16x4 o;
#pragma unroll
                    for (int e = 0; e < 4; ++e) o[e] = (f16)((((y4[e] - mean) * rstd) * lng[e] + lnb[e] + pbo * pv4[e]) * pg4[e]);
                    *(f16x4*)(OB + (size_t)(b * SEQ + (tF - NMETA)) * 512 + hc) = o;
                }
            }
          }
        }
        f32x4 cumN = {0.f, 0.f, 0.f, 0.f}, totN = cumN;
        if (more) { RW_SET(par ^ 1);
        for (int jb = (wave < 2) ? wave : wave, jn = 0; jb < 12 && !(wave < 2 && jn > 0); jb += 6, ++jn) {
            const bf16_t *Ab, *Bb; int ta, tb;
            if (jb < 2) { ta = jb; tb = jb; Ab = sAt; Bb = sBt; }
            else if (jb == 2) { ta = 0; tb = 1; Ab = sBt; Bb = sAt; }
            else { const int ti = (jb - 3) % 3, prod = (jb - 3) / 3; ta = (ti == 2) ? 1 : 0; tb = (ti >= 1) ? 1 : 0; Ab = (prod == 1) ? sBt : sKt; Bb = (prod == 0) ? sAt : sRt; }
            f32x4 acc = {0, 0, 0, 0};
#pragma unroll
            for (int ks = 0; ks < 2; ++ks) { const bf16x8 a = *(const bf16x8*)(Ab + (16 * ta + fr) * RS + 32 * ks + 8 * fq); const bf16x8 bq = *(const bf16x8*)(Bb + (16 * tb + fr) * RS + 32 * ks + 8 * fq); acc = MFMA_BF(a, bq, acc); }
            const int rloc = 4 * fq, cloc = fr;
            if (jb < 2) {
#pragma unroll
                for (int e = 0; e < 4; ++e) acc[e] = (cloc < rloc + e) ? acc[e] : 0.f;
                *(f32x4*)(sAabT + jb * 16 * FS + cloc * FS + rloc) = acc;
                asm volatile("s_waitcnt lgkmcnt(0)" ::: "memory");
                if (lane < 16) {
                    const int col = lane;
                    const float* At_ = sAabT + jb * 16 * FS;
                    float x[16];
#pragma unroll
                    for (int s2 = 0; s2 < 16; ++s2) x[s2] = (s2 == col) ? 1.f : 0.f;
#define RW_INV_BATCH(J0, J1) do { f32x4 cv_[(J1) - (J0)][4]; \
                    _Pragma("unroll") for (int j = (J0); j < (J1); ++j) _Pragma("unroll") for (int q4 = (j + 1) / 4; q4 < 4; ++q4) cv_[j - (J0)][q4] = *(const f32x4*)(At_ + j * FS + 4 * q4); \
                    __builtin_amdgcn_sched_barrier(0); \
                    _Pragma("unroll") for (int j = (J0); j < (J1); ++j) { const float xj = x[j]; \
                        _Pragma("unroll") for (int q4 = (j + 1) / 4; q4 < 4; ++q4) _Pragma("unroll") for (int e = 0; e < 4; ++e) if (4 * q4 + e > j) x[4 * q4 + e] += cv_[j - (J0)][q4][e] * xj; } \
                    __builtin_amdgcn_sched_barrier(0); } while (0)
                    RW_INV_BATCH(0, 3); RW_INV_BATCH(3, 7); RW_INV_BATCH(7, 15);
#pragma unroll
                    for (int s2 = 0; s2 < 16; ++s2) sT[(16 * jb + s2) * PSt + 8 * (col >> 2) + (col & 3)] = f2bf(x[s2]);
                }
            } else if (jb == 2) {
                *(u32x2*)(sAabB + cloc * PSt + 8 * fq) = pk4(acc);
            } else {
                const int prod = (jb - 3) / 3; const int jrow = 16 * ta + rloc, scol = 16 * tb + cloc;
                if (prod == 0) {
#pragma unroll
                    for (int e = 0; e < 4; ++e) acc[e] = (jrow + e < scol) ? acc[e] : 0.f;
                } else {
#pragma unroll
                    for (int e = 0; e < 4; ++e) acc[e] = (jrow + e <= scol) ? acc[e] : 0.f;
                }
                *(u32x2*)(((prod == 0) ? sAak : (prod == 1) ? sMrb : sMrk) + scol * PSt + 8 * fq + 4 * ta) = pk4(acc);
            }
        }
            RW_SCAN_LOCAL(cumN, n_lw);
        }
        __syncthreads();
        if (more) { RW_SCAN_FINISH(cumN, totN); cumC = cumN; totC = totN; }
    }
    __syncthreads();
}

constexpr int SCW = 8224;
__device__ __forceinline__ void dsa_item(const Params& p, int b, int g, unsigned char* lds) {
    int tid_ = threadIdx.x; asm volatile("" : "+v"(tid_));
    const int tid = tid_, lane = tid & 63, wave = __builtin_amdgcn_readfirstlane(tid >> 6);
    const f16* PB = (const f16*)(p.ws + WS_PB); const f16* CKV = (const f16*)(p.ws + WS_CKV); const f16* KIDX = (const f16*)(p.ws + WS_KIDX); const float* WIS = (const float*)(p.ws + WS_WIS);
    f16* OLAT = (f16*)(p.ws + WS_OLAT);
    float* sc = (float*)lds;
    unsigned* hist = (unsigned*)(lds + 4 * SCW * 4);
    unsigned short* sel = (unsigned short*)(lds + 4 * SCW * 4 + 4096);
    unsigned* misc = (unsigned*)(lds + 4 * SCW * 4 + 4096 + 2048);
    f16* sq = (f16*)(lds + 4 * SCW * 4 + 4096 + 2048 + 512);
    const int i0 = 4 * g, n_adm = 80 + 64 * (i0 >> 6), ntile = (n_adm + 31) >> 5;
    const int mq0 = b * SEQ + i0;
    {
        const int rho = lane & 31, hh = lane >> 5;
        const int q = 2 * ((rho >> 2) & 1) + (rho >> 4), hd = 4 * ((rho >> 3) & 1) + (rho & 3);
        const f16* qip = PB + (size_t)(mq0 + q) * N1 + C_QI + hd * 64 + 8 * hh;
        f16x8 af[4];
#pragma unroll
        for (int ks = 0; ks < 4; ++ks) af[ks] = *(const f16x8*)(qip + 16 * ks);
        float wsc[16];
#pragma unroll
        for (int j = 0; j < 16; ++j) wsc[j] = WIS[(size_t)(mq0 + 2 * hh + (j >> 3)) * 8 + (j & 7)];
        float mn0 = INFINITY, mx0 = -INFINITY, mn1 = INFINITY, mx1 = -INFINITY;
        f16x8 bn[2][4];
#pragma unroll
        for (int u = 0; u < 2; ++u) { const f16* kp = KIDX + (size_t)b * KIDX_B + (size_t)(wave + 8 * u) * 2048 + hh * 256 + (lane & 31) * 8;
#pragma unroll
          for (int ks = 0; ks < 4; ++ks) bn[u][ks] = *(const f16x8*)(kp + 512 * ks); }
        for (int kt = wave; kt < ntile; kt += 16) {
            f16x8 bf[2][4];
#pragma unroll
            for (int u = 0; u < 2; ++u)
#pragma unroll
                for (int ks = 0; ks < 4; ++ks) bf[u][ks] = bn[u][ks];
#pragma unroll
            for (int u = 0; u < 2; ++u) { int kn = kt + 16 + 8 * u; kn = (kn < ntile) ? kn : kt;
                const f16* kp = KIDX + (size_t)b * KIDX_B + (size_t)kn * 2048 + hh * 256 + (lane & 31) * 8;
#pragma unroll
                for (int ks = 0; ks < 4; ++ks) bn[u][ks] = *(const f16x8*)(kp + 512 * ks); }
            f32x16 acc0, acc1;
#pragma unroll
            for (int j = 0; j < 16; ++j) { acc0[j] = 0.f; acc1[j] = 0.f; }
#pragma unroll
            for (int ks = 0; ks < 4; ++ks) { acc0 = __builtin_amdgcn_mfma_f32_32x32x16_f16(af[ks], bf[0][ks], acc0, 0, 0, 0); acc1 = __builtin_amdgcn_mfma_f32_32x32x16_f16(af[ks], bf[1][ks], acc1, 0, 0, 0); }
            float sa0 = 0.f, sb0 = 0.f, sa1 = 0.f, sb1 = 0.f;
#pragma unroll
            for (int jj = 0; jj < 8; ++jj) { sa0 += wsc[jj] * fmaxf(acc0[jj], 0.f); sb0 += wsc[8 + jj] * fmaxf(acc0[8 + jj], 0.f); sa1 += wsc[jj] * fmaxf(acc1[jj], 0.f); sb1 += wsc[8 + jj] * fmaxf(acc1[8 + jj], 0.f); }
            const int key0 = kt * 32 + (lane & 31), key1 = key0 + 256;
            sc[(2 * hh) * SCW + key0] = sa0; sc[(2 * hh + 1) * SCW + key0] = sb0;
            if (key0 < n_adm) { mn0 = fminf(mn0, sa0); mx0 = fmaxf(mx0, sa0); mn1 = fminf(mn1, sb0); mx1 = fmaxf(mx1, sb0); }
            if (kt + 8 < ntile) { sc[(2 * hh) * SCW + key1] = sa1; sc[(2 * hh + 1) * SCW + key1] = sb1;
                if (key1 < n_adm) { mn0 = fminf(mn0, sa1); mx0 = fmaxf(mx0, sa1); mn1 = fminf(mn1, sb1); mx1 = fmaxf(mx1, sb1); } }
        }
#pragma unroll
        for (int o = 1; o < 32; o <<= 1) { mn0 = fminf(mn0, __shfl_xor(mn0, o)); mx0 = fmaxf(mx0, __shfl_xor(mx0, o)); mn1 = fminf(mn1, __shfl_xor(mn1, o)); mx1 = fmaxf(mx1, __shfl_xor(mx1, o)); }
        float* mm = (float*)(misc + 64);
        if ((lane & 31) == 0) { mm[((2 * hh) * 8 + wave) * 2] = mn0; mm[((2 * hh) * 8 + wave) * 2 + 1] = mx0; mm[((2 * hh + 1) * 8 + wave) * 2] = mn1; mm[((2 * hh + 1) * 8 + wave) * 2 + 1] = mx1; }
        *(f16x8*)(sq + tid * 8) = *(const f16x8*)(PB + (size_t)(mq0 + (tid >> 7)) * N1 + C_QABS + (tid & 127) * 8);
    }
    const int qs = tid >> 7, tl = tid & 127;
    if (n_adm > 256) { hist[qs * 256 + tl] = 0u; hist[qs * 256 + 128 + tl] = 0u; if (tl < 4) misc[qs * 8 + 2 + tl] = 0u; }
    __syncthreads();
    int nsel;
    {
        const float* scq = sc + qs * SCW;
        if (n_adm <= 256) { for (int idx = tl; idx < n_adm; idx += 128) sel[qs * 256 + idx] = (unsigned short)idx; nsel = n_adm; }
        else {
            constexpr int NK = 65;
            const float* mm = (const float*)(misc + 64);
            float lo = INFINITY, hi = -INFINITY;
#pragma unroll
            for (int w = 0; w < 8; ++w) { lo = fminf(lo, mm[(qs * 8 + w) * 2]); hi = fmaxf(hi, mm[(qs * 8 + w) * 2 + 1]); }
            const float scale = (hi > lo) ? 16777215.f / (hi - lo) : 0.f;
            unsigned kreg[NK];
#pragma unroll
            for (int i = 0; i < NK; ++i) { const int idx = tl + 128 * i; const float v = (idx < n_adm) ? scq[idx] : lo; unsigned k = (unsigned)((v - lo) * scale); k = k > 0xFFFFFFu ? 0xFFFFFFu : k; kreg[i] = k;
                if (idx < n_adm) atomicAdd(&hist[qs * 256 + (k >> 16)], 1u); }
            __syncthreads();
            if (tl < 64) {
                const int c0 = (int)hist[qs * 256 + 4 * tl], c1 = (int)hist[qs * 256 + 4 * tl + 1], c2 = (int)hist[qs * 256 + 4 * tl + 2], c3 = (int)hist[qs * 256 + 4 * tl + 3];
                const int tot = c0 + c1 + c2 + c3; int sfx = tot;
#pragma unroll
                for (int off = 1; off < 64; off <<= 1) { const int tv = __shfl_down(sfx, off); if (tl + off < 64) sfx += tv; }
                const int above = sfx - tot;
                if (above < 256 && 256 <= sfx) { const int rem = 256 - above; int bin, nk;
                    if (rem <= c3) { bin = 4 * tl + 3; nk = rem; } else if (rem <= c3 + c2) { bin = 4 * tl + 2; nk = rem - c3; }
                    else if (rem <= c3 + c2 + c1) { bin = 4 * tl + 1; nk = rem - c3 - c2; } else { bin = 4 * tl; nk = rem - c3 - c2 - c1; }
                    misc[qs * 8] = (unsigned)bin; misc[qs * 8 + 1] = (unsigned)nk; }
            }
            __syncthreads();
            const unsigned bin = misc[qs * 8]; const int need = (int)misc[qs * 8 + 1];
            unsigned* cand = (unsigned*)(sc + qs * SCW) + 0;
            const int lane_ = tid & 63;
            __syncthreads();
#pragma unroll
            for (int i = 0; i < NK; ++i) { const int idx = tl + 128 * i; const unsigned u = kreg[i]; const bool ok = idx < n_adm; const unsigned tb = u >> 16;
                if (ok && tb > bin) { const unsigned long long m = __ballot(1); const int leader = __ffsll((long long)m) - 1; unsigned base = 0u;
                    if (lane_ == leader) base = atomicAdd(&misc[qs * 8 + 2], (unsigned)__popcll(m));
                    base = __shfl(base, leader);
                    sel[qs * 256 + base + __popcll(m & ((1ull << lane_) - 1ull))] = (unsigned short)idx; }
                else if (ok && tb == bin) { const unsigned e = atomicAdd(&misc[qs * 8 + 3], 1u); if (e < 4096u) { cand[2 * e] = u; cand[2 * e + 1] = (unsigned)idx; } } }
            __syncthreads();
            { const int m = min((int)misc[qs * 8 + 3], 4096); const int base = (int)misc[qs * 8 + 2];
              for (int i = tl; i < m; i += 128) { const unsigned ku = cand[2 * i]; const unsigned ki = cand[2 * i + 1]; int rank = 0;
                  for (int j = 0; j < m; ++j) { const unsigned kj = cand[2 * j]; const unsigned ij = cand[2 * j + 1]; rank += (kj > ku || (kj == ku && ij < ki)) ? 1 : 0; }
                  if (rank < need) sel[qs * 256 + base + rank] = (unsigned short)ki; } }
            nsel = 256;
        }
    }
    __syncthreads();
    {
        int lane_ = lane; asm volatile("" : "+v"(lane_));
        const int fr = lane_ & 15, fq = lane_ >> 4, aq = wave >> 1, rh = wave & 1;
        const unsigned short* selq = sel + aq * 256;
        unsigned char* cq = lds + aq * 32768;
        f16x8 qf[4];
#pragma unroll
        for (int ks = 0; ks < 4; ++ks) { qf[ks] = *(const f16x8*)(sq + (aq * 8 + (fr & 7)) * 128 + 32 * ks + 8 * fq); if (fr >= 8) qf[ks] = (f16x8){(f16)0.f, (f16)0.f, (f16)0.f, (f16)0.f, (f16)0.f, (f16)0.f, (f16)0.f, (f16)0.f}; }
        f16x8 I0, I1;
#pragma unroll
        for (int j = 0; j < 8; ++j) { I0[j] = (8 * fq + j == fr) ? (f16)1.f : (f16)0.f; I1[j] = (8 * fq + j == 16 + fr) ? (f16)1.f : (f16)0.f; }
        f32x4 O[4];
#pragma unroll
        for (int j = 0; j < 4; ++j) O[j] = (f32x4){0.f, 0.f, 0.f, 0.f};
        float m_run = -1e30f, l_run = 0.f;
        for (int kb = 0; kb < 2; ++kb) {
            {
                f16x8 g[16];
#pragma unroll
                for (int i = 0; i < 16; ++i) { const int rl = 64 * rh + 4 * i + fq; const int kk = 128 * kb + rl; const int kidx = (kk < nsel) ? (int)selq[kk] : 0;
                    g[i] = *(const f16x8*)(CKV + (size_t)row_of(b, kidx) * 128 + fr * 8); }
                __builtin_amdgcn_sched_barrier(0);
#pragma unroll
                for (int i = 0; i < 16; ++i) { const int rl = 64 * rh + 4 * i + fq; *(f16x8*)(cq + rl * 256 + ((fr ^ (rl & 15)) << 4)) = g[i]; }
            }
            __syncthreads();
            f32x4 S[8];
#pragma unroll
            for (int kt = 0; kt < 8; ++kt) { const int rl = 16 * kt + fr; f16x8 a[4];
#pragma unroll
                for (int ks = 0; ks < 4; ++ks) a[ks] = *(const f16x8*)(cq + rl * 256 + (((4 * ks + fq) ^ fr) << 4));
                f32x4 acc = {0.f, 0.f, 0.f, 0.f};
#pragma unroll
                for (int ks = 0; ks < 4; ++ks) acc = __builtin_amdgcn_mfma_f32_16x16x32_f16(a[ks], qf[ks], acc, 0, 0, 0);
                S[kt] = acc; }
            float mx = -1e30f;
#pragma unroll
            for (int kt = 0; kt < 8; ++kt)
#pragma unroll
                for (int e = 0; e < 4; ++e) { const float v = (128 * kb + 16 * kt + 4 * fq + e < nsel) ? S[kt][e] * 0.125f : -1e30f; S[kt][e] = v; mx = fmaxf(mx, v); }
            mx = fmaxf(mx, __shfl_xor(mx, 16)); mx = fmaxf(mx, __shfl_xor(mx, 32));
            const float m_new = fmaxf(m_run, mx);
            const float alpha = __expf(m_run - m_new);
            float sum = 0.f;
#pragma unroll
            for (int kt = 0; kt < 8; ++kt)
#pragma unroll
                for (int e = 0; e < 4; ++e) { const float pv = (S[kt][e] > -1e29f) ? __expf(S[kt][e] - m_new) : 0.f; S[kt][e] = pv; sum += pv; }
            sum += __shfl_xor(sum, 16); sum += __shfl_xor(sum, 32);
            l_run = l_run * alpha + sum; m_run = m_new;
#pragma unroll
            for (int e = 0; e < 4; ++e) { const float al = __shfl(alpha, 4 * fq + e);
#pragma unroll
                for (int j = 0; j < 4; ++j) O[j][e] *= al; }
            f16x8 Pf[4];
#pragma unroll
            for (int i = 0; i < 4; ++i)
#pragma unroll
                for (int e = 0; e < 4; ++e) { Pf[i][e] = (f16)S[2 * i][e]; Pf[i][4 + e] = (f16)S[2 * i + 1][e]; }
#pragma unroll
            for (int i = 0; i < 4; ++i) {
                const int ra = 32 * i + fr, rb = ra + 16;
                f16x8 xa[2], xb[2];
#pragma unroll
                for (int u = 0; u < 2; ++u) { xa[u] = *(const f16x8*)(cq + ra * 256 + (((4 * (2 * rh + u) + fq) ^ fr) << 4)); xb[u] = *(const f16x8*)(cq + rb * 256 + (((4 * (2 * rh + u) + fq) ^ fr) << 4)); }
#pragma unroll
                for (int j = 0; j < 4; ++j) {
                    const f32x4 z = {0.f, 0.f, 0.f, 0.f};
                    const f32x4 da = __builtin_amdgcn_mfma_f32_16x16x32_f16(xa[j >> 1], (j & 1) ? I1 : I0, z, 0, 0, 0);
                    const f32x4 db = __builtin_amdgcn_mfma_f32_16x16x32_f16(xb[j >> 1], (j & 1) ? I1 : I0, z, 0, 0, 0);
                    f16x8 bfr;
#pragma unroll
                    for (int e = 0; e < 4; ++e) { bfr[e] = (f16)da[e]; bfr[4 + e] = (f16)db[e]; }
                    O[j] = __builtin_amdgcn_mfma_f32_16x16x32_f16(Pf[i], bfr, O[j], 0, 0, 0);
                }
            }
            __syncthreads();
        }
        const float inv = 1.f / l_run;
        if (fq < 2) {
#pragma unroll
            for (int e = 0; e < 4; ++e) { const float il = __shfl(inv, 4 * fq + e);
#pragma unroll
                for (int j = 0; j < 4; ++j) OLAT[(size_t)(mq0 + aq) * 1024 + (4 * fq + e) * 128 + 64 * rh + 16 * j + fr] = (f16)(O[j][e] * il); }
        }
    }
    __syncthreads();
}

__device__ __forceinline__ void phc2_mixers(const Params& p, unsigned char* lds, int rep) {
    unsigned* ctr = (unsigned*)(p.ws + WS_CTL) + 64 + 64 * rep;
    int* s_item = (int*)(lds + 150 * 1024 - 16);
    constexpr int NRW = 16, NDSA = 2 * (SEQ / 4), NFILL = 512;
    for (;;) {
        if (threadIdx.x == 0) *s_item = (int)atomicAdd(ctr, 1u);
        __syncthreads();
        const int item = *s_item;
        __syncthreads();
        if (item >= NRW + NDSA + NFILL) break;
        if (item >= NRW + NDSA) { ph0_prep<true>(p, lds, item - (NRW + NDSA), NFILL); __syncthreads(); continue; }
        if (item < NRW) rwkv_item(p, item >> 3, item & 7, lds);
        else { const int d = item - NRW; dsa_item(p, d & 1, (SEQ / 4 - 1) - (d >> 1), lds); }
    }
}

__device__ __forceinline__ void phd3_ln1(const Params& p) {
    const int tid = threadIdx.x, lane = tid & 63, wave = tid >> 6;
    const int gw = blockIdx.x * 8 + wave, NGW = gridDim.x * 8;
    f16* H1H = (f16*)(p.ws + WS_H1H);
    for (int m = gw; m < MREAL; m += NGW) {
        float* row = p.out + (size_t)m * D;
        f32x4 v[4]; float s = 0.f;
#pragma unroll
        for (int j = 0; j < 4; ++j) { v[j] = *(const f32x4*)(row + j * 256 + lane * 4); s += (v[j].x + v[j].y) + (v[j].z + v[j].w); }
        const float mean = wave_sum(s) * (1.f / D); float s2 = 0.f;
#pragma unroll
        for (int j = 0; j < 4; ++j) { v[j] = v[j] - mean; s2 += (v[j].x * v[j].x + v[j].y * v[j].y) + (v[j].z * v[j].z + v[j].w * v[j].w); }
        const float rstd = 1.f / sqrtf(wave_sum(s2) * (1.f / D) + LN_EPS);
#pragma unroll
        for (int j = 0; j < 4; ++j) { const f32x4 g = *(const f32x4*)(p.ln1_g + j * 256 + lane * 4), bb = *(const f32x4*)(p.ln1_b + j * 256 + lane * 4);
            const f32x4 o = v[j] * rstd * g + bb; *(f32x4*)(row + j * 256 + lane * 4) = o; *(f16x4*)(H1H + (size_t)m * D + j * 256 + lane * 4) = to_h4(o); }
    }
}

#define INS16(L, x_) do { unsigned x__ = (x_); _Pragma("unroll") for (int j_ = 0; j_ < 16; ++j_) { const unsigned hi_ = max(L[j_], x__); x__ = min(L[j_], x__); L[j_] = hi_; } } while (0)
__device__ __forceinline__ void top16_of_128(const unsigned short* src, unsigned (&L)[16]) {
#pragma unroll
    for (int j = 0; j < 16; ++j) L[j] = 0u;
#pragma unroll 1
    for (int hb = 0; hb < 2; ++hb) {
        u32x4 w[8];
#pragma unroll
        for (int c = 0; c < 8; ++c) w[c] = *(const u32x4*)(src + hb * 64 + c * 8);
        __builtin_amdgcn_sched_barrier(0);
#pragma unroll
        for (int c = 0; c < 8; ++c)
#pragma unroll
            for (int e = 0; e < 8; ++e) {
                const unsigned sc16 = (w[c][e >> 1] >> (16 * (e & 1))) & 0xFFFFu;
                const unsigned key = (sc16 << 16) | (unsigned)(127 - (hb * 64 + c * 8 + e));
                INS16(L, key);
            }
    }
}
__device__ __forceinline__ void phd5_topk(const Params& p) {
    const unsigned short* SC = (const unsigned short*)(p.ws + WS_SC);
    unsigned short* EIDX = (unsigned short*)(p.ws + WS_EIDX); float* EGATE = (float*)(p.ws + WS_EGATE);
    const long gt = (long)blockIdx.x * NT + threadIdx.x, NGT = (long)gridDim.x * NT;
    for (long e = gt; e < (long)MREAL * 8; e += NGT) {
        const int m = (int)(e >> 3), h = (int)(e & 7);
        unsigned A[16], B[16];
        top16_of_128(SC + (size_t)m * 2048 + h * 256, A);
        top16_of_128(SC + (size_t)m * 2048 + h * 256 + 128, B);
        unsigned T[16];
#pragma unroll
        for (int j = 0; j < 16; ++j) T[j] = 0u;
#pragma unroll
        for (int i = 0; i < 16; ++i)
#pragma unroll
            for (int j = 0; j < 16; ++j)
                if ((i + 1) * (j + 1) <= 16) {
                    const unsigned sum = (A[i] >> 16) + (B[j] >> 16);
                    const unsigned eid = (127u - (A[i] & 0xFFFFu)) * 128u + (127u - (B[j] & 0xFFFFu));
                    INS16(T, (sum << 14) | eid);
                }
        float sumf = 0.f; float ex[16];
        const int s0 = (int)(T[0] >> 14);
#pragma unroll
        for (int j = 0; j < 16; ++j) { ex[j] = __expf((float)((int)(T[j] >> 14) - s0) * (1.f / 8192.f)); sumf += ex[j]; }
        const float inv = 1.f / sumf;
#pragma unroll
        for (int j = 0; j < 16; ++j) { EIDX[(size_t)m * 128 + h * 16 + j] = (unsigned short)(T[j] & 0x3FFFu); EGATE[(size_t)m * 128 + h * 16 + j] = ex[j] * inv; }
    }
}

__device__ __forceinline__ void dec16(const u32x4 w, float (&o)[16]) {
#pragma unroll
    for (int q = 0; q < 4; ++q) { const f32x2 lo = __builtin_amdgcn_cvt_pk_f32_fp8((int)w[q], false), hi = __builtin_amdgcn_cvt_pk_f32_fp8((int)w[q], true); o[4 * q] = lo.x; o[4 * q + 1] = lo.y; o[4 * q + 2] = hi.x; o[4 * q + 3] = hi.y; }
}
__device__ __forceinline__ float wave_sum_u(float v) {
    v = row16_sum(v);
    const float a = __builtin_bit_cast(float, __builtin_amdgcn_readlane(__builtin_bit_cast(int, v), 0)), b = __builtin_bit_cast(float, __builtin_amdgcn_readlane(__builtin_bit_cast(int, v), 16));
    const float c = __builtin_bit_cast(float, __builtin_amdgcn_readlane(__builtin_bit_cast(int, v), 32)), d = __builtin_bit_cast(float, __builtin_amdgcn_readlane(__builtin_bit_cast(int, v), 48));
    return (a + b) + (c + d);
}
__device__ __forceinline__ void phd6_gather(const Params& p) {
    const int tid = threadIdx.x, lane = tid & 63, wave = tid >> 6;
    const int gw = blockIdx.x * 8 + wave, NGW = gridDim.x * 8;
    const unsigned char* U8 = p.ws + WS_U8; const unsigned char* V8A = p.ws + WS_V8A; const unsigned char* V8B = p.ws + WS_V8B - (size_t)V8A_ROWS * D;
    const unsigned short* EIDX = (const unsigned short*)(p.ws + WS_EIDX); const float* EGATE = (const float*)(p.ws + WS_EGATE);
    for (int m = gw; m < MREAL; m += NGW) {
        float* row = p.out + (size_t)m * D + 16 * lane;
        float hv[16];
#pragma unroll
        for (int q = 0; q < 4; ++q) { const f32x4 t4 = *(const f32x4*)(row + 4 * q); hv[4 * q] = t4.x; hv[4 * q + 1] = t4.y; hv[4 * q + 2] = t4.z; hv[4 * q + 3] = t4.w; }
        const int e_lo = (int)EIDX[(size_t)m * 128 + lane], e_hi = (int)EIDX[(size_t)m * 128 + 64 + lane];
        const float g_lo = EGATE[(size_t)m * 128 + lane], g_hi = EGATE[(size_t)m * 128 + 64 + lane];
        float hd_lo = 0.f, hd_hi = 0.f;
#define G_LOAD(buf, g_, TAB) do { _Pragma("unroll") for (int i_ = 0; i_ < 8; ++i_) { const int e_ = 8 * (g_) + i_; \
            const int id_ = (e_ < 64) ? __builtin_amdgcn_readlane(e_lo, e_ & 63) : __builtin_amdgcn_readlane(e_hi, e_ & 63); \
            buf[i_] = *(const u32x4*)(((TAB) ? ((id_ < V8A_ROWS) ? V8A : V8B) : U8) + (size_t)id_ * D + 16 * lane); } } while (0)
#define U_PROC(buf, g_) do { _Pragma("unroll") for (int i_ = 0; i_ < 8; ++i_) { const int e_ = 8 * (g_) + i_; float uf[16]; dec16(buf[i_], uf); float s_ = 0.f; \
            _Pragma("unroll") for (int j_ = 0; j_ < 16; ++j_) s_ += hv[j_] * uf[j_]; s_ = wave_sum_u(s_); \
            if (e_ < 64) { if (lane == (e_ & 63)) hd_lo = s_; } else { if (lane == (e_ & 63)) hd_hi = s_; } } } while (0)
        {
            u32x4 b0[8], b1[8];
            G_LOAD(b0, 0, 0);
            for (int g2 = 0; g2 < 16; g2 += 2) {
                G_LOAD(b1, g2 + 1, 0); __builtin_amdgcn_sched_barrier(0);
                U_PROC(b0, g2); __builtin_amdgcn_sched_barrier(0);
                if (g2 + 2 < 16) { G_LOAD(b0, g2 + 2, 0); } __builtin_amdgcn_sched_barrier(0);
                U_PROC(b1, g2 + 1); __builtin_amdgcn_sched_barrier(0);
            }
        }
        hd_lo *= (1.f / 256.f); hd_hi *= (1.f / 256.f);
        const float c_lo = g_lo * 0.5f * hd_lo * (1.f + erff(hd_lo * 0.70710678118654752f)) * (1.f / 16.f);
        const float c_hi = g_hi * 0.5f * hd_hi * (1.f + erff(hd_hi * 0.70710678118654752f)) * (1.f / 16.f);
        float acc[16];
#pragma unroll
        for (int j = 0; j < 16; ++j) acc[j] = 0.f;
#define V_PROC(buf, g_) do { _Pragma("unroll") for (int i_ = 0; i_ < 8; ++i_) { const int e_ = 8 * (g_) + i_; float vf[16]; dec16(buf[i_], vf); \
            const float cf_ = (e_ < 64) ? __builtin_bit_cast(float, __builtin_amdgcn_readlane(__builtin_bit_cast(int, c_lo), e_ & 63)) : __builtin_bit_cast(float, __builtin_amdgcn_readlane(__builtin_bit_cast(int, c_hi), e_ & 63)); \
            _Pragma("unroll") for (int j_ = 0; j_ < 16; ++j_) acc[j_] += cf_ * vf[j_]; } } while (0)
        {
            u32x4 b0[8], b1[8];
            G_LOAD(b0, 0, 1);
            for (int g2 = 0; g2 < 16; g2 += 2) {
                G_LOAD(b1, g2 + 1, 1); __builtin_amdgcn_sched_barrier(0);
                V_PROC(b0, g2); __builtin_amdgcn_sched_barrier(0);
                if (g2 + 2 < 16) { G_LOAD(b0, g2 + 2, 1); } __builtin_amdgcn_sched_barrier(0);
                V_PROC(b1, g2 + 1); __builtin_amdgcn_sched_barrier(0);
            }
        }
        float sm = 0.f;
#pragma unroll
        for (int j = 0; j < 16; ++j) { acc[j] += ALPHA * hv[j]; sm += acc[j]; }
        const float mean = wave_sum_u(sm) * (1.f / D); float s2 = 0.f;
#pragma unroll
        for (int j = 0; j < 16; ++j) { acc[j] -= mean; s2 += acc[j] * acc[j]; }
        const float rstd = __builtin_amdgcn_rsqf(wave_sum_u(s2) * (1.f / D) + LN_EPS);
#pragma unroll
        for (int q = 0; q < 4; ++q) { const int col = 16 * lane + 4 * q; const f32x4 g = *(const f32x4*)(p.ln2_g + col), bb = *(const f32x4*)(p.ln2_b + col);
            f32x4 o; o.x = acc[4 * q] * rstd * g.x + bb.x; o.y = acc[4 * q + 1] * rstd * g.y + bb.y; o.z = acc[4 * q + 2] * rstd * g.z + bb.z; o.w = acc[4 * q + 3] * rstd * g.w + bb.w;
            *(f32x4*)(row + 4 * q) = o; }
    }
}

struct EpiLora {
    f16 *LW, *AA, *GG; const float *w0, *a0;
    __device__ __forceinline__ void operator()(const f32x4 (&acc)[2][2][4][2], const pg8::Unit& u, int wr, int wc, int fr, int fq) const {
        const int row0 = u.pm * 256 + wr * 64 + fr, col0 = (u.pn & 1) * 256 + wc * 32 + 4 * fq;
        if (u.pn < 2) {
#pragma unroll
            for (int bj = 0; bj < 2; ++bj)
#pragma unroll
                for (int n = 0; n < 2; ++n) { const int col = col0 + bj * 128 + n * 16; const f32x4 c = *(const f32x4*)(w0 + col);
#pragma unroll
                    for (int ai = 0; ai < 2; ++ai)
#pragma unroll
                        for (int m = 0; m < 4; ++m) { const f32x4 v = acc[ai][bj][m][n]; f16x4 o;
#pragma unroll
                            for (int e = 0; e < 4; ++e) { const float wl = -softplusf_(-(c[e] + v[e])) - 0.5f; o[e] = (f16)(-__expf(wl)); }
                            *(f16x4*)(LW + (size_t)(row0 + ai * 128 + m * 16) * 512 + col) = o; } }
        } else if (u.pn < 4) {
#pragma unroll
            for (int bj = 0; bj < 2; ++bj)
#pragma unroll
                for (int n = 0; n < 2; ++n) { const int col = col0 + bj * 128 + n * 16; const f32x4 c = *(const f32x4*)(a0 + col);
#pragma unroll
                    for (int ai = 0; ai < 2; ++ai)
#pragma unroll
                        for (int m = 0; m < 4; ++m) { const f32x4 v = acc[ai][bj][m][n]; f16x4 o;
#pragma unroll
                            for (int e = 0; e < 4; ++e) o[e] = (f16)sigmoidf_(c[e] + v[e]);
                            *(f16x4*)(AA + (size_t)(row0 + ai * 128 + m * 16) * 512 + col) = o; } }
        } else {
#pragma unroll
            for (int bj = 0; bj < 2; ++bj)
#pragma unroll
                for (int n = 0; n < 2; ++n) { const int col = col0 + bj * 128 + n * 16;
#pragma unroll
                    for (int ai = 0; ai < 2; ++ai)
#pragma unroll
                        for (int m = 0; m < 4; ++m) *(f16x4*)(GG + (size_t)(row0 + ai * 128 + m * 16) * 512 + col) = to_h4(acc[ai][bj][m][n]); }
        }
    }
};

#define XB_TMO      128
#define XB_XCNT(j)  (256  + 64 * (j))
#define XB_XSUB(j)  (1280 + 64 * (j))
#define XB_XGEN(j)  (2304 + 64 * (j))
#define XB_TOP      3328
#define XB_TOPGEN   3392
#define XCD_BAR_WORDS 3456
#define XB_SPIN_CAP (1u << 20)
__device__ __forceinline__ unsigned xb_ld(unsigned* p)              { return __hip_atomic_load(p, __ATOMIC_RELAXED, __HIP_MEMORY_SCOPE_AGENT); }
__device__ __forceinline__ unsigned xb_add(unsigned* p, unsigned v) { return __hip_atomic_fetch_add(p, v, __ATOMIC_RELAXED, __HIP_MEMORY_SCOPE_AGENT); }
__device__ __forceinline__ unsigned xb_xcc_id() { return (unsigned)__builtin_amdgcn_s_getreg((3 << 11) | 20) & 0xFu; }
#define XB_SPIN(cond, bar) do { unsigned _sp = 0; while (cond) { __builtin_amdgcn_s_sleep(1); \
    if ((++_sp & 255u) == 0u) { if (xb_ld(&(bar)[XB_TMO])) break; if (_sp > XB_SPIN_CAP) { atomicAdd(&(bar)[XB_TMO], 1u); break; } } } } while (0)
struct XcdBarrier { unsigned* bar; unsigned x; volatile LAS unsigned* st; };
__device__ __forceinline__ XcdBarrier xcd_barrier_post(unsigned* bar, volatile LAS unsigned* st) {
    XcdBarrier b; b.bar = bar; b.x = xb_xcc_id(); b.st = st;
    if (threadIdx.x == 0) (void)xb_add(&bar[XB_XCNT(b.x)], 1u);
    return b;
}
__device__ __forceinline__ void xcd_barrier_complete(unsigned* bar, unsigned x, unsigned& nloc, unsigned& nx) {
    const unsigned G = gridDim.x * gridDim.y * gridDim.z;
    unsigned sum, cnt, mine, sp = 0u;
    for (;;) {
        sum = 0u; cnt = 0u; mine = 0u;
#pragma unroll
        for (unsigned j = 0; j < 16; ++j) { const unsigned c = xb_ld(&bar[XB_XCNT(j)]); sum += c; cnt += (c > 0u) ? 1u : 0u; mine = (j == x) ? c : mine; }
        if (sum == G) break;
        __builtin_amdgcn_s_sleep(1);
        if ((++sp & 255u) == 0u) { if (xb_ld(&bar[XB_TMO])) break; if (sp > XB_SPIN_CAP) { atomicAdd(&bar[XB_TMO], 1u); break; } }
    }
    nloc = mine > 0u ? mine : 1u; nx = cnt > 0u ? cnt : 1u;
}
__device__ __forceinline__ void xcd_barrier(const XcdBarrier& b) {
    asm volatile("s_waitcnt vmcnt(0)" ::: "memory");
    __syncthreads();
    if (threadIdx.x == 0) {
        unsigned* bar = b.bar;
        __builtin_amdgcn_s_waitcnt(0);
        unsigned nloc = b.st[0], nx = b.st[1];
        if (nloc == 0u) { xcd_barrier_complete(bar, b.x, nloc, nx); b.st[0] = nloc; b.st[1] = nx; }
        const unsigned old = xb_add(&bar[XB_XSUB(b.x)], 1u);
        const unsigned gen = old / nloc;
        if (old + 1u == (gen + 1u) * nloc) {
            __builtin_amdgcn_fence(__ATOMIC_RELEASE, "agent");
            asm volatile("s_waitcnt vmcnt(0)" ::: "memory");
            const unsigned og = xb_add(&bar[XB_TOP], 1u);
            const unsigned tg = og / nx;
            if (og + 1u == (tg + 1u) * nx) xb_add(&bar[XB_TOPGEN], 1u);
            else XB_SPIN(xb_ld(&bar[XB_TOPGEN]) == tg, bar);
            __builtin_amdgcn_fence(__ATOMIC_ACQUIRE, "agent");
            xb_add(&bar[XB_XGEN(b.x)], 1u);
            asm volatile("s_waitcnt vmcnt(0)" ::: "memory");
        } else {
            XB_SPIN(xb_ld(&bar[XB_XGEN(b.x)]) == gen, bar);
            __builtin_amdgcn_fence(__ATOMIC_ACQUIRE, "agent");
            asm volatile("s_waitcnt vmcnt(0)" ::: "memory");
        }
    }
    __syncthreads();
}

constexpr int LDS_BYTES = 150 * 1024;
constexpr int REP0 = 1, REP1 = 1, REP4 = 1, REP5 = 1, REP8 = 1, REP9 = 1;
constexpr int NPHASE = 11;
__global__ void __launch_bounds__(NT) mk_fwd(Params p) {
    extern __shared__ __attribute__((aligned(16))) unsigned char lds[];
    unsigned char* ws = p.ws;
    const int lo = p.ph_lo, hi = p.ph_hi;
    volatile LAS unsigned* bst = (volatile LAS unsigned*)((LAS unsigned char*)lds + LDS_BYTES - 64);
    if (threadIdx.x < 2) bst[threadIdx.x] = 0u;
    __syncthreads();
    const XcdBarrier xbar = xcd_barrier_post((unsigned*)(ws + WS_CTL) + 4096, bst);
#define IN(k) (lo <= (k) && (k) < hi)
#define SEAM(k) do { if (IN(k) && IN((k) + 1)) xcd_barrier(xbar); } while (0)
    if (IN(0)) ph0_prep<false>(p, lds, (int)blockIdx.x, (int)gridDim.x);
    SEAM(0);
    if (IN(1)) {
        f16* PB = (f16*)(ws + WS_PB);
        auto f = [=](int row, int col, f32x4 v) { *(f16x4*)(PB + (size_t)row * N1 + col) = to_h4(v); };
        pg8::run_gemm(lds, (const f16*)(ws + WS_H0), (const f16*)(ws + WS_W1T), MR, N1, D, f);
    }
    SEAM(1);
    if (IN(2)) phc1_rowprep(p);
    SEAM(2);
    if (IN(3)) {
        pg8::Gemm g{(const f16*)((unsigned char*)p.out + DO_LORAIN), (const f16*)(ws + WS_WLT), MR, 1536, 256}; pg8::StaticOrder S; S.init(MR, 1536, (int)gridDim.x, (int)blockIdx.x);
        EpiLora E{(f16*)((unsigned char*)p.out + DO_LW), (f16*)((unsigned char*)p.out + DO_AA), (f16*)((unsigned char*)p.out + DO_GG), p.b_w0, p.b_a0};
        pg8::gemm_phase<EpiLora>((PG8_LAS unsigned char*)lds, g, S, E);
        __syncthreads();
    }
    SEAM(3);
    if (IN(4)) for (int rep = 0; rep < REP4; ++rep) { if (rep) xcd_barrier(xbar); phc2_mixers(p, lds, rep); }
    SEAM(4);
    if (IN(5)) {
        f16* MIX = (f16*)(ws + WS_MIXED); f16* TMP = (f16*)(ws + WS_TMP); const float* bg = p.b_gate;
        auto f1 = [=](int row, int col, f32x4 v) { const f32x4 c = *(const f32x4*)(bg + col); f16x4 o;
#pragma unroll
            for (int e = 0; e < 4; ++e) o[e] = (f16)sigmoidf_(v[e] + c[e]);
            *(f16x4*)(MIX + (size_t)row * D + col) = o; };
        pg8::run_gemm(lds, (const f16*)(ws + WS_H0), (const f16*)(ws + WS_WGT), MREAL, D, D, f1);
        auto f2 = [=](int row, int col, f32x4 v) { f16x4* q = (f16x4*)(MIX + (size_t)row * D + col); const f16x4 gq = *q; f16x4 o;
#pragma unroll
            for (int e = 0; e < 4; ++e) o[e] = (f16)((float)gq[e] * v[e]);
            *q = o; };
        pg8::run_gemm(lds, (const f16*)(ws + WS_OLAT), (const f16*)(ws + WS_WPAT), MREAL, D, D, f2);
        auto f3 = [=](int row, int col, f32x4 v) { const f32x4 c = *(const f32x4*)(bg + 1024 + col); f16x4 o;
#pragma unroll
            for (int e = 0; e < 4; ++e) o[e] = (f16)sigmoidf_(v[e] + c[e]);
            *(f16x4*)(TMP + (size_t)row * D + col) = o; };
        pg8::run_gemm(lds, (const f16*)(ws + WS_H0), (const f16*)(ws + WS_WGT) + (size_t)1024 * D, MREAL, D, D, f3);
        auto f4 = [=](int row, int col, f32x4 v) { f16x4* q = (f16x4*)(MIX + (size_t)row * D + col); const f16x4 m0 = *q; const f16x4 gq = *(const f16x4*)(TMP + (size_t)row * D + col); f16x4 o;
#pragma unroll
            for (int e = 0; e < 4; ++e) o[e] = (f16)((float)m0[e] + (float)gq[e] * v[e]);
            *q = o; };
        pg8::run_gemm(lds, (const f16*)(ws + WS_OB), (const f16*)(ws + WS_WPBT), MREAL, D, 512, f4);
    }
    SEAM(5);
    if (IN(6)) {
        const float* x = p.x; const float* STAT = (const float*)(ws + WS_STAT); const float* lg = p.ln_in_g; const float* lb = p.ln_in_b; float* out = p.out;
        auto f = [=](int row, int col, f32x4 v) { const f32x4 xv = *(const f32x4*)(x + (size_t)row * D + col); const float mean = STAT[2 * row], rstd = STAT[2 * row + 1];
            const f32x4 g = *(const f32x4*)(lg + col), bb = *(const f32x4*)(lb + col);
            *(f32x4*)(out + (size_t)row * D + col) = ((xv - mean) * rstd * g + bb) * ALPHA + v; };
        pg8::run_gemm(lds, (const f16*)(ws + WS_MIXED), (const f16*)(ws + WS_WOT), MREAL, D, D, f);
    }
    SEAM(6);
    if (IN(7)) phd3_ln1(p);
    SEAM(7);
    if (IN(8)) {
        unsigned short* SC = (unsigned short*)(ws + WS_SC);
        auto f = [=](int row, int col, f32x4 v) { u32x2 o; unsigned q[4];
#pragma unroll
            for (int e = 0; e < 4; ++e) q[e] = (unsigned)__float2int_rn(fminf(fmaxf((v[e] + 2.f) * 8192.f, 0.f), 65535.f));
            o.x = q[0] | (q[1] << 16); o.y = q[2] | (q[3] << 16); *(u32x2*)(SC + (size_t)row * 2048 + col) = o; };
        pg8::run_gemm(lds, (const f16*)(ws + WS_H1H), (const f16*)(ws + WS_WSKT), MREAL, 2048, D, f);
    }
    SEAM(8);
    if (IN(9)) phd5_topk(p);
    SEAM(9);
    if (IN(10)) phd6_gather(p);
#undef IN
#undef SEAM
}

extern "C" void kernel_launch(void* const* d_in, const int* in_sizes, int n_in, void* d_out, int out_size, void* d_ws, size_t ws_size, hipStream_t stream) {
    static int grid = 0;
    if (grid == 0) {
        int dev = 0, cus = 0, per_cu = 0;
        if (hipGetDevice(&dev) != hipSuccess || hipDeviceGetAttribute(&cus, hipDeviceAttributeMultiprocessorCount, dev) != hipSuccess) { fprintf(stderr, "kernel_launch: device query failed\n"); grid = -1; return; }
        if (hipFuncSetAttribute((const void*)mk_fwd, hipFuncAttributeMaxDynamicSharedMemorySize, LDS_BYTES) != hipSuccess) { fprintf(stderr, "kernel_launch: hipFuncSetAttribute failed\n"); grid = -1; return; }
        if (hipOccupancyMaxActiveBlocksPerMultiprocessor(&per_cu, (const void*)mk_fwd, NT, LDS_BYTES) != hipSuccess || per_cu < 1) { fprintf(stderr, "kernel_launch: occupancy query says %d\n", per_cu); grid = -1; return; }
        if (n_in != 33 || out_size != MREAL * D || ws_size < WS_END) { fprintf(stderr, "kernel_launch: unexpected shapes n_in %d out %d ws %zu\n", n_in, out_size, ws_size); grid = -1; return; }
        grid = cus;
    }
    if (grid < 0) return;
    (void)hipMemsetAsync((char*)d_ws + WS_CTL, 0, 1 * MiB, stream);
    Params p{};
    const float** pf = (const float**)&p;
    for (int i = 0; i < 33; ++i) pf[i] = (const float*)d_in[i];
    p.out = (float*)d_out; p.ws = (unsigned char*)d_ws; p.ph_lo = 0; p.ph_hi = NPHASE;
    void* args[] = {&p};
    hipError_t e = hipLaunchCooperativeKernel((void*)mk_fwd, dim3(grid), dim3(NT), args, LDS_BYTES, stream);
    if (e != hipSuccess) fprintf(stderr, "kernel_launch: cooperative launch failed: %s (grid %d)\n", hipGetErrorString(e), grid);
}
```

```cpp
#include <hip/hip_runtime.h>
#include <hip/hip_cooperative_groups.h>
#include <cstdio>
#include <cstdint>
namespace cg = cooperative_groups;

#define LAS __attribute__((address_space(3)))
typedef _Float16 f16;
typedef _Float16 f16x2 __attribute__((ext_vector_type(2)));
typedef _Float16 f16x4 __attribute__((ext_vector_type(4)));
typedef _Float16 f16x8 __attribute__((ext_vector_type(8)));
typedef float f32x2 __attribute__((ext_vector_type(2)));
typedef float f32x4 __attribute__((ext_vector_type(4)));
typedef float f32x16 __attribute__((ext_vector_type(16)));
typedef unsigned u32x4 __attribute__((ext_vector_type(4)));

constexpr int D = 1024, SEQ = 8192, NMETA = 16, TT = 8208;
constexpr int MREAL = 16384, MR = 16640;
constexpr int NIN = 5064;
constexpr int N1 = 3584;
constexpr int C_QABS = 0, C_QI = 1024, C_CKV = 1536, C_KI = 1664, C_WI = 1728, C_BC = 1792;
constexpr int NT = 512;
constexpr int KIDX_B = 264 * 2048;
constexpr float LN_EPS = 1e-5f;
constexpr float ALPHA = 1.189207115002721f;

__device__ __forceinline__ int row_of(int b, int t) { return t < NMETA ? MREAL + b * NMETA + t : b * SEQ + (t - NMETA); }

constexpr size_t MiB = 1u << 20;
constexpr size_t WS_CTL = 0, WS_STAT = 1 * MiB, WS_WIS = 2 * MiB, WS_W1T = 3 * MiB, WS_WGT = 10 * MiB, WS_WPAT = 14 * MiB, WS_WPBT = 16 * MiB,
                 WS_WOT = 17 * MiB, WS_WSKT = 19 * MiB, WS_WLT = 23 * MiB, WS_CKV = 24 * MiB, WS_KIDX = 29 * MiB, WS_H0 = 32 * MiB,
                 WS_OLAT = 65 * MiB, WS_OB = 97 * MiB, WS_PB = 113 * MiB, WS_U8 = 227 * MiB, WS_V8A = 243 * MiB, WS_V8B = 3 * MiB, WS_END = 256 * MiB;
constexpr int V8A_ROWS = 13312;
constexpr size_t WS_MIXED = WS_PB, WS_H1H = WS_PB, WS_TMP = WS_PB + 32 * MiB, WS_SC = WS_PB + 32 * MiB, WS_EIDX = WS_PB + 96 * MiB, WS_EGATE = WS_PB + 100 * MiB;
constexpr size_t DO_LORAIN = 0, DO_LW = 9 * MiB, DO_AA = 26 * MiB, DO_GG = 43 * MiB;

struct Params {
    const float *x, *meta, *ln_in_g, *ln_in_b, *w_in, *b_gate, *a_kv_norm_g, *a_w_uk, *a_w_uv, *a_kidx_g, *a_kidx_b, *b_mu, *b_w0, *b_w2, *b_a0, *b_a2,
        *b_g2, *b_k_k, *b_k_a, *b_r_k, *b_lnx_g, *b_lnx_b, *w_pa, *w_pb, *w_o, *ln1_g, *ln1_b, *peer_wq, *peer_subkeys, *peer_u, *peer_v, *ln2_g, *ln2_b;
    float* out;
    unsigned char* ws;
    int ph_lo, ph_hi;
};

__device__ __forceinline__ float wave_sum(float v) {
#pragma unroll
    for (int o = 1; o < 64; o <<= 1) v += __shfl_xor(v, o);
    return v;
}
__device__ __forceinline__ float wave_max(float v) {
#pragma unroll
    for (int o = 1; o < 64; o <<= 1) v = fmaxf(v, __shfl_xor(v, o));
    return v;
}
#define DPP_F(v, ctrl) __builtin_bit_cast(float, __builtin_amdgcn_update_dpp(0, __builtin_bit_cast(int, (v)), (ctrl), 0xF, 0xF, true))
__device__ __forceinline__ float row16_sum(float v) {
    v += DPP_F(v, 0xB1);
    v += DPP_F(v, 0x4E);
    v += DPP_F(v, 0x141);
    v += DPP_F(v, 0x140);
    return v;
}
__device__ __forceinline__ float sigmoidf_(float x) { return __builtin_amdgcn_rcpf(1.f + __expf(-x)); }
__device__ __forceinline__ float softplusf_(float z) { return fmaxf(z, 0.f) + __logf(1.f + __expf(-fabsf(z))); }
__device__ __forceinline__ unsigned fkey(float f) { unsigned u = __float_as_uint(f); return u ^ ((u >> 31) ? 0xFFFFFFFFu : 0x80000000u); }

namespace pg8 {
#define PG8_LAS __attribute__((address_space(3)))
typedef short h16x8 __attribute__((ext_vector_type(8)));
constexpr int BM = 256, BK = 64, HALF = 128, HTB = HALF * BK * 2, STAGE_BYTES = 8 * HTB, NXCD = 8, WGM = 8;
__host__ __device__ __forceinline__ int lds_byte(int r, int c) { const int st = (r >> 4) * 2 + (c >> 5), rr = r & 15, cc = c & 31, ob = rr * 64 + cc * 2; return st * 1024 + (ob ^ (((ob >> 9) & 1) << 5)); }
__host__ __device__ __forceinline__ void stage_rc(int b, int& R, int& C) { const int st = b / 1024, sb = b % 1024, swz = sb ^ (((sb >> 9) & 1) << 5); R = (st >> 1) * 16 + swz / 64; C = (st & 1) * 32 + (swz % 64) / 2; }
struct Unit { int pm, pn; };
struct Gemm { const f16* A; const f16* Bt; int M, N, K; };
struct StaticOrder {
    int nM, nN, nwg, G, c;
    __host__ __device__ void init(int M, int N, int G_, int c_) { nM = M / BM; nN = N / BM; nwg = nM * nN; G = G_; c = c_; }
    __host__ __device__ bool next(int i, Unit& u) const {
        const long L = (long)i * G + c; if (L >= nwg) return false;
        int wgid = (int)L; { const int q = nwg / NXCD, r = nwg % NXCD, xcd = wgid % NXCD, off = wgid / NXCD; wgid = (xcd < r ? xcd * (q + 1) : r * (q + 1) + (xcd - r) * q) + off; }
        const int nig = WGM * nN, gid = wgid / nig, fm = gid * WGM, gsz = (nM - fm) < WGM ? (nM - fm) : WGM;
        u.pm = fm + ((wgid % nig) % gsz); u.pn = (wgid % nig) / gsz; return true;
    }
};
template <class F> struct EpiElem {
    F f;
    __device__ __forceinline__ void operator()(const f32x4 (&acc)[2][2][4][2], const Unit& u, int wr, int wc, int fr, int fq) const {
        const int row0 = u.pm * BM + wr * 64 + fr, col0 = u.pn * BM + wc * 32 + 4 * fq;
#pragma unroll
        for (int ai = 0; ai < 2; ++ai)
#pragma unroll
            for (int m = 0; m < 4; ++m)
#pragma unroll
                for (int bj = 0; bj < 2; ++bj)
#pragma unroll
                    for (int n = 0; n < 2; ++n) f(row0 + ai * HALF + m * 16, col0 + bj * HALF + n * 16, acc[ai][bj][m][n]);
    }
};
template <class Epi, bool ALIGN_EPI = true, bool SP2 = true>
__device__ __forceinline__ void gemm_phase(PG8_LAS unsigned char* lds, const Gemm g, const StaticOrder& S, const Epi& E) {
    const int tid = threadIdx.x, wid = __builtin_amdgcn_readfirstlane(tid >> 6), lane = tid & 63, wr = wid >> 2, wc = wid & 3, fr = lane & 15, fq = lane >> 4;
    int K = g.K; asm volatile("" : "+s"(K));
    const int nt = K / BK;
    unsigned voffA[2], voffB[2];
#pragma unroll
    for (int i = 0; i < 2; ++i) { int R, C; stage_rc(tid * 16 + i * 8192, R, C); voffA[i] = (unsigned)(R * K + C) * 2u; voffB[i] = (unsigned)(R * K + C) * 2u; }
    const size_t kstep = (size_t)(BK * 2);
    const size_t hstep = (size_t)HALF * K * 2;
    const size_t tstep = 2 * hstep;
    const unsigned ldsw = (unsigned)wid * 1024u;
    const int aoff = lds_byte(wr * 64 + fr, fq * 8), boff = lds_byte(wc * 32 + fr, fq * 8);
#define PG8_SA(b, h) (((b) * 2 + (h)) * HTB)
#define PG8_SB(b, h) ((4 + (b) * 2 + (h)) * HTB)
#define PG8_STAGE(bufoff, gbase, voff) do { _Pragma("unroll") for (int _i = 0; _i < 2; ++_i) \
        __builtin_amdgcn_global_load_lds((const unsigned*)((const char*)(gbase) + (voff)[_i]), (PG8_LAS unsigned*)(lds + (bufoff) + ldsw + _i * 8192), 16, 0, 0); } while (0)
#define PG8_LDA(dst, b, h) do { _Pragma("unroll") for (int m = 0; m < 4; ++m) _Pragma("unroll") for (int k = 0; k < 2; ++k) dst[m][k] = *(const PG8_LAS h16x8*)(lds + PG8_SA(b, h) + aoff + m * 2048 + k * 1024); } while (0)
#define PG8_LDB(dst, b, h) do { _Pragma("unroll") for (int n = 0; n < 2; ++n) _Pragma("unroll") for (int k = 0; k < 2; ++k) dst[n][k] = *(const PG8_LAS h16x8*)(lds + PG8_SB(b, h) + boff + n * 2048 + k * 1024); } while (0)
#define PG8_MMA(ai, bj, At, Bt) do { __builtin_amdgcn_s_setprio(1); _Pragma("unroll") for (int m = 0; m < 4; ++m) _Pragma("unroll") for (int n = 0; n < 2; ++n) _Pragma("unroll") for (int k = 0; k < 2; ++k) \
        acc[ai][bj][m][n] = __builtin_amdgcn_mfma_f32_16x16x32_f16(__builtin_bit_cast(f16x8, Bt[n][k]), __builtin_bit_cast(f16x8, At[m][k]), acc[ai][bj][m][n], 0, 0, 0); __builtin_amdgcn_s_setprio(0); } while (0)
#define PG8_WAIT_V(n) asm volatile("s_waitcnt vmcnt(" #n ")" ::: "memory")
#define PG8_WAIT_L(n) asm volatile("s_waitcnt lgkmcnt(" #n ")" ::: "memory")
#define PG8_BAR __builtin_amdgcn_s_barrier()
#define PG8_SCHED __builtin_amdgcn_sched_barrier(0)
    Unit cur, nxt; int ui = 0;
    if (!S.next(0, cur)) return;
    f32x4 acc[2][2][4][2];
#pragma unroll
    for (int a = 0; a < 2; ++a)
#pragma unroll
        for (int b = 0; b < 2; ++b)
#pragma unroll
            for (int m = 0; m < 4; ++m)
#pragma unroll
                for (int n = 0; n < 2; ++n) acc[a][b][m][n] = (f32x4){0.f, 0.f, 0.f, 0.f};
    h16x8 At[4][2], B0[2][2], B1[2][2];
    const char* cA = (const char*)g.A + (size_t)cur.pm * tstep; const char* cB = (const char*)g.Bt + (size_t)cur.pn * tstep;
    if constexpr (SP2) {
        PG8_STAGE(PG8_SB(0, 0), cB, voffB); PG8_STAGE(PG8_SB(0, 1), cB + hstep, voffB); PG8_STAGE(PG8_SA(0, 0), cA, voffA); PG8_STAGE(PG8_SA(0, 1), cA + hstep, voffA);
        if (wr == 1) PG8_BAR;
        PG8_WAIT_V(2); PG8_BAR;
        PG8_STAGE(PG8_SB(1, 0), cB + kstep, voffB); PG8_STAGE(PG8_SA(1, 0), cA + kstep, voffA); PG8_STAGE(PG8_SB(1, 1), cB + hstep + kstep, voffB);
        PG8_WAIT_V(6); PG8_BAR;
    } else {
        PG8_STAGE(PG8_SB(0, 0), cB, voffB); PG8_STAGE(PG8_SA(0, 0), cA, voffA); PG8_STAGE(PG8_SB(0, 1), cB + hstep, voffB); PG8_STAGE(PG8_SA(0, 1), cA + hstep, voffA);
        if (wr == 1) PG8_BAR;
        PG8_WAIT_V(4); PG8_BAR;
        PG8_STAGE(PG8_SB(1, 0), cB + kstep, voffB); PG8_STAGE(PG8_SA(1, 0), cA + kstep, voffA); PG8_STAGE(PG8_SB(1, 1), cB + hstep + kstep, voffB);
        PG8_WAIT_V(6); PG8_BAR;
    }
    for (;;) {
        const bool has_next = S.next(ui + 1, nxt);
        const char* nA = has_next ? (const char*)g.A + (size_t)nxt.pm * tstep : cA; const char* nB = has_next ? (const char*)g.Bt + (size_t)nxt.pn * tstep : cB;
        for (int t = 0; t < nt; t += 2) {
            const bool last = (t == nt - 2);
            const char* a1 = cA + (size_t)(t + 1) * kstep;
            const char* a2 = last ? nA : cA + (size_t)(t + 2) * kstep; const char* b2 = last ? nB : cB + (size_t)(t + 2) * kstep;
            const char* a3 = a2 + kstep; const char* b3 = b2 + kstep;
            if constexpr (SP2) {
            PG8_LDB(B0, 0, 0); PG8_LDB(B1, 0, 1); PG8_SCHED; PG8_LDA(At, 0, 0); PG8_STAGE(PG8_SA(1, 1), a1 + hstep, voffA);
            PG8_WAIT_V(8); PG8_WAIT_L(0); PG8_BAR; PG8_MMA(0, 0, At, B0); PG8_MMA(0, 1, At, B1); PG8_BAR; PG8_SCHED;
            PG8_LDA(At, 0, 1); PG8_STAGE(PG8_SB(0, 0), b2, voffB); PG8_STAGE(PG8_SB(0, 1), b2 + hstep, voffB); PG8_STAGE(PG8_SA(0, 0), a2, voffA);
            PG8_WAIT_V(8); PG8_WAIT_L(0); PG8_BAR; PG8_MMA(1, 0, At, B0); PG8_MMA(1, 1, At, B1); PG8_BAR; PG8_SCHED;
            PG8_LDB(B0, 1, 0); PG8_LDB(B1, 1, 1); PG8_SCHED; PG8_LDA(At, 1, 0); PG8_STAGE(PG8_SA(0, 1), a2 + hstep, voffA);
            PG8_WAIT_V(8); PG8_WAIT_L(0); PG8_BAR; PG8_MMA(0, 0, At, B0); PG8_MMA(0, 1, At, B1); PG8_BAR; PG8_SCHED;
            PG8_LDA(At, 1, 1); PG8_STAGE(PG8_SB(1, 0), b3, voffB); PG8_STAGE(PG8_SB(1, 1), b3 + hstep, voffB); PG8_STAGE(PG8_SA(1, 0), a3, voffA);
            PG8_WAIT_V(8); PG8_WAIT_L(0); PG8_BAR; PG8_MMA(1, 0, At, B0); PG8_MMA(1, 1, At, B1); PG8_BAR; PG8_SCHED;
            } else {
            PG8_LDB(B0, 0, 0); PG8_SCHED; PG8_LDA(At, 0, 0); PG8_STAGE(PG8_SA(1, 1), a1 + hstep, voffA);
            PG8_WAIT_L(8); PG8_BAR; PG8_WAIT_L(0); PG8_MMA(0, 0, At, B0); PG8_BAR; PG8_SCHED;
            PG8_LDB(B1, 0, 1); PG8_STAGE(PG8_SB(0, 0), b2, voffB);
            PG8_BAR; PG8_WAIT_L(0); PG8_MMA(0, 1, At, B1); PG8_BAR;
            PG8_LDA(At, 0, 1); PG8_STAGE(PG8_SA(0, 0), a2, voffA);
            PG8_BAR; PG8_WAIT_L(0); PG8_MMA(1, 0, At, B0); PG8_BAR; PG8_SCHED;
            PG8_STAGE(PG8_SB(0, 1), b2 + hstep, voffB);
            PG8_WAIT_V(6); PG8_BAR; PG8_MMA(1, 1, At, B1); PG8_BAR;
            PG8_LDB(B0, 1, 0); PG8_SCHED; PG8_LDA(At, 1, 0); PG8_STAGE(PG8_SA(0, 1), a2 + hstep, voffA);
            PG8_WAIT_L(8); PG8_BAR; PG8_WAIT_L(0); PG8_MMA(0, 0, At, B0); PG8_BAR; PG8_SCHED;
            PG8_LDB(B1, 1, 1); PG8_STAGE(PG8_SB(1, 0), b3, voffB);
            PG8_BAR; PG8_WAIT_L(0); PG8_MMA(0, 1, At, B1); PG8_BAR;
            PG8_LDA(At, 1, 1); PG8_STAGE(PG8_SA(1, 0), a3, voffA);
            PG8_BAR; PG8_WAIT_L(0); PG8_MMA(1, 0, At, B0); PG8_BAR; PG8_SCHED;
            PG8_STAGE(PG8_SB(1, 1), b3 + hstep, voffB);
            PG8_WAIT_V(6); PG8_BAR; PG8_MMA(1, 1, At, B1); PG8_BAR;
            }
        }
        if constexpr (ALIGN_EPI) { if (wr == 0) PG8_BAR; }
        E(acc, cur, wr, wc, fr, fq);
        if (!has_next) break;
#pragma unroll
        for (int a = 0; a < 2; ++a)
#pragma unroll
            for (int b = 0; b < 2; ++b)
#pragma unroll
                for (int m = 0; m < 4; ++m)
#pragma unroll
                    for (int n = 0; n < 2; ++n) acc[a][b][m][n] = (f32x4){0.f, 0.f, 0.f, 0.f};
        cur = nxt; cA = nA; cB = nB; ++ui;
        if constexpr (ALIGN_EPI) { if (wr == 1) PG8_BAR; }
    }
    PG8_WAIT_V(0);
    if constexpr (!ALIGN_EPI) { if (wr == 0) PG8_BAR; }
    PG8_BAR;
#undef PG8_SA
#undef PG8_SB
#undef PG8_STAGE
#undef PG8_LDA
#undef PG8_LDB
#undef PG8_MMA
#undef PG8_WAIT_V
#undef PG8_WAIT_L
#undef PG8_BAR
#undef PG8_SCHED
}
template <class F>
__device__ __forceinline__ void run_gemm(unsigned char* lds, const f16* A, const f16* Bt, int M, int N, int K, const F& f) {
    Gemm g{A, Bt, M, N, K}; StaticOrder S; S.init(M, N, (int)gridDim.x, (int)blockIdx.x);
    EpiElem<F> E{f};
    gemm_phase<EpiElem<F>>((PG8_LAS unsigned char*)lds, g, S, E);
    __syncthreads();
}
}

__device__ __forceinline__ f16x4 to_h4(f32x4 v) { f16x4 r; r.x = (f16)v.x; r.y = (f16)v.y; r.z = (f16)v.z; r.w = (f16)v.w; return r; }

__device__ __forceinline__ void tr_item(const float* W, int ldw, int col0, int nvalid, int K, f16* out, int nrow0, int item, int nblk, float* scr, int lane) {
    const int kb = item / nblk, nb = item % nblk, k0 = 64 * kb, n0 = 32 * nb;
#pragma unroll 8
    for (int i = 0; i < 32; ++i) { const int kk = 2 * i + (lane >> 5); const int j = n0 + (lane & 31);
        scr[kk * 33 + (lane & 31)] = (j < nvalid) ? W[(size_t)(k0 + kk) * ldw + col0 + j] : 0.f; }
    asm volatile("s_waitcnt vmcnt(0) lgkmcnt(0)" ::: "memory");
    const int c = lane & 7;
#pragma unroll
    for (int jj = 0; jj < 4; ++jj) { const int n = (lane >> 3) + 8 * jj; const float* s = scr + (8 * c) * 33 + n;
        f16x8 o;
#pragma unroll
        for (int e = 0; e < 8; ++e) o[e] = (f16)s[e * 33];
        *(f16x8*)(out + (size_t)(nrow0 + n0 + n) * K + k0 + 8 * c) = o; }
    asm volatile("s_waitcnt lgkmcnt(0)" ::: "memory");
}

template <bool LATE>
__device__ __forceinline__ void ph0_prep(const Params& p, unsigned char* lds, int vwg, int nvwg) {
    int tid_ = threadIdx.x; asm volatile("" : "+v"(tid_));
    const int tid = tid_, lane = tid & 63, wave = tid >> 6;
    const int gw = vwg * 8 + wave, NGW = nvwg * 8;
    f16* H0 = (f16*)(p.ws + WS_H0); float* STAT = (float*)(p.ws + WS_STAT);
    for (int m = gw; m < (LATE ? 0 : MR); m += NGW) {
        f16* orow = H0 + (size_t)m * D;
        if (m >= MREAL + 2 * NMETA) {
#pragma unroll
            for (int j = 0; j < 4; ++j) *(f16x4*)(orow + j * 256 + lane * 4) = (f16x4){(f16)0.f, (f16)0.f, (f16)0.f, (f16)0.f};
            continue;
        }
        const float* src = (m < MREAL) ? p.x + (size_t)m * D : p.meta + (size_t)((m - MREAL) & 15) * D;
        f32x4 v[4]; float s = 0.f;
#pragma unroll
        for (int j = 0; j < 4; ++j) { v[j] = *(const f32x4*)(src + j * 256 + lane * 4); s += (v[j].x + v[j].y) + (v[j].z + v[j].w); }
        const float mean = wave_sum(s) * (1.f / D); float s2 = 0.f;
#pragma unroll
        for (int j = 0; j < 4; ++j) { v[j] = v[j] - mean; s2 += (v[j].x * v[j].x + v[j].y * v[j].y) + (v[j].z * v[j].z + v[j].w * v[j].w); }
        const float rstd = 1.f / sqrtf(wave_sum(s2) * (1.f / D) + LN_EPS);
        if (lane == 0) { STAT[2 * m] = mean; STAT[2 * m + 1] = rstd; }
#pragma unroll
        for (int j = 0; j < 4; ++j) { const f32x4 g = *(const f32x4*)(p.ln_in_g + j * 256 + lane * 4), bb = *(const f32x4*)(p.ln_in_b + j * 256 + lane * 4);
            *(f16x4*)(orow + j * 256 + lane * 4) = to_h4(v[j] * rstd * g + bb); }
    }
    float* scr = (float*)lds + wave * (64 * 33);
    f16* W1T = (f16*)(p.ws + WS_W1T); f16* WGT = (f16*)(p.ws + WS_WGT); f16* WPBT = (f16*)(p.ws + WS_WPBT); f16* WOT = (f16*)(p.ws + WS_WOT);
    constexpr int I_QI = 16 * 16, I_CKV = 4 * 16, I_KI = 4 * 16, I_BC = 56 * 16, I_G = 64 * 16, I_PB = 32 * 8, I_O = 32 * 16;
    constexpr int NITEMS = I_QI + I_CKV + I_KI + I_BC + I_G + I_PB + I_O;
    for (int it = gw + (LATE ? I_QI + I_CKV + I_KI + I_BC : 0); it < (LATE ? NITEMS : I_QI + I_CKV + I_KI + I_BC); it += NGW) {
        int r = it;
        if (r < I_QI) { tr_item(p.w_in, NIN, 640, 512, D, W1T, C_QI, r, 16, scr, lane); continue; } r -= I_QI;
        if (r < I_CKV) { tr_item(p.w_in, NIN, 512, 128, D, W1T, C_CKV, r, 4, scr, lane); continue; } r -= I_CKV;
        if (r < I_KI) { tr_item(p.w_in, NIN, 1152, 72, D, W1T, C_KI, r, 4, scr, lane); continue; } r -= I_KI;
        if (r < I_BC) { tr_item(p.w_in, NIN, 1224, 1792, D, W1T, C_BC, r, 56, scr, lane); continue; } r -= I_BC;
        if (r < I_G) { tr_item(p.w_in, NIN, 3016, 2048, D, WGT, 0, r, 64, scr, lane); continue; } r -= I_G;
        if (r < I_PB) { tr_item(p.w_pb, D, 0, 1024, 512, WPBT, 0, r, 32, scr, lane); continue; } r -= I_PB;
        tr_item(p.w_o, D, 0, 1024, D, WOT, 0, r, 32, scr, lane);
    }
    {
        const int fr = lane & 15, fq = lane >> 4;
        constexpr int T_W1 = 8 * 8 * 64, T_SK = 16 * 8 * 64, T_PA = 8 * 8 * 64;
        f16* WPAT = (f16*)(p.ws + WS_WPAT); f16* WSKT = (f16*)(p.ws + WS_WSKT);
        for (int it = gw + (LATE ? T_W1 : 0); it < (LATE ? T_W1 + T_SK + T_PA : T_W1); it += NGW) {
            int r = it; int kind = 0; if (r >= T_W1) { r -= T_W1; kind = 1; if (r >= T_SK) { r -= T_SK; kind = 2; } }
            const int g = r >> 9, mt = (r >> 6) & 7, nt = r & 63;
            const int m = 16 * mt + fr, n = 16 * nt + fr;
            const int KK = (kind == 1) ? 128 : 64;
            f32x4 acc = {0.f, 0.f, 0.f, 0.f};
            for (int k0 = 0; k0 < KK; k0 += 32) {
                const int kb = k0 + 8 * fq;
                f16x8 af, bf;
                if (kind == 0) { const float* ap = p.a_w_uk + (size_t)(m * 8 + g) * 64 + kb; const float* bp = p.w_in + (size_t)n * NIN + g * 64 + kb;
                    const f32x4 a0 = *(const f32x4*)ap, a1 = *(const f32x4*)(ap + 4), b0 = *(const f32x4*)bp, b1 = *(const f32x4*)(bp + 4);
#pragma unroll
                    for (int e = 0; e < 4; ++e) { af[e] = (f16)a0[e]; af[4 + e] = (f16)a1[e]; bf[e] = (f16)b0[e]; bf[4 + e] = (f16)b1[e]; } }
                else if (kind == 1) { const float* ap = p.peer_subkeys + (size_t)(g * 128 + m) * 128 + kb; const float* bp = p.peer_wq + (size_t)n * 2048 + g * 128 + kb;
                    const f32x4 a0 = *(const f32x4*)ap, a1 = *(const f32x4*)(ap + 4), b0 = *(const f32x4*)bp, b1 = *(const f32x4*)(bp + 4);
#pragma unroll
                    for (int e = 0; e < 4; ++e) { af[e] = (f16)a0[e]; af[4 + e] = (f16)a1[e]; bf[e] = (f16)b0[e]; bf[4 + e] = (f16)b1[e]; } }
                else { const float* ap = p.a_w_uv + (size_t)(m * 8 + g) * 64 + kb; const float* bp = p.w_pa + (size_t)(g * 64 + kb) * D + n;
                    const f32x4 a0 = *(const f32x4*)ap, a1 = *(const f32x4*)(ap + 4);
#pragma unroll
                    for (int e = 0; e < 4; ++e) { af[e] = (f16)a0[e]; af[4 + e] = (f16)a1[e]; }
#pragma unroll
                    for (int e = 0; e < 8; ++e) bf[e] = (f16)bp[(size_t)e * D]; }
                acc = __builtin_amdgcn_mfma_f32_16x16x32_f16(af, bf, acc, 0, 0, 0);
            }
            if (kind == 2) { *(f16x4*)(WPAT + (size_t)n * D + g * 128 + 16 * mt + 4 * fq) = to_h4(acc); }
            else { f16* o = ((kind == 0) ? W1T : WSKT) + (size_t)(g * 128 + 16 * mt + 4 * fq) * D + n;
#pragma unroll
                for (int e = 0; e < 4; ++e) o[(size_t)e * D] = (f16)acc[e]; }
        }
    }
    const long gt = (long)vwg * NT + tid, NGT = (long)nvwg * NT;
    f16* WLT = (f16*)(p.ws + WS_WLT);
    for (long e = gt; e < (LATE ? 0L : 1536L * 256); e += NGT) { const int n = (int)(e >> 8), k = (int)(e & 255); float v = 0.f;
        if (n < 512) { if (k < 64) v = p.b_w2[(size_t)k * 512 + n]; }
        else if (n < 1024) { if (k >= 64 && k < 128) v = p.b_a2[(size_t)(k - 64) * 512 + (n - 512)]; }
        else { if (k >= 128) v = p.b_g2[(size_t)(k - 128) * 512 + (n - 1024)]; }
        WLT[e] = (f16)v; }
    if (LATE) {
        unsigned char* U8 = p.ws + WS_U8;
        for (long e = gt; e < 16384L * 1024 / 16; e += NGT) {
            u32x4 ou, ov;
#pragma unroll
            for (int q = 0; q < 4; ++q) { const f32x4 a = *(const f32x4*)(p.peer_u + e * 16 + q * 4) * 256.f; const f32x4 c = *(const f32x4*)(p.peer_v + e * 16 + q * 4) * 16.f;
                int w = 0; w = __builtin_amdgcn_cvt_pk_fp8_f32(a[0], a[1], w, false); w = __builtin_amdgcn_cvt_pk_fp8_f32(a[2], a[3], w, true); ou[q] = (unsigned)w;
                int x = 0; x = __builtin_amdgcn_cvt_pk_fp8_f32(c[0], c[1], x, false); x = __builtin_amdgcn_cvt_pk_fp8_f32(c[2], c[3], x, true); ov[q] = (unsigned)x; }
            const long row = e >> 6;
            unsigned char* vdst = (row < V8A_ROWS) ? p.ws + WS_V8A + e * 16 : p.ws + WS_V8B + (e - (long)V8A_ROWS * 64) * 16;
            *(u32x4*)(U8 + e * 16) = ou; *(u32x4*)vdst = ov;
        }
    }
}

__device__ __forceinline__ void phc1_rowprep(const Params& p) {
    const int tid = threadIdx.x, lane = tid & 63, wave = tid >> 6;
    const int gw = blockIdx.x * 8 + wave, NGW = gridDim.x * 8;
    const f16* PB = (const f16*)(p.ws + WS_PB); f16* CKV = (f16*)(p.ws + WS_CKV); f16* KIDX = (f16*)(p.ws + WS_KIDX); float* WIS = (float*)(p.ws + WS_WIS);
    f16* LORAIN = (f16*)((unsigned char*)p.out + DO_LORAIN);
    for (int m = gw; m < MR; m += NGW) {
        if (m >= MREAL + 2 * NMETA) { *(f16x4*)(LORAIN + (size_t)m * 256 + lane * 4) = (f16x4){(f16)0.f, (f16)0.f, (f16)0.f, (f16)0.f}; continue; }
        const f16* pr = PB + (size_t)m * N1;
        { const f16x2 c2 = *(const f16x2*)(pr + C_CKV + 2 * lane); const float a = (float)c2.x, b = (float)c2.y;
          const float ss = wave_sum(a * a + b * b); const float r = 1.f / sqrtf(ss * (1.f / 128.f) + 1e-6f);
          f16x2 o; o.x = (f16)(a * r * p.a_kv_norm_g[2 * lane]); o.y = (f16)(b * r * p.a_kv_norm_g[2 * lane + 1]);
          *(f16x2*)(CKV + (size_t)m * 128 + 2 * lane) = o; }
        { const float a = (float)pr[C_KI + lane]; const float mu = wave_sum(a) * (1.f / 64.f); const float d = a - mu;
          const float var = wave_sum(d * d) * (1.f / 64.f);
          int kb_, kt_; if (m < MREAL) { kb_ = m >> 13; kt_ = NMETA + (m & 8191); } else { kb_ = (m - MREAL) >> 4; kt_ = (m - MREAL) & 15; }
          KIDX[(size_t)kb_ * KIDX_B + (size_t)(kt_ >> 5) * 2048 + (lane >> 4) * 512 + ((lane >> 3) & 1) * 256 + (kt_ & 31) * 8 + (lane & 7)] = (f16)(d * (1.f / sqrtf(var + LN_EPS)) * p.a_kidx_g[lane] + p.a_kidx_b[lane]); }
        if (lane < 8) WIS[(size_t)m * 8 + lane] = (float)pr[C_WI + lane] * 0.04419417382415922f;
        { int b, t; if (m < MREAL) { b = m >> 13; t = NMETA + (m & 8191); } else { b = (m - MREAL) >> 4; t = (m - MREAL) & 15; }
          const f16x4 cur = *(const f16x4*)(pr + C_BC + 1536 + lane * 4);
          f16x4 prv = (f16x4){(f16)0.f, (f16)0.f, (f16)0.f, (f16)0.f};
          if (t > 0) prv = *(const f16x4*)(PB + (size_t)row_of(b, t - 1) * N1 + C_BC + 1536 + lane * 4);
          const f32x4 mu = *(const f32x4*)(p.b_mu + 1536 + lane * 4);
          f16x4 o;
#pragma unroll
          for (int e = 0; e < 4; ++e) { const float c = (float)cur[e], q = (float)prv[e]; float xs = c + (q - c) * mu[e];
              const int j = lane * 4 + e; if (j < 64) xs = tanhf(xs); else if (j >= 128) xs = sigmoidf_(xs); o[e] = (f16)xs; }
          *(f16x4*)(LORAIN + (size_t)m * 256 + lane * 4) = o; }
    }
}

typedef short bf16x8 __attribute__((ext_vector_type(8)));
typedef unsigned short bf16_t;
typedef unsigned u32x2 __attribute__((ext_vector_type(2)));
typedef __bf16 bf16x2_t __attribute__((ext_vector_type(2)));
__device__ __forceinline__ unsigned cvt_pk_bf16(float lo, float hi) { const f32x2 v = {lo, hi}; const bf16x2_t b = __builtin_convertvector(v, bf16x2_t); return __builtin_bit_cast(unsigned, b); }
__device__ __forceinline__ bf16_t f2bf(float f) { unsigned u = __float_as_uint(f); return (bf16_t)((u + 0x7fffu + ((u >> 16) & 1u)) >> 16); }
__device__ __forceinline__ u32x2 pk4(f32x4 v) { u32x2 r; r.x = cvt_pk_bf16(v[0], v[1]); r.y = cvt_pk_bf16(v[2], v[3]); return r; }
__device__ __forceinline__ bf16x8 pk8(f32x4 a, f32x4 b) { u32x4 r; r.x = cvt_pk_bf16(a[0], a[1]); r.y = cvt_pk_bf16(a[2], a[3]); r.z = cvt_pk_bf16(b[0], b[1]); r.w = cvt_pk_bf16(b[2], b[3]); return __builtin_bit_cast(bf16x8, r); }
#define MFMA_BF(a, b, c) __builtin_amdgcn_mfma_f32_16x16x32_bf16((a), (b), (c), 0, 0, 0)
constexpr int RS = 72, PSt = 40, FS = 36, YS = 68;
__device__ __forceinline__ void rwkv_item(const Params& p, int b, int h, unsigned char* lds) {
    int tid_ = threadIdx.x; asm volatile("" : "+v"(tid_));
    const int tid = tid_, lane = tid & 63, wave = __builtin_amdgcn_readfirstlane(tid >> 6), fr = lane & 15, fq = lane >> 4;
    const f16* PB = (const f16*)(p.ws + WS_PB);
    const f16* LW = (const f16*)((unsigned char*)p.out + DO_LW); const f16* AA = (const f16*)((unsigned char*)p.out + DO_AA); const f16* GG = (const f16*)((unsigned char*)p.out + DO_GG);
    f16* OB = (f16*)(p.ws + WS_OB);
    constexpr int SETB = 4 * 32 * RS * 2 + 3 * 64 * PSt * 2 + 256 + 4608 * 4;
#define RW_SET(par_) bf16_t* sAt = (bf16_t*)(lds + (par_) * SETB); bf16_t* sRt = sAt + 32 * RS; bf16_t* sBt = sRt + 32 * RS; bf16_t* sKt = sBt + 32 * RS; \
        bf16_t* sBPT = sKt + 32 * RS; bf16_t* sKPT = sBPT + 64 * PSt; bf16_t* sVT = sKPT + 64 * PSt; float* sPL = (float*)(sVT + 64 * PSt); float* sFst = sPL + 64; \
        (void)sAt; (void)sRt; (void)sBt; (void)sKt; (void)sBPT; (void)sKPT; (void)sVT; (void)sPL; (void)sFst
    bf16_t* sAak = (bf16_t*)(lds + 2 * SETB); bf16_t* sMrb = sAak + 32 * PSt; bf16_t* sMrk = sMrb + 32 * PSt; bf16_t* sT = sMrk + 32 * PSt; bf16_t* sAabB = sT + 32 * PSt;
    float* sAabT = (float*)(sAabB + 16 * PSt); float* sTot = sAabT + 2 * 16 * FS; float* sY = sTot + 8 * 64;
    float* sEnd = sY + 32 * YS;
    float* sCst = sEnd;
    for (unsigned* z = (unsigned*)lds + tid; z < (unsigned*)sEnd; z += NT) *z = 0u;
    const int ps = tid >> 4, cg = tid & 15, c4 = cg * 4, hc = h * 64 + c4;
    const int chslot = 32 * (cg >> 3) + 8 * (cg & 3) + 4 * ((cg >> 2) & 1);
    const int pslot = 8 * ((ps & 15) >> 2) + 4 * (ps >> 4) + (ps & 3);
#define PSWZ(row, slot) ((row) * PSt + ((((slot) >> 3) ^ (((row) >> 3) & 3)) << 3) + ((slot) & 7))
    if (tid < 64) { sCst[tid] = p.b_mu[h * 64 + tid]; sCst[64 + tid] = p.b_mu[512 + h * 64 + tid]; sCst[128 + tid] = p.b_mu[1024 + h * 64 + tid]; sCst[192 + tid] = p.b_k_k[h * 64 + tid];
        sCst[256 + tid] = p.b_k_a[h * 64 + tid]; sCst[320 + tid] = p.b_r_k[h * 64 + tid]; sCst[384 + tid] = p.b_lnx_g[h * 64 + tid]; sCst[448 + tid] = p.b_lnx_b[h * 64 + tid]; }
    f32x4 Hacc[4];
#pragma unroll
    for (int i = 0; i < 4; ++i) Hacc[i] = (f32x4){0.f, 0.f, 0.f, 0.f};
    const f16x4 hz = (f16x4){(f16)0.f, (f16)0.f, (f16)0.f, (f16)0.f};
    f16x4 n_cr = hz, n_ck = hz, n_cv = hz, n_qr = hz, n_qk = hz, n_qv = hz, n_lw = hz, n_aa = hz, n_gg = hz;
#define RW_PREFETCH(tt) do { const int _t = (tt); n_cr = hz; n_ck = hz; n_cv = hz; n_qr = hz; n_qk = hz; n_qv = hz; n_lw = hz; n_aa = hz; n_gg = hz; \
        if (_t < TT) { const int _m = row_of(b, _t); const f16* _pr = PB + (size_t)_m * N1 + C_BC + hc; n_cr = *(const f16x4*)(_pr); n_ck = *(const f16x4*)(_pr + 512); n_cv = *(const f16x4*)(_pr + 1024); \
            if (_t > 0) { const f16* _pp = PB + (size_t)row_of(b, _t - 1) * N1 + C_BC + hc; n_qr = *(const f16x4*)(_pp); n_qk = *(const f16x4*)(_pp + 512); n_qv = *(const f16x4*)(_pp + 1024); } \
            n_lw = *(const f16x4*)(LW + (size_t)_m * 512 + hc); n_aa = *(const f16x4*)(AA + (size_t)_m * 512 + hc); n_gg = *(const f16x4*)(GG + (size_t)_m * 512 + hc); } } while (0)
    const f16* pf_pb = PB + (size_t)(b * SEQ + 32 - NMETA + ps) * N1 + C_BC + hc;
    size_t pf_lo = (size_t)(b * SEQ + 32 - NMETA + ps) * 512 + hc; int pf_t = 32 + ps;
#define RW_PREFETCH_INC() do { n_cr = hz; n_ck = hz; n_cv = hz; n_qr = hz; n_qk = hz; n_qv = hz; n_lw = hz; n_aa = hz; n_gg = hz; \
        if (pf_t < TT) { n_cr = *(const f16x4*)(pf_pb); n_ck = *(const f16x4*)(pf_pb + 512); n_cv = *(const f16x4*)(pf_pb + 1024); \
            n_qr = *(const f16x4*)(pf_pb - N1); n_qk = *(const f16x4*)(pf_pb - N1 + 512); n_qv = *(const f16x4*)(pf_pb - N1 + 1024); \
            n_lw = *(const f16x4*)(LW + pf_lo); n_aa = *(const f16x4*)(AA + pf_lo); n_gg = *(const f16x4*)(GG + pf_lo); } \
        pf_pb += 32 * N1; pf_lo += 32 * 512; pf_t += 32; } while (0)
    RW_PREFETCH(ps);
    __syncthreads();
#define RW_SCAN_LOCAL(dst, lwv) do { dst = (f32x4){(float)(lwv)[0], (float)(lwv)[1], (float)(lwv)[2], (float)(lwv)[3]}; f32x4 u1_; \
        _Pragma("unroll") for (int e = 0; e < 4; ++e) u1_[e] = __shfl_up(dst[e], 16); if (lane >= 16) dst += u1_; \
        _Pragma("unroll") for (int e = 0; e < 4; ++e) u1_[e] = __shfl_up(dst[e], 32); if (lane >= 32) dst += u1_; \
        if (lane >= 48) *(f32x4*)(sTot + wave * 64 + c4) = dst; } while (0)
#define RW_SCAN_FINISH(dst, totv) do { totv = (f32x4){0.f, 0.f, 0.f, 0.f}; f32x4 tw_[8]; \
        _Pragma("unroll") for (int w = 0; w < 8; ++w) tw_[w] = *(const f32x4*)(sTot + w * 64 + c4); \
        __builtin_amdgcn_sched_barrier(0); \
        _Pragma("unroll") for (int w = 0; w < 8; ++w) { totv += tw_[w]; const float msk_ = (w < wave) ? 1.f : 0.f; dst += tw_[w] * msk_; } } while (0)
    f32x4 cumC, totC;
    RW_SCAN_LOCAL(cumC, n_lw);
    __syncthreads();
    RW_SCAN_FINISH(cumC, totC);
    __syncthreads();
    constexpr int NCH = (TT + 31) / 32;
    { RW_SET(0); const int t = ps;
        f32x4 r4 = {0, 0, 0, 0}, k4 = r4, v4 = r4, kk4 = r4, a4 = r4, g4 = r4, lw4 = r4;
        f32x4 rkw;
        {
            const f16x4 cr = n_cr, ck = n_ck, cv = n_cv, qr = n_qr, qk = n_qk, qv = n_qv, lw = n_lw, aa = n_aa, gg = n_gg;
            RW_PREFETCH_INC();
            const f32x4 mu_r = *(const f32x4*)(sCst + c4), mu_k = *(const f32x4*)(sCst + 64 + c4), mu_v = *(const f32x4*)(sCst + 128 + c4), kkw = *(const f32x4*)(sCst + 192 + c4), kaw = *(const f32x4*)(sCst + 256 + c4);
            rkw = *(const f32x4*)(sCst + 320 + c4);
#pragma unroll
            for (int e = 0; e < 4; ++e) {
                const float c0 = (float)cr[e], c1 = (float)ck[e], c2 = (float)cv[e];
                r4[e] = c0 + ((float)qr[e] - c0) * mu_r[e];
                const float k0 = c1 + ((float)qk[e] - c1) * mu_k[e];
                v4[e] = c2 + ((float)qv[e] - c2) * mu_v[e];
                a4[e] = (float)aa[e]; lw4[e] = (float)lw[e]; g4[e] = (float)gg[e];
                kk4[e] = k0 * kkw[e];
                k4[e] = k0 * (1.f + (a4[e] - 1.f) * kaw[e]);
            }
        }
        float ss = kk4[0] * kk4[0] + kk4[1] * kk4[1] + kk4[2] * kk4[2] + kk4[3] * kk4[3];
        float bo = r4[0] * k4[0] * rkw[0] + r4[1] * k4[1] * rkw[1] + r4[2] * k4[2] * rkw[2] + r4[3] * k4[3] * rkw[3];
        ss = row16_sum(ss); bo = row16_sum(bo);
        *(f32x4*)(sFst + tid * 4) = v4; *(f32x4*)(sFst + 2048 + tid * 4) = g4; sFst[4096 + tid] = bo;
        const float rn = __builtin_amdgcn_rsqf(ss + 1e-12f);
        f32x4 bb4;
#pragma unroll
        for (int e = 0; e < 4; ++e) { kk4[e] *= rn; bb4[e] = kk4[e] * a4[e]; }
        const f32x4 cum = cumC, tot = totC;
        {
            f32x4 xa, xb, xk, xr, xbp, xkp;
#pragma unroll
            for (int e = 0; e < 4; ++e) { const float e1 = __expf(cum[e]), e2 = __expf(-cum[e]), e3 = __expf(cum[e] - lw4[e]), e4 = __expf(tot[e] - cum[e]);
                xa[e] = -kk4[e] * e3; xb[e] = bb4[e] * e2; xk[e] = k4[e] * e2; xr[e] = r4[e] * e1; xbp[e] = bb4[e] * e4; xkp[e] = k4[e] * e4; }
            *(u32x2*)(sAt + ps * RS + chslot) = pk4(xa); *(u32x2*)(sBt + ps * RS + chslot) = pk4(xb); *(u32x2*)(sKt + ps * RS + chslot) = pk4(xk); *(u32x2*)(sRt + ps * RS + chslot) = pk4(xr);
#pragma unroll
            for (int e = 0; e < 4; e += 2) { const unsigned pb_ = cvt_pk_bf16(xbp[e], xbp[e + 1]), pk_ = cvt_pk_bf16(xkp[e], xkp[e + 1]), pv_ = cvt_pk_bf16(v4[e], v4[e + 1]);
                sBPT[PSWZ(c4 + e, pslot)] = (bf16_t)pb_; sBPT[PSWZ(c4 + e + 1, pslot)] = (bf16_t)(pb_ >> 16); sKPT[PSWZ(c4 + e, pslot)] = (bf16_t)pk_; sKPT[PSWZ(c4 + e + 1, pslot)] = (bf16_t)(pk_ >> 16);
                sVT[PSWZ(c4 + e, pslot)] = (bf16_t)pv_; sVT[PSWZ(c4 + e + 1, pslot)] = (bf16_t)(pv_ >> 16); }
            if (ps == 0) { f32x4 pl;
#pragma unroll
                for (int e = 0; e < 4; ++e) pl[e] = __expf(tot[e]);
                *(f32x4*)(sPL + c4) = pl; }
        }
    }
    __syncthreads();
    { RW_SET(0);
        for (int jb = (wave < 2) ? wave : wave, jn = 0; jb < 12 && !(wave < 2 && jn > 0); jb += 6, ++jn) {
            const bf16_t *Ab, *Bb; int ta, tb;
            if (jb < 2) { ta = jb; tb = jb; Ab = sAt; Bb = sBt; }
            else if (jb == 2) { ta = 0; tb = 1; Ab = sBt; Bb = sAt; }
            else { const int ti = (jb - 3) % 3, prod = (jb - 3) / 3; ta = (ti == 2) ? 1 : 0; tb = (ti >= 1) ? 1 : 0; Ab = (prod == 1) ? sBt : sKt; Bb = (prod == 0) ? sAt : sRt; }
            f32x4 acc = {0, 0, 0, 0};
#pragma unroll
            for (int ks = 0; ks < 2; ++ks) { const bf16x8 a = *(const bf16x8*)(Ab + (16 * ta + fr) * RS + 32 * ks + 8 * fq); const bf16x8 bq = *(const bf16x8*)(Bb + (16 * tb + fr) * RS + 32 * ks + 8 * fq); acc = MFMA_BF(a, bq, acc); }
            const int rloc = 4 * fq, cloc = fr;
            if (jb < 2) {
#pragma unroll
                for (int e = 0; e < 4; ++e) acc[e] = (cloc < rloc + e) ? acc[e] : 0.f;
                *(f32x4*)(sAabT + jb * 16 * FS + cloc * FS + rloc) = acc;
                asm volatile("s_waitcnt lgkmcnt(0)" ::: "memory");
                if (lane < 16) {
                    const int col = lane;
                    const float* At_ = sAabT + jb * 16 * FS;
                    float x[16];
#pragma unroll
                    for (int s2 = 0; s2 < 16; ++s2) x[s2] = (s2 == col) ? 1.f : 0.f;
#define RW_INV_BATCH(J0, J1) do { f32x4 cv_[(J1) - (J0)][4]; \
                    _Pragma("unroll") for (int j = (J0); j < (J1); ++j) _Pragma("unroll") for (int q4 = (j + 1) / 4; q4 < 4; ++q4) cv_[j - (J0)][q4] = *(const f32x4*)(At_ + j * FS + 4 * q4); \
                    __builtin_amdgcn_sched_barrier(0); \
                    _Pragma("unroll") for (int j = (J0); j < (J1); ++j) { const float xj = x[j]; \
                        _Pragma("unroll") for (int q4 = (j + 1) / 4; q4 < 4; ++q4) _Pragma("unroll") for (int e = 0; e < 4; ++e) if (4 * q4 + e > j) x[4 * q4 + e] += cv_[j - (J0)][q4][e] * xj; } \
                    __builtin_amdgcn_sched_barrier(0); } while (0)
                    RW_INV_BATCH(0, 3); RW_INV_BATCH(3, 7); RW_INV_BATCH(7, 15);
#pragma unroll
                    for (int s2 = 0; s2 < 16; ++s2) sT[(16 * jb + s2) * PSt + 8 * (col >> 2) + (col & 3)] = f2bf(x[s2]);
                }
            } else if (jb == 2) {
                *(u32x2*)(sAabB + cloc * PSt + 8 * fq) = pk4(acc);
            } else {
                const int prod = (jb - 3) / 3; const int jrow = 16 * ta + rloc, scol = 16 * tb + cloc;
                if (prod == 0) {
#pragma unroll
                    for (int e = 0; e < 4; ++e) acc[e] = (jrow + e < scol) ? acc[e] : 0.f;
                } else {
#pragma unroll
                    for (int e = 0; e < 4; ++e) acc[e] = (jrow + e <= scol) ? acc[e] : 0.f;
                }
                *(u32x2*)(((prod == 0) ? sAak : (prod == 1) ? sMrb : sMrk) + scol * PSt + 8 * fq + 4 * ta) = pk4(acc);
            }
        }
    }
    { f32x4 cumN, totN; RW_SCAN_LOCAL(cumN, n_lw); __syncthreads(); RW_SCAN_FINISH(cumN, totN); cumC = cumN; totC = totN; }
    for (int c = 0; c < NCH; ++c) {
        const int par = c & 1; const bool more = (c + 1 < NCH);
        { RW_SET(par);
        if (wave < 4) {
            const int v0 = 16 * wave;
            const f32x4 z4 = {0.f, 0.f, 0.f, 0.f};
            const bf16x8 hb0 = pk8(Hacc[0], Hacc[1]), hb1 = pk8(Hacc[2], Hacc[3]);
            const bf16x8 vb = *(const bf16x8*)(sVT + PSWZ(v0 + fr, 8 * fq));
            bf16x8 fAt[2][2], fAak[2], fT[2], fAabB;
#pragma unroll
            for (int ts = 0; ts < 2; ++ts) { const bf16_t* atr = sAt + (16 * ts + fr) * RS;
                fAt[ts][0] = *(const bf16x8*)(atr + 8 * fq); fAt[ts][1] = *(const bf16x8*)(atr + 32 + 8 * fq); fAak[ts] = *(const bf16x8*)(sAak + (16 * ts + fr) * PSt + 8 * fq); fT[ts] = *(const bf16x8*)(sT + (16 * ts + fr) * PSt + 8 * fq); }
            fAabB = *(const bf16x8*)(sAabB + fr * PSt + 8 * fq);
            __builtin_amdgcn_sched_barrier(0);
            f32x4 zt = MFMA_BF(fAt[0][0], hb0, z4); f32x4 zb = MFMA_BF(fAt[1][0], hb0, z4);
            zt = MFMA_BF(fAt[0][1], hb1, zt); zb = MFMA_BF(fAt[1][1], hb1, zb);
            zt = MFMA_BF(fAak[0], vb, zt); zb = MFMA_BF(fAak[1], vb, zb);
            bf16x8 fRt[2][2], fMrk[2], fMrb[2];
#pragma unroll
            for (int ts = 0; ts < 2; ++ts) { const bf16_t* rtr = sRt + (16 * ts + fr) * RS;
                fRt[ts][0] = *(const bf16x8*)(rtr + 8 * fq); fRt[ts][1] = *(const bf16x8*)(rtr + 32 + 8 * fq);
                fMrk[ts] = *(const bf16x8*)(sMrk + (16 * ts + fr) * PSt + 8 * fq); fMrb[ts] = *(const bf16x8*)(sMrb + (16 * ts + fr) * PSt + 8 * fq); }
            __builtin_amdgcn_sched_barrier(0);
            const f32x4 ut = MFMA_BF(fT[0], pk8(zt, z4), z4);
            f32x4 y0 = MFMA_BF(fRt[0][0], hb0, z4); f32x4 y1 = MFMA_BF(fRt[1][0], hb0, z4);
            y0 = MFMA_BF(fRt[0][1], hb1, y0); y1 = MFMA_BF(fRt[1][1], hb1, y1);
            zb = MFMA_BF(fAabB, pk8(ut, z4), zb);
            y0 = MFMA_BF(fMrk[0], vb, y0); y1 = MFMA_BF(fMrk[1], vb, y1);
            const f32x4 ubt = MFMA_BF(fT[1], pk8(zb, z4), z4);
            const bf16x8 ub = pk8(ut, ubt);
            y0 = MFMA_BF(fMrb[0], ub, y0); y1 = MFMA_BF(fMrb[1], ub, y1);
#pragma unroll
            for (int e = 0; e < 4; ++e) { sY[(4 * fq + e) * YS + v0 + fr] = y0[e]; sY[(16 + 4 * fq + e) * YS + v0 + fr] = y1[e]; }
            __builtin_amdgcn_sched_barrier(0);
            bf16x8 fBP[4], fKP[4]; f32x4 fPL[4];
#pragma unroll
            for (int tc = 0; tc < 4; ++tc) { fBP[tc] = *(const bf16x8*)(sBPT + PSWZ(16 * tc + fr, 8 * fq)); fKP[tc] = *(const bf16x8*)(sKPT + PSWZ(16 * tc + fr, 8 * fq)); fPL[tc] = *(const f32x4*)(sPL + 16 * tc + 4 * fq); }
            __builtin_amdgcn_sched_barrier(0);
#pragma unroll
            for (int tc = 0; tc < 4; ++tc) {
                f32x4 acc = Hacc[tc] * fPL[tc];
                acc = MFMA_BF(fBP[tc], ub, acc);
                acc = MFMA_BF(fKP[tc], vb, acc);
                Hacc[tc] = acc; }
        }
        }
        if (more) { RW_SET(par ^ 1); const int t = 32 * (c + 1) + ps;
        f32x4 r4 = {0, 0, 0, 0}, k4 = r4, v4 = r4, kk4 = r4, a4 = r4, g4 = r4, lw4 = r4;
        f32x4 rkw;
        {
            const f16x4 cr = n_cr, ck = n_ck, cv = n_cv, qr = n_qr, qk = n_qk, qv = n_qv, lw = n_lw, aa = n_aa, gg = n_gg;
            RW_PREFETCH_INC();
            const f32x4 mu_r = *(const f32x4*)(sCst + c4), mu_k = *(const f32x4*)(sCst + 64 + c4), mu_v = *(const f32x4*)(sCst + 128 + c4), kkw = *(const f32x4*)(sCst + 192 + c4), kaw = *(const f32x4*)(sCst + 256 + c4);
            rkw = *(const f32x4*)(sCst + 320 + c4);
#pragma unroll
            for (int e = 0; e < 4; ++e) {
                const float c0 = (float)cr[e], c1 = (float)ck[e], c2 = (float)cv[e];
                r4[e] = c0 + ((float)qr[e] - c0) * mu_r[e];
                const float k0 = c1 + ((float)qk[e] - c1) * mu_k[e];
                v4[e] = c2 + ((float)qv[e] - c2) * mu_v[e];
                a4[e] = (float)aa[e]; lw4[e] = (float)lw[e]; g4[e] = (float)gg[e];
                kk4[e] = k0 * kkw[e];
                k4[e] = k0 * (1.f + (a4[e] - 1.f) * kaw[e]);
            }
        }
        float ss = kk4[0] * kk4[0] + kk4[1] * kk4[1] + kk4[2] * kk4[2] + kk4[3] * kk4[3];
        float bo = r4[0] * k4[0] * rkw[0] + r4[1] * k4[1] * rkw[1] + r4[2] * k4[2] * rkw[2] + r4[3] * k4[3] * rkw[3];
        ss = row16_sum(ss); bo = row16_sum(bo);
        *(f32x4*)(sFst + tid * 4) = v4; *(f32x4*)(sFst + 2048 + tid * 4) = g4; sFst[4096 + tid] = bo;
        const float rn = __builtin_amdgcn_rsqf(ss + 1e-12f);
        f32x4 bb4;
#pragma unroll
        for (int e = 0; e < 4; ++e) { kk4[e] *= rn; bb4[e] = kk4[e] * a4[e]; }
        const f32x4 cum = cumC, tot = totC;
        {
            f32x4 xa, xb, xk, xr, xbp, xkp;
#pragma unroll
            for (int e = 0; e < 4; ++e) { const float e1 = __expf(cum[e]), e2 = __expf(-cum[e]), e3 = __expf(cum[e] - lw4[e]), e4 = __expf(tot[e] - cum[e]);
                xa[e] = -kk4[e] * e3; xb[e] = bb4[e] * e2; xk[e] = k4[e] * e2; xr[e] = r4[e] * e1; xbp[e] = bb4[e] * e4; xkp[e] = k4[e] * e4; }
            *(u32x2*)(sAt + ps * RS + chslot) = pk4(xa); *(u32x2*)(sBt + ps * RS + chslot) = pk4(xb); *(u32x2*)(sKt + ps * RS + chslot) = pk4(xk); *(u32x2*)(sRt + ps * RS + chslot) = pk4(xr);
#pragma unroll
            for (int e = 0; e < 4; e += 2) { const unsigned pb_ = cvt_pk_bf16(xbp[e], xbp[e + 1]), pk_ = cvt_pk_bf16(xkp[e], xkp[e + 1]), pv_ = cvt_pk_bf16(v4[e], v4[e + 1]);
                sBPT[PSWZ(c4 + e, pslot)] = (bf16_t)pb_; sBPT[PSWZ(c4 + e + 1, pslot)] = (bf16_t)(pb_ >> 16); sKPT[PSWZ(c4 + e, pslot)] = (bf16_t)pk_; sKPT[PSWZ(c4 + e + 1, pslot)] = (bf16_t)(pk_ >> 16);
                sVT[PSWZ(c4 + e, pslot)] = (bf16_t)pv_; sVT[PSWZ(c4 + e + 1, pslot)] = (bf16_t)(pv_ >> 16); }
            if (ps == 0) { f32x4 pl;
#pragma unroll
                for (int e = 0; e < 4; ++e) pl[e] = __expf(tot[e]);
                *(f32x4*)(sPL + c4) = pl; }
        }
        }
        __syncthreads();
        { RW_SET(par);
#pragma unroll
          for (int rr = 0; rr < 2; ++rr) {
            const int vt = rr ? tid - 384 : tid; const bool act = rr ? (wave >= 6) : (wave >= 2);
            if (act) {
                const int psv = vt >> 4, tF = 32 * c + psv;
                const f32x4 y4 = *(const f32x4*)(sY + psv * YS + c4); const f32x4 lng = *(const f32x4*)(sCst + 384 + c4), lnb = *(const f32x4*)(sCst + 448 + c4);
                const f32x4 pv4 = *(const f32x4*)(sFst + vt * 4), pg4 = *(const f32x4*)(sFst + 2048 + vt * 4); const float pbo = sFst[4096 + vt];
                const float mean = row16_sum((y4[0] + y4[1]) + (y4[2] + y4[3])) * (1.f / 64.f);
                float q = 0.f;
#pragma unroll
                for (int e = 0; e < 4; ++e) { const float d = y4[e] - mean; q += d * d; }
                const float rstd = __builtin_amdgcn_rsqf(row16_sum(q) * (1.f / 64.f) + 64e-5f);
                if (tF < TT && tF >= NMETA) {
                    f16x4 o;
#pragma unroll
                    for (int e = 0; e < 4; ++e) o[e] = (f16)((((y4[e] - mean) * rstd) * lng[e] + lnb[e] + pbo * pv4[e]) * pg4[e]);
                    *(f16x4*)(OB + (size_t)(b * SEQ + (tF - NMETA)) * 512 + hc) = o;
                }
            }
          }
        }
        f32x4 cumN = {0.f, 0.f, 0.f, 0.f}, totN = cumN;
        if (more) { RW_SET(par ^ 1);
        for (int jb = (wave < 2) ? wave : wave, jn = 0; jb < 12 && !(wave < 2 && jn > 0); jb += 6, ++jn) {
            const bf16_t *Ab, *Bb; int ta, tb;
            if (jb < 2) { ta = jb; tb = jb; Ab = sAt; Bb = sBt; }
            else if (jb == 2) { ta = 0; tb = 1; Ab = sBt; Bb = sAt; }
            else { const int ti = (jb - 3) % 3, prod = (jb - 3) / 3; ta = (ti == 2) ? 1 : 0; tb = (ti >= 1) ? 1 : 0; Ab = (prod == 1) ? sBt : sKt; Bb = (prod == 0) ? sAt : sRt; }
            f32x4 acc = {0, 0, 0, 0};
#pragma unroll
            for (int ks = 0; ks < 2; ++ks) { const bf16x8 a = *(const bf16x8*)(Ab + (16 * ta + fr) * RS + 32 * ks + 8 * fq); const bf16x8 bq = *(const bf16x8*)(Bb + (16 * tb + fr) * RS + 32 * ks + 8 * fq); acc = MFMA_BF(a, bq, acc); }
            const int rloc = 4 * fq, cloc = fr;
            if (jb < 2) {
#pragma unroll
                for (int e = 0; e < 4; ++e) acc[e] = (cloc < rloc + e) ? acc[e] : 0.f;
                *(f32x4*)(sAabT + jb * 16 * FS + cloc * FS + rloc) = acc;
                asm volatile("s_waitcnt lgkmcnt(0)" ::: "memory");
                if (lane < 16) {
                    const int col = lane;
                    const float* At_ = sAabT + jb * 16 * FS;
                    float x[16];
#pragma unroll
                    for (int s2 = 0; s2 < 16; ++s2) x[s2] = (s2 == col) ? 1.f : 0.f;
#define RW_INV_BATCH(J0, J1) do { f32x4 cv_[(J1) - (J0)][4]; \
                    _Pragma("unroll") for (int j = (J0); j < (J1); ++j) _Pragma("unroll") for (int q4 = (j + 1) / 4; q4 < 4; ++q4) cv_[j - (J0)][q4] = *(const f32x4*)(At_ + j * FS + 4 * q4); \
                    __builtin_amdgcn_sched_barrier(0); \
                    _Pragma("unroll") for (int j = (J0); j < (J1); ++j) { const float xj = x[j]; \
                        _Pragma("unroll") for (int q4 = (j + 1) / 4; q4 < 4; ++q4) _Pragma("unroll") for (int e = 0; e < 4; ++e) if (4 * q4 + e > j) x[4 * q4 + e] += cv_[j - (J0)][q4][e] * xj; } \
                    __builtin_amdgcn_sched_barrier(0); } while (0)
                    RW_INV_BATCH(0, 3); RW_INV_BATCH(3, 7); RW_INV_BATCH(7, 15);
#pragma unroll
                    for (int s2 = 0; s2 < 16; ++s2) sT[(16 * jb + s2) * PSt + 8 * (col >> 2) + (col & 3)] = f2bf(x[s2]);
                }
            } else if (jb == 2) {
                *(u32x2*)(sAabB + cloc * PSt + 8 * fq) = pk4(acc);
            } else {
                const int prod = (jb - 3) / 3; const int jrow = 16 * ta + rloc, scol = 16 * tb + cloc;
                if (prod == 0) {
#pragma unroll
                    for (int e = 0; e < 4; ++e) acc[e] = (jrow + e < scol) ? acc[e] : 0.f;
                } else {
#pragma unroll
                    for (int e = 0; e < 4; ++e) acc[e] = (jrow + e <= scol) ? acc[e] : 0.f;
                }
                *(u32x2*)(((prod == 0) ? sAak : (prod == 1) ? sMrb : sMrk) + scol * PSt + 8 * fq + 4 * ta) = pk4(acc);
            }
        }
            RW_SCAN_LOCAL(cumN, n_lw);
        }
        __syncthreads();
        if (more) { RW_SCAN_FINISH(cumN, totN); cumC = cumN; totC = totN; }
    }
    __syncthreads();
}

constexpr int SCW = 8224;
__device__ __forceinline__ void dsa_item(const Params& p, int b, int g, unsigned char* lds) {
    int tid_ = threadIdx.x; asm volatile("" : "+v"(tid_));
    const int tid = tid_, lane = tid & 63, wave = __builtin_amdgcn_readfirstlane(tid >> 6);
    const f16* PB = (const f16*)(p.ws + WS_PB); const f16* CKV = (const f16*)(p.ws + WS_CKV); const f16* KIDX = (const f16*)(p.ws + WS_KIDX); const float* WIS = (const float*)(p.ws + WS_WIS);
    f16* OLAT = (f16*)(p.ws + WS_OLAT);
    float* sc = (float*)lds;
    unsigned* hist = (unsigned*)(lds + 4 * SCW * 4);
    unsigned short* sel = (unsigned short*)(lds + 4 * SCW * 4 + 4096);
    unsigned* misc = (unsigned*)(lds + 4 * SCW * 4 + 4096 + 2048);
    f16* sq = (f16*)(lds + 4 * SCW * 4 + 4096 + 2048 + 512);
    const int i0 = 4 * g, n_adm = 80 + 64 * (i0 >> 6), ntile = (n_adm + 31) >> 5;
    const int mq0 = b * SEQ + i0;
    {
        const int rho = lane & 31, hh = lane >> 5;
        const int q = 2 * ((rho >> 2) & 1) + (rho >> 4), hd = 4 * ((rho >> 3) & 1) + (rho & 3);
        const f16* qip = PB + (size_t)(mq0 + q) * N1 + C_QI + hd * 64 + 8 * hh;
        f16x8 af[4];
#pragma unroll
        for (int ks = 0; ks < 4; ++ks) af[ks] = *(const f16x8*)(qip + 16 * ks);
        float wsc[16];
#pragma unroll
        for (int j = 0; j < 16; ++j) wsc[j] = WIS[(size_t)(mq0 + 2 * hh + (j >> 3)) * 8 + (j & 7)];
        float mn0 = INFINITY, mx0 = -INFINITY, mn1 = INFINITY, mx1 = -INFINITY;
        f16x8 bn[2][4];
#pragma unroll
        for (int u = 0; u < 2; ++u) { const f16* kp = KIDX + (size_t)b * KIDX_B + (size_t)(wave + 8 * u) * 2048 + hh * 256 + (lane & 31) * 8;
#pragma unroll
          for (int ks = 0; ks < 4; ++ks) bn[u][ks] = *(const f16x8*)(kp + 512 * ks); }
        for (int kt = wave; kt < ntile; kt += 16) {
            f16x8 bf[2][4];
#pragma unroll
            for (int u = 0; u < 2; ++u)
#pragma unroll
                for (int ks = 0; ks < 4; ++ks) bf[u][ks] = bn[u][ks];
#pragma unroll
            for (int u = 0; u < 2; ++u) { int kn = kt + 16 + 8 * u; kn = (kn < ntile) ? kn : kt;
                const f16* kp = KIDX + (size_t)b * KIDX_B + (size_t)kn * 2048 + hh * 256 + (lane & 31) * 8;
#pragma unroll
                for (int ks = 0; ks < 4; ++ks) bn[u][ks] = *(const f16x8*)(kp + 512 * ks); }
            f32x16 acc0, acc1;
#pragma unroll
            for (int j = 0; j < 16; ++j) { acc0[j] = 0.f; acc1[j] = 0.f; }
#pragma unroll
            for (int ks = 0; ks < 4; ++ks) { acc0 = __builtin_amdgcn_mfma_f32_32x32x16_f16(af[ks], bf[0][ks], acc0, 0, 0, 0); acc1 = __builtin_amdgcn_mfma_f32_32x32x16_f16(af[ks], bf[1][ks], acc1, 0, 0, 0); }
            float sa0 = 0.f, sb0 = 0.f, sa1 = 0.f, sb1 = 0.f;
#pragma unroll
            for (int jj = 0; jj < 8; ++jj) { sa0 += wsc[jj] * fmaxf(acc0[jj], 0.f); sb0 += wsc[8 + jj] * fmaxf(acc0[8 + jj], 0.f); sa1 += wsc[jj] * fmaxf(acc1[jj], 0.f); sb1 += wsc[8 + jj] * fmaxf(acc1[8 + jj], 0.f); }
            const int key0 = kt * 32 + (lane & 31), key1 = key0 + 256;
            sc[(2 * hh) * SCW + key0] = sa0; sc[(2 * hh + 1) * SCW + key0] = sb0;
            if (key0 < n_adm) { mn0 = fminf(mn0, sa0); mx0 = fmaxf(mx0, sa0); mn1 = fminf(mn1, sb0); mx1 = fmaxf(mx1, sb0); }
            if (kt + 8 < ntile) { sc[(2 * hh) * SCW + key1] = sa1; sc[(2 * hh + 1) * SCW + key1] = sb1;
                if (key1 < n_adm) { mn0 = fminf(mn0, sa1); mx0 = fmaxf(mx0, sa1); mn1 = fminf(mn1, sb1); mx1 = fmaxf(mx1, sb1); } }
        }
#pragma unroll
        for (int o = 1; o < 32; o <<= 1) { mn0 = fminf(mn0, __shfl_xor(mn0, o)); mx0 = fmaxf(mx0, __shfl_xor(mx0, o)); mn1 = fminf(mn1, __shfl_xor(mn1, o)); mx1 = fmaxf(mx1, __shfl_xor(mx1, o)); }
        float* mm = (float*)(misc + 64);
        if ((lane & 31) == 0) { mm[((2 * hh) * 8 + wave) * 2] = mn0; mm[((2 * hh) * 8 + wave) * 2 + 1] = mx0; mm[((2 * hh + 1) * 8 + wave) * 2] = mn1; mm[((2 * hh + 1) * 8 + wave) * 2 + 1] = mx1; }
        *(f16x8*)(sq + tid * 8) = *(const f16x8*)(PB + (size_t)(mq0 + (tid >> 7)) * N1 + C_QABS + (tid & 127) * 8);
    }
    const int qs = tid >> 7, tl = tid & 127;
    if (n_adm > 256) { hist[qs * 256 + tl] = 0u; hist[qs * 256 + 128 + tl] = 0u; if (tl < 4) misc[qs * 8 + 2 + tl] = 0u; }
    __syncthreads();
    int nsel;
    {
        const float* scq = sc + qs * SCW;
        if (n_adm <= 256) { for (int idx = tl; idx < n_adm; idx += 128) sel[qs * 256 + idx] = (unsigned short)idx; nsel = n_adm; }
        else {
            constexpr int NK = 65;
            const float* mm = (const float*)(misc + 64);
            float lo = INFINITY, hi = -INFINITY;
#pragma unroll
            for (int w = 0; w < 8; ++w) { lo = fminf(lo, mm[(qs * 8 + w) * 2]); hi = fmaxf(hi, mm[(qs * 8 + w) * 2 + 1]); }
            const float scale = (hi > lo) ? 16777215.f / (hi - lo) : 0.f;
            unsigned kreg[NK];
#pragma unroll
            for (int i = 0; i < NK; ++i) { const int idx = tl + 128 * i; const float v = (idx < n_adm) ? scq[idx] : lo; unsigned k = (unsigned)((v - lo) * scale); k = k > 0xFFFFFFu ? 0xFFFFFFu : k; kreg[i] = k;
                if (idx < n_adm) atomicAdd(&hist[qs * 256 + (k >> 16)], 1u); }
            __syncthreads();
            if (tl < 64) {
                const int c0 = (int)hist[qs * 256 + 4 * tl], c1 = (int)hist[qs * 256 + 4 * tl + 1], c2 = (int)hist[qs * 256 + 4 * tl + 2], c3 = (int)hist[qs * 256 + 4 * tl + 3];
                const int tot = c0 + c1 + c2 + c3; int sfx = tot;
#pragma unroll
                for (int off = 1; off < 64; off <<= 1) { const int tv = __shfl_down(sfx, off); if (tl + off < 64) sfx += tv; }
                const int above = sfx - tot;
                if (above < 256 && 256 <= sfx) { const int rem = 256 - above; int bin, nk;
                    if (rem <= c3) { bin = 4 * tl + 3; nk = rem; } else if (rem <= c3 + c2) { bin = 4 * tl + 2; nk = rem - c3; }
                    else if (rem <= c3 + c2 + c1) { bin = 4 * tl + 1; nk = rem - c3 - c2; } else { bin = 4 * tl; nk = rem - c3 - c2 - c1; }
                    misc[qs * 8] = (unsigned)bin; misc[qs * 8 + 1] = (unsigned)nk; }
            }
            __syncthreads();
            const unsigned bin = misc[qs * 8]; const int need = (int)misc[qs * 8 + 1];
            unsigned* cand = (unsigned*)(sc + qs * SCW) + 0;
            const int lane_ = tid & 63;
            __syncthreads();
#pragma unroll
            for (int i = 0; i < NK; ++i) { const int idx = tl + 128 * i; const unsigned u = kreg[i]; const bool ok = idx < n_adm; const unsigned tb = u >> 16;
                if (ok && tb > bin) { const unsigned long long m = __ballot(1); const int leader = __ffsll((long long)m) - 1; unsigned base = 0u;
                    if (lane_ == leader) base = atomicAdd(&misc[qs * 8 + 2], (unsigned)__popcll(m));
                    base = __shfl(base, leader);
                    sel[qs * 256 + base + __popcll(m & ((1ull << lane_) - 1ull))] = (unsigned short)idx; }
                else if (ok && tb == bin) { const unsigned e = atomicAdd(&misc[qs * 8 + 3], 1u); if (e < 4096u) { cand[2 * e] = u; cand[2 * e + 1] = (unsigned)idx; } } }
            __syncthreads();
            { const int m = min((int)misc[qs * 8 + 3], 4096); const int base = (int)misc[qs * 8 + 2];
              for (int i = tl; i < m; i += 128) { const unsigned ku = cand[2 * i]; const unsigned ki = cand[2 * i + 1]; int rank = 0;
                  for (int j = 0; j < m; ++j) { const unsigned kj = cand[2 * j]; const unsigned ij = cand[2 * j + 1]; rank += (kj > ku || (kj == ku && ij < ki)) ? 1 : 0; }
                  if (rank < need) sel[qs * 256 + base + rank] = (unsigned short)ki; } }
            nsel = 256;
        }
    }
    __syncthreads();
    {
        int lane_ = lane; asm volatile("" : "+v"(lane_));
        const int fr = lane_ & 15, fq = lane_ >> 4, aq = wave >> 1, rh = wave & 1;
        const unsigned short* selq = sel + aq * 256;
        unsigned char* cq = lds + aq * 32768;
        f16x8 qf[4];
#pragma unroll
        for (int ks = 0; ks < 4; ++ks) { qf[ks] = *(const f16x8*)(sq + (aq * 8 + (fr & 7)) * 128 + 32 * ks + 8 * fq); if (fr >= 8) qf[ks] = (f16x8){(f16)0.f, (f16)0.f, (f16)0.f, (f16)0.f, (f16)0.f, (f16)0.f, (f16)0.f, (f16)0.f}; }
        f16x8 I0, I1;
#pragma unroll
        for (int j = 0; j < 8; ++j) { I0[j] = (8 * fq + j == fr) ? (f16)1.f : (f16)0.f; I1[j] = (8 * fq + j == 16 + fr) ? (f16)1.f : (f16)0.f; }
        f32x4 O[4];
#pragma unroll
        for (int j = 0; j < 4; ++j) O[j] = (f32x4){0.f, 0.f, 0.f, 0.f};
        float m_run = -1e30f, l_run = 0.f;
        for (int kb = 0; kb < 2; ++kb) {
            {
                f16x8 g[16];
#pragma unroll
                for (int i = 0; i < 16; ++i) { const int rl = 64 * rh + 4 * i + fq; const int kk = 128 * kb + rl; const int kidx = (kk < nsel) ? (int)selq[kk] : 0;
                    g[i] = *(const f16x8*)(CKV + (size_t)row_of(b, kidx) * 128 + fr * 8); }
                __builtin_amdgcn_sched_barrier(0);
#pragma unroll
                for (int i = 0; i < 16; ++i) { const int rl = 64 * rh + 4 * i + fq; *(f16x8*)(cq + rl * 256 + ((fr ^ (rl & 15)) << 4)) = g[i]; }
            }
            __syncthreads();
            f32x4 S[8];
#pragma unroll
            for (int kt = 0; kt < 8; ++kt) { const int rl = 16 * kt + fr; f16x8 a[4];
#pragma unroll
                for (int ks = 0; ks < 4; ++ks) a[ks] = *(const f16x8*)(cq + rl * 256 + (((4 * ks + fq) ^ fr) << 4));
                f32x4 acc = {0.f, 0.f, 0.f, 0.f};
#pragma unroll
                for (int ks = 0; ks < 4; ++ks) acc = __builtin_amdgcn_mfma_f32_16x16x32_f16(a[ks], qf[ks], acc, 0, 0, 0);
                S[kt] = acc; }
            float mx = -1e30f;
#pragma unroll
            for (int kt = 0; kt < 8; ++kt)
#pragma unroll
                for (int e = 0; e < 4; ++e) { const float v = (128 * kb + 16 * kt + 4 * fq + e < nsel) ? S[kt][e] * 0.125f : -1e30f; S[kt][e] = v; mx = fmaxf(mx, v); }
            mx = fmaxf(mx, __shfl_xor(mx, 16)); mx = fmaxf(mx, __shfl_xor(mx, 32));
            const float m_new = fmaxf(m_run, mx);
            const float alpha = __expf(m_run - m_new);
            float sum = 0.f;
#pragma unroll
            for (int kt = 0; kt < 8; ++kt)
#pragma unroll
                for (int e = 0; e < 4; ++e) { const float pv = (S[kt][e] > -1e29f) ? __expf(S[kt][e] - m_new) : 0.f; S[kt][e] = pv; sum += pv; }
            sum += __shfl_xor(sum, 16); sum += __shfl_xor(sum, 32);
            l_run = l_run * alpha + sum; m_run = m_new;
#pragma unroll
            for (int e = 0; e < 4; ++e) { const float al = __shfl(alpha, 4 * fq + e);
#pragma unroll
                for (int j = 0; j < 4; ++j) O[j][e] *= al; }
            f16x8 Pf[4];
#pragma unroll
            for (int i = 0; i < 4; ++i)
#pragma unroll
                for (int e = 0; e < 4; ++e) { Pf[i][e] = (f16)S[2 * i][e]; Pf[i][4 + e] = (f16)S[2 * i + 1][e]; }
#pragma unroll
            for (int i = 0; i < 4; ++i) {
                const int ra = 32 * i + fr, rb = ra + 16;
                f16x8 xa[2], xb[2];
#pragma unroll
                for (int u = 0; u < 2; ++u) { xa[u] = *(const f16x8*)(cq + ra * 256 + (((4 * (2 * rh + u) + fq) ^ fr) << 4)); xb[u] = *(const f16x8*)(cq + rb * 256 + (((4 * (2 * rh + u) + fq) ^ fr) << 4)); }
#pragma unroll
                for (int j = 0; j < 4; ++j) {
                    const f32x4 z = {0.f, 0.f, 0.f, 0.f};
                    const f32x4 da = __builtin_amdgcn_mfma_f32_16x16x32_f16(xa[j >> 1], (j & 1) ? I1 : I0, z, 0, 0, 0);
                    const f32x4 db = __builtin_amdgcn_mfma_f32_16x16x32_f16(xb[j >> 1], (j & 1) ? I1 : I0, z, 0, 0, 0);
                    f16x8 bfr;
#pragma unroll
                    for (int e = 0; e < 4; ++e) { bfr[e] = (f16)da[e]; bfr[4 + e] = (f16)db[e]; }
                    O[j] = __builtin_amdgcn_mfma_f32_16x16x32_f16(Pf[i], bfr, O[j], 0, 0, 0);
                }
            }
            __syncthreads();
        }
        const float inv = 1.f / l_run;
        if (fq < 2) {
#pragma unroll
            for (int e = 0; e < 4; ++e) { const float il = __shfl(inv, 4 * fq + e);
#pragma unroll
                for (int j = 0; j < 4; ++j) OLAT[(size_t)(mq0 + aq) * 1024 + (4 * fq + e) * 128 + 64 * rh + 16 * j + fr] = (f16)(O[j][e] * il); }
        }
    }
    __syncthreads();
}

__device__ __forceinline__ void phc2_mixers(const Params& p, unsigned char* lds, int rep) {
    unsigned* ctr = (unsigned*)(p.ws + WS_CTL) + 64 + 64 * rep;
    int* s_item = (int*)(lds + 150 * 1024 - 16);
    constexpr int NRW = 16, NDSA = 2 * (SEQ / 4), NFILL = 512;
    for (;;) {
        if (threadIdx.x == 0) *s_item = (int)atomicAdd(ctr, 1u);
        __syncthreads();
        const int item = *s_item;
        __syncthreads();
        if (item >= NRW + NDSA + NFILL) break;
        if (item >= NRW + NDSA) { ph0_prep<true>(p, lds, item - (NRW + NDSA), NFILL); __syncthreads(); continue; }
        if (item < NRW) rwkv_item(p, item >> 3, item & 7, lds);
        else { const int d = item - NRW; dsa_item(p, d & 1, (SEQ / 4 - 1) - (d >> 1), lds); }
    }
}

__device__ __forceinline__ void phd3_ln1(const Params& p) {
    const int tid = threadIdx.x, lane = tid & 63, wave = tid >> 6;
    const int gw = blockIdx.x * 8 + wave, NGW = gridDim.x * 8;
    f16* H1H = (f16*)(p.ws + WS_H1H);
    for (int m = gw; m < MREAL; m += NGW) {
        float* row = p.out + (size_t)m * D;
        f32x4 v[4]; float s = 0.f;
#pragma unroll
        for (int j = 0; j < 4; ++j) { v[j] = *(const f32x4*)(row + j * 256 + lane * 4); s += (v[j].x + v[j].y) + (v[j].z + v[j].w); }
        const float mean = wave_sum(s) * (1.f / D); float s2 = 0.f;
#pragma unroll
        for (int j = 0; j < 4; ++j) { v[j] = v[j] - mean; s2 += (v[j].x * v[j].x + v[j].y * v[j].y) + (v[j].z * v[j].z + v[j].w * v[j].w); }
        const float rstd = 1.f / sqrtf(wave_sum(s2) * (1.f / D) + LN_EPS);
#pragma unroll
        for (int j = 0; j < 4; ++j) { const f32x4 g = *(const f32x4*)(p.ln1_g + j * 256 + lane * 4), bb = *(const f32x4*)(p.ln1_b + j * 256 + lane * 4);
            const f32x4 o = v[j] * rstd * g + bb; *(f32x4*)(row + j * 256 + lane * 4) = o; *(f16x4*)(H1H + (size_t)m * D + j * 256 + lane * 4) = to_h4(o); }
    }
}

#define INS16(L, x_) do { unsigned x__ = (x_); _Pragma("unroll") for (int j_ = 0; j_ < 16; ++j_) { const unsigned hi_ = max(L[j_], x__); x__ = min(L[j_], x__); L[j_] = hi_; } } while (0)
__device__ __forceinline__ void top16_of_128(const unsigned short* src, unsigned (&L)[16]) {
#pragma unroll
    for (int j = 0; j < 16; ++j) L[j] = 0u;
#pragma unroll 1
    for (int hb = 0; hb < 2; ++hb) {
        u32x4 w[8];
#pragma unroll
        for (int c = 0; c < 8; ++c) w[c] = *(const u32x4*)(src + hb * 64 + c * 8);
        __builtin_amdgcn_sched_barrier(0);
#pragma unroll
        for (int c = 0; c < 8; ++c)
#pragma unroll
            for (int e = 0; e < 8; ++e) {
                const unsigned sc16 = (w[c][e >> 1] >> (16 * (e & 1))) & 0xFFFFu;
                const unsigned key = (sc16 << 16) | (unsigned)(127 - (hb * 64 + c * 8 + e));
                INS16(L, key);
            }
    }
}
__device__ __forceinline__ void phd5_topk(const Params& p) {
    const unsigned short* SC = (const unsigned short*)(p.ws + WS_SC);
    unsigned short* EIDX = (unsigned short*)(p.ws + WS_EIDX); float* EGATE = (float*)(p.ws + WS_EGATE);
    const long gt = (long)blockIdx.x * NT + threadIdx.x, NGT = (long)gridDim.x * NT;
    for (long e = gt; e < (long)MREAL * 8; e += NGT) {
        const int m = (int)(e >> 3), h = (int)(e & 7);
        unsigned A[16], B[16];
        top16_of_128(SC + (size_t)m * 2048 + h * 256, A);
        top16_of_128(SC + (size_t)m * 2048 + h * 256 + 128, B);
        unsigned T[16];
#pragma unroll
        for (int j = 0; j < 16; ++j) T[j] = 0u;
#pragma unroll
        for (int i = 0; i < 16; ++i)
#pragma unroll
            for (int j = 0; j < 16; ++j)
                if ((i + 1) * (j + 1) <= 16) {
                    const unsigned sum = (A[i] >> 16) + (B[j] >> 16);
                    const unsigned eid = (127u - (A[i] & 0xFFFFu)) * 128u + (127u - (B[j] & 0xFFFFu));
                    INS16(T, (sum << 14) | eid);
                }
        float sumf = 0.f; float ex[16];
        const int s0 = (int)(T[0] >> 14);
#pragma unroll
        for (int j = 0; j < 16; ++j) { ex[j] = __expf((float)((int)(T[j] >> 14) - s0) * (1.f / 8192.f)); sumf += ex[j]; }
        const float inv = 1.f / sumf;
#pragma unroll
        for (int j = 0; j < 16; ++j) { EIDX[(size_t)m * 128 + h * 16 + j] = (unsigned short)(T[j] & 0x3FFFu); EGATE[(size_t)m * 128 + h * 16 + j] = ex[j] * inv; }
    }
}

__device__ __forceinline__ void dec16(const u32x4 w, float (&o)[16]) {
#pragma unroll
    for (int q = 0; q < 4; ++q) { const f32x2 lo = __builtin_amdgcn_cvt_pk_f32_fp8((int)w[q], false), hi = __builtin_amdgcn_cvt_pk_f32_fp8((int)w[q], true); o[4 * q] = lo.x; o[4 * q + 1] = lo.y; o[4 * q + 2] = hi.x; o[4 * q + 3] = hi.y; }
}
__device__ __forceinline__ float wave_sum_u(float v) {
    v = row16_sum(v);
    const float a = __builtin_bit_cast(float, __builtin_amdgcn_readlane(__builtin_bit_cast(int, v), 0)), b = __builtin_bit_cast(float, __builtin_amdgcn_readlane(__builtin_bit_cast(int, v), 16));
    const float c = __builtin_bit_cast(float, __builtin_amdgcn_readlane(__builtin_bit_cast(int, v), 32)), d = __builtin_bit_cast(float, __builtin_amdgcn_readlane(__builtin_bit_cast(int, v), 48));
    return (a + b) + (c + d);
}
__device__ __forceinline__ void phd6_gather(const Params& p) {
    const int tid = threadIdx.x, lane = tid & 63, wave = tid >> 6;
    const int gw = blockIdx.x * 8 + wave, NGW = gridDim.x * 8;
    const unsigned char* U8 = p.ws + WS_U8; const unsigned char* V8A = p.ws + WS_V8A; const unsigned char* V8B = p.ws + WS_V8B - (size_t)V8A_ROWS * D;
    const unsigned short* EIDX = (const unsigned short*)(p.ws + WS_EIDX); const float* EGATE = (const float*)(p.ws + WS_EGATE);
    for (int m = gw; m < MREAL; m += NGW) {
        float* row = p.out + (size_t)m * D + 16 * lane;
        float hv[16];
#pragma unroll
        for (int q = 0; q < 4; ++q) { const f32x4 t4 = *(const f32x4*)(row + 4 * q); hv[4 * q] = t4.x; hv[4 * q + 1] = t4.y; hv[4 * q + 2] = t4.z; hv[4 * q + 3] = t4.w; }
        const int e_lo = (int)EIDX[(size_t)m * 128 + lane], e_hi = (int)EIDX[(size_t)m * 128 + 64 + lane];
        const float g_lo = EGATE[(size_t)m * 128 + lane], g_hi = EGATE[(size_t)m * 128 + 64 + lane];
        float hd_lo = 0.f, hd_hi = 0.f;
#define G_LOAD(buf, g_, TAB) do { _Pragma("unroll") for (int i_ = 0; i_ < 8; ++i_) { const int e_ = 8 * (g_) + i_; \
            const int id_ = (e_ < 64) ? __builtin_amdgcn_readlane(e_lo, e_ & 63) : __builtin_amdgcn_readlane(e_hi, e_ & 63); \
            buf[i_] = *(const u32x4*)(((TAB) ? ((id_ < V8A_ROWS) ? V8A : V8B) : U8) + (size_t)id_ * D + 16 * lane); } } while (0)
#define U_PROC(buf, g_) do { _Pragma("unroll") for (int i_ = 0; i_ < 8; ++i_) { const int e_ = 8 * (g_) + i_; float uf[16]; dec16(buf[i_], uf); float s_ = 0.f; \
            _Pragma("unroll") for (int j_ = 0; j_ < 16; ++j_) s_ += hv[j_] * uf[j_]; s_ = wave_sum_u(s_); \
            if (e_ < 64) { if (lane == (e_ & 63)) hd_lo = s_; } else { if (lane == (e_ & 63)) hd_hi = s_; } } } while (0)
        {
            u32x4 b0[8], b1[8];
            G_LOAD(b0, 0, 0);
            for (int g2 = 0; g2 < 16; g2 += 2) {
                G_LOAD(b1, g2 + 1, 0); __builtin_amdgcn_sched_barrier(0);
                U_PROC(b0, g2); __builtin_amdgcn_sched_barrier(0);
                if (g2 + 2 < 16) { G_LOAD(b0, g2 + 2, 0); } __builtin_amdgcn_sched_barrier(0);
                U_PROC(b1, g2 + 1); __builtin_amdgcn_sched_barrier(0);
            }
        }
        hd_lo *= (1.f / 256.f); hd_hi *= (1.f / 256.f);
        const float c_lo = g_lo * 0.5f * hd_lo * (1.f + erff(hd_lo * 0.70710678118654752f)) * (1.f / 16.f);
        const float c_hi = g_hi * 0.5f * hd_hi * (1.f + erff(hd_hi * 0.70710678118654752f)) * (1.f / 16.f);
        float acc[16];
#pragma unroll
        for (int j = 0; j < 16; ++j) acc[j] = 0.f;
#define V_PROC(buf, g_) do { _Pragma("unroll") for (int i_ = 0; i_ < 8; ++i_) { const int e_ = 8 * (g_) + i_; float vf[16]; dec16(buf[i_], vf); \
            const float cf_ = (e_ < 64) ? __builtin_bit_cast(float, __builtin_amdgcn_readlane(__builtin_bit_cast(int, c_lo), e_ & 63)) : __builtin_bit_cast(float, __builtin_amdgcn_readlane(__builtin_bit_cast(int, c_hi), e_ & 63)); \
            _Pragma("unroll") for (int j_ = 0; j_ < 16; ++j_) acc[j_] += cf_ * vf[j_]; } } while (0)
        {
            u32x4 b0[8], b1[8];
            G_LOAD(b0, 0, 1);
            for (int g2 = 0; g2 < 16; g2 += 2) {
                G_LOAD(b1, g2 + 1, 1); __builtin_amdgcn_sched_barrier(0);
                V_PROC(b0, g2); __builtin_amdgcn_sched_barrier(0);
                if (g2 + 2 < 16) { G_LOAD(b0, g2 + 2, 1); } __builtin_amdgcn_sched_barrier(0);
                V_PROC(b1, g2 + 1); __builtin_amdgcn_sched_barrier(0);
            }
        }
        float sm = 0.f;
#pragma unroll
        for (int j = 0; j < 16; ++j) { acc[j] += ALPHA * hv[j]; sm += acc[j]; }
        const float mean = wave_sum_u(sm) * (1.f / D); float s2 = 0.f;
#pragma unroll
        for (int j = 0; j < 16; ++j) { acc[j] -= mean; s2 += acc[j] * acc[j]; }
        const float rstd = __builtin_amdgcn_rsqf(wave_sum_u(s2) * (1.f / D) + LN_EPS);
#pragma unroll
        for (int q = 0; q < 4; ++q) { const int col = 16 * lane + 4 * q; const f32x4 g = *(const f32x4*)(p.ln2_g + col), bb = *(const f32x4*)(p.ln2_b + col);
            f32x4 o; o.x = acc[4 * q] * rstd * g.x + bb.x; o.y = acc[4 * q + 1] * rstd * g.y + bb.y; o.z = acc[4 * q + 2] * rstd * g.z + bb.z; o.w = acc[4 * q + 3] * rstd * g.w + bb.w;
            *(f32x4*)(row + 4 * q) = o; }
    }
}

struct EpiLora {
    f16 *LW, *AA, *GG; const float *w0, *a0;
    __device__ __forceinline__ void operator()(const f32x4 (&acc)[2][2][4][2], const pg8::Unit& u, int wr, int wc, int fr, int fq) const {
        const int row0 = u.pm * 256 + wr * 64 + fr, col0 = (u.pn & 1) * 256 + wc * 32 + 4 * fq;
        if (u.pn < 2) {
#pragma unroll
            for (int bj = 0; bj < 2; ++bj)
#pragma unroll
                for (int n = 0; n < 2; ++n) { const int col = col0 + bj * 128 + n * 16; const f32x4 c = *(const f32x4*)(w0 + col);
#pragma unroll
                    for (int ai = 0; ai < 2; ++ai)
#pragma unroll
                        for (int m = 0; m < 4; ++m) { const f32x4 v = acc[ai][bj][m][n]; f16x4 o;
#pragma unroll
                            for (int e = 0; e < 4; ++e) { const float wl = -softplusf_(-(c[e] + v[e])) - 0.5f; o[e] = (f16)(-__expf(wl)); }
                            *(f16x4*)(LW + (size_t)(row0 + ai * 128 + m * 16) * 512 + col) = o; } }
        } else if (u.pn < 4) {
#pragma unroll
            for (int bj = 0; bj < 2; ++bj)
#pragma unroll
                for (int n = 0; n < 2; ++n) { const int col = col0 + bj * 128 + n * 16; const f32x4 c = *(const f32x4*)(a0 + col);
#pragma unroll
                    for (int ai = 0; ai < 2; ++ai)
#pragma unroll
                        for (int m = 0; m < 4; ++m) { const f32x4 v = acc[ai][bj][m][n]; f16x4 o;
#pragma unroll
                            for (int e = 0; e < 4; ++e) o[e] = (f16)sigmoidf_(c[e] + v[e]);
                            *(f16x4*)(AA + (size_t)(row0 + ai * 128 + m * 16) * 512 + col) = o; } }
        } else {
#pragma unroll
            for (int bj = 0; bj < 2; ++bj)
#pragma unroll
                for (int n = 0; n < 2; ++n) { const int col = col0 + bj * 128 + n * 16;
#pragma unroll
                    for (int ai = 0; ai < 2; ++ai)
#pragma unroll
                        for (int m = 0; m < 4; ++m) *(f16x4*)(GG + (size_t)(row0 + ai * 128 + m * 16) * 512 + col) = to_h4(acc[ai][bj][m][n]); }
        }
    }
};

#define XB_TMO      128
#define XB_XCNT(j)  (256  + 64 * (j))
#define XB_XSUB(j)  (1280 + 64 * (j))
#define XB_XGEN(j)  (2304 + 64 * (j))
#define XB_TOP      3328
#define XB_TOPGEN   3392
#define XCD_BAR_WORDS 3456
#define XB_SPIN_CAP (1u << 20)
__device__ __forceinline__ unsigned xb_ld(unsigned* p)              { return __hip_atomic_load(p, __ATOMIC_RELAXED, __HIP_MEMORY_SCOPE_AGENT); }
__device__ __forceinline__ unsigned xb_add(unsigned* p, unsigned v) { return __hip_atomic_fetch_add(p, v, __ATOMIC_RELAXED, __HIP_MEMORY_SCOPE_AGENT); }
__device__ __forceinline__ unsigned xb_xcc_id() { return (unsigned)__builtin_amdgcn_s_getreg((3 << 11) | 20) & 0xFu; }
#define XB_SPIN(cond, bar) do { unsigned _sp = 0; while (cond) { __builtin_amdgcn_s_sleep(1); \
    if ((++_sp & 255u) == 0u) { if (xb_ld(&(bar)[XB_TMO])) break; if (_sp > XB_SPIN_CAP) { atomicAdd(&(bar)[XB_TMO], 1u); break; } } } } while (0)
struct XcdBarrier { unsigned* bar; unsigned x; volatile LAS unsigned* st; };
__device__ __forceinline__ XcdBarrier xcd_barrier_post(unsigned* bar, volatile LAS unsigned* st) {
    XcdBarrier b; b.bar = bar; b.x = xb_xcc_id(); b.st = st;
    if (threadIdx.x == 0) (void)xb_add(&bar[XB_XCNT(b.x)], 1u);
    return b;
}
__device__ __forceinline__ void xcd_barrier_complete(unsigned* bar, unsigned x, unsigned& nloc, unsigned& nx) {
    const unsigned G = gridDim.x * gridDim.y * gridDim.z;
    unsigned sum, cnt, mine, sp = 0u;
    for (;;) {
        sum = 0u; cnt = 0u; mine = 0u;
#pragma unroll
        for (unsigned j = 0; j < 16; ++j) { const unsigned c = xb_ld(&bar[XB_XCNT(j)]); sum += c; cnt += (c > 0u) ? 1u : 0u; mine = (j == x) ? c : mine; }
        if (sum == G) break;
        __builtin_amdgcn_s_sleep(1);
        if ((++sp & 255u) == 0u) { if (xb_ld(&bar[XB_TMO])) break; if (sp > XB_SPIN_CAP) { atomicAdd(&bar[XB_TMO], 1u); break; } }
    }
    nloc = mine > 0u ? mine : 1u; nx = cnt > 0u ? cnt : 1u;
}
__device__ __forceinline__ void xcd_barrier(const XcdBarrier& b) {
    asm volatile("s_waitcnt vmcnt(0)" ::: "memory");
    __syncthreads();
    if (threadIdx.x == 0) {
        unsigned* bar = b.bar;
        __builtin_amdgcn_s_waitcnt(0);
        unsigned nloc = b.st[0], nx = b.st[1];
        if (nloc == 0u) { xcd_barrier_complete(bar, b.x, nloc, nx); b.st[0] = nloc; b.st[1] = nx; }
        const unsigned old = xb_add(&bar[XB_XSUB(b.x)], 1u);
        const unsigned gen = old / nloc;
        if (old + 1u == (gen + 1u) * nloc) {
            __builtin_amdgcn_fence(__ATOMIC_RELEASE, "agent");
            asm volatile("s_waitcnt vmcnt(0)" ::: "memory");
            const unsigned og = xb_add(&bar[XB_TOP], 1u);
            const unsigned tg = og / nx;
            if (og + 1u == (tg + 1u) * nx) xb_add(&bar[XB_TOPGEN], 1u);
            else XB_SPIN(xb_ld(&bar[XB_TOPGEN]) == tg, bar);
            __builtin_amdgcn_fence(__ATOMIC_ACQUIRE, "agent");
            xb_add(&bar[XB_XGEN(b.x)], 1u);
            asm volatile("s_waitcnt vmcnt(0)" ::: "memory");
        } else {
            XB_SPIN(xb_ld(&bar[XB_XGEN(b.x)]) == gen, bar);
            __builtin_amdgcn_fence(__ATOMIC_ACQUIRE, "agent");
            asm volatile("s_waitcnt vmcnt(0)" ::: "memory");
        }
    }
    __syncthreads();
}

constexpr int LDS_BYTES = 150 * 1024;
constexpr int REP0 = 1, REP1 = 1, REP4 = 1, REP5 = 1, REP8 = 1, REP9 = 1;
constexpr int NPHASE = 11;
__global__ void __launch_bounds__(NT) mk_fwd(Params p) {
    extern __shared__ __attribute__((aligned(16))) unsigned char lds[];
    unsigned char* ws = p.ws;
    const int lo = p.ph_lo, hi = p.ph_hi;
    volatile LAS unsigned* bst = (volatile LAS unsigned*)((LAS unsigned char*)lds + LDS_BYTES - 64);
    if (threadIdx.x < 2) bst[threadIdx.x] = 0u;
    __syncthreads();
    const XcdBarrier xbar = xcd_barrier_post((unsigned*)(ws + WS_CTL) + 4096, bst);
#define IN(k) (lo <= (k) && (k) < hi)
#define SEAM(k) do { if (IN(k) && IN((k) + 1)) xcd_barrier(xbar); } while (0)
    if (IN(0)) ph0_prep<false>(p, lds, (int)blockIdx.x, (int)gridDim.x);
    SEAM(0);
    if (IN(1)) {
        f16* PB = (f16*)(ws + WS_PB);
        auto f = [=](int row, int col, f32x4 v) { *(f16x4*)(PB + (size_t)row * N1 + col) = to_h4(v); };
        pg8::run_gemm(lds, (const f16*)(ws + WS_H0), (const f16*)(ws + WS_W1T), MR, N1, D, f);
    }
    SEAM(1);
    if (IN(2)) phc1_rowprep(p);
    SEAM(2);
    if (IN(3)) {
        pg8::Gemm g{(const f16*)((unsigned char*)p.out + DO_LORAIN), (const f16*)(ws + WS_WLT), MR, 1536, 256}; pg8::StaticOrder S; S.init(MR, 1536, (int)gridDim.x, (int)blockIdx.x);
        EpiLora E{(f16*)((unsigned char*)p.out + DO_LW), (f16*)((unsigned char*)p.out + DO_AA), (f16*)((unsigned char*)p.out + DO_GG), p.b_w0, p.b_a0};
        pg8::gemm_phase<EpiLora>((PG8_LAS unsigned char*)lds, g, S, E);
        __syncthreads();
    }
    SEAM(3);
    if (IN(4)) for (int rep = 0; rep < REP4; ++rep) { if (rep) xcd_barrier(xbar); phc2_mixers(p, lds, rep); }
    SEAM(4);
    if (IN(5)) {
        f16* MIX = (f16*)(ws + WS_MIXED); f16* TMP = (f16*)(ws + WS_TMP); const float* bg = p.b_gate;
        auto f1 = [=](int row, int col, f32x4 v) { const f32x4 c = *(const f32x4*)(bg + col); f16x4 o;
#pragma unroll
            for (int e = 0; e < 4; ++e) o[e] = (f16)sigmoidf_(v[e] + c[e]);
            *(f16x4*)(MIX + (size_t)row * D + col) = o; };
        pg8::run_gemm(lds, (const f16*)(ws + WS_H0), (const f16*)(ws + WS_WGT), MREAL, D, D, f1);
        auto f2 = [=](int row, int col, f32x4 v) { f16x4* q = (f16x4*)(MIX + (size_t)row * D + col); const f16x4 gq = *q; f16x4 o;
#pragma unroll
            for (int e = 0; e < 4; ++e) o[e] = (f16)((float)gq[e] * v[e]);
            *q = o; };
        pg8::run_gemm(lds, (const f16*)(ws + WS_OLAT), (const f16*)(ws + WS_WPAT), MREAL, D, D, f2);
        auto f3 = [=](int row, int col, f32x4 v) { const f32x4 c = *(const f32x4*)(bg + 1024 + col); f16x4 o;
#pragma unroll
            for (int e = 0; e < 4; ++e) o[e] = (f16)sigmoidf_(v[e] + c[e]);
            *(f16x4*)(TMP + (size_t)row * D + col) = o; };
        pg8::run_gemm(lds, (const f16*)(ws + WS_H0), (const f16*)(ws + WS_WGT) + (size_t)1024 * D, MREAL, D, D, f3);
        auto f4 = [=](int row, int col, f32x4 v) { f16x4* q = (f16x4*)(MIX + (size_t)row * D + col); const f16x4 m0 = *q; const f16x4 gq = *(const f16x4*)(TMP + (size_t)row * D + col); f16x4 o;
#pragma unroll
            for (int e = 0; e < 4; ++e) o[e] = (f16)((float)m0[e] + (float)gq[e] * v[e]);
            *q = o; };
        pg8::run_gemm(lds, (const f16*)(ws + WS_OB), (const f16*)(ws + WS_WPBT), MREAL, D, 512, f4);
    }
    SEAM(5);
    if (IN(6)) {
        const float* x = p.x; const float* STAT = (const float*)(ws + WS_STAT); const float* lg = p.ln_in_g; const float* lb = p.ln_in_b; float* out = p.out;
        auto f = [=](int row, int col, f32x4 v) { const f32x4 xv = *(const f32x4*)(x + (size_t)row * D + col); const float mean = STAT[2 * row], rstd = STAT[2 * row + 1];
            const f32x4 g = *(const f32x4*)(lg + col), bb = *(const f32x4*)(lb + col);
            *(f32x4*)(out + (size_t)row * D + col) = ((xv - mean) * rstd * g + bb) * ALPHA + v; };
        pg8::run_gemm(lds, (const f16*)(ws + WS_MIXED), (const f16*)(ws + WS_WOT), MREAL, D, D, f);
    }
    SEAM(6);
    if (IN(7)) phd3_ln1(p);
    SEAM(7);
    if (IN(8)) {
        unsigned short* SC = (unsigned short*)(ws + WS_SC);
        auto f = [=](int row, int col, f32x4 v) { u32x2 o; unsigned q[4];
#pragma unroll
            for (int e = 0; e < 4; ++e) q[e] = (unsigned)__float2int_rn(fminf(fmaxf((v[e] + 2.f) * 8192.f, 0.f), 65535.f));
            o.x = q[0] | (q[1] << 16); o.y = q[2] | (q[3] << 16); *(u32x2*)(SC + (size_t)row * 2048 + col) = o; };
        pg8::run_gemm(lds, (const f16*)(ws + WS_H1H), (const f16*)(ws + WS_WSKT), MREAL, 2048, D, f);
    }
    SEAM(8);
    if (IN(9)) phd5_topk(p);
    SEAM(9);
    if (IN(10)) phd6_gather(p);
#undef IN
#undef SEAM
}

extern "C" void kernel_launch(void* const* d_in, const int* in_sizes, int n_in, void* d_out, int out_size, void* d_ws, size_t ws_size, hipStream_t stream) {
    static int grid = 0;
    if (grid == 0) {
        int dev = 0, cus = 0, per_cu = 0;
        if (hipGetDevice(&dev) != hipSuccess || hipDeviceGetAttribute(&cus, hipDeviceAttributeMultiprocessorCount, dev) != hipSuccess) { fprintf(stderr, "kernel_launch: device query failed\n"); grid = -1; return; }
        if (hipFuncSetAttribute((const void*)mk_fwd, hipFuncAttributeMaxDynamicSharedMemorySize, LDS_BYTES) != hipSuccess) { fprintf(stderr, "kernel_launch: hipFuncSetAttribute failed\n"); grid = -1; return; }
        if (hipOccupancyMaxActiveBlocksPerMultiprocessor(&per_cu, (const void*)mk_fwd, NT, LDS_BYTES) != hipSuccess || per_cu < 1) { fprintf(stderr, "kernel_launch: occupancy query says %d\n", per_cu); grid = -1; return; }
        if (n_in != 33 || out_size != MREAL * D || ws_size < WS_END) { fprintf(stderr, "kernel_launch: unexpected shapes n_in %d out %d ws %zu\n", n_in, out_size, ws_size); grid = -1; return; }
        grid = cus;
    }
    if (grid < 0) return;
    (void)hipMemsetAsync((char*)d_ws + WS_CTL, 0, 1 * MiB, stream);
    Params p{};
    const float** pf = (const float**)&p;
    for (int i = 0; i < 33; ++i) pf[i] = (const float*)d_in[i];
    p.out = (float*)d_out; p.ws = (unsigned char*)d_ws; p.ph_lo = 0; p.ph_hi = NPHASE;
    void* args[] = {&p};
    hipError_t e = hipLaunchCooperativeKernel((void*)mk_fwd, dim3(grid), dim3(NT), args, LDS_BYTES, stream);
    if (e != hipSuccess) fprintf(stderr, "kernel_launch: cooperative launch failed: %s (grid %d)\n", hipGetErrorString(e), grid);
}
```

```cpp
#include <hip/hip_runtime.h>
#include <hip/hip_cooperative_groups.h>
#include <cstdio>
#include <cstdint>
namespace cg = cooperative_groups;

#define LAS __attribute__((address_space(3)))
typedef _Float16 f16;
typedef _Float16 f16x2 __attribute__((ext_vector_type(2)));
typedef _Float16 f16x4 __attribute__((ext_vector_type(4)));
typedef _Float16 f16x8 __attribute__((ext_vector_type(8)));
typedef float f32x2 __attribute__((ext_vector_type(2)));
typedef float f32x4 __attribute__((ext_vector_type(4)));
typedef float f32x16 __attribute__((ext_vector_type(16)));
typedef unsigned u32x4 __attribute__((ext_vector_type(4)));

constexpr int D = 1024, SEQ = 8192, NMETA = 16, TT = 8208;
constexpr int MREAL = 16384, MR = 16640;
constexpr int NIN = 5064;
constexpr int N1 = 3584;
constexpr int C_QABS = 0, C_QI = 1024, C_CKV = 1536, C_KI = 1664, C_WI = 1728, C_BC = 1792;
constexpr int NT = 512;
constexpr int KIDX_B = 264 * 2048;
constexpr float LN_EPS = 1e-5f;
constexpr float ALPHA = 1.189207115002721f;

__device__ __forceinline__ int row_of(int b, int t) { return t < NMETA ? MREAL + b * NMETA + t : b * SEQ + (t - NMETA); }

constexpr size_t MiB = 1u << 20;
constexpr size_t WS_CTL = 0, WS_STAT = 1 * MiB, WS_WIS = 2 * MiB, WS_W1T = 3 * MiB, WS_WGT = 10 * MiB, WS_WPAT = 14 * MiB, WS_WPBT = 16 * MiB,
                 WS_WOT = 17 * MiB, WS_WSKT = 19 * MiB, WS_WLT = 23 * MiB, WS_CKV = 24 * MiB, WS_KIDX = 29 * MiB, WS_H0 = 32 * MiB,
                 WS_OLAT = 65 * MiB, WS_OB = 97 * MiB, WS_PB = 113 * MiB, WS_U8 = 227 * MiB, WS_V8A = 243 * MiB, WS_V8B = 3 * MiB, WS_END = 256 * MiB;
constexpr int V8A_ROWS = 13312;
constexpr size_t WS_MIXED = WS_PB, WS_H1H = WS_PB, WS_TMP = WS_PB + 32 * MiB, WS_SC = WS_PB + 32 * MiB, WS_EIDX = WS_PB + 96 * MiB, WS_EGATE = WS_PB + 100 * MiB;
constexpr size_t DO_LORAIN = 0, DO_LW = 9 * MiB, DO_AA = 26 * MiB, DO_GG = 43 * MiB;

struct Params {
    const float *x, *meta, *ln_in_g, *ln_in_b, *w_in, *b_gate, *a_kv_norm_g, *a_w_uk, *a_w_uv, *a_kidx_g, *a_kidx_b, *b_mu, *b_w0, *b_w2, *b_a0, *b_a2,
        *b_g2, *b_k_k, *b_k_a, *b_r_k, *b_lnx_g, *b_lnx_b, *w_pa, *w_pb, *w_o, *ln1_g, *ln1_b, *peer_wq, *peer_subkeys, *peer_u, *peer_v, *ln2_g, *ln2_b;
    float* out;
    unsigned char* ws;
    int ph_lo, ph_hi;
};

__device__ __forceinline__ float wave_sum(float v) {
#pragma unroll
    for (int o = 1; o < 64; o <<= 1) v += __shfl_xor(v, o);
    return v;
}
__device__ __forceinline__ float wave_max(float v) {
#pragma unroll
    for (int o = 1; o < 64; o <<= 1) v = fmaxf(v, __shfl_xor(v, o));
    return v;
}
#define DPP_F(v, ctrl) __builtin_bit_cast(float, __builtin_amdgcn_update_dpp(0, __builtin_bit_cast(int, (v)), (ctrl), 0xF, 0xF, true))
__device__ __forceinline__ float row16_sum(float v) {
    v += DPP_F(v, 0xB1);
    v += DPP_F(v, 0x4E);
    v += DPP_F(v, 0x141);
    v += DPP_F(v, 0x140);
    return v;
}
__device__ __forceinline__ float sigmoidf_(float x) { return __builtin_amdgcn_rcpf(1.f + __expf(-x)); }
__device__ __forceinline__ float softplusf_(float z) { return fmaxf(z, 0.f) + __logf(1.f + __expf(-fabsf(z))); }
__device__ __forceinline__ unsigned fkey(float f) { unsigned u = __float_as_uint(f); return u ^ ((u >> 31) ? 0xFFFFFFFFu : 0x80000000u); }

namespace pg8 {
#define PG8_LAS __attribute__((address_space(3)))
typedef short h16x8 __attribute__((ext_vector_type(8)));
constexpr int BM = 256, BK = 64, HALF = 128, HTB = HALF * BK * 2, STAGE_BYTES = 8 * HTB, NXCD = 8, WGM = 8;
__host__ __device__ __forceinline__ int lds_byte(int r, int c) { const int st = (r >> 4) * 2 + (c >> 5), rr = r & 15, cc = c & 31, ob = rr * 64 + cc * 2; return st * 1024 + (ob ^ (((ob >> 9) & 1) << 5)); }
__host__ __device__ __forceinline__ void stage_rc(int b, int& R, int& C) { const int st = b / 1024, sb = b % 1024, swz = sb ^ (((sb >> 9) & 1) << 5); R = (st >> 1) * 16 + swz / 64; C = (st & 1) * 32 + (swz % 64) / 2; }
struct Unit { int pm, pn; };
struct Gemm { const f16* A; const f16* Bt; int M, N, K; };
struct StaticOrder {
    int nM, nN, nwg, G, c;
    __host__ __device__ void init(int M, int N, int G_, int c_) { nM = M / BM; nN = N / BM; nwg = nM * nN; G = G_; c = c_; }
    __host__ __device__ bool next(int i, Unit& u) const {
        const long L = (long)i * G + c; if (L >= nwg) return false;
        int wgid = (int)L; { const int q = nwg / NXCD, r = nwg % NXCD, xcd = wgid % NXCD, off = wgid / NXCD; wgid = (xcd < r ? xcd * (q + 1) : r * (q + 1) + (xcd - r) * q) + off; }
        const int nig = WGM * nN, gid = wgid / nig, fm = gid * WGM, gsz = (nM - fm) < WGM ? (nM - fm) : WGM;
        u.pm = fm + ((wgid % nig) % gsz); u.pn = (wgid % nig) / gsz; return true;
    }
};
template <class F> struct EpiElem {
    F f;
    __device__ __forceinline__ void operator()(const f32x4 (&acc)[2][2][4][2], const Unit& u, int wr, int wc, int fr, int fq) const {
        const int row0 = u.pm * BM + wr * 64 + fr, col0 = u.pn * BM + wc * 32 + 4 * fq;
#pragma unroll
        for (int ai = 0; ai < 2; ++ai)
#pragma unroll
            for (int m = 0; m < 4; ++m)
#pragma unroll
                for (int bj = 0; bj < 2; ++bj)
#pragma unroll
                    for (int n = 0; n < 2; ++n) f(row0 + ai * HALF + m * 16, col0 + bj * HALF + n * 16, acc[ai][bj][m][n]);
    }
};
template <class Epi, bool ALIGN_EPI = true, bool SP2 = true>
__device__ __forceinline__ void gemm_phase(PG8_LAS unsigned char* lds, const Gemm g, const StaticOrder& S, const Epi& E) {
    const int tid = threadIdx.x, wid = __builtin_amdgcn_readfirstlane(tid >> 6), lane = tid & 63, wr = wid >> 2, wc = wid & 3, fr = lane & 15, fq = lane >> 4;
    int K = g.K; asm volatile("" : "+s"(K));
    const int nt = K / BK;
    unsigned voffA[2], voffB[2];
#pragma unroll
    for (int i = 0; i < 2; ++i) { int R, C; stage_rc(tid * 16 + i * 8192, R, C); voffA[i] = (unsigned)(R * K + C) * 2u; voffB[i] = (unsigned)(R * K + C) * 2u; }
    const size_t kstep = (size_t)(BK * 2);
    const size_t hstep = (size_t)HALF * K * 2;
    const size_t tstep = 2 * hstep;
    const unsigned ldsw = (unsigned)wid * 1024u;
    const int aoff = lds_byte(wr * 64 + fr, fq * 8), boff = lds_byte(wc * 32 + fr, fq * 8);
#define PG8_SA(b, h) (((b) * 2 + (h)) * HTB)
#define PG8_SB(b, h) ((4 + (b) * 2 + (h)) * HTB)
#define PG8_STAGE(bufoff, gbase, voff) do { _Pragma("unroll") for (int _i = 0; _i < 2; ++_i) \
        __builtin_amdgcn_global_load_lds((const unsigned*)((const char*)(gbase) + (voff)[_i]), (PG8_LAS unsigned*)(lds + (bufoff) + ldsw + _i * 8192), 16, 0, 0); } while (0)
#define PG8_LDA(dst, b, h) do { _Pragma("unroll") for (int m = 0; m < 4; ++m) _Pragma("unroll") for (int k = 0; k < 2; ++k) dst[m][k] = *(const PG8_LAS h16x8*)(lds + PG8_SA(b, h) + aoff + m * 2048 + k * 1024); } while (0)
#define PG8_LDB(dst, b, h) do { _Pragma("unroll") for (int n = 0; n < 2; ++n) _Pragma("unroll") for (int k = 0; k < 2; ++k) dst[n][k] = *(const PG8_LAS h16x8*)(lds + PG8_SB(b, h) + boff + n * 2048 + k * 1024); } while (0)
#define PG8_MMA(ai, bj, At, Bt) do { __builtin_amdgcn_s_setprio(1); _Pragma("unroll") for (int m = 0; m < 4; ++m) _Pragma("unroll") for (int n = 0; n < 2; ++n) _Pragma("unroll") for (int k = 0; k < 2; ++k) \
        acc[ai][bj][m][n] = __builtin_amdgcn_mfma_f32_16x16x32_f16(__builtin_bit_cast(f16x8, Bt[n][k]), __builtin_bit_cast(f16x8, At[m][k]), acc[ai][bj][m][n], 0, 0, 0); __builtin_amdgcn_s_setprio(0); } while (0)
#define PG8_WAIT_V(n) asm volatile("s_waitcnt vmcnt(" #n ")" ::: "memory")
#define PG8_WAIT_L(n) asm volatile("s_waitcnt lgkmcnt(" #n ")" ::: "memory")
#define PG8_BAR __builtin_amdgcn_s_barrier()
#define PG8_SCHED __builtin_amdgcn_sched_barrier(0)
    Unit cur, nxt; int ui = 0;
    if (!S.next(0, cur)) return;
    f32x4 acc[2][2][4][2];
#pragma unroll
    for (int a = 0; a < 2; ++a)
#pragma unroll
        for (int b = 0; b < 2; ++b)
#pragma unroll
            for (int m = 0; m < 4; ++m)
#pragma unroll
                for (int n = 0; n < 2; ++n) acc[a][b][m][n] = (f32x4){0.f, 0.f, 0.f, 0.f};
    h16x8 At[4][2], B0[2][2], B1[2][2];
    const char* cA = (const char*)g.A + (size_t)cur.pm * tstep; const char* cB = (const char*)g.Bt + (size_t)cur.pn * tstep;
    if constexpr (SP2) {
        PG8_STAGE(PG8_SB(0, 0), cB, voffB); PG8_STAGE(PG8_SB(0, 1), cB + hstep, voffB); PG8_STAGE(PG8_SA(0, 0), cA, voffA); PG8_STAGE(PG8_SA(0, 1), cA + hstep, voffA);
        if (wr == 1) PG8_BAR;
        PG8_WAIT_V(2); PG8_BAR;
        PG8_STAGE(PG8_SB(1, 0), cB + kstep, voffB); PG8_STAGE(PG8_SA(1, 0), cA + kstep, voffA); PG8_STAGE(PG8_SB(1, 1), cB + hstep + kstep, voffB);
        PG8_WAIT_V(6); PG8_BAR;
    } else {
        PG8_STAGE(PG8_SB(0, 0), cB, voffB); PG8_STAGE(PG8_SA(0, 0), cA, voffA); PG8_STAGE(PG8_SB(0, 1), cB + hstep, voffB); PG8_STAGE(PG8_SA(0, 1), cA + hstep, voffA);
        if (wr == 1) PG8_BAR;
        PG8_WAIT_V(4); PG8_BAR;
        PG8_STAGE(PG8_SB(1, 0), cB + kstep, voffB); PG8_STAGE(PG8_SA(1, 0), cA + kstep, voffA); PG8_STAGE(PG8_SB(1, 1), cB + hstep + kstep, voffB);
        PG8_WAIT_V(6); PG8_BAR;
    }
    for (;;) {
        const bool has_next = S.next(ui + 1, nxt);
        const char* nA = has_next ? (const char*)g.A + (size_t)nxt.pm * tstep : cA; const char* nB = has_next ? (const char*)g.Bt + (size_t)nxt.pn * tstep : cB;
        for (int t = 0; t < nt; t += 2) {
            const bool last = (t == nt - 2);
            const char* a1 = cA + (size_t)(t + 1) * kstep;
            const char* a2 = last ? nA : cA + (size_t)(t + 2) * kstep; const char* b2 = last ? nB : cB + (size_t)(t + 2) * kstep;
            const char* a3 = a2 + kstep; const char* b3 = b2 + kstep;
            if constexpr (SP2) {
            PG8_LDB(B0, 0, 0); PG8_LDB(B1, 0, 1); PG8_SCHED; PG8_LDA(At, 0, 0); PG8_STAGE(PG8_SA(1, 1), a1 + hstep, voffA);
            PG8_WAIT_V(8); PG8_WAIT_L(0); PG8_BAR; PG8_MMA(0, 0, At, B0); PG8_MMA(0, 1, At, B1); PG8_BAR; PG8_SCHED;
            PG8_LDA(At, 0, 1); PG8_STAGE(PG8_SB(0, 0), b2, voffB); PG8_STAGE(PG8_SB(0, 1), b2 + hstep, voffB); PG8_STAGE(PG8_SA(0, 0), a2, voffA);
            PG8_WAIT_V(8); PG8_WAIT_L(0); PG8_BAR; PG8_MMA(1, 0, At, B0); PG8_MMA(1, 1, At, B1); PG8_BAR; PG8_SCHED;
            PG8_LDB(B0, 1, 0); PG8_LDB(B1, 1, 1); PG8_SCHED; PG8_LDA(At, 1, 0); PG8_STAGE(PG8_SA(0, 1), a2 + hstep, voffA);
            PG8_WAIT_V(8); PG8_WAIT_L(0); PG8_BAR; PG8_MMA(0, 0, At, B0); PG8_MMA(0, 1, At, B1); PG8_BAR; PG8_SCHED;
            PG8_LDA(At, 1, 1); PG8_STAGE(PG8_SB(1, 0), b3, voffB); PG8_STAGE(PG8_SB(1, 1), b3 + hstep, voffB); PG8_STAGE(PG8_SA(1, 0), a3, voffA);
            PG8_WAIT_V(8); PG8_WAIT_L(0); PG8_BAR; PG8_MMA(1, 0, At, B0); PG8_MMA(1, 1, At, B1); PG8_BAR; PG8_SCHED;
            } else {
            PG8_LDB(B0, 0, 0); PG8_SCHED; PG8_LDA(At, 0, 0); PG8_STAGE(PG8_SA(1, 1), a1 + hstep, voffA);
            PG8_WAIT_L(8); PG8_BAR; PG8_WAIT_L(0); PG8_MMA(0, 0, At, B0); PG8_BAR; PG8_SCHED;
            PG8_LDB(B1, 0, 1); PG8_STAGE(PG8_SB(0, 0), b2, voffB);
            PG8_BAR; PG8_WAIT_L(0); PG8_MMA(0, 1, At, B1); PG8_BAR;
            PG8_LDA(At, 0, 1); PG8_STAGE(PG8_SA(0, 0), a2, voffA);
            PG8_BAR; PG8_WAIT_L(0); PG8_MMA(1, 0, At, B0); PG8_BAR; PG8_SCHED;
            PG8_STAGE(PG8_SB(0, 1), b2 + hstep, voffB);
            PG8_WAIT_V(6); PG8_BAR; PG8_MMA(1, 1, At, B1); PG8_BAR;
            PG8_LDB(B0, 1, 0); PG8_SCHED; PG8_LDA(At, 1, 0); PG8_STAGE(PG8_SA(0, 1), a2 + hstep, voffA);
            PG8_WAIT_L(8); PG8_BAR; PG8_WAIT_L(0); PG8_MMA(0, 0, At, B0); PG8_BAR; PG8_SCHED;
            PG8_LDB(B1, 1, 1); PG8_STAGE(PG8_SB(1, 0), b3, voffB);
            PG8_BAR; PG8_WAIT_L(0); PG8_MMA(0, 1, At, B1); PG8_BAR;
            PG8_LDA(At, 1, 1); PG8_STAGE(PG8_SA(1, 0), a3, voffA);
            PG8_BAR; PG8_WAIT_L(0); PG8_MMA(1, 0, At, B0); PG8_BAR; PG8_SCHED;
            PG8_STAGE(PG8_SB(1, 1), b3 + hstep, voffB);
            PG8_WAIT_V(6); PG8_BAR; PG8_MMA(1, 1, At, B1); PG8_BAR;
            }
        }
        if constexpr (ALIGN_EPI) { if (wr == 0) PG8_BAR; }
        E(acc, cur, wr, wc, fr, fq);
        if (!has_next) break;
#pragma unroll
        for (int a = 0; a < 2; ++a)
#pragma unroll
            for (int b = 0; b < 2; ++b)
#pragma unroll
                for (int m = 0; m < 4; ++m)
#pragma unroll
                    for (int n = 0; n < 2; ++n) acc[a][b][m][n] = (f32x4){0.f, 0.f, 0.f, 0.f};
        cur = nxt; cA = nA; cB = nB; ++ui;
        if constexpr (ALIGN_EPI) { if (wr == 1) PG8_BAR; }
    }
    PG8_WAIT_V(0);
    if constexpr (!ALIGN_EPI) { if (wr == 0) PG8_BAR; }
    PG8_BAR;
#undef PG8_SA
#undef PG8_SB
#undef PG8_STAGE
#undef PG8_LDA
#undef PG8_LDB
#undef PG8_MMA
#undef PG8_WAIT_V
#undef PG8_WAIT_L
#undef PG8_BAR
#undef PG8_SCHED
}
template <class F>
__device__ __forceinline__ void run_gemm(unsigned char* lds, const f16* A, const f16* Bt, int M, int N, int K, const F& f) {
    Gemm g{A, Bt, M, N, K}; StaticOrder S; S.init(M, N, (int)gridDim.x, (int)blockIdx.x);
    EpiElem<F> E{f};
    gemm_phase<EpiElem<F>>((PG8_LAS unsigned char*)lds, g, S, E);
    __syncthreads();
}
}

__device__ __forceinline__ f16x4 to_h4(f32x4 v) { f16x4 r; r.x = (f16)v.x; r.y = (f16)v.y; r.z = (f16)v.z; r.w = (f16)v.w; return r; }

__device__ __forceinline__ void tr_item(const float* W, int ldw, int col0, int nvalid, int K, f16* out, int nrow0, int item, int nblk, float* scr, int lane) {
    const int kb = item / nblk, nb = item % nblk, k0 = 64 * kb, n0 = 32 * nb;
#pragma unroll 8
    for (int i = 0; i < 32; ++i) { const int kk = 2 * i + (lane >> 5); const int j = n0 + (lane & 31);
        scr[kk * 33 + (lane & 31)] = (j < nvalid) ? W[(size_t)(k0 + kk) * ldw + col0 + j] : 0.f; }
    asm volatile("s_waitcnt vmcnt(0) lgkmcnt(0)" ::: "memory");
    const int c = lane & 7;
#pragma unroll
    for (int jj = 0; jj < 4; ++jj) { const int n = (lane >> 3) + 8 * jj; const float* s = scr + (8 * c) * 33 + n;
        f16x8 o;
#pragma unroll
        for (int e = 0; e < 8; ++e) o[e] = (f16)s[e * 33];
        *(f16x8*)(out + (size_t)(nrow0 + n0 + n) * K + k0 + 8 * c) = o; }
    asm volatile("s_waitcnt lgkmcnt(0)" ::: "memory");
}

template <bool LATE>
__device__ __forceinline__ void ph0_prep(const Params& p, unsigned char* lds, int vwg, int nvwg) {
    int tid_ = threadIdx.x; asm volatile("" : "+v"(tid_));
    const int tid = tid_, lane = tid & 63, wave = tid >> 6;
    const int gw = vwg * 8 + wave, NGW = nvwg * 8;
    f16* H0 = (f16*)(p.ws + WS_H0); float* STAT = (float*)(p.ws + WS_STAT);
    for (int m = gw; m < (LATE ? 0 : MR); m += NGW) {
        f16* orow = H0 + (size_t)m * D;
        if (m >= MREAL + 2 * NMETA) {
#pragma unroll
            for (int j = 0; j < 4; ++j) *(f16x4*)(orow + j * 256 + lane * 4) = (f16x4){(f16)0.f, (f16)0.f, (f16)0.f, (f16)0.f};
            continue;
        }
        const float* src = (m < MREAL) ? p.x + (size_t)m * D : p.meta + (size_t)((m - MREAL) & 15) * D;
        f32x4 v[4]; float s = 0.f;
#pragma unroll
        for (int j = 0; j < 4; ++j) { v[j] = *(const f32x4*)(src + j * 256 + lane * 4); s += (v[j].x + v[j].y) + (v[j].z + v[j].w); }
        const float mean = wave_sum(s) * (1.f / D); float s2 = 0.f;
#pragma unroll
        for (int j = 0; j < 4; ++j) { v[j] = v[j] - mean; s2 += (v[j].x * v[j].x + v[j].y * v[j].y) + (v[j].z * v[j].z + v[j].w * v[j].w); }
        const float rstd = 1.f / sqrtf(wave_sum(s2) * (1.f / D) + LN_EPS);
        if (lane == 0) { STAT[2 * m] = mean; STAT[2 * m + 1] = rstd; }
#pragma unroll
        for (int j = 0; j < 4; ++j) { const f32x4 g = *(const f32x4*)(p.ln_in_g + j * 256 + lane * 4), bb = *(const f32x4*)(p.ln_in_b + j * 256 + lane * 4);
            *(f16x4*)(orow + j * 256 + lane * 4) = to_h4(v[j] * rstd * g + bb); }
    }
    float* scr = (float*)lds + wave * (64 * 33);
    f16* W1T = (f16*)(p.ws + WS_W1T); f16* WGT = (f16*)(p.ws + WS_WGT); f16* WPBT = (f16*)(p.ws + WS_WPBT); f16* WOT = (f16*)(p.ws + WS_WOT);
    constexpr int I_QI = 16 * 16, I_CKV = 4 * 16, I_KI = 4 * 16, I_BC = 56 * 16, I_G = 64 * 16, I_PB = 32 * 8, I_O = 32 * 16;
    constexpr int NITEMS = I_QI + I_CKV + I_KI + I_BC + I_G + I_PB + I_O;
    for (int it = gw + (LATE ? I_QI + I_CKV + I_KI + I_BC : 0); it < (LATE ? NITEMS : I_QI + I_CKV + I_KI + I_BC); it += NGW) {
        int r = it;
        if (r < I_QI) { tr_item(p.w_in, NIN, 640, 512, D, W1T, C_QI, r, 16, scr, lane); continue; } r -= I_QI;
        if (r < I_CKV) { tr_item(p.w_in, NIN, 512, 128, D, W1T, C_CKV, r, 4, scr, lane); continue; } r -= I_CKV;
        if (r < I_KI) { tr_item(p.w_in, NIN, 1152, 72, D, W1T, C_KI, r, 4, scr, lane); continue; } r -= I_KI;
        if (r < I_BC) { tr_item(p.w_in, NIN, 1224, 1792, D, W1T, C_BC, r, 56, scr, lane); continue; } r -= I_BC;
        if (r < I_G) { tr_item(p.w_in, NIN, 3016, 2048, D, WGT, 0, r, 64, scr, lane); continue; } r -= I_G;
        if (r < I_PB) { tr_item(p.w_pb, D, 0, 1024, 512, WPBT, 0, r, 32, scr, lane); continue; } r -= I_PB;
        tr_item(p.w_o, D, 0, 1024, D, WOT, 0, r, 32, scr, lane);
    }
    {
        const int fr = lane & 15, fq = lane >> 4;
        constexpr int T_W1 = 8 * 8 * 64, T_SK = 16 * 8 * 64, T_PA = 8 * 8 * 64;
        f16* WPAT = (f16*)(p.ws + WS_WPAT); f16* WSKT = (f16*)(p.ws + WS_WSKT);
        for (int it = gw + (LATE ? T_W1 : 0); it < (LATE ? T_W1 + T_SK + T_PA : T_W1); it += NGW) {
            int r = it; int kind = 0; if (r >= T_W1) { r -= T_W1; kind = 1; if (r >= T_SK) { r -= T_SK; kind = 2; } }
            const int g = r >> 9, mt = (r >> 6) & 7, nt = r & 63;
            const int m = 16 * mt + fr, n = 16 * nt + fr;
            const int KK = (kind == 1) ? 128 : 64;
            f32x4 acc = {0.f, 0.f, 0.f, 0.f};
            for (int k0 = 0; k0 < KK; k0 += 32) {
                const int kb = k0 + 8 * fq;
                f16x8 af, bf;
                if (kind == 0) { const float* ap = p.a_w_uk + (size_t)(m * 8 + g) * 64 + kb; const float* bp = p.w_in + (size_t)n * NIN + g * 64 + kb;
                    const f32x4 a0 = *(const f32x4*)ap, a1 = *(const f32x4*)(ap + 4), b0 = *(const f32x4*)bp, b1 = *(const f32x4*)(bp + 4);
#pragma unroll
                    for (int e = 0; e < 4; ++e) { af[e] = (f16)a0[e]; af[4 + e] = (f16)a1[e]; bf[e] = (f16)b0[e]; bf[4 + e] = (f16)b1[e]; } }
                else if (kind == 1) { const float* ap = p.peer_subkeys + (size_t)(g * 128 + m) * 128 + kb; const float* bp = p.peer_wq + (size_t)n * 2048 + g * 128 + kb;
                    const f32x4 a0 = *(const f32x4*)ap, a1 = *(const f32x4*)(ap + 4), b0 = *(const f32x4*)bp, b1 = *(const f32x4*)(bp + 4);
#pragma unroll
                    for (int e = 0; e < 4; ++e) { af[e] = (f16)a0[e]; af[4 + e] = (f16)a1[e]; bf[e] = (f16)b0[e]; bf[4 + e] = (f16)b1[e]; } }
                else { const float* ap = p.a_w_uv + (size_t)(m * 8 + g) * 64 + kb; const float* bp = p.w_pa + (size_t)(g * 64 + kb) * D + n;
                    const f32x4 a0 = *(const f32x4*)ap, a1 = *(const f32x4*)(ap + 4);
#pragma unroll
                    for (int e = 0; e < 4; ++e) { af[e] = (f16)a0[e]; af[4 + e] = (f16)a1[e]; }
#pragma unroll
                    for (int e = 0; e < 8; ++e) bf[e] = (f16)bp[(size_t)e * D]; }
                acc = __builtin_amdgcn_mfma_f32_16x16x32_f16(af, bf, acc, 0, 0, 0);
            }
            if (kind == 2) { *(f16x4*)(WPAT + (size_t)n * D + g * 128 + 16 * mt + 4 * fq) = to_h4(acc); }
            else { f16* o = ((kind == 0) ? W1T : WSKT) + (size_t)(g * 128 + 16 * mt + 4 * fq) * D + n;
#pragma unroll
                for (int e = 0; e < 4; ++e) o[(size_t)e * D] = (f16)acc[e]; }
        }
    }
    const long gt = (long)vwg * NT + tid, NGT = (long)nvwg * NT;
    f16* WLT = (f16*)(p.ws + WS_WLT);
    for (long e = gt; e < (LATE ? 0L : 1536L * 256); e += NGT) { const int n = (int)(e >> 8), k = (int)(e & 255); float v = 0.f;
        if (n < 512) { if (k < 64) v = p.b_w2[(size_t)k * 512 + n]; }
        else if (n < 1024) { if (k >= 64 && k < 128) v = p.b_a2[(size_t)(k - 64) * 512 + (n - 512)]; }
        else { if (k >= 128) v = p.b_g2[(size_t)(k - 128) * 512 + (n - 1024)]; }
        WLT[e] = (f16)v; }
    if (LATE) {
        unsigned char* U8 = p.ws + WS_U8;
        for (long e = gt; e < 16384L * 1024 / 16; e += NGT) {
            u32x4 ou, ov;
#pragma unroll
            for (int q = 0; q < 4; ++q) { const f32x4 a = *(const f32x4*)(p.peer_u + e * 16 + q * 4) * 256.f; const f32x4 c = *(const f32x4*)(p.peer_v + e * 16 + q * 4) * 16.f;
                int w = 0; w = __builtin_amdgcn_cvt_pk_fp8_f32(a[0], a[1], w, false); w = __builtin_amdgcn_cvt_pk_fp8_f32(a[2], a[3], w, true); ou[q] = (unsigned)w;
                int x = 0; x = __builtin_amdgcn_cvt_pk_fp8_f32(c[0], c[1], x, false); x = __builtin_amdgcn_cvt_pk_fp8_f32(c[2], c[3], x, true); ov[q] = (unsigned)x; }
            const long row = e >> 6;
            unsigned char* vdst = (row < V8A_ROWS) ? p.ws + WS_V8A + e * 16 : p.ws + WS_V8B + (e - (long)V8A_ROWS * 64) * 16;
            *(u32x4*)(U8 + e * 16) = ou; *(u32x4*)vdst = ov;
        }
    }
}

__device__ __forceinline__ void phc1_rowprep(const Params& p) {
    const int tid = threadIdx.x, lane = tid & 63, wave = tid >> 6;
    const int gw = blockIdx.x * 8 + wave, NGW = gridDim.x * 8;
    const f16* PB = (const f16*)(p.ws + WS_PB); f16* CKV = (f16*)(p.ws + WS_CKV); f16* KIDX = (f16*)(p.ws + WS_KIDX); float* WIS = (float*)(p.ws + WS_WIS);
    f16* LORAIN = (f16*)((unsigned char*)p.out + DO_LORAIN);
    for (int m = gw; m < MR; m += NGW) {
        if (m >= MREAL + 2 * NMETA) { *(f16x4*)(LORAIN + (size_t)m * 256 + lane * 4) = (f16x4){(f16)0.f, (f16)0.f, (f16)0.f, (f16)0.f}; continue; }
        const f16* pr = PB + (size_t)m * N1;
        { const f16x2 c2 = *(const f16x2*)(pr + C_CKV + 2 * lane); const float a = (float)c2.x, b = (float)c2.y;
          const float ss = wave_sum(a * a + b * b); const float r = 1.f / sqrtf(ss * (1.f / 128.f) + 1e-6f);
          f16x2 o; o.x = (f16)(a * r * p.a_kv_norm_g[2 * lane]); o.y = (f16)(b * r * p.a_kv_norm_g[2 * lane + 1]);
          *(f16x2*)(CKV + (size_t)m * 128 + 2 * lane) = o; }
        { const float a = (float)pr[C_KI + lane]; const float mu = wave_sum(a) * (1.f / 64.f); const float d = a - mu;
          const float var = wave_sum(d * d) * (1.f / 64.f);
          int kb_, kt_; if (m < MREAL) { kb_ = m >> 13; kt_ = NMETA + (m & 8191); } else { kb_ = (m - MREAL) >> 4; kt_ = (m - MREAL) & 15; }
          KIDX[(size_t)kb_ * KIDX_B + (size_t)(kt_ >> 5) * 2048 + (lane >> 4) * 512 + ((lane >> 3) & 1) * 256 + (kt_ & 31) * 8 + (lane & 7)] = (f16)(d * (1.f / sqrtf(var + LN_EPS)) * p.a_kidx_g[lane] + p.a_kidx_b[lane]); }
        if (lane < 8) WIS[(size_t)m * 8 + lane] = (float)pr[C_WI + lane] * 0.04419417382415922f;
        { int b, t; if (m < MREAL) { b = m >> 13; t = NMETA + (m & 8191); } else { b = (m - MREAL) >> 4; t = (m - MREAL) & 15; }
          const f16x4 cur = *(const f16x4*)(pr + C_BC + 1536 + lane * 4);
          f16x4 prv = (f16x4){(f16)0.f, (f16)0.f, (f16)0.f, (f16)0.f};
          if (t > 0) prv = *(const f16x4*)(PB + (size_t)row_of(b, t - 1) * N1 + C_BC + 1536 + lane * 4);
          const f32x4 mu = *(const f32x4*)(p.b_mu + 1536 + lane * 4);
          f16x4 o;
#pragma unroll
          for (int e = 0; e < 4; ++e) { const float c = (float)cur[e], q = (float)prv[e]; float xs = c + (q - c) * mu[e];
              const int j = lane * 4 + e; if (j < 64) xs = tanhf(xs); else if (j >= 128) xs = sigmoidf_(xs); o[e] = (f16)xs; }
          *(f16x4*)(LORAIN + (size_t)m * 256 + lane * 4) = o; }
    }
}

typedef short bf16x8 __attribute__((ext_vector_type(8)));
typedef unsigned short bf16_t;
typedef unsigned u32x2 __attribute__((ext_vector_type(2)));
typedef __bf16 bf16x2_t __attribute__((ext_vector_type(2)));
__device__ __forceinline__ unsigned cvt_pk_bf16(float lo, float hi) { const f32x2 v = {lo, hi}; const bf16x2_t b = __builtin_convertvector(v, bf16x2_t); return __builtin_bit_cast(unsigned, b); }
__device__ __forceinline__ bf16_t f2bf(float f) { unsigned u = __float_as_uint(f); return (bf16_t)((u + 0x7fffu + ((u >> 16) & 1u)) >> 16); }
__device__ __forceinline__ u32x2 pk4(f32x4 v) { u32x2 r; r.x = cvt_pk_bf16(v[0], v[1]); r.y = cvt_pk_bf16(v[2], v[3]); return r; }
__device__ __forceinline__ bf16x8 pk8(f32x4 a, f32x4 b) { u32x4 r; r.x = cvt_pk_bf16(a[0], a[1]); r.y = cvt_pk_bf16(a[2], a[3]); r.z = cvt_pk_bf16(b[0], b[1]); r.w = cvt_pk_bf16(b[2], b[3]); return __builtin_bit_cast(bf16x8, r); }
#define MFMA_BF(a, b, c) __builtin_amdgcn_mfma_f32_16x16x32_bf16((a), (b), (c), 0, 0, 0)
constexpr int RS = 72, PSt = 40, FS = 36, YS = 68;
__device__ __forceinline__ void rwkv_item(const Params& p, int b, int h, unsigned char* lds) {
    int tid_ = threadIdx.x; asm volatile("" : "+v"(tid_));
    const int tid = tid_, lane = tid & 63, wave = __builtin_amdgcn_readfirstlane(tid >> 6), fr = lane & 15, fq = lane >> 4;
    const f16* PB = (const f16*)(p.ws + WS_PB);
    const f16* LW = (const f16*)((unsigned char*)p.out + DO_LW); const f16* AA = (const f16*)((unsigned char*)p.out + DO_AA); const f16* GG = (const f16*)((unsigned char*)p.out + DO_GG);
    f16* OB = (f16*)(p.ws + WS_OB);
    constexpr int SETB = 4 * 32 * RS * 2 + 3 * 64 * PSt * 2 + 256 + 4608 * 4;
#define RW_SET(par_) bf16_t* sAt = (bf16_t*)(lds + (par_) * SETB); bf16_t* sRt = sAt + 32 * RS; bf16_t* sBt = sRt + 32 * RS; bf16_t* sKt = sBt + 32 * RS; \
        bf16_t* sBPT = sKt + 32 * RS; bf16_t* sKPT = sBPT + 64 * PSt; bf16_t* sVT = sKPT + 64 * PSt; float* sPL = (float*)(sVT + 64 * PSt); float* sFst = sPL + 64; \
        (void)sAt; (void)sRt; (void)sBt; (void)sKt; (void)sBPT; (void)sKPT; (void)sVT; (void)sPL; (void)sFst
    bf16_t* sAak = (bf16_t*)(lds + 2 * SETB); bf16_t* sMrb = sAak + 32 * PSt; bf16_t* sMrk = sMrb + 32 * PSt; bf16_t* sT = sMrk + 32 * PSt; bf16_t* sAabB = sT + 32 * PSt;
    float* sAabT = (float*)(sAabB + 16 * PSt); float* sTot = sAabT + 2 * 16 * FS; float* sY = sTot + 8 * 64;
    float* sEnd = sY + 32 * YS;
    float* sCst = sEnd;
    for (unsigned* z = (unsigned*)lds + tid; z < (unsigned*)sEnd; z += NT) *z = 0u;
    const int ps = tid >> 4, cg = tid & 15, c4 = cg * 4, hc = h * 64 + c4;
    const int chslot = 32 * (cg >> 3) + 8 * (cg & 3) + 4 * ((cg >> 2) & 1);
    const int pslot = 8 * ((ps & 15) >> 2) + 4 * (ps >> 4) + (ps & 3);
#define PSWZ(row, slot) ((row) * PSt + ((((slot) >> 3) ^ (((row) >> 3) & 3)) << 3) + ((slot) & 7))
    if (tid < 64) { sCst[tid] = p.b_mu[h * 64 + tid]; sCst[64 + tid] = p.b_mu[512 + h * 64 + tid]; sCst[128 + tid] = p.b_mu[1024 + h * 64 + tid]; sCst[192 + tid] = p.b_k_k[h * 64 + tid];
        sCst[256 + tid] = p.b_k_a[h * 64 + tid]; sCst[320 + tid] = p.b_r_k[h * 64 + tid]; sCst[384 + tid] = p.b_lnx_g[h * 64 + tid]; sCst[448 + tid] = p.b_lnx_b[h * 64 + tid]; }
    f32x4 Hacc[4];
#pragma unroll
    for (int i = 0; i < 4; ++i) Hacc[i] = (f32x4){0.f, 0.f, 0.f, 0.f};
    const f16x4 hz = (f16x4){(f16)0.f, (f16)0.f, (f16)0.f, (f16)0.f};
    f16x4 n_cr = hz, n_ck = hz, n_cv = hz, n_qr = hz, n_qk = hz, n_qv = hz, n_lw = hz, n_aa = hz, n_gg = hz;
#define RW_PREFETCH(tt) do { const int _t = (tt); n_cr = hz; n_ck = hz; n_cv = hz; n_qr = hz; n_qk = hz; n_qv = hz; n_lw = hz; n_aa = hz; n_gg = hz; \
        if (_t < TT) { const int _m = row_of(b, _t); const f16* _pr = PB + (size_t)_m * N1 + C_BC + hc; n_cr = *(const f16x4*)(_pr); n_ck = *(const f16x4*)(_pr + 512); n_cv = *(const f16x4*)(_pr + 1024); \
            if (_t > 0) { const f16* _pp = PB + (size_t)row_of(b, _t - 1) * N1 + C_BC + hc; n_qr = *(const f16x4*)(_pp); n_qk = *(const f16x4*)(_pp + 512); n_qv = *(const f16x4*)(_pp + 1024); } \
            n_lw = *(const f16x4*)(LW + (size_t)_m * 512 + hc); n_aa = *(const f16x4*)(AA + (size_t)_m * 512 + hc); n_gg = *(const f16x4*)(GG + (size_t)_m * 512 + hc); } } while (0)
    const f16* pf_pb = PB + (size_t)(b * SEQ + 32 - NMETA + ps) * N1 + C_BC + hc;
    size_t pf_lo = (size_t)(b * SEQ + 32 - NMETA + ps) * 512 + hc; int pf_t = 32 + ps;
#define RW_PREFETCH_INC() do { n_cr = hz; n_ck = hz; n_cv = hz; n_qr = hz; n_qk = hz; n_qv = hz; n_lw = hz; n_aa = hz; n_gg = hz; \
        if (pf_t < TT) { n_cr = *(const f16x4*)(pf_pb); n_ck = *(const f16x4*)(pf_pb + 512); n_cv = *(const f16x4*)(pf_pb + 1024); \
            n_qr = *(const f16x4*)(pf_pb - N1); n_qk = *(const f16x4*)(pf_pb - N1 + 512); n_qv = *(const f16x4*)(pf_pb - N1 + 1024); \
            n_lw = *(const f16x4*)(LW + pf_lo); n_aa = *(const f16x4*)(AA + pf_lo); n_gg = *(const f16x4*)(GG + pf_lo); } \
        pf_pb += 32 * N1; pf_lo += 32 * 512; pf_t += 32; } while (0)
    RW_PREFETCH(ps);
    __syncthreads();
#define RW_SCAN_LOCAL(dst, lwv) do { dst = (f32x4){(float)(lwv)[0], (float)(lwv)[1], (float)(lwv)[2], (float)(lwv)[3]}; f32x4 u1_; \
        _Pragma("unroll") for (int e = 0; e < 4; ++e) u1_[e] = __shfl_up(dst[e], 16); if (lane >= 16) dst += u1_; \
        _Pragma("unroll") for (int e = 0; e < 4; ++e) u1_[e] = __shfl_up(dst[e], 32); if (lane >= 32) dst += u1_; \
        if (lane >= 48) *(f32x4*)(sTot + wave * 64 + c4) = dst; } while (0)
#define RW_SCAN_FINISH(dst, totv) do { totv = (f32x4){0.f, 0.f, 0.f, 0.f}; f32x4 tw_[8]; \
        _Pragma("unroll") for (int w = 0; w < 8; ++w) tw_[w] = *(const f32x4*)(sTot + w * 64 + c4); \
        __builtin_amdgcn_sched_barrier(0); \
        _Pragma("unroll") for (int w = 0; w < 8; ++w) { totv += tw_[w]; const float msk_ = (w < wave) ? 1.f : 0.f; dst += tw_[w] * msk_; } } while (0)
    f32x4 cumC, totC;
    RW_SCAN_LOCAL(cumC, n_lw);
    __syncthreads();
    RW_SCAN_FINISH(cumC, totC);
    __syncthreads();
    constexpr int NCH = (TT + 31) / 32;
    { RW_SET(0); const int t = ps;
        f32x4 r4 = {0, 0, 0, 0}, k4 = r4, v4 = r4, kk4 = r4, a4 = r4, g4 = r4, lw4 = r4;
        f32x4 rkw;
        {
            const f16x4 cr = n_cr, ck = n_ck, cv = n_cv, qr = n_qr, qk = n_qk, qv = n_qv, lw = n_lw, aa = n_aa, gg = n_gg;
            RW_PREFETCH_INC();
            const f32x4 mu_r = *(const f32x4*)(sCst + c4), mu_k = *(const f32x4*)(sCst + 64 + c4), mu_v = *(const f32x4*)(sCst + 128 + c4), kkw = *(const f32x4*)(sCst + 192 + c4), kaw = *(const f32x4*)(sCst + 256 + c4);
            rkw = *(const f32x4*)(sCst + 320 + c4);
#pragma unroll
            for (int e = 0; e < 4; ++e) {
                const float c0 = (float)cr[e], c1 = (float)ck[e], c2 = (float)cv[e];
                r4[e] = c0 + ((float)qr[e] - c0) * mu_r[e];
                const float k0 = c1 + ((float)qk[e] - c1) * mu_k[e];
                v4[e] = c2 + ((float)qv[e] - c2) * mu_v[e];
                a4[e] = (float)aa[e]; lw4[e] = (float)lw[e]; g4[e] = (float)gg[e];
                kk4[e] = k0 * kkw[e];
                k4[e] = k0 * (1.f + (a4[e] - 1.f) * kaw[e]);
            }
        }
        float ss = kk4[0] * kk4[0] + kk4[1] * kk4[1] + kk4[2] * kk4[2] + kk4[3] * kk4[3];
        float bo = r4[0] * k4[0] * rkw[0] + r4[1] * k4[1] * rkw[1] + r4[2] * k4[2] * rkw[2] + r4[3] * k4[3] * rkw[3];
        ss = row16_sum(ss); bo = row16_sum(bo);
        *(f32x4*)(sFst + tid * 4) = v4; *(f32x4*)(sFst + 2048 + tid * 4) = g4; sFst[4096 + tid] = bo;
        const float rn = __builtin_amdgcn_rsqf(ss + 1e-12f);
        f32x4 bb4;
#pragma unroll
        for (int e = 0; e < 4; ++e) { kk4[e] *= rn; bb4[e] = kk4[e] * a4[e]; }
        const f32x4 cum = cumC, tot = totC;
        {
            f32x4 xa, xb, xk, xr, xbp, xkp;
#pragma unroll
            for (int e = 0; e < 4; ++e) { const float e1 = __expf(cum[e]), e2 = __expf(-cum[e]), e3 = __expf(cum[e] - lw4[e]), e4 = __expf(tot[e] - cum[e]);
                xa[e] = -kk4[e] * e3; xb[e] = bb4[e] * e2; xk[e] = k4[e] * e2; xr[e] = r4[e] * e1; xbp[e] = bb4[e] * e4; xkp[e] = k4[e] * e4; }
            *(u32x2*)(sAt + ps * RS + chslot) = pk4(xa); *(u32x2*)(sBt + ps * RS + chslot) = pk4(xb); *(u32x2*)(sKt + ps * RS + chslot) = pk4(xk); *(u32x2*)(sRt + ps * RS + chslot) = pk4(xr);
#pragma unroll
            for (int e = 0; e < 4; e += 2) { const unsigned pb_ = cvt_pk_bf16(xbp[e], xbp[e + 1]), pk_ = cvt_pk_bf16(xkp[e], xkp[e + 1]), pv_ = cvt_pk_bf16(v4[e], v4[e + 1]);
                sBPT[PSWZ(c4 + e, pslot)] = (bf16_t)pb_; sBPT[PSWZ(c4 + e + 1, pslot)] = (bf16_t)(pb_ >> 16); sKPT[PSWZ(c4 + e, pslot)] = (bf16_t)pk_; sKPT[PSWZ(c4 + e + 1, pslot)] = (bf16_t)(pk_ >> 16);
                sVT[PSWZ(c4 + e, pslot)] = (bf16_t)pv_; sVT[PSWZ(c4 + e + 1, pslot)] = (bf16_t)(pv_ >> 16); }
            if (ps == 0) { f32x4 pl;
#pragma unroll
                for (int e = 0; e < 4; ++e) pl[e] = __expf(tot[e]);
                *(f32x4*)(sPL + c4) = pl; }
        }
    }
    __syncthreads();
    { RW_SET(0);
        for (int jb = (wave < 2) ? wave : wave, jn = 0; jb < 12 && !(wave < 2 && jn > 0); jb += 6, ++jn) {
            const bf16_t *Ab, *Bb; int ta, tb;
            if (jb < 2) { ta = jb; tb = jb; Ab = sAt; Bb = sBt; }
            else if (jb == 2) { ta = 0; tb = 1; Ab = sBt; Bb = sAt; }
            else { const int ti = (jb - 3) % 3, prod = (jb - 3) / 3; ta = (ti == 2) ? 1 : 0; tb = (ti >= 1) ? 1 : 0; Ab = (prod == 1) ? sBt : sKt; Bb = (prod == 0) ? sAt : sRt; }
            f32x4 acc = {0, 0, 0, 0};
#pragma unroll
            for (int ks = 0; ks < 2; ++ks) { const bf16x8 a = *(const bf16x8*)(Ab + (16 * ta + fr) * RS + 32 * ks + 8 * fq); const bf16x8 bq = *(const bf16x8*)(Bb + (16 * tb + fr) * RS + 32 * ks + 8 * fq); acc = MFMA_BF(a, bq, acc); }
            const int rloc = 4 * fq, cloc = fr;
            if (jb < 2) {
#pragma unroll
                for (int e = 0; e < 4; ++e) acc[e] = (cloc < rloc + e) ? acc[e] : 0.f;
                *(f32x4*)(sAabT + jb * 16 * FS + cloc * FS + rloc) = acc;
                asm volatile("s_waitcnt lgkmcnt(0)" ::: "memory");
                if (lane < 16) {
                    const int col = lane;
                    const float* At_ = sAabT + jb * 16 * FS;
                    float x[16];
#pragma unroll
                    for (int s2 = 0; s2 < 16; ++s2) x[s2] = (s2 == col) ? 1.f : 0.f;
#define RW_INV_BATCH(J0, J1) do { f32x4 cv_[(J1) - (J0)][4]; \
                    _Pragma("unroll") for (int j = (J0); j < (J1); ++j) _Pragma("unroll") for (int q4 = (j + 1) / 4; q4 < 4; ++q4) cv_[j - (J0)][q4] = *(const f32x4*)(At_ + j * FS + 4 * q4); \
                    __builtin_amdgcn_sched_barrier(0); \
                    _Pragma("unroll") for (int j = (J0); j < (J1); ++j) { const float xj = x[j]; \
                        _Pragma("unroll") for (int q4 = (j + 1) / 4; q4 < 4; ++q4) _Pragma("unroll") for (int e = 0; e < 4; ++e) if (4 * q4 + e > j) x[4 * q4 + e] += cv_[j - (J0)][q4][e] * xj; } \
                    __builtin_amdgcn_sched_barrier(0); } while (0)
                    RW_INV_BATCH(0, 3); RW_INV_BATCH(3, 7); RW_INV_BATCH(7, 15);
#pragma unroll
                    for (int s2 = 0; s2 < 16; ++s2) sT[(16 * jb + s2) * PSt + 8 * (col >> 2) + (col & 3)] = f2bf(x[s2]);
                }
            } else if (jb == 2) {
                *(u32x2*)(sAabB + cloc * PSt + 8 * fq) = pk4(acc);
            } else {
                const int prod = (jb - 3) / 3; const int jrow = 16 * ta + rloc, scol = 16 * tb + cloc;
                if (prod == 0) {
#pragma unroll
                    for (int e = 0; e < 4; ++e) acc[e] = (jrow + e < scol) ? acc[e] : 0.f;
                } else {
#pragma unroll
                    for (int e = 0; e < 4; ++e) acc[e] = (jrow + e <= scol) ? acc[e] : 0.f;
                }
                *(u32x2*)(((prod == 0) ? sAak : (prod == 1) ? sMrb : sMrk) + scol * PSt + 8 * fq + 4 * ta) = pk4(acc);
            }
        }
    }
    { f32x4 cumN, totN; RW_SCAN_LOCAL(cumN, n_lw); __syncthreads(); RW_SCAN_FINISH(cumN, totN); cumC = cumN; totC = totN; }
    for (int c = 0; c < NCH; ++c) {
        const int par = c & 1; const bool more = (c + 1 < NCH);
        { RW_SET(par);
        if (wave < 4) {
            const int v0 = 16 * wave;
            const f32x4 z4 = {0.f, 0.f, 0.f, 0.f};
            const bf16x8 hb0 = pk8(Hacc[0], Hacc[1]), hb1 = pk8(Hacc[2], Hacc[3]);
            const bf16x8 vb = *(const bf16x8*)(sVT + PSWZ(v0 + fr, 8 * fq));
            bf16x8 fAt[2][2], fAak[2], fT[2], fAabB;
#pragma unroll
            for (int ts = 0; ts < 2; ++ts) { const bf16_t* atr = sAt + (16 * ts + fr) * RS;
                fAt[ts][0] = *(const bf16x8*)(atr + 8 * fq); fAt[ts][1] = *(const bf16x8*)(atr + 32 + 8 * fq); fAak[ts] = *(const bf16x8*)(sAak + (16 * ts + fr) * PSt + 8 * fq); fT[ts] = *(const bf16x8*)(sT + (16 * ts + fr) * PSt + 8 * fq); }
            fAabB = *(const bf16x8*)(sAabB + fr * PSt + 8 * fq);
            __builtin_amdgcn_sched_barrier(0);
            f32x4 zt = MFMA_BF(fAt[0][0], hb0, z4); f32x4 zb = MFMA_BF(fAt[1][0], hb0, z4);
            zt = MFMA_BF(fAt[0][1], hb1, zt); zb = MFMA_BF(fAt[1][1], hb1, zb);
            zt = MFMA_BF(fAak[0], vb, zt); zb = MFMA_BF(fAak[1], vb, zb);
            bf16x8 fRt[2][2], fMrk[2], fMrb[2];
#pragma unroll
            for (int ts = 0; ts < 2; ++ts) { const bf16_t* rtr = sRt + (16 * ts + fr) * RS;
                fRt[ts][0] = *(const bf16x8*)(rtr + 8 * fq); fRt[ts][1] = *(const bf16x8*)(rtr + 32 + 8 * fq);
                fMrk[ts] = *(const bf16x8*)(sMrk + (16 * ts + fr) * PSt + 8 * fq); fMrb[ts] = *(const bf16x8*)(sMrb + (16 * ts + fr) * PSt + 8 * fq); }
            __builtin_amdgcn_sched_barrier(0);
            const f32x4 ut = MFMA_BF(fT[0], pk8(zt, z4), z4);
            f32x4 y0 = MFMA_BF(fRt[0][0], hb0, z4); f32x4 y1 = MFMA_BF(fRt[1][0], hb0, z4);
            y0 = MFMA_BF(fRt[0][1], hb1, y0); y1 = MFMA_BF(fRt[1][1], hb1, y1);
            zb = MFMA_BF(fAabB, pk8(ut, z4), zb);
            y0 = MFMA_BF(fMrk[0], vb, y0); y1 = MFMA_BF(fMrk[1], vb, y1);
            const f32x4 ubt = MFMA_BF(fT[1], pk8(zb, z4), z4);
            const bf16x8 ub = pk8(ut, ubt);
            y0 = MFMA_BF(fMrb[0], ub, y0); y1 = MFMA_BF(fMrb[1], ub, y1);
#pragma unroll
            for (int e = 0; e < 4; ++e) { sY[(4 * fq + e) * YS + v0 + fr] = y0[e]; sY[(16 + 4 * fq + e) * YS + v0 + fr] = y1[e]; }
            __builtin_amdgcn_sched_barrier(0);
            bf16x8 fBP[4], fKP[4]; f32x4 fPL[4];
#pragma unroll
            for (int tc = 0; tc < 4; ++tc) { fBP[tc] = *(const bf16x8*)(sBPT + PSWZ(16 * tc + fr, 8 * fq)); fKP[tc] = *(const bf16x8*)(sKPT + PSWZ(16 * tc + fr, 8 * fq)); fPL[tc] = *(const f32x4*)(sPL + 16 * tc + 4 * fq); }
            __builtin_amdgcn_sched_barrier(0);
#pragma unroll
            for (int tc = 0; tc < 4; ++tc) {
                f32x4 acc = Hacc[tc] * fPL[tc];
                acc = MFMA_BF(fBP[tc], ub, acc);
                acc = MFMA_BF(fKP[tc], vb, acc);
                Hacc[tc] = acc; }
        }
        }
        if (more) { RW_SET(par ^ 1); const int t = 32 * (c + 1) + ps;
        f32x4 r4 = {0, 0, 0, 0}, k4 = r4, v4 = r4, kk4 = r4, a4 = r4, g4 = r4, lw4 = r4;
        f32x4 rkw;
        {
            const f16x4 cr = n_cr, ck = n_ck, cv = n_cv, qr = n_qr, qk = n_qk, qv = n_qv, lw = n_lw, aa = n_aa, gg = n_gg;
            RW_PREFETCH_INC();
            const f32x4 mu_r = *(const f32x4*)(sCst + c4), mu_k = *(const f32x4*)(sCst + 64 + c4), mu_v = *(const f32x4*)(sCst + 128 + c4), kkw = *(const f32x4*)(sCst + 192 + c4), kaw = *(const f32x4*)(sCst + 256 + c4);
            rkw = *(const f32x4*)(sCst + 320 + c4);
#pragma unroll
            for (int e = 0; e < 4; ++e) {
                const float c0 = (float)cr[e], c1 = (float)ck[e], c2 = (float)cv[e];
                r4[e] = c0 + ((float)qr[e] - c0) * mu_r[e];
                const float k0 = c1 + ((float)qk[e] - c1) * mu_k[e];
                v4[e] = c2 + ((float)qv[e] - c2) * mu_v[e];
                a4[e] = (float)aa[e]; lw4[e] = (float)lw[e]; g4[e] = (float)gg[e];
                kk4[e] = k0 * kkw[e];
                k4[e] = k0 * (1.f + (a4[e] - 1.f) * kaw[e]);
            }
        }
        float ss = kk4[0] * kk4[0] + kk4[1] * kk4[1] + kk4[2] * kk4[2] + kk4[3] * kk4[3];
        float bo = r4[0] * k4[0] * rkw[0] + r4[1] * k4[1] * rkw[1] + r4[2] * k4[2] * rkw[2] + r4[3] * k4[3] * rkw[3];
        ss = row16_sum(ss); bo = row16_sum(bo);
        *(f32x4*)(sFst + tid * 4) = v4; *(f32x4*)(sFst + 2048 + tid * 4) = g4; sFst[4096 + tid] = bo;
        const float rn = __builtin_amdgcn_rsqf(ss + 1e-12f);
        f32x4 bb4;
#pragma unroll
        for (int e = 0; e < 4; ++e) { kk4[e] *= rn; bb4[e] = kk4[e] * a4[e]; }
        const f32x4 cum = cumC, tot = totC;
        {
            f32x4 xa, xb, xk, xr, xbp, xkp;
#pragma unroll
            for (int e = 0; e < 4; ++e) { const float e1 = __expf(cum[e]), e2 = __expf(-cum[e]), e3 = __expf(cum[e] - lw4[e]), e4 = __expf(tot[e] - cum[e]);
                xa[e] = -kk4[e] * e3; xb[e] = bb4[e] * e2; xk[e] = k4[e] * e2; xr[e] = r4[e] * e1; xbp[e] = bb4[e] * e4; xkp[e] = k4[e] * e4; }
            *(u32x2*)(sAt + ps * RS + chslot) = pk4(xa); *(u32x2*)(sBt + ps * RS + chslot) = pk4(xb); *(u32x2*)(sKt + ps * RS + chslot) = pk4(xk); *(u32x2*)(sRt + ps * RS + chslot) = pk4(xr);
#pragma unroll
            for (int e = 0; e < 4; e += 2) { const unsigned pb_ = cvt_pk_bf16(xbp[e], xbp[e + 1]), pk_ = cvt_pk_bf16(xkp[e], xkp[e + 1]), pv_ = cvt_pk_bf16(v4[e], v4[e + 1]);
                sBPT[PSWZ(c4 + e, pslot)] = (bf16_t)pb_; sBPT[PSWZ(c4 + e + 1, pslot)] = (bf16_t)(pb_ >> 16); sKPT[PSWZ(c4 + e, pslot)] = (bf16_t)pk_; sKPT[PSWZ(c4 + e + 1, pslot)] = (bf16_t)(pk_ >> 16);
                sVT[PSWZ(c4 + e, pslot)] = (bf16_t)pv_; sVT[PSWZ(c4 + e + 1, pslot)] = (bf16_t)(pv_ >> 16); }
            if (ps == 0) { f32x4 pl;
#pragma unroll
                for (int e = 0; e < 4; ++e) pl[e] = __expf(tot[e]);
                *(f32x4*)(sPL + c4) = pl; }
        }
        }
        __syncthreads();
        { RW_SET(par);
#pragma unroll
          for (int rr = 0; rr < 2; ++rr) {
            const int vt = rr ? tid - 384 : tid; const bool act = rr ? (wave >= 6) : (wave >= 2);
            if (act) {
                const int psv = vt >> 4, tF = 32 * c + psv;
                const f32x4 y4 = *(const f32x4*)(sY + psv * YS + c4); const f32x4 lng = *(const f32x4*)(sCst + 384 + c4), lnb = *(const f32x4*)(sCst + 448 + c4);
                const f32x4 pv4 = *(const f32x4*)(sFst + vt * 4), pg4 = *(const f32x4*)(sFst + 2048 + vt * 4); const float pbo = sFst[4096 + vt];
                const float mean = row16_sum((y4[0] + y4[1]) + (y4[2] + y4[3])) * (1.f / 64.f);
                float q = 0.f;
#pragma unroll
                for (int e = 0; e < 4; ++e) { const float d = y4[e] - mean; q += d * d; }
                const float rstd = __builtin_amdgcn_rsqf(row16_sum(q) * (1.f / 64.f) + 64e-5f);
                if (tF < TT && tF >= NMETA) {
                    f16x4 o;
#pragma unroll
                    for (int e = 0; e < 4; ++e) o[e] = (f16)((((y4[e] - mean) * rstd) * lng[e] + lnb[e] + pbo * pv4[e]) * pg4[e]);
                    *(f16x4*)(OB + (size_t)(b * SEQ + (tF - NMETA)) * 512 + hc) = o;
                }
            }
          }
        }
        f32x4 cumN = {0.f, 0.f, 0.f, 0.f}, totN = cumN;
        if (more) { RW_SET(par ^ 1);
        for (int jb = (wave < 2) ? wave : wave, jn = 0; jb < 12 && !(wave < 2 && jn > 0); jb += 6, ++jn) {
            const bf16_t *Ab, *Bb; int ta, tb;
            if (jb < 2) { ta = jb; tb = jb; Ab = sAt; Bb = sBt; }
            else if (jb == 2) { ta = 0; tb = 1; Ab = sBt; Bb = sAt; }
            else { const int ti = (jb - 3) % 3, prod = (jb - 3) / 3; ta = (ti == 2) ? 1 : 0; tb = (ti >= 1) ? 1 : 0; Ab = (prod == 1) ? sBt : sKt; Bb = (prod == 0) ? sAt : sRt; }
            f32x4 acc = {0, 0, 0, 0};
#pragma unroll
            for (int ks = 0; ks < 2; ++ks) { const bf16x8 a = *(const bf16x8*)(Ab + (16 * ta + fr) * RS + 32 * ks + 8 * fq); const bf16x8 bq = *(const bf16x8*)(Bb + (16 * tb + fr) * RS + 32 * ks + 8 * fq); acc = MFMA_BF(a, bq, acc); }
            const int rloc = 4 * fq, cloc = fr;
            if (jb < 2) {
#pragma unroll
                for (int e = 0; e < 4; ++e) acc[e] = (cloc < rloc + e) ? acc[e] : 0.f;
                *(f32x4*)(sAabT + jb * 16 * FS + cloc * FS + rloc) = acc;
                asm volatile("s_waitcnt lgkmcnt(0)" ::: "memory");
                if (lane < 16) {
                    const int col = lane;
                    const float* At_ = sAabT + jb * 16 * FS;
                    float x[16];
#pragma unroll
                    for (int s2 = 0; s2 < 16; ++s2) x[s2] = (s2 == col) ? 1.f : 0.f;
#define RW_INV_BATCH(J0, J1) do { f32x4 cv_[(J1) - (J0)][4]; \
                    _Pragma("unroll") for (int j = (J0); j < (J1); ++j) _Pragma("unroll") for (int q4 = (j + 1) / 4; q4 < 4; ++q4) cv_[j - (J0)][q4] = *(const f32x4*)(At_ + j * FS + 4 * q4); \
                    __builtin_amdgcn_sched_barrier(0); \
                    _Pragma("unroll") for (int j = (J0); j < (J1); ++j) { const float xj = x[j]; \
                        _Pragma("unroll") for (int q4 = (j + 1) / 4; q4 < 4; ++q4) _Pragma("unroll") for (int e = 0; e < 4; ++e) if (4 * q4 + e > j) x[4 * q4 + e] += cv_[j - (J0)][q4][e] * xj; } \
                    __builtin_amdgcn_sched_barrier(0); } while (0)
                    RW_INV_BATCH(0, 3); RW_INV_BATCH(3, 7); RW_INV_BATCH(7, 15);
#pragma unroll
                    for (int s2 = 0; s2 < 16; ++s2) sT[(16 * jb + s2) * PSt + 8 * (col >> 2) + (col & 3)] = f2bf(x[s2]);
                }
            } else if (jb == 2) {
                *(u32x2*)(sAabB + cloc * PSt + 8 * fq) = pk4(acc);
            } else {
                const int prod = (jb - 3) / 3; const int jrow = 16 * ta + rloc, scol = 16 * tb + cloc;
                if (prod == 0) {
#pragma unroll
                    for (int e = 0; e < 4; ++e) acc[e] = (jrow + e < scol) ? acc[e] : 0.f;
                } else {
#pragma unroll
                    for (int e = 0; e < 4; ++e) acc[e] = (jrow + e <= scol) ? acc[e] : 0.f;
                }
                *(u32x2*)(((prod == 0) ? sAak : (prod == 1) ? sMrb : sMrk) + scol * PSt + 8 * fq + 4 * ta) = pk4(acc);
            }
        }
            RW_SCAN_LOCAL(cumN, n_lw);
        }
        __syncthreads();
        if (more) { RW_SCAN_FINISH(cumN, totN); cumC = cumN; totC = totN; }
    }
    __syncthreads();
}

constexpr int SCW = 8224;
__device__ __forceinline__ void dsa_item(const Params& p, int b, int g, unsigned char* lds) {
    int tid_ = threadIdx.x; asm volatile("" : "+v"(tid_));
    const int tid = tid_, lane = tid & 63, wave = __builtin_amdgcn_readfirstlane(tid >> 6);
    const f16* PB = (const f16*)(p.ws + WS_PB); const f16* CKV = (const f16*)(p.ws + WS_CKV); const f16* KIDX = (const f16*)(p.ws + WS_KIDX); const float* WIS = (const float*)(p.ws + WS_WIS);
    f16* OLAT = (f16*)(p.ws + WS_OLAT);
    float* sc = (float*)lds;
    unsigned* hist = (unsigned*)(lds + 4 * SCW * 4);
    unsigned short* sel = (unsigned short*)(lds + 4 * SCW * 4 + 4096);
    unsigned* misc = (unsigned*)(lds + 4 * SCW * 4 + 4096 + 2048);
    f16* sq = (f16*)(lds + 4 * SCW * 4 + 4096 + 2048 + 512);
    const int i0 = 4 * g, n_adm = 80 + 64 * (i0 >> 6), ntile = (n_adm + 31) >> 5;
    const int mq0 = b * SEQ + i0;
    {
        const int rho = lane & 31, hh = lane >> 5;
        const int q = 2 * ((rho >> 2) & 1) + (rho >> 4), hd = 4 * ((rho >> 3) & 1) + (rho & 3);
        const f16* qip = PB + (size_t)(mq0 + q) * N1 + C_QI + hd * 64 + 8 * hh;
        f16x8 af[4];
#pragma unroll
        for (int ks = 0; ks < 4; ++ks) af[ks] = *(const f16x8*)(qip + 16 * ks);
        float wsc[16];
#pragma unroll
        for (int j = 0; j < 16; ++j) wsc[j] = WIS[(size_t)(mq0 + 2 * hh + (j >> 3)) * 8 + (j & 7)];
        float mn0 = INFINITY, mx0 = -INFINITY, mn1 = INFINITY, mx1 = -INFINITY;
        f16x8 bn[2][4];
#pragma unroll
        for (int u = 0; u < 2; ++u) { const f16* kp = KIDX + (size_t)b * KIDX_B + (size_t)(wave + 8 * u) * 2048 + hh * 256 + (lane & 31) * 8;
#pragma unroll
          for (int ks = 0; ks < 4; ++ks) bn[u][ks] = *(const f16x8*)(kp + 512 * ks); }
        for (int kt = wave; kt < ntile; kt += 16) {
            f16x8 bf[2][4];
#pragma unroll
            for (int u = 0; u < 2; ++u)
#pragma unroll
                for (int ks = 0; ks < 4; ++ks) bf[u][ks] = bn[u][ks];
#pragma unroll
            for (int u = 0; u < 2; ++u) { int kn = kt + 16 + 8 * u; kn = (kn < ntile) ? kn : kt;
                const f16* kp = KIDX + (size_t)b * KIDX_B + (size_t)kn * 2048 + hh * 256 + (lane & 31) * 8;
#pragma unroll
                for (int ks = 0; ks < 4; ++ks) bn[u][ks] = *(const f16x8*)(kp + 512 * ks); }
            f32x16 acc0, acc1;
#pragma unroll
            for (int j = 0; j < 16; ++j) { acc0[j] = 0.f; acc1[j] = 0.f; }
#pragma unroll
            for (int ks = 0; ks < 4; ++ks) { acc0 = __builtin_amdgcn_mfma_f32_32x32x16_f16(af[ks], bf[0][ks], acc0, 0, 0, 0); acc1 = __builtin_amdgcn_mfma_f32_32x32x16_f16(af[ks], bf[1][ks], acc1, 0, 0, 0); }
            float sa0 = 0.f, sb0 = 0.f, sa1 = 0.f, sb1 = 0.f;
#pragma unroll
            for (int jj = 0; jj < 8; ++jj) { sa0 += wsc[jj] * fmaxf(acc0[jj], 0.f); sb0 += wsc[8 + jj] * fmaxf(acc0[8 + jj], 0.f); sa1 += wsc[jj] * fmaxf(acc1[jj], 0.f); sb1 += wsc[8 + jj] * fmaxf(acc1[8 + jj], 0.f); }
            const int key0 = kt * 32 + (lane & 31), key1 = key0 + 256;
            sc[(2 * hh) * SCW + key0] = sa0; sc[(2 * hh + 1) * SCW + key0] = sb0;
            if (key0 < n_adm) { mn0 = fminf(mn0, sa0); mx0 = fmaxf(mx0, sa0); mn1 = fminf(mn1, sb0); mx1 = fmaxf(mx1, sb0); }
            if (kt + 8 < ntile) { sc[(2 * hh) * SCW + key1] = sa1; sc[(2 * hh + 1) * SCW + key1] = sb1;
                if (key1 < n_adm) { mn0 = fminf(mn0, sa1); mx0 = fmaxf(mx0, sa1); mn1 = fminf(mn1, sb1); mx1 = fmaxf(mx1, sb1); } }
        }
#pragma unroll
        for (int o = 1; o < 32; o <<= 1) { mn0 = fminf(mn0, __shfl_xor(mn0, o)); mx0 = fmaxf(mx0, __shfl_xor(mx0, o)); mn1 = fminf(mn1, __shfl_xor(mn1, o)); mx1 = fmaxf(mx1, __shfl_xor(mx1, o)); }
        float* mm = (float*)(misc + 64);
        if ((lane & 31) == 0) { mm[((2 * hh) * 8 + wave) * 2] = mn0; mm[((2 * hh) * 8 + wave) * 2 + 1] = mx0; mm[((2 * hh + 1) * 8 + wave) * 2] = mn1; mm[((2 * hh + 1) * 8 + wave) * 2 + 1] = mx1; }
        *(f16x8*)(sq + tid * 8) = *(const f16x8*)(PB + (size_t)(mq0 + (tid >> 7)) * N1 + C_QABS + (tid & 127) * 8);
    }
    const int qs = tid >> 7, tl = tid & 127;
    if (n_adm > 256) { hist[qs * 256 + tl] = 0u; hist[qs * 256 + 128 + tl] = 0u; if (tl < 4) misc[qs * 8 + 2 + tl] = 0u; }
    __syncthreads();
    int nsel;
    {
        const float* scq = sc + qs * SCW;
        if (n_adm <= 256) { for (int idx = tl; idx < n_adm; idx += 128) sel[qs * 256 + idx] = (unsigned short)idx; nsel = n_adm; }
        else {
            constexpr int NK = 65;
            const float* mm = (const float*)(misc + 64);
            float lo = INFINITY, hi = -INFINITY;
#pragma unroll
            for (int w = 0; w < 8; ++w) { lo = fminf(lo, mm[(qs * 8 + w) * 2]); hi = fmaxf(hi, mm[(qs * 8 + w) * 2 + 1]); }
            const float scale = (hi > lo) ? 16777215.f / (hi - lo) : 0.f;
            unsigned kreg[NK];
#pragma unroll
            for (int i = 0; i < NK; ++i) { const int idx = tl + 128 * i; const float v = (idx < n_adm) ? scq[idx] : lo; unsigned k = (unsigned)((v - lo) * scale); k = k > 0xFFFFFFu ? 0xFFFFFFu : k; kreg[i] = k;
                if (idx < n_adm) atomicAdd(&hist[qs * 256 + (k >> 16)], 1u); }
            __syncthreads();
            if (tl < 64) {
                const int c0 = (int)hist[qs * 256 + 4 * tl], c1 = (int)hist[qs * 256 + 4 * tl + 1], c2 = (int)hist[qs * 256 + 4 * tl + 2], c3 = (int)hist[qs * 256 + 4 * tl + 3];
                const int tot = c0 + c1 + c2 + c3; int sfx = tot;
#pragma unroll
                for (int off = 1; off < 64; off <<= 1) { const int tv = __shfl_down(sfx, off); if (tl + off < 64) sfx += tv; }
                const int above = sfx - tot;
                if (above < 256 && 256 <= sfx) { const int rem = 256 - above; int bin, nk;
                    if (rem <= c3) { bin = 4 * tl + 3; nk = rem; } else if (rem <= c3 + c2) { bin = 4 * tl + 2; nk = rem - c3; }
                    else if (rem <= c3 + c2 + c1) { bin = 4 * tl + 1; nk = rem - c3 - c2; } else { bin = 4 * tl; nk = rem - c3 - c2 - c1; }
                    misc[qs * 8] = (unsigned)bin; misc[qs * 8 + 1] = (unsigned)nk; }
            }
            __syncthreads();
            const unsigned bin = misc[qs * 8]; const int need = (int)misc[qs * 8 + 1];
            unsigned* cand = (unsigned*)(sc + qs * SCW) + 0;
            const int lane_ = tid & 63;
            __syncthreads();
#pragma unroll
            for (int i = 0; i < NK; ++i) { const int idx = tl + 128 * i; const unsigned u = kreg[i]; const bool ok = idx < n_adm; const unsigned tb = u >> 16;
                if (ok && tb > bin) { const unsigned long long m = __ballot(1); const int leader = __ffsll((long long)m) - 1; unsigned base = 0u;
                    if (lane_ == leader) base = atomicAdd(&misc[qs * 8 + 2], (unsigned)__popcll(m));
                    base = __shfl(base, leader);
                    sel[qs * 256 + base + __popcll(m & ((1ull << lane_) - 1ull))] = (unsigned short)idx; }
                else if (ok && tb == bin) { const unsigned e = atomicAdd(&misc[qs * 8 + 3], 1u); if (e < 4096u) { cand[2 * e] = u; cand[2 * e + 1] = (unsigned)idx; } } }
            __syncthreads();
            { const int m = min((int)misc[qs * 8 + 3], 4096); const int base = (int)misc[qs * 8 + 2];
              for (int i = tl; i < m; i += 128) { const unsigned ku = cand[2 * i]; const unsigned ki = cand[2 * i + 1]; int rank = 0;
                  for (int j = 0; j < m; ++j) { const unsigned kj = cand[2 * j]; const unsigned ij = cand[2 * j + 1]; rank += (kj > ku || (kj == ku && ij < ki)) ? 1 : 0; }
                  if (rank < need) sel[qs * 256 + base + rank] = (unsigned short)ki; } }
            nsel = 256;
        }
    }
    __syncthreads();
    {
        int lane_ = lane; asm volatile("" : "+v"(lane_));
        const int fr = lane_ & 15, fq = lane_ >> 4, aq = wave >> 1, rh = wave & 1;
        const unsigned short* selq = sel + aq * 256;
        unsigned char* cq = lds + aq * 32768;
        f16x8 qf[4];
#pragma unroll
        for (int ks = 0; ks < 4; ++ks) { qf[ks] = *(const f16x8*)(sq + (aq * 8 + (fr & 7)) * 128 + 32 * ks + 8 * fq); if (fr >= 8) qf[ks] = (f16x8){(f16)0.f, (f16)0.f, (f16)0.f, (f16)0.f, (f16)0.f, (f16)0.f, (f16)0.f, (f16)0.f}; }
        f16x8 I0, I1;
#pragma unroll
        for (int j = 0; j < 8; ++j) { I0[j] = (8 * fq + j == fr) ? (f16)1.f : (f16)0.f; I1[j] = (8 * fq + j == 16 + fr) ? (f16)1.f : (f16)0.f; }
        f32x4 O[4];
#pragma unroll
        for (int j = 0; j < 4; ++j) O[j] = (f32x4){0.f, 0.f, 0.f, 0.f};
        float m_run = -1e30f, l_run = 0.f;
        for (int kb = 0; kb < 2; ++kb) {
            {
                f16x8 g[16];
#pragma unroll
                for (int i = 0; i < 16; ++i) { const int rl = 64 * rh + 4 * i + fq; const int kk = 128 * kb + rl; const int kidx = (kk < nsel) ? (int)selq[kk] : 0;
                    g[i] = *(const f16x8*)(CKV + (size_t)row_of(b, kidx) * 128 + fr * 8); }
                __builtin_amdgcn_sched_barrier(0);
#pragma unroll
                for (int i = 0; i < 16; ++i) { const int rl = 64 * rh + 4 * i + fq; *(f16x8*)(cq + rl * 256 + ((fr ^ (rl & 15)) << 4)) = g[i]; }
            }
            __syncthreads();
            f32x4 S[8];
#pragma unroll
            for (int kt = 0; kt < 8; ++kt) { const int rl = 16 * kt + fr; f16x8 a[4];
#pragma unroll
                for (int ks = 0; ks < 4; ++ks) a[ks] = *(const f16x8*)(cq + rl * 256 + (((4 * ks + fq) ^ fr) << 4));
                f32x4 acc = {0.f, 0.f, 0.f, 0.f};
#pragma unroll
                for (int ks = 0; ks < 4; ++ks) acc = __builtin_amdgcn_mfma_f32_16x16x32_f16(a[ks], qf[ks], acc, 0, 0, 0);
                S[kt] = acc; }
            float mx = -1e30f;
#pragma unroll
            for (int kt = 0; kt < 8; ++kt)
#pragma unroll
                for (int e = 0; e < 4; ++e) { const float v = (128 * kb + 16 * kt + 4 * fq + e < nsel) ? S[kt][e] * 0.125f : -1e30f; S[kt][e] = v; mx = fmaxf(mx, v); }
            mx = fmaxf(mx, __shfl_xor(mx, 16)); mx = fmaxf(mx, __shfl_xor(mx, 32));
            const float m_new = fmaxf(m_run, mx);
            const float alpha = __expf(m_run - m_new);
            float sum = 0.f;
#pragma unroll
            for (int kt = 0; kt < 8; ++kt)
#pragma unroll
                for (int e = 0; e < 4; ++e) { const float pv = (S[kt][e] > -1e29f) ? __expf(S[kt][e] - m_new) : 0.f; S[kt][e] = pv; sum += pv; }
            sum += __shfl_xor(sum, 16); sum += __shfl_xor(sum, 32);
            l_run = l_run * alpha + sum; m_run = m_new;
#pragma unroll
            for (int e = 0; e < 4; ++e) { const float al = __shfl(alpha, 4 * fq + e);
#pragma unroll
                for (int j = 0; j < 4; ++j) O[j][e] *= al; }
            f16x8 Pf[4];
#pragma unroll
            for (int i = 0; i < 4; ++i)
#pragma unroll
                for (int e = 0; e < 4; ++e) { Pf[i][e] = (f16)S[2 * i][e]; Pf[i][4 + e] = (f16)S[2 * i + 1][e]; }
#pragma unroll
            for (int i = 0; i < 4; ++i) {
                const int ra = 32 * i + fr, rb = ra + 16;
                f16x8 xa[2], xb[2];
#pragma unroll
                for (int u = 0; u < 2; ++u) { xa[u] = *(const f16x8*)(cq + ra * 256 + (((4 * (2 * rh + u) + fq) ^ fr) << 4)); xb[u] = *(const f16x8*)(cq + rb * 256 + (((4 * (2 * rh + u) + fq) ^ fr) << 4)); }
#pragma unroll
                for (int j = 0; j < 4; ++j) {
                    const f32x4 z = {0.f, 0.f, 0.f, 0.f};
                    const f32x4 da = __builtin_amdgcn_mfma_f32_16x16x32_f16(xa[j >> 1], (j & 1) ? I1 : I0, z, 0, 0, 0);
                    const f32x4 db = __builtin_amdgcn_mfma_f32_16x16x32_f16(xb[j >> 1], (j & 1) ? I1 : I0, z, 0, 0, 0);
                    f16x8 bfr;
#pragma unroll
                    for (int e = 0; e < 4; ++e) { bfr[e] = (f16)da[e]; bfr[4 + e] = (f16)db[e]; }
                    O[j] = __builtin_amdgcn_mfma_f32_16x16x32_f16(Pf[i], bfr, O[j], 0, 0, 0);
                }
            }
            __syncthreads();
        }
        const float inv = 1.f / l_run;
        if (fq < 2) {
#pragma unroll
            for (int e = 0; e < 4; ++e) { const float il = __shfl(inv, 4 * fq + e);
#pragma unroll
                for (int j = 0; j < 4; ++j) OLAT[(size_t)(mq0 + aq) * 1024 + (4 * fq + e) * 128 + 64 * rh + 16 * j + fr] = (f16)(O[j][e] * il); }
        }
    }
    __syncthreads();
}

__device__ __forceinline__ void phc2_mixers(const Params& p, unsigned char* lds, int rep) {
    unsigned* ctr = (unsigned*)(p.ws + WS_CTL) + 64 + 64 * rep;
    int* s_item = (int*)(lds + 150 * 1024 - 16);
    constexpr int NRW = 16, NDSA = 2 * (SEQ / 4), NFILL = 512;
    for (;;) {
        if (threadIdx.x == 0) *s_item = (int)atomicAdd(ctr, 1u);
        __syncthreads();
        const int item = *s_item;
        __syncthreads();
        if (item >= NRW + NDSA + NFILL) break;
        if (item >= NRW + NDSA) { ph0_prep<true>(p, lds, item - (NRW + NDSA), NFILL); __syncthreads(); continue; }
        if (item < NRW) rwkv_item(p, item >> 3, item & 7, lds);
        else { const int d = item - NRW; dsa_item(p, d & 1, (SEQ / 4 - 1) - (d >> 1), lds); }
    }
}

__device__ __forceinline__ void phd3_ln1(const Params& p) {
    const int tid = threadIdx.x, lane = tid & 63, wave = tid >> 6;
    const int gw = blockIdx.x * 8 + wave, NGW = gridDim.x * 8;
    f16* H1H = (f16*)(p.ws + WS_H1H);
    for (int m = gw; m < MREAL; m += NGW) {
        float* row = p.out + (size_t)m * D;
        f32x4 v[4]; float s = 0.f;
#pragma unroll
        for (int j = 0; j < 4; ++j) { v[j] = *(const f32x4*)(row + j * 256 + lane * 4); s += (v[j].x + v[j].y) + (v[j].z + v[j].w); }
        const float mean = wave_sum(s) * (1.f / D); float s2 = 0.f;
#pragma unroll
        for (int j = 0; j < 4; ++j) { v[j] = v[j] - mean; s2 += (v[j].x * v[j].x + v[j].y * v[j].y) + (v[j].z * v[j].z + v[j].w * v[j].w); }
        const float rstd = 1.f / sqrtf(wave_sum(s2) * (1.f / D) + LN_EPS);
#pragma unroll
        for (int j = 0; j < 4; ++j) { const f32x4 g = *(const f32x4*)(p.ln1_g + j * 256 + lane * 4), bb = *(const f32x4*)(p.ln1_b + j * 256 + lane * 4);
            const f32x4 o = v[j] * rstd * g + bb; *(f32x4*)(row + j * 256 + lane * 4) = o; *(f16x4*)(H1H + (size_t)m * D + j * 256 + lane * 4) = to_h4(o); }
    }
}

#define INS16(L, x_) do { unsigned x__ = (x_); _Pragma("unroll") for (int j_ = 0; j_ < 16; ++j_) { const unsigned hi_ = max(L[j_], x__); x__ = min(L[j_], x__); L[j_] = hi_; } } while (0)
__device__ __forceinline__ void top16_of_128(const unsigned short* src, unsigned (&L)[16]) {
#pragma unroll
    for (int j = 0; j < 16; ++j) L[j] = 0u;
#pragma unroll 1
    for (int hb = 0; hb < 2; ++hb) {
        u32x4 w[8];
#pragma unroll
        for (int c = 0; c < 8; ++c) w[c] = *(const u32x4*)(src + hb * 64 + c * 8);
        __builtin_amdgcn_sched_barrier(0);
#pragma unroll
        for (int c = 0; c < 8; ++c)
#pragma unroll
            for (int e = 0; e < 8; ++e) {
                const unsigned sc16 = (w[c][e >> 1] >> (16 * (e & 1))) & 0xFFFFu;
                const unsigned key = (sc16 << 16) | (unsigned)(127 - (hb * 64 + c * 8 + e));
                INS16(L, key);
            }
    }
}
__device__ __forceinline__ void phd5_topk(const Params& p) {
    const unsigned short* SC = (const unsigned short*)(p.ws + WS_SC);
    unsigned short* EIDX = (unsigned short*)(p.ws + WS_EIDX); float* EGATE = (float*)(p.ws + WS_EGATE);
    const long gt = (long)blockIdx.x * NT + threadIdx.x, NGT = (long)gridDim.x * NT;
    for (long e = gt; e < (long)MREAL * 8; e += NGT) {
        const int m = (int)(e >> 3), h = (int)(e & 7);
        unsigned A[16], B[16];
        top16_of_128(SC + (size_t)m * 2048 + h * 256, A);
        top16_of_128(SC + (size_t)m * 2048 + h * 256 + 128, B);
        unsigned T[16];
#pragma unroll
        for (int j = 0; j < 16; ++j) T[j] = 0u;
#pragma unroll
        for (int i = 0; i < 16; ++i)
#pragma unroll
            for (int j = 0; j < 16; ++j)
                if ((i + 1) * (j + 1) <= 16) {
                    const unsigned sum = (A[i] >> 16) + (B[j] >> 16);
                    const unsigned eid = (127u - (A[i] & 0xFFFFu)) * 128u + (127u - (B[j] & 0xFFFFu));
                    INS16(T, (sum << 14) | eid);
                }
        float sumf = 0.f; float ex[16];
        const int s0 = (int)(T[0] >> 14);
#pragma unroll
        for (int j = 0; j < 16; ++j) { ex[j] = __expf((float)((int)(T[j] >> 14) - s0) * (1.f / 8192.f)); sumf += ex[j]; }
        const float inv = 1.f / sumf;
#pragma unroll
        for (int j = 0; j < 16; ++j) { EIDX[(size_t)m * 128 + h * 16 + j] = (unsigned short)(T[j] & 0x3FFFu); EGATE[(size_t)m * 128 + h * 16 + j] = ex[j] * inv; }
    }
}

__device__ __forceinline__ void dec16(const u32x4 w, float (&o)[16]) {
#pragma unroll
    for (int q = 0; q < 4; ++q) { const f32x2 lo = __builtin_amdgcn_cvt_pk_f32_fp8((int)w[q], false), hi = __builtin_amdgcn_cvt_pk_f32_fp8((int)w[q], true); o[4 * q] = lo.x; o[4 * q + 1] = lo.y; o[4 * q + 2] = hi.x; o[4 * q + 3] = hi.y; }
}
__device__ __forceinline__ float wave_sum_u(float v) {
    v = row16_sum(v);
    const float a = __builtin_bit_cast(float, __builtin_amdgcn_readlane(__builtin_bit_cast(int, v), 0)), b = __builtin_bit_cast(float, __builtin_amdgcn_readlane(__builtin_bit_cast(int, v), 16));
    const float c = __builtin_bit_cast(float, __builtin_amdgcn_readlane(__builtin_bit_cast(int, v), 32)), d = __builtin_bit_cast(float, __builtin_amdgcn_readlane(__builtin_bit_cast(int, v), 48));
    return (a + b) + (c + d);
}
__device__ __forceinline__ void phd6_gather(const Params& p) {
    const int tid = threadIdx.x, lane = tid & 63, wave = tid >> 6;
    const int gw = blockIdx.x * 8 + wave, NGW = gridDim.x * 8;
    const unsigned char* U8 = p.ws + WS_U8; const unsigned char* V8A = p.ws + WS_V8A; const unsigned char* V8B = p.ws + WS_V8B - (size_t)V8A_ROWS * D;
    const unsigned short* EIDX = (const unsigned short*)(p.ws + WS_EIDX); const float* EGATE = (const float*)(p.ws + WS_EGATE);
    for (int m = gw; m < MREAL; m += NGW) {
        float* row = p.out + (size_t)m * D + 16 * lane;
        float hv[16];
#pragma unroll
        for (int q = 0; q < 4; ++q) { const f32x4 t4 = *(const f32x4*)(row + 4 * q); hv[4 * q] = t4.x; hv[4 * q + 1] = t4.y; hv[4 * q + 2] = t4.z; hv[4 * q + 3] = t4.w; }
        const int e_lo = (int)EIDX[(size_t)m * 128 + lane], e_hi = (int)EIDX[(size_t)m * 128 + 64 + lane];
        const float g_lo = EGATE[(size_t)m * 128 + lane], g_hi = EGATE[(size_t)m * 128 + 64 + lane];
        float hd_lo = 0.f, hd_hi = 0.f;
#define G_LOAD(buf, g_, TAB) do { _Pragma("unroll") for (int i_ = 0; i_ < 8; ++i_) { const int e_ = 8 * (g_) + i_; \
            const int id_ = (e_ < 64) ? __builtin_amdgcn_readlane(e_lo, e_ & 63) : __builtin_amdgcn_readlane(e_hi, e_ & 63); \
            buf[i_] = *(const u32x4*)(((TAB) ? ((id_ < V8A_ROWS) ? V8A : V8B) : U8) + (size_t)id_ * D + 16 * lane); } } while (0)
#define U_PROC(buf, g_) do { _Pragma("unroll") for (int i_ = 0; i_ < 8; ++i_) { const int e_ = 8 * (g_) + i_; float uf[16]; dec16(buf[i_], uf); float s_ = 0.f; \
            _Pragma("unroll") for (int j_ = 0; j_ < 16; ++j_) s_ += hv[j_] * uf[j_]; s_ = wave_sum_u(s_); \
            if (e_ < 64) { if (lane == (e_ & 63)) hd_lo = s_; } else { if (lane == (e_ & 63)) hd_hi = s_; } } } while (0)
        {
            u32x4 b0[8], b1[8];
            G_LOAD(b0, 0, 0);
            for (int g2 = 0; g2 < 16; g2 += 2) {
                G_LOAD(b1, g2 + 1, 0); __builtin_amdgcn_sched_barrier(0);
                U_PROC(b0, g2); __builtin_amdgcn_sched_barrier(0);
                if (g2 + 2 < 16) { G_LOAD(b0, g2 + 2, 0); } __builtin_amdgcn_sched_barrier(0);
                U_PROC(b1, g2 + 1); __builtin_amdgcn_sched_barrier(0);
            }
        }
        hd_lo *= (1.f / 256.f); hd_hi *= (1.f / 256.f);
        const float c_lo = g_lo * 0.5f * hd_lo * (1.f + erff(hd_lo * 0.70710678118654752f)) * (1.f / 16.f);
        const float c_hi = g_hi * 0.5f * hd_hi * (1.f + erff(hd_hi * 0.70710678118654752f)) * (1.f / 16.f);
        float acc[16];
#pragma unroll
        for (int j = 0; j < 16; ++j) acc[j] = 0.f;
#define V_PROC(buf, g_) do { _Pragma("unroll") for (int i_ = 0; i_ < 8; ++i_) { const int e_ = 8 * (g_) + i_; float vf[16]; dec16(buf[i_], vf); \
            const float cf_ = (e_ < 64) ? __builtin_bit_cast(float, __builtin_amdgcn_readlane(__builtin_bit_cast(int, c_lo), e_ & 63)) : __builtin_bit_cast(float, __builtin_amdgcn_readlane(__builtin_bit_cast(int, c_hi), e_ & 63)); \
            _Pragma("unroll") for (int j_ = 0; j_ < 16; ++j_) acc[j_] += cf_ * vf[j_]; } } while (0)
        {
            u32x4 b0[8], b1[8];
            G_LOAD(b0, 0, 1);
            for (int g2 = 0; g2 < 16; g2 += 2) {
                G_LOAD(b1, g2 + 1, 1); __builtin_amdgcn_sched_barrier(0);
                V_PROC(b0, g2); __builtin_amdgcn_sched_barrier(0);
                if (g2 + 2 < 16) { G_LOAD(b0, g2 + 2, 1); } __builtin_amdgcn_sched_barrier(0);
                V_PROC(b1, g2 + 1); __builtin_amdgcn_sched_barrier(0);
            }
        }
        float sm = 0.f;
#pragma unroll
        for (int j = 0; j < 16; ++j) { acc[j] += ALPHA * hv[j]; sm += acc[j]; }
        const float mean = wave_sum_u(sm) * (1.f / D); float s2 = 0.f;
#pragma unroll
        for (int j = 0; j < 16; ++j) { acc[j] -= mean; s2 += acc[j] * acc[j]; }
        const float rstd = __builtin_amdgcn_rsqf(wave_sum_u(s2) * (1.f / D) + LN_EPS);
#pragma unroll
        for (int q = 0; q < 4; ++q) { const int col = 16 * lane + 4 * q; const f32x4 g = *(const f32x4*)(p.ln2_g + col), bb = *(const f32x4*)(p.ln2_b + col);
            f32x4 o; o.x = acc[4 * q] * rstd * g.x + bb.x; o.y = acc[4 * q + 1] * rstd * g.y + bb.y; o.z = acc[4 * q + 2] * rstd * g.z + bb.z; o.w = acc[4 * q + 3] * rstd * g.w + bb.w;
            *(f32x4*)(row + 4 * q) = o; }
    }
}

__device__ __forceinline__ void phd6_u_plain(const Params& p) {
    const int tid = threadIdx.x, lane = tid & 63, wave = tid >> 6;
    const int gw = blockIdx.x * 8 + wave, NGW = gridDim.x * 8;
    const unsigned char* U8 = p.ws + WS_U8; const unsigned char* V8A = p.ws + WS_V8A; const unsigned char* V8B = p.ws + WS_V8B - (size_t)V8A_ROWS * D;
    const unsigned short* EIDX = (const unsigned short*)(p.ws + WS_EIDX); const float* EGATE = (const float*)(p.ws + WS_EGATE);
    for (int m = gw; m < MREAL; m += NGW) {
        float* row = p.out + (size_t)m * D + 16 * lane;
        float hv[16];
#pragma unroll
        for (int q = 0; q < 4; ++q) { const f32x4 t4 = *(const f32x4*)(row + 4 * q); hv[4 * q] = t4.x; hv[4 * q + 1] = t4.y; hv[4 * q + 2] = t4.z; hv[4 * q + 3] = t4.w; }
        const int e_lo = (int)EIDX[(size_t)m * 128 + lane], e_hi = (int)EIDX[(size_t)m * 128 + 64 + lane];
        const float g_lo = EGATE[(size_t)m * 128 + lane], g_hi = EGATE[(size_t)m * 128 + 64 + lane];
        float hd_lo = 0.f, hd_hi = 0.f;
#define G_LOAD(buf, g_, TAB) do { _Pragma("unroll") for (int i_ = 0; i_ < 8; ++i_) { const int e_ = 8 * (g_) + i_; \
            const int id_ = (e_ < 64) ? __builtin_amdgcn_readlane(e_lo, e_ & 63) : __builtin_amdgcn_readlane(e_hi, e_ & 63); \
            buf[i_] = *(const u32x4*)(((TAB) ? ((id_ < V8A_ROWS) ? V8A : V8B) : U8) + (size_t)id_ * D + 16 * lane); } } while (0)
#define U_PROC(buf, g_) do { _Pragma("unroll") for (int i_ = 0; i_ < 8; ++i_) { const int e_ = 8 * (g_) + i_; float uf[16]; dec16(buf[i_], uf); float s_ = 0.f; \
            _Pragma("unroll") for (int j_ = 0; j_ < 16; ++j_) s_ += hv[j_] * uf[j_]; s_ = wave_sum_u(s_); \
            if (e_ < 64) { if (lane == (e_ & 63)) hd_lo = s_; } else { if (lane == (e_ & 63)) hd_hi = s_; } } } while (0)
        {
            u32x4 b0[8], b1[8];
            G_LOAD(b0, 0, 0);
            for (int g2 = 0; g2 < 16; g2 += 2) {
                G_LOAD(b1, g2 + 1, 0); __builtin_amdgcn_sched_barrier(0);
                U_PROC(b0, g2); __builtin_amdgcn_sched_barrier(0);
                if (g2 + 2 < 16) { G_LOAD(b0, g2 + 2, 0); } __builtin_amdgcn_sched_barrier(0);
                U_PROC(b1, g2 + 1); __builtin_amdgcn_sched_barrier(0);
            }
        }
        hd_lo *= (1.f / 256.f); hd_hi *= (1.f / 256.f);
        const float c_lo = g_lo * 0.5f * hd_lo * (1.f + erff(hd_lo * 0.70710678118654752f)) * (1.f / 16.f);
        const float c_hi = g_hi * 0.5f * hd_hi * (1.f + erff(hd_hi * 0.70710678118654752f)) * (1.f / 16.f);
        float* ECOEF = (float*)(p.ws + WS_SC);
        ECOEF[(size_t)m * 128 + lane] = c_lo; ECOEF[(size_t)m * 128 + 64 + lane] = c_hi;
    }
}
__device__ __forceinline__ void phd6_u_item(const Params& p, int blk, int slice, unsigned char* lds) {
    const int tid = threadIdx.x, lane = tid & 63, wave = tid >> 6;
    const unsigned char* U8 = p.ws + WS_U8;
    const unsigned short* EIDX = (const unsigned short*)(p.ws + WS_EIDX); float* EGATE = (float*)(p.ws + WS_EGATE); const f16* H1H = (const f16*)(p.ws + WS_H1H);
    f16* sH = (f16*)lds;
    unsigned short* sID = (unsigned short*)(lds + 65536);
    float* sG = (float*)(lds + 65536 + 8192);
    unsigned short* sPair = (unsigned short*)(lds + 65536 + 8192 + 16384);
    unsigned* sCnt = (unsigned*)(lds + 65536 + 8192 + 16384 + 8192);
    const int m0 = blk * 32;
#pragma unroll
    for (int i = 0; i < 8; ++i) { const int o = (i * NT + tid) * 8; *(f16x8*)(sH + o) = *(const f16x8*)(H1H + (size_t)m0 * D + o); }
    *(u32x4*)(sID + tid * 8) = *(const u32x4*)(EIDX + (size_t)m0 * 128 + tid * 8);
#pragma unroll
    for (int i = 0; i < 2; ++i) { const int o = (i * NT + tid) * 4; *(f32x4*)(sG + o) = *(const f32x4*)(EGATE + (size_t)m0 * 128 + o); }
    if (tid == 0) *sCnt = 0u;
    __syncthreads();
    {
        const int tk = tid >> 4, s0 = (tid & 15) * 8;
#pragma unroll
        for (int i = 0; i < 8; ++i) { const bool hit = ((int)sID[tk * 128 + s0 + i] >> 11) == slice;
            const unsigned long long mk = __ballot(hit);
            if (mk) { const int leader = __ffsll((long long)mk) - 1; unsigned base = 0u;
                if (lane == leader) base = atomicAdd(sCnt, (unsigned)__popcll(mk));
                base = __shfl(base, leader);
                if (hit) sPair[base + __popcll(mk & ((1ull << lane) - 1ull))] = (unsigned short)((tk << 7) | (s0 + i)); } }
    }
    __syncthreads();
    const int n = (int)*sCnt;
#define UP_LOAD(buf, ent, base_) do { _Pragma("unroll") for (int k = 0; k < 8; ++k) { const int pi = (base_) + 8 * k; const int en = (pi < n) ? (int)sPair[pi] : -1; ent[k] = en; \
        if (en >= 0) { const int id = (int)sID[(en >> 7) * 128 + (en & 127)]; buf[k] = *(const u32x4*)(U8 + (size_t)id * D + 16 * lane); } } } while (0)
#define UP_PROC(buf, ent) do { float mytot = 0.f; int myent = -1; \
        _Pragma("unroll") for (int k = 0; k < 8; ++k) if (ent[k] >= 0) { float uf[16]; dec16(buf[k], uf); const f16* hp = sH + (ent[k] >> 7) * D + 16 * lane; \
            const f16x8 h0 = *(const f16x8*)hp, h1 = *(const f16x8*)(hp + 8); float s_ = 0.f; \
            _Pragma("unroll") for (int q = 0; q < 8; ++q) { s_ += (float)h0[q] * uf[q]; s_ += (float)h1[q] * uf[8 + q]; } \
            s_ = wave_sum_u(s_); if (lane == k) { mytot = s_; myent = ent[k]; } } \
        if (myent >= 0) { const float hd = mytot * (1.f / 256.f); const float cf = 0.5f * hd * (1.f + erff(hd * 0.70710678118654752f)) * (1.f / 16.f); \
            ((float*)(p.ws + WS_SC))[(size_t)(m0 + (myent >> 7)) * 128 + (myent & 127)] = sG[(myent >> 7) * 128 + (myent & 127)] * cf; } } while (0)
    {
        u32x4 b0[8], b1[8]; int e0[8], e1[8];
        UP_LOAD(b0, e0, wave);
        for (int base = wave; base < n; base += 128) {
            UP_LOAD(b1, e1, base + 64); __builtin_amdgcn_sched_barrier(0);
            UP_PROC(b0, e0); __builtin_amdgcn_sched_barrier(0);
            UP_LOAD(b0, e0, base + 128); __builtin_amdgcn_sched_barrier(0);
            UP_PROC(b1, e1); __builtin_amdgcn_sched_barrier(0);
        }
    }
    __syncthreads();
}
__device__ __forceinline__ void phd6_v_item(const Params& p, int blk, int slice, unsigned char* lds) {
    const int tid = threadIdx.x, lane = tid & 63, wave = tid >> 6;
    const unsigned char* V8A = p.ws + WS_V8A; const unsigned char* V8B = p.ws + WS_V8B - (size_t)V8A_ROWS * D;
    const unsigned short* EIDX = (const unsigned short*)(p.ws + WS_EIDX); const float* ECOEF = (const float*)(p.ws + WS_SC);
    unsigned short* sID = (unsigned short*)lds;
    float* sC = (float*)(lds + 16384);
    const int m0 = blk * 64;
#pragma unroll
    for (int i = 0; i < 2; ++i) { const int o = (i * NT + tid) * 8; *(u32x4*)(sID + o) = *(const u32x4*)(EIDX + (size_t)m0 * 128 + o); }
#pragma unroll
    for (int i = 0; i < 4; ++i) { const int o = (i * NT + tid) * 4; *(f32x4*)(sC + o) = *(const f32x4*)(ECOEF + (size_t)m0 * 128 + o); }
    const int tl = wave * 8 + (lane >> 3), ch = lane & 7;
    float* row = p.out + (size_t)(m0 + tl) * D + 128 * slice + 16 * ch;
    f32x4 hr[4];
#pragma unroll
    for (int q4 = 0; q4 < 4; ++q4) hr[q4] = *(const f32x4*)(row + 4 * q4);
    __syncthreads();
    float acc[16];
#pragma unroll
    for (int q = 0; q < 16; ++q) acc[q] = 0.f;
    const unsigned short* idr = sID + tl * 128; const float* cr = sC + tl * 128;
#define VP_LOAD(buf, cf, e0_) do { _Pragma("unroll") for (int k = 0; k < 8; ++k) { const int id = (int)idr[(e0_) + k]; cf[k] = cr[(e0_) + k]; \
        buf[k] = *(const u32x4*)(((id < V8A_ROWS) ? V8A : V8B) + (size_t)id * D + 128 * slice + 16 * ch); } } while (0)
#define VP_PROC(buf, cf) do { _Pragma("unroll") for (int k = 0; k < 8; ++k) { float vf[16]; dec16(buf[k], vf); _Pragma("unroll") for (int q = 0; q < 16; ++q) acc[q] += cf[k] * vf[q]; } } while (0)
    {
        u32x4 b0[8], b1[8]; float c0[8], c1[8];
        VP_LOAD(b0, c0, 0);
        for (int e0 = 0; e0 < 128; e0 += 16) {
            VP_LOAD(b1, c1, e0 + 8); __builtin_amdgcn_sched_barrier(0);
            VP_PROC(b0, c0); __builtin_amdgcn_sched_barrier(0);
            if (e0 + 16 < 128) { VP_LOAD(b0, c0, e0 + 16); } __builtin_amdgcn_sched_barrier(0);
            VP_PROC(b1, c1); __builtin_amdgcn_sched_barrier(0);
        }
    }
#pragma unroll
    for (int q4 = 0; q4 < 4; ++q4) { f32x4 h4 = hr[q4]; h4.x = ALPHA * h4.x + acc[4 * q4]; h4.y = ALPHA * h4.y + acc[4 * q4 + 1]; h4.z = ALPHA * h4.z + acc[4 * q4 + 2]; h4.w = ALPHA * h4.w + acc[4 * q4 + 3];
        *(f32x4*)(row + 4 * q4) = h4; }
    __syncthreads();
}
template <int PHASEV>
__device__ __forceinline__ void phd6_sliced(const Params& p, unsigned char* lds) {
    unsigned* q = (unsigned*)(p.ws + WS_CTL) + 1024 + PHASEV * 512;
    int* s_it = (int*)(lds + 150 * 1024 - 16);
    const int xs = (int)((unsigned)__builtin_amdgcn_s_getreg((3 << 11) | 20) & 7u);
    for (int r = 0; r < 8; ++r) {
        const int slice = (xs + r) & 7;
        for (;;) {
            if (threadIdx.x == 0) *s_it = (int)atomicAdd(q + 64 * slice, 1u);
            __syncthreads();
            const int it = *s_it;
            __syncthreads();
            if (it >= (PHASEV ? MREAL / 64 : MREAL / 32)) break;
            if (PHASEV) phd6_v_item(p, it, slice, lds); else phd6_u_item(p, it, slice, lds);
        }
    }
}
__device__ __forceinline__ void phd6_ln2(const Params& p) {
    const int tid = threadIdx.x, lane = tid & 63, wave = tid >> 6;
    const int gw = blockIdx.x * 8 + wave, NGW = gridDim.x * 8;
    for (int m = gw; m < MREAL; m += NGW) {
        float* row = p.out + (size_t)m * D;
        f32x4 v[4]; float s = 0.f;
#pragma unroll
        for (int j = 0; j < 4; ++j) { v[j] = *(const f32x4*)(row + j * 256 + lane * 4); s += (v[j].x + v[j].y) + (v[j].z + v[j].w); }
        const float mean = wave_sum_u(s) * (1.f / D); float s2 = 0.f;
#pragma unroll
        for (int j = 0; j < 4; ++j) { v[j] = v[j] - mean; s2 += (v[j].x * v[j].x + v[j].y * v[j].y) + (v[j].z * v[j].z + v[j].w * v[j].w); }
        const float rstd = __builtin_amdgcn_rsqf(wave_sum_u(s2) * (1.f / D) + LN_EPS);
#pragma unroll
        for (int j = 0; j < 4; ++j) { const f32x4 g = *(const f32x4*)(p.ln2_g + j * 256 + lane * 4), bb = *(const f32x4*)(p.ln2_b + j * 256 + lane * 4);
            *(f32x4*)(row + j * 256 + lane * 4) = v[j] * rstd * g + bb; }
    }
}

struct EpiLora {
    f16 *LW, *AA, *GG; const float *w0, *a0;
    __device__ __forceinline__ void operator()(const f32x4 (&acc)[2][2][4][2], const pg8::Unit& u, int wr, int wc, int fr, int fq) const {
        const int row0 = u.pm * 256 + wr * 64 + fr, col0 = (u.pn & 1) * 256 + wc * 32 + 4 * fq;
        if (u.pn < 2) {
#pragma unroll
            for (int bj = 0; bj < 2; ++bj)
#pragma unroll
                for (int n = 0; n < 2; ++n) { const int col = col0 + bj * 128 + n * 16; const f32x4 c = *(const f32x4*)(w0 + col);
#pragma unroll
                    for (int ai = 0; ai < 2; ++ai)
#pragma unroll
                        for (int m = 0; m < 4; ++m) { const f32x4 v = acc[ai][bj][m][n]; f16x4 o;
#pragma unroll
                            for (int e = 0; e < 4; ++e) { const float wl = -softplusf_(-(c[e] + v[e])) - 0.5f; o[e] = (f16)(-__expf(wl)); }
                            *(f16x4*)(LW + (size_t)(row0 + ai * 128 + m * 16) * 512 + col) = o; } }
        } else if (u.pn < 4) {
#pragma unroll
            for (int bj = 0; bj < 2; ++bj)
#pragma unroll
                for (int n = 0; n < 2; ++n) { const int col = col0 + bj * 128 + n * 16; const f32x4 c = *(const f32x4*)(a0 + col);
#pragma unroll
                    for (int ai = 0; ai < 2; ++ai)
#pragma unroll
                        for (int m = 0; m < 4; ++m) { const f32x4 v = acc[ai][bj][m][n]; f16x4 o;
#pragma unroll
                            for (int e = 0; e < 4; ++e) o[e] = (f16)sigmoidf_(c[e] + v[e]);
                            *(f16x4*)(AA + (size_t)(row0 + ai * 128 + m * 16) * 512 + col) = o; } }
        } else {
#pragma unroll
            for (int bj = 0; bj < 2; ++bj)
#pragma unroll
                for (int n = 0; n < 2; ++n) { const int col = col0 + bj * 128 + n * 16;
#pragma unroll
                    for (int ai = 0; ai < 2; ++ai)
#pragma unroll
                        for (int m = 0; m < 4; ++m) *(f16x4*)(GG + (size_t)(row0 + ai * 128 + m * 16) * 512 + col) = to_h4(acc[ai][bj][m][n]); }
        }
    }
};

#define XB_TMO      128
#define XB_XCNT(j)  (256  + 64 * (j))
#define XB_XSUB(j)  (1280 + 64 * (j))
#define XB_XGEN(j)  (2304 + 64 * (j))
#define XB_TOP      3328
#define XB_TOPGEN   3392
#define XCD_BAR_WORDS 3456
#define XB_SPIN_CAP (1u << 20)
__device__ __forceinline__ unsigned xb_ld(unsigned* p)              { return __hip_atomic_load(p, __ATOMIC_RELAXED, __HIP_MEMORY_SCOPE_AGENT); }
__device__ __forceinline__ unsigned xb_add(unsigned* p, unsigned v) { return __hip_atomic_fetch_add(p, v, __ATOMIC_RELAXED, __HIP_MEMORY_SCOPE_AGENT); }
__device__ __forceinline__ unsigned xb_xcc_id() { return (unsigned)__builtin_amdgcn_s_getreg((3 << 11) | 20) & 0xFu; }
#define XB_SPIN(cond, bar) do { unsigned _sp = 0; while (cond) { __builtin_amdgcn_s_sleep(1); \
    if ((++_sp & 255u) == 0u) { if (xb_ld(&(bar)[XB_TMO])) break; if (_sp > XB_SPIN_CAP) { atomicAdd(&(bar)[XB_TMO], 1u); break; } } } } while (0)
struct XcdBarrier { unsigned* bar; unsigned x; volatile LAS unsigned* st; };
__device__ __forceinline__ XcdBarrier xcd_barrier_post(unsigned* bar, volatile LAS unsigned* st) {
    XcdBarrier b; b.bar = bar; b.x = xb_xcc_id(); b.st = st;
    if (threadIdx.x == 0) (void)xb_add(&bar[XB_XCNT(b.x)], 1u);
    return b;
}
__device__ __forceinline__ void xcd_barrier_complete(unsigned* bar, unsigned x, unsigned& nloc, unsigned& nx) {
    const unsigned G = gridDim.x * gridDim.y * gridDim.z;
    unsigned sum, cnt, mine, sp = 0u;
    for (;;) {
        sum = 0u; cnt = 0u; mine = 0u;
#pragma unroll
        for (unsigned j = 0; j < 16; ++j) { const unsigned c = xb_ld(&bar[XB_XCNT(j)]); sum += c; cnt += (c > 0u) ? 1u : 0u; mine = (j == x) ? c : mine; }
        if (sum == G) break;
        __builtin_amdgcn_s_sleep(1);
        if ((++sp & 255u) == 0u) { if (xb_ld(&bar[XB_TMO])) break; if (sp > XB_SPIN_CAP) { atomicAdd(&bar[XB_TMO], 1u); break; } }
    }
    nloc = mine > 0u ? mine : 1u; nx = cnt > 0u ? cnt : 1u;
}
__device__ __forceinline__ void xcd_barrier(const XcdBarrier& b) {
    asm volatile("s_waitcnt vmcnt(0)" ::: "memory");
    __syncthreads();
    if (threadIdx.x == 0) {
        unsigned* bar = b.bar;
        __builtin_amdgcn_s_waitcnt(0);
        unsigned nloc = b.st[0], nx = b.st[1];
        if (nloc == 0u) { xcd_barrier_complete(bar, b.x, nloc, nx); b.st[0] = nloc; b.st[1] = nx; }
        const unsigned old = xb_add(&bar[XB_XSUB(b.x)], 1u);
        const unsigned gen = old / nloc;
        if (old + 1u == (gen + 1u) * nloc) {
            __builtin_amdgcn_fence(__ATOMIC_RELEASE, "agent");
            asm volatile("s_waitcnt vmcnt(0)" ::: "memory");
            const unsigned og = xb_add(&bar[XB_TOP], 1u);
            const unsigned tg = og / nx;
            if (og + 1u == (tg + 1u) * nx) xb_add(&bar[XB_TOPGEN], 1u);
            else XB_SPIN(xb_ld(&bar[XB_TOPGEN]) == tg, bar);
            __builtin_amdgcn_fence(__ATOMIC_ACQUIRE, "agent");
            xb_add(&bar[XB_XGEN(b.x)], 1u);
            asm volatile("s_waitcnt vmcnt(0)" ::: "memory");
        } else {
            XB_SPIN(xb_ld(&bar[XB_XGEN(b.x)]) == gen, bar);
            __builtin_amdgcn_fence(__ATOMIC_ACQUIRE, "agent");
            asm volatile("s_waitcnt vmcnt(0)" ::: "memory");
        }
    }
    __syncthreads();
}

constexpr int LDS_BYTES = 150 * 1024;
constexpr int REP0 = 1, REP1 = 1, REP4 = 1, REP5 = 1, REP8 = 1, REP9 = 1;
constexpr int NPHASE = 13;
__global__ void __launch_bounds__(NT) mk_fwd(Params p) {
    extern __shared__ __attribute__((aligned(16))) unsigned char lds[];
    unsigned char* ws = p.ws;
    const int lo = p.ph_lo, hi = p.ph_hi;
    volatile LAS unsigned* bst = (volatile LAS unsigned*)((LAS unsigned char*)lds + LDS_BYTES - 64);
    if (threadIdx.x < 2) bst[threadIdx.x] = 0u;
    __syncthreads();
    const XcdBarrier xbar = xcd_barrier_post((unsigned*)(ws + WS_CTL) + 4096, bst);
#define IN(k) (lo <= (k) && (k) < hi)
#define SEAM(k) do { if (IN(k) && IN((k) + 1)) xcd_barrier(xbar); } while (0)
    if (IN(0)) ph0_prep<false>(p, lds, (int)blockIdx.x, (int)gridDim.x);
    SEAM(0);
    if (IN(1)) {
        f16* PB = (f16*)(ws + WS_PB);
        auto f = [=](int row, int col, f32x4 v) { *(f16x4*)(PB + (size_t)row * N1 + col) = to_h4(v); };
        pg8::run_gemm(lds, (const f16*)(ws + WS_H0), (const f16*)(ws + WS_W1T), MR, N1, D, f);
    }
    SEAM(1);
    if (IN(2)) phc1_rowprep(p);
    SEAM(2);
    if (IN(3)) {
        pg8::Gemm g{(const f16*)((unsigned char*)p.out + DO_LORAIN), (const f16*)(ws + WS_WLT), MR, 1536, 256}; pg8::StaticOrder S; S.init(MR, 1536, (int)gridDim.x, (int)blockIdx.x);
        EpiLora E{(f16*)((unsigned char*)p.out + DO_LW), (f16*)((unsigned char*)p.out + DO_AA), (f16*)((unsigned char*)p.out + DO_GG), p.b_w0, p.b_a0};
        pg8::gemm_phase<EpiLora>((PG8_LAS unsigned char*)lds, g, S, E);
        __syncthreads();
    }
    SEAM(3);
    if (IN(4)) for (int rep = 0; rep < REP4; ++rep) { if (rep) xcd_barrier(xbar); phc2_mixers(p, lds, rep); }
    SEAM(4);
    if (IN(5)) {
        f16* MIX = (f16*)(ws + WS_MIXED); f16* TMP = (f16*)(ws + WS_TMP); const float* bg = p.b_gate;
        auto f1 = [=](int row, int col, f32x4 v) { const f32x4 c = *(const f32x4*)(bg + col); f16x4 o;
#pragma unroll
            for (int e = 0; e < 4; ++e) o[e] = (f16)sigmoidf_(v[e] + c[e]);
            *(f16x4*)(MIX + (size_t)row * D + col) = o; };
        pg8::run_gemm(lds, (const f16*)(ws + WS_H0), (const f16*)(ws + WS_WGT), MREAL, D, D, f1);
        auto f2 = [=](int row, int col, f32x4 v) { f16x4* q = (f16x4*)(MIX + (size_t)row * D + col); const f16x4 gq = *q; f16x4 o;
#pragma unroll
            for (int e = 0; e < 4; ++e) o[e] = (f16)((float)gq[e] * v[e]);
            *q = o; };
        pg8::run_gemm(lds, (const f16*)(ws + WS_OLAT), (const f16*)(ws + WS_WPAT), MREAL, D, D, f2);
        auto f3 = [=](int row, int col, f32x4 v) { const f32x4 c = *(const f32x4*)(bg + 1024 + col); f16x4 o;
#pragma unroll
            for (int e = 0; e < 4; ++e) o[e] = (f16)sigmoidf_(v[e] + c[e]);
            *(f16x4*)(TMP + (size_t)row * D + col) = o; };
        pg8::run_gemm(lds, (const f16*)(ws + WS_H0), (const f16*)(ws + WS_WGT) + (size_t)1024 * D, MREAL, D, D, f3);
        auto f4 = [=](int row, int col, f32x4 v) { f16x4* q = (f16x4*)(MIX + (size_t)row * D + col); const f16x4 m0 = *q; const f16x4 gq = *(const f16x4*)(TMP + (size_t)row * D + col); f16x4 o;
#pragma unroll
            for (int e = 0; e < 4; ++e) o[e] = (f16)((float)m0[e] + (float)gq[e] * v[e]);
            *q = o; };
        pg8::run_gemm(lds, (const f16*)(ws + WS_OB), (const f16*)(ws + WS_WPBT), MREAL, D, 512, f4);
    }
    SEAM(5);
    if (IN(6)) {
        const float* x = p.x; const float* STAT = (const float*)(ws + WS_STAT); const float* lg = p.ln_in_g; const float* lb = p.ln_in_b; float* out = p.out;
        auto f = [=](int row, int col, f32x4 v) { const f32x4 xv = *(const f32x4*)(x + (size_t)row * D + col); const float mean = STAT[2 * row], rstd = STAT[2 * row + 1];
            const f32x4 g = *(const f32x4*)(lg + col), bb = *(const f32x4*)(lb + col);
            *(f32x4*)(out + (size_t)row * D + col) = ((xv - mean) * rstd * g + bb) * ALPHA + v; };
        pg8::run_gemm(lds, (const f16*)(ws + WS_MIXED), (const f16*)(ws + WS_WOT), MREAL, D, D, f);
    }
    SEAM(6);
    if (IN(7)) phd3_ln1(p);
    SEAM(7);
    if (IN(8)) {
        unsigned short* SC = (unsigned short*)(ws + WS_SC);
        auto f = [=](int row, int col, f32x4 v) { u32x2 o; unsigned q[4];
#pragma unroll
            for (int e = 0; e < 4; ++e) q[e] = (unsigned)__float2int_rn(fminf(fmaxf((v[e] + 2.f) * 8192.f, 0.f), 65535.f));
            o.x = q[0] | (q[1] << 16); o.y = q[2] | (q[3] << 16); *(u32x2*)(SC + (size_t)row * 2048 + col) = o; };
        pg8::run_gemm(lds, (const f16*)(ws + WS_H1H), (const f16*)(ws + WS_WSKT), MREAL, 2048, D, f);
    }
    SEAM(8);
    if (IN(9)) phd5_topk(p);
    SEAM(9);
    if (IN(10)) phd6_u_plain(p);
    SEAM(10);
    if (IN(11)) phd6_sliced<1>(p, lds);
    SEAM(11);
    if (IN(12)) phd6_ln2(p);
#undef IN
#undef SEAM
}

extern "C" void kernel_launch(void* const* d_in, const int* in_sizes, int n_in, void* d_out, int out_size, void* d_ws, size_t ws_size, hipStream_t stream) {
    static int grid = 0;
    if (grid == 0) {
        int dev = 0, cus = 0, per_cu = 0;
        if (hipGetDevice(&dev) != hipSuccess || hipDeviceGetAttribute(&cus, hipDeviceAttributeMultiprocessorCount, dev) != hipSuccess) { fprintf(stderr, "kernel_launch: device query failed\n"); grid = -1; return; }
        if (hipFuncSetAttribute((const void*)mk_fwd, hipFuncAttributeMaxDynamicSharedMemorySize, LDS_BYTES) != hipSuccess) { fprintf(stderr, "kernel_launch: hipFuncSetAttribute failed\n"); grid = -1; return; }
        if (hipOccupancyMaxActiveBlocksPerMultiprocessor(&per_cu, (const void*)mk_fwd, NT, LDS_BYTES) != hipSuccess || per_cu < 1) { fprintf(stderr, "kernel_launch: occupancy query says %d\n", per_cu); grid = -1; return; }
        if (n_in != 33 || out_size != MREAL * D || ws_size < WS_END) { fprintf(stderr, "kernel_launch: unexpected shapes n_in %d out %d ws %zu\n", n_in, out_size, ws_size); grid = -1; return; }
        grid = cus;
    }
    if (grid < 0) return;
    (void)hipMemsetAsync((char*)d_ws + WS_CTL, 0, 1 * MiB, stream);
    Params p{};
    const float** pf = (const float**)&p;
    for (int i = 0; i < 33; ++i) pf[i] = (const float*)d_in[i];
    p.out = (float*)d_out; p.ws = (unsigned char*)d_ws; p.ph_lo = 0; p.ph_hi = NPHASE;
    void* args[] = {&p};
    hipError_t e = hipLaunchCooperativeKernel((void*)mk_fwd, dim3(grid), dim3(NT), args, LDS_BYTES, stream);
    if (e != hipSuccess) fprintf(stderr, "kernel_launch: cooperative launch failed: %s (grid %d)\n", hipGetErrorString(e), grid);
}
```

```cpp
#include <hip/hip_runtime.h>
#include <hip/hip_cooperative_groups.h>
#include <cstdio>
#include <cstdint>
namespace cg = cooperative_groups;

#define LAS __attribute__((address_space(3)))
typedef _Float16 f16;
typedef _Float16 f16x2 __attribute__((ext_vector_type(2)));
typedef _Float16 f16x4 __attribute__((ext_vector_type(4)));
typedef _Float16 f16x8 __attribute__((ext_vector_type(8)));
typedef float f32x2 __attribute__((ext_vector_type(2)));
typedef float f32x4 __attribute__((ext_vector_type(4)));
typedef float f32x16 __attribute__((ext_vector_type(16)));
typedef unsigned u32x4 __attribute__((ext_vector_type(4)));

constexpr int D = 1024, SEQ = 8192, NMETA = 16, TT = 8208;
constexpr int MREAL = 16384, MR = 16640;
constexpr int NIN = 5064;
constexpr int N1 = 3584;
constexpr int C_QABS = 0, C_QI = 1024, C_CKV = 1536, C_KI = 1664, C_WI = 1728, C_BC = 1792;
constexpr int NT = 512;
constexpr int KIDX_B = 264 * 2048;
constexpr float LN_EPS = 1e-5f;
constexpr float ALPHA = 1.189207115002721f;

__device__ __forceinline__ int row_of(int b, int t) { return t < NMETA ? MREAL + b * NMETA + t : b * SEQ + (t - NMETA); }

constexpr size_t MiB = 1u << 20;
constexpr size_t WS_CTL = 0, WS_STAT = 1 * MiB, WS_WIS = 2 * MiB, WS_W1T = 3 * MiB, WS_WGT = 10 * MiB, WS_WPAT = 14 * MiB, WS_WPBT = 16 * MiB,
                 WS_WOT = 17 * MiB, WS_WSKT = 19 * MiB, WS_WLT = 23 * MiB, WS_CKV = 24 * MiB, WS_KIDX = 29 * MiB, WS_H0 = 32 * MiB,
                 WS_OLAT = 65 * MiB, WS_OB = 97 * MiB, WS_PB = 113 * MiB, WS_U8 = 227 * MiB, WS_V8A = 243 * MiB, WS_V8B = 3 * MiB, WS_END = 256 * MiB;
constexpr int V8A_ROWS = 13312;
constexpr size_t WS_MIXED = WS_PB, WS_H1H = WS_PB, WS_TMP = WS_PB + 32 * MiB, WS_SC = WS_PB + 32 * MiB, WS_EIDX = WS_PB + 96 * MiB, WS_EGATE = WS_PB + 100 * MiB;
constexpr size_t DO_LORAIN = 0, DO_LW = 9 * MiB, DO_AA = 26 * MiB, DO_GG = 43 * MiB;

struct Params {
    const float *x, *meta, *ln_in_g, *ln_in_b, *w_in, *b_gate, *a_kv_norm_g, *a_w_uk, *a_w_uv, *a_kidx_g, *a_kidx_b, *b_mu, *b_w0, *b_w2, *b_a0, *b_a2,
        *b_g2, *b_k_k, *b_k_a, *b_r_k, *b_lnx_g, *b_lnx_b, *w_pa, *w_pb, *w_o, *ln1_g, *ln1_b, *peer_wq, *peer_subkeys, *peer_u, *peer_v, *ln2_g, *ln2_b;
    float* out;
    unsigned char* ws;
    int ph_lo, ph_hi;
};

__device__ __forceinline__ float wave_sum(float v) {
#pragma unroll
    for (int o = 1; o < 64; o <<= 1) v += __shfl_xor(v, o);
    return v;
}
__device__ __forceinline__ float wave_max(float v) {
#pragma unroll
    for (int o = 1; o < 64; o <<= 1) v = fmaxf(v, __shfl_xor(v, o));
    return v;
}
#define DPP_F(v, ctrl) __builtin_bit_cast(float, __builtin_amdgcn_update_dpp(0, __builtin_bit_cast(int, (v)), (ctrl), 0xF, 0xF, true))
__device__ __forceinline__ float row16_sum(float v) {
    v += DPP_F(v, 0xB1);
    v += DPP_F(v, 0x4E);
    v += DPP_F(v, 0x141);
    v += DPP_F(v, 0x140);
    return v;
}
__device__ __forceinline__ float sigmoidf_(float x) { return __builtin_amdgcn_rcpf(1.f + __expf(-x)); }
__device__ __forceinline__ float softplusf_(float z) { return fmaxf(z, 0.f) + __logf(1.f + __expf(-fabsf(z))); }
__device__ __forceinline__ unsigned fkey(float f) { unsigned u = __float_as_uint(f); return u ^ ((u >> 31) ? 0xFFFFFFFFu : 0x80000000u); }

namespace pg8 {
#define PG8_LAS __attribute__((address_space(3)))
typedef short h16x8 __attribute__((ext_vector_type(8)));
constexpr int BM = 256, BK = 64, HALF = 128, HTB = HALF * BK * 2, STAGE_BYTES = 8 * HTB, NXCD = 8, WGM = 8;
__host__ __device__ __forceinline__ int lds_byte(int r, int c) { const int st = (r >> 4) * 2 + (c >> 5), rr = r & 15, cc = c & 31, ob = rr * 64 + cc * 2; return st * 1024 + (ob ^ (((ob >> 9) & 1) << 5)); }
__host__ __device__ __forceinline__ void stage_rc(int b, int& R, int& C) { const int st = b / 1024, sb = b % 1024, swz = sb ^ (((sb >> 9) & 1) << 5); R = (st >> 1) * 16 + swz / 64; C = (st & 1) * 32 + (swz % 64) / 2; }
struct Unit { int pm, pn; };
struct Gemm { const f16* A; const f16* Bt; int M, N, K; };
struct StaticOrder {
    int nM, nN, nwg, G, c;
    __host__ __device__ void init(int M, int N, int G_, int c_) { nM = M / BM; nN = N / BM; nwg = nM * nN; G = G_; c = c_; }
    __host__ __device__ bool next(int i, Unit& u) const {
        const long L = (long)i * G + c; if (L >= nwg) return false;
        int wgid = (int)L; { const int q = nwg / NXCD, r = nwg % NXCD, xcd = wgid % NXCD, off = wgid / NXCD; wgid = (xcd < r ? xcd * (q + 1) : r * (q + 1) + (xcd - r) * q) + off; }
        const int nig = WGM * nN, gid = wgid / nig, fm = gid * WGM, gsz = (nM - fm) < WGM ? (nM - fm) : WGM;
        u.pm = fm + ((wgid % nig) % gsz); u.pn = (wgid % nig) / gsz; return true;
    }
};
template <class F> struct EpiElem {
    F f;
    __device__ __forceinline__ void operator()(const f32x4 (&acc)[2][2][4][2], const Unit& u, int wr, int wc, int fr, int fq) const {
        const int row0 = u.pm * BM + wr * 64 + fr, col0 = u.pn * BM + wc * 32 + 4 * fq;
#pragma unroll
        for (int ai = 0; ai < 2; ++ai)
#pragma unroll
            for (int m = 0; m < 4; ++m)
#pragma unroll
                for (int bj = 0; bj < 2; ++bj)
#pragma unroll
                    for (int n = 0; n < 2; ++n) f(row0 + ai * HALF + m * 16, col0 + bj * HALF + n * 16, acc[ai][bj][m][n]);
    }
};
template <class Epi, bool ALIGN_EPI = true, bool SP2 = true>
__device__ __forceinline__ void gemm_phase(PG8_LAS unsigned char* lds, const Gemm g, const StaticOrder& S, const Epi& E) {
    const int tid = threadIdx.x, wid = __builtin_amdgcn_readfirstlane(tid >> 6), lane = tid & 63, wr = wid >> 2, wc = wid & 3, fr = lane & 15, fq = lane >> 4;
    int K = g.K; asm volatile("" : "+s"(K));
    const int nt = K / BK;
    unsigned voffA[2], voffB[2];
#pragma unroll
    for (int i = 0; i < 2; ++i) { int R, C; stage_rc(tid * 16 + i * 8192, R, C); voffA[i] = (unsigned)(R * K + C) * 2u; voffB[i] = (unsigned)(R * K + C) * 2u; }
    const size_t kstep = (size_t)(BK * 2);
    const size_t hstep = (size_t)HALF * K * 2;
    const size_t tstep = 2 * hstep;
    const unsigned ldsw = (unsigned)wid * 1024u;
    const int aoff = lds_byte(wr * 64 + fr, fq * 8), boff = lds_byte(wc * 32 + fr, fq * 8);
#define PG8_SA(b, h) (((b) * 2 + (h)) * HTB)
#define PG8_SB(b, h) ((4 + (b) * 2 + (h)) * HTB)
#define PG8_STAGE(bufoff, gbase, voff) do { _Pragma("unroll") for (int _i = 0; _i < 2; ++_i) \
        __builtin_amdgcn_global_load_lds((const unsigned*)((const char*)(gbase) + (voff)[_i]), (PG8_LAS unsigned*)(lds + (bufoff) + ldsw + _i * 8192), 16, 0, 0); } while (0)
#define PG8_LDA(dst, b, h) do { _Pragma("unroll") for (int m = 0; m < 4; ++m) _Pragma("unroll") for (int k = 0; k < 2; ++k) dst[m][k] = *(const PG8_LAS h16x8*)(lds + PG8_SA(b, h) + aoff + m * 2048 + k * 1024); } while (0)
#define PG8_LDB(dst, b, h) do { _Pragma("unroll") for (int n = 0; n < 2; ++n) _Pragma("unroll") for (int k = 0; k < 2; ++k) dst[n][k] = *(const PG8_LAS h16x8*)(lds + PG8_SB(b, h) + boff + n * 2048 + k * 1024); } while (0)
#define PG8_MMA(ai, bj, At, Bt) do { __builtin_amdgcn_s_setprio(1); _Pragma("unroll") for (int m = 0; m < 4; ++m) _Pragma("unroll") for (int n = 0; n < 2; ++n) _Pragma("unroll") for (int k = 0; k < 2; ++k) \
        acc[ai][bj][m][n] = __builtin_amdgcn_mfma_f32_16x16x32_f16(__builtin_bit_cast(f16x8, Bt[n][k]), __builtin_bit_cast(f16x8, At[m][k]), acc[ai][bj][m][n], 0, 0, 0); __builtin_amdgcn_s_setprio(0); } while (0)
#define PG8_WAIT_V(n) asm volatile("s_waitcnt vmcnt(" #n ")" ::: "memory")
#define PG8_WAIT_L(n) asm volatile("s_waitcnt lgkmcnt(" #n ")" ::: "memory")
#define PG8_BAR __builtin_amdgcn_s_barrier()
#define PG8_SCHED __builtin_amdgcn_sched_barrier(0)
    Unit cur, nxt; int ui = 0;
    if (!S.next(0, cur)) return;
    f32x4 acc[2][2][4][2];
#pragma unroll
    for (int a = 0; a < 2; ++a)
#pragma unroll
        for (int b = 0; b < 2; ++b)
#pragma unroll
            for (int m = 0; m < 4; ++m)
#pragma unroll
                for (int n = 0; n < 2; ++n) acc[a][b][m][n] = (f32x4){0.f, 0.f, 0.f, 0.f};
    h16x8 At[4][2], B0[2][2], B1[2][2];
    const char* cA = (const char*)g.A + (size_t)cur.pm * tstep; const char* cB = (const char*)g.Bt + (size_t)cur.pn * tstep;
    if constexpr (SP2) {
        PG8_STAGE(PG8_SB(0, 0), cB, voffB); PG8_STAGE(PG8_SB(0, 1), cB + hstep, voffB); PG8_STAGE(PG8_SA(0, 0), cA, voffA); PG8_STAGE(PG8_SA(0, 1), cA + hstep, voffA);
        if (wr == 1) PG8_BAR;
        PG8_WAIT_V(2); PG8_BAR;
        PG8_STAGE(PG8_SB(1, 0), cB + kstep, voffB); PG8_STAGE(PG8_SA(1, 0), cA + kstep, voffA); PG8_STAGE(PG8_SB(1, 1), cB + hstep + kstep, voffB);
        PG8_WAIT_V(6); PG8_BAR;
    } else {
        PG8_STAGE(PG8_SB(0, 0), cB, voffB); PG8_STAGE(PG8_SA(0, 0), cA, voffA); PG8_STAGE(PG8_SB(0, 1), cB + hstep, voffB); PG8_STAGE(PG8_SA(0, 1), cA + hstep, voffA);
        if (wr == 1) PG8_BAR;
        PG8_WAIT_V(4); PG8_BAR;
        PG8_STAGE(PG8_SB(1, 0), cB + kstep, voffB); PG8_STAGE(PG8_SA(1, 0), cA + kstep, voffA); PG8_STAGE(PG8_SB(1, 1), cB + hstep + kstep, voffB);
        PG8_WAIT_V(6); PG8_BAR;
    }
    for (;;) {
        const bool has_next = S.next(ui + 1, nxt);
        const char* nA = has_next ? (const char*)g.A + (size_t)nxt.pm * tstep : cA; const char* nB = has_next ? (const char*)g.Bt + (size_t)nxt.pn * tstep : cB;
        for (int t = 0; t < nt; t += 2) {
            const bool last = (t == nt - 2);
            const char* a1 = cA + (size_t)(t + 1) * kstep;
            const char* a2 = last ? nA : cA + (size_t)(t + 2) * kstep; const char* b2 = last ? nB : cB + (size_t)(t + 2) * kstep;
            const char* a3 = a2 + kstep; const char* b3 = b2 + kstep;
            if constexpr (SP2) {
            PG8_LDB(B0, 0, 0); PG8_LDB(B1, 0, 1); PG8_SCHED; PG8_LDA(At, 0, 0); PG8_STAGE(PG8_SA(1, 1), a1 + hstep, voffA);
            PG8_WAIT_V(8); PG8_WAIT_L(0); PG8_BAR; PG8_MMA(0, 0, At, B0); PG8_MMA(0, 1, At, B1); PG8_BAR; PG8_SCHED;
            PG8_LDA(At, 0, 1); PG8_STAGE(PG8_SB(0, 0), b2, voffB); PG8_STAGE(PG8_SB(0, 1), b2 + hstep, voffB); PG8_STAGE(PG8_SA(0, 0), a2, voffA);
            PG8_WAIT_V(8); PG8_WAIT_L(0); PG8_BAR; PG8_MMA(1, 0, At, B0); PG8_MMA(1, 1, At, B1); PG8_BAR; PG8_SCHED;
            PG8_LDB(B0, 1, 0); PG8_LDB(B1, 1, 1); PG8_SCHED; PG8_LDA(At, 1, 0); PG8_STAGE(PG8_SA(0, 1), a2 + hstep, voffA);
            PG8_WAIT_V(8); PG8_WAIT_L(0); PG8_BAR; PG8_MMA(0, 0, At, B0); PG8_MMA(0, 1, At, B1); PG8_BAR; PG8_SCHED;
            PG8_LDA(At, 1, 1); PG8_STAGE(PG8_SB(1, 0), b3, voffB); PG8_STAGE(PG8_SB(1, 1), b3 + hstep, voffB); PG8_STAGE(PG8_SA(1, 0), a3, voffA);
            PG8_WAIT_V(8); PG8_WAIT_L(0); PG8_BAR; PG8_MMA(1, 0, At, B0); PG8_MMA(1, 1, At, B1); PG8_BAR; PG8_SCHED;
            } else {
            PG8_LDB(B0, 0, 0); PG8_SCHED; PG8_LDA(At, 0, 0); PG8_STAGE(PG8_SA(1, 1), a1 + hstep, voffA);
            PG8_WAIT_L(8); PG8_BAR; PG8_WAIT_L(0); PG8_MMA(0, 0, At, B0); PG8_BAR; PG8_SCHED;
            PG8_LDB(B1, 0, 1); PG8_STAGE(PG8_SB(0, 0), b2, voffB);
            PG8_BAR; PG8_WAIT_L(0); PG8_MMA(0, 1, At, B1); PG8_BAR;
            PG8_LDA(At, 0, 1); PG8_STAGE(PG8_SA(0, 0), a2, voffA);
            PG8_BAR; PG8_WAIT_L(0); PG8_MMA(1, 0, At, B0); PG8_BAR; PG8_SCHED;
            PG8_STAGE(PG8_SB(0, 1), b2 + hstep, voffB);
            PG8_WAIT_V(6); PG8_BAR; PG8_MMA(1, 1, At, B1); PG8_BAR;
            PG8_LDB(B0, 1, 0); PG8_SCHED; PG8_LDA(At, 1, 0); PG8_STAGE(PG8_SA(0, 1), a2 + hstep, voffA);
            PG8_WAIT_L(8); PG8_BAR; PG8_WAIT_L(0); PG8_MMA(0, 0, At, B0); PG8_BAR; PG8_SCHED;
            PG8_LDB(B1, 1, 1); PG8_STAGE(PG8_SB(1, 0), b3, voffB);
            PG8_BAR; PG8_WAIT_L(0); PG8_MMA(0, 1, At, B1); PG8_BAR;
            PG8_LDA(At, 1, 1); PG8_STAGE(PG8_SA(1, 0), a3, voffA);
            PG8_BAR; PG8_WAIT_L(0); PG8_MMA(1, 0, At, B0); PG8_BAR; PG8_SCHED;
            PG8_STAGE(PG8_SB(1, 1), b3 + hstep, voffB);
            PG8_WAIT_V(6); PG8_BAR; PG8_MMA(1, 1, At, B1); PG8_BAR;
            }
        }
        if constexpr (ALIGN_EPI) { if (wr == 0) PG8_BAR; }
        E(acc, cur, wr, wc, fr, fq);
        if (!has_next) break;
#pragma unroll
        for (int a = 0; a < 2; ++a)
#pragma unroll
            for (int b = 0; b < 2; ++b)
#pragma unroll
                for (int m = 0; m < 4; ++m)
#pragma unroll
                    for (int n = 0; n < 2; ++n) acc[a][b][m][n] = (f32x4){0.f, 0.f, 0.f, 0.f};
        cur = nxt; cA = nA; cB = nB; ++ui;
        if constexpr (ALIGN_EPI) { if (wr == 1) PG8_BAR; }
    }
    PG8_WAIT_V(0);
    if constexpr (!ALIGN_EPI) { if (wr == 0) PG8_BAR; }
    PG8_BAR;
#undef PG8_SA
#undef PG8_SB
#undef PG8_STAGE
#undef PG8_LDA
#undef PG8_LDB
#undef PG8_MMA
#undef PG8_WAIT_V
#undef PG8_WAIT_L
#undef PG8_BAR
#undef PG8_SCHED
}
template <class F>
__device__ __forceinline__ void run_gemm(unsigned char* lds, const f16* A, const f16* Bt, int M, int N, int K, const F& f) {
    Gemm g{A, Bt, M, N, K}; StaticOrder S; S.init(M, N, (int)gridDim.x, (int)blockIdx.x);
    EpiElem<F> E{f};
    gemm_phase<EpiElem<F>>((PG8_LAS unsigned char*)lds, g, S, E);
    __syncthreads();
}
}

__device__ __forceinline__ f16x4 to_h4(f32x4 v) { f16x4 r; r.x = (f16)v.x; r.y = (f16)v.y; r.z = (f16)v.z; r.w = (f16)v.w; return r; }

__device__ __forceinline__ void tr_item(const float* W, int ldw, int col0, int nvalid, int K, f16* out, int nrow0, int item, int nblk, float* scr, int lane) {
    const int kb = item / nblk, nb = item % nblk, k0 = 64 * kb, n0 = 32 * nb;
#pragma unroll 8
    for (int i = 0; i < 32; ++i) { const int kk = 2 * i + (lane >> 5); const int j = n0 + (lane & 31);
        scr[kk * 33 + (lane & 31)] = (j < nvalid) ? W[(size_t)(k0 + kk) * ldw + col0 + j] : 0.f; }
    asm volatile("s_waitcnt vmcnt(0) lgkmcnt(0)" ::: "memory");
    const int c = lane & 7;
#pragma unroll
    for (int jj = 0; jj < 4; ++jj) { const int n = (lane >> 3) + 8 * jj; const float* s = scr + (8 * c) * 33 + n;
        f16x8 o;
#pragma unroll
        for (int e = 0; e < 8; ++e) o[e] = (f16)s[e * 33];
        *(f16x8*)(out + (size_t)(nrow0 + n0 + n) * K + k0 + 8 * c) = o; }
    asm volatile("s_waitcnt lgkmcnt(0)" ::: "memory");
}

template <bool LATE>
__device__ __forceinline__ void ph0_prep(const Params& p, unsigned char* lds, int vwg, int nvwg) {
    int tid_ = threadIdx.x; asm volatile("" : "+v"(tid_));
    const int tid = tid_, lane = tid & 63, wave = tid >> 6;
    const int gw = vwg * 8 + wave, NGW = nvwg * 8;
    f16* H0 = (f16*)(p.ws + WS_H0); float* STAT = (float*)(p.ws + WS_STAT);
    for (int m = gw; m < (LATE ? 0 : MR); m += NGW) {
        f16* orow = H0 + (size_t)m * D;
        if (m >= MREAL + 2 * NMETA) {
#pragma unroll
            for (int j = 0; j < 4; ++j) *(f16x4*)(orow + j * 256 + lane * 4) = (f16x4){(f16)0.f, (f16)0.f, (f16)0.f, (f16)0.f};
            continue;
        }
        const float* src = (m < MREAL) ? p.x + (size_t)m * D : p.meta + (size_t)((m - MREAL) & 15) * D;
        f32x4 v[4]; float s = 0.f;
#pragma unroll
        for (int j = 0; j < 4; ++j) { v[j] = *(const f32x4*)(src + j * 256 + lane * 4); s += (v[j].x + v[j].y) + (v[j].z + v[j].w); }
        const float mean = wave_sum(s) * (1.f / D); float s2 = 0.f;
#pragma unroll
        for (int j = 0; j < 4; ++j) { v[j] = v[j] - mean; s2 += (v[j].x * v[j].x + v[j].y * v[j].y) + (v[j].z * v[j].z + v[j].w * v[j].w); }
        const float rstd = 1.f / sqrtf(wave_sum(s2) * (1.f / D) + LN_EPS);
        if (lane == 0) { STAT[2 * m] = mean; STAT[2 * m + 1] = rstd; }
#pragma unroll
        for (int j = 0; j < 4; ++j) { const f32x4 g = *(const f32x4*)(p.ln_in_g + j * 256 + lane * 4), bb = *(const f32x4*)(p.ln_in_b + j * 256 + lane * 4);
            *(f16x4*)(orow + j * 256 + lane * 4) = to_h4(v[j] * rstd * g + bb); }
    }
    float* scr = (float*)lds + wave * (64 * 33);
    f16* W1T = (f16*)(p.ws + WS_W1T); f16* WGT = (f16*)(p.ws + WS_WGT); f16* WPBT = (f16*)(p.ws + WS_WPBT); f16* WOT = (f16*)(p.ws + WS_WOT);
    constexpr int I_QI = 16 * 16, I_CKV = 4 * 16, I_KI = 4 * 16, I_BC = 56 * 16, I_G = 64 * 16, I_PB = 32 * 8, I_O = 32 * 16;
    constexpr int NITEMS = I_QI + I_CKV + I_KI + I_BC + I_G + I_PB + I_O;
    for (int it = gw + (LATE ? I_QI + I_CKV + I_KI + I_BC : 0); it < (LATE ? NITEMS : I_QI + I_CKV + I_KI + I_BC); it += NGW) {
        int r = it;
        if (r < I_QI) { tr_item(p.w_in, NIN, 640, 512, D, W1T, C_QI, r, 16, scr, lane); continue; } r -= I_QI;
        if (r < I_CKV) { tr_item(p.w_in, NIN, 512, 128, D, W1T, C_CKV, r, 4, scr, lane); continue; } r -= I_CKV;
        if (r < I_KI) { tr_item(p.w_in, NIN, 1152, 72, D, W1T, C_KI, r, 4, scr, lane); continue; } r -= I_KI;
        if (r < I_BC) { tr_item(p.w_in, NIN, 1224, 1792, D, W1T, C_BC, r, 56, scr, lane); continue; } r -= I_BC;
        if (r < I_G) { tr_item(p.w_in, NIN, 3016, 2048, D, WGT, 0, r, 64, scr, lane); continue; } r -= I_G;
        if (r < I_PB) { tr_item(p.w_pb, D, 0, 1024, 512, WPBT, 0, r, 32, scr, lane); continue; } r -= I_PB;
        tr_item(p.w_o, D, 0, 1024, D, WOT, 0, r, 32, scr, lane);
    }
    {
        const int fr = lane & 15, fq = lane >> 4;
        constexpr int T_W1 = 8 * 8 * 64, T_SK = 16 * 8 * 64, T_PA = 8 * 8 * 64;
        f16* WPAT = (f16*)(p.ws + WS_WPAT); f16* WSKT = (f16*)(p.ws + WS_WSKT);
        for (int it = gw + (LATE ? T_W1 : 0); it < (LATE ? T_W1 + T_SK + T_PA : T_W1); it += NGW) {
            int r = it; int kind = 0; if (r >= T_W1) { r -= T_W1; kind = 1; if (r >= T_SK) { r -= T_SK; kind = 2; } }
            const int g = r >> 9, mt = (r >> 6) & 7, nt = r & 63;
            const int m = 16 * mt + fr, n = 16 * nt + fr;
            const int KK = (kind == 1) ? 128 : 64;
            f32x4 acc = {0.f, 0.f, 0.f, 0.f};
            for (int k0 = 0; k0 < KK; k0 += 32) {
                const int kb = k0 + 8 * fq;
                f16x8 af, bf;
                if (kind == 0) { const float* ap = p.a_w_uk + (size_t)(m * 8 + g) * 64 + kb; const float* bp = p.w_in + (size_t)n * NIN + g * 64 + kb;
                    const f32x4 a0 = *(const f32x4*)ap, a1 = *(const f32x4*)(ap + 4), b0 = *(const f32x4*)bp, b1 = *(const f32x4*)(bp + 4);
#pragma unroll
                    for (int e = 0; e < 4; ++e) { af[e] = (f16)a0[e]; af[4 + e] = (f16)a1[e]; bf[e] = (f16)b0[e]; bf[4 + e] = (f16)b1[e]; } }
                else if (kind == 1) { const float* ap = p.peer_subkeys + (size_t)(g * 128 + m) * 128 + kb; const float* bp = p.peer_wq + (size_t)n * 2048 + g * 128 + kb;
                    const f32x4 a0 = *(const f32x4*)ap, a1 = *(const f32x4*)(ap + 4), b0 = *(const f32x4*)bp, b1 = *(const f32x4*)(bp + 4);
#pragma unroll
                    for (int e = 0; e < 4; ++e) { af[e] = (f16)a0[e]; af[4 + e] = (f16)a1[e]; bf[e] = (f16)b0[e]; bf[4 + e] = (f16)b1[e]; } }
                else { const float* ap = p.a_w_uv + (size_t)(m * 8 + g) * 64 + kb; const float* bp = p.w_pa + (size_t)(g * 64 + kb) * D + n;
                    const f32x4 a0 = *(const f32x4*)ap, a1 = *(const f32x4*)(ap + 4);
#pragma unroll
                    for (int e = 0; e < 4; ++e) { af[e] = (f16)a0[e]; af[4 + e] = (f16)a1[e]; }
#pragma unroll
                    for (int e = 0; e < 8; ++e) bf[e] = (f16)bp[(size_t)e * D]; }
                acc = __builtin_amdgcn_mfma_f32_16x16x32_f16(af, bf, acc, 0, 0, 0);
            }
            if (kind == 2) { *(f16x4*)(WPAT + (size_t)n * D + g * 128 + 16 * mt + 4 * fq) = to_h4(acc); }
            else { f16* o = ((kind == 0) ? W1T : WSKT) + (size_t)(g * 128 + 16 * mt + 4 * fq) * D + n;
#pragma unroll
                for (int e = 0; e < 4; ++e) o[(size_t)e * D] = (f16)acc[e]; }
        }
    }
    const long gt = (long)vwg * NT + tid, NGT = (long)nvwg * NT;
    f16* WLT = (f16*)(p.ws + WS_WLT);
    for (long e = gt; e < (LATE ? 0L : 1536L * 256); e += NGT) { const int n = (int)(e >> 8), k = (int)(e & 255); float v = 0.f;
        if (n < 512) { if (k < 64) v = p.b_w2[(size_t)k * 512 + n]; }
        else if (n < 1024) { if (k >= 64 && k < 128) v = p.b_a2[(size_t)(k - 64) * 512 + (n - 512)]; }
        else { if (k >= 128) v = p.b_g2[(size_t)(k - 128) * 512 + (n - 1024)]; }
        WLT[e] = (f16)v; }
    if (LATE) {
        unsigned char* U8 = p.ws + WS_U8;
        for (long e = gt; e < 16384L * 1024 / 16; e += NGT) {
            u32x4 ou, ov;
#pragma unroll
            for (int q = 0; q < 4; ++q) { const f32x4 a = *(const f32x4*)(p.peer_u + e * 16 + q * 4) * 256.f; const f32x4 c = *(const f32x4*)(p.peer_v + e * 16 + q * 4) * 16.f;
                int w = 0; w = __builtin_amdgcn_cvt_pk_fp8_f32(a[0], a[1], w, false); w = __builtin_amdgcn_cvt_pk_fp8_f32(a[2], a[3], w, true); ou[q] = (unsigned)w;
                int x = 0; x = __builtin_amdgcn_cvt_pk_fp8_f32(c[0], c[1], x, false); x = __builtin_amdgcn_cvt_pk_fp8_f32(c[2], c[3], x, true); ov[q] = (unsigned)x; }
            const long row = e >> 6;
            unsigned char* vdst = (row < V8A_ROWS) ? p.ws + WS_V8A + e * 16 : p.ws + WS_V8B + (e - (long)V8A_ROWS * 64) * 16;
            *(u32x4*)(U8 + e * 16) = ou; *(u32x4*)vdst = ov;
        }
    }
}

__device__ __forceinline__ void phc1_rowprep(const Params& p) {
    const int tid = threadIdx.x, lane = tid & 63, wave = tid >> 6;
    const int gw = blockIdx.x * 8 + wave, NGW = gridDim.x * 8;
    const f16* PB = (const f16*)(p.ws + WS_PB); f16* CKV = (f16*)(p.ws + WS_CKV); f16* KIDX = (f16*)(p.ws + WS_KIDX); float* WIS = (float*)(p.ws + WS_WIS);
    f16* LORAIN = (f16*)((unsigned char*)p.out + DO_LORAIN);
    for (int m = gw; m < MR; m += NGW) {
        if (m >= MREAL + 2 * NMETA) { *(f16x4*)(LORAIN + (size_t)m * 256 + lane * 4) = (f16x4){(f16)0.f, (f16)0.f, (f16)0.f, (f16)0.f}; continue; }
        const f16* pr = PB + (size_t)m * N1;
        { const f16x2 c2 = *(const f16x2*)(pr + C_CKV + 2 * lane); const float a = (float)c2.x, b = (float)c2.y;
          const float ss = wave_sum(a * a + b * b); const float r = 1.f / sqrtf(ss * (1.f / 128.f) + 1e-6f);
          f16x2 o; o.x = (f16)(a * r * p.a_kv_norm_g[2 * lane]); o.y = (f16)(b * r * p.a_kv_norm_g[2 * lane + 1]);
          *(f16x2*)(CKV + (size_t)m * 128 + 2 * lane) = o; }
        { const float a = (float)pr[C_KI + lane]; const float mu = wave_sum(a) * (1.f / 64.f); const float d = a - mu;
          const float var = wave_sum(d * d) * (1.f / 64.f);
          int kb_, kt_; if (m < MREAL) { kb_ = m >> 13; kt_ = NMETA + (m & 8191); } else { kb_ = (m - MREAL) >> 4; kt_ = (m - MREAL) & 15; }
          KIDX[(size_t)kb_ * KIDX_B + (size_t)(kt_ >> 5) * 2048 + (lane >> 4) * 512 + ((lane >> 3) & 1) * 256 + (kt_ & 31) * 8 + (lane & 7)] = (f16)(d * (1.f / sqrtf(var + LN_EPS)) * p.a_kidx_g[lane] + p.a_kidx_b[lane]); }
        if (lane < 8) WIS[(size_t)m * 8 + lane] = (float)pr[C_WI + lane] * 0.04419417382415922f;
        { int b, t; if (m < MREAL) { b = m >> 13; t = NMETA + (m & 8191); } else { b = (m - MREAL) >> 4; t = (m - MREAL) & 15; }
          const f16x4 cur = *(const f16x4*)(pr + C_BC + 1536 + lane * 4);
          f16x4 prv = (f16x4){(f16)0.f, (f16)0.f, (f16)0.f, (f16)0.f};
          if (t > 0) prv = *(const f16x4*)(PB + (size_t)row_of(b, t - 1) * N1 + C_BC + 1536 + lane * 4);
          const f32x4 mu = *(const f32x4*)(p.b_mu + 1536 + lane * 4);
          f16x4 o;
#pragma unroll
          for (int e = 0; e < 4; ++e) { const float c = (float)cur[e], q = (float)prv[e]; float xs = c + (q - c) * mu[e];
              const int j = lane * 4 + e; if (j < 64) xs = tanhf(xs); else if (j >= 128) xs = sigmoidf_(xs); o[e] = (f16)xs; }
          *(f16x4*)(LORAIN + (size_t)m * 256 + lane * 4) = o; }
    }
}

typedef short bf16x8 __attribute__((ext_vector_type(8)));
typedef unsigned short bf16_t;
typedef unsigned u32x2 __attribute__((ext_vector_type(2)));
typedef __bf16 bf16x2_t __attribute__((ext_vector_type(2)));
__device__ __forceinline__ unsigned cvt_pk_bf16(float lo, float hi) { const f32x2 v = {lo, hi}; const bf16x2_t b = __builtin_convertvector(v, bf16x2_t); return __builtin_bit_cast(unsigned, b); }
__device__ __forceinline__ bf16_t f2bf(float f) { unsigned u = __float_as_uint(f); return (bf16_t)((u + 0x7fffu + ((u >> 16) & 1u)) >> 16); }
__device__ __forceinline__ u32x2 pk4(f32x4 v) { u32x2 r; r.x = cvt_pk_bf16(v[0], v[1]); r.y = cvt_pk_bf16(v[2], v[3]); return r; }
__device__ __forceinline__ bf16x8 pk8(f32x4 a, f32x4 b) { u32x4 r; r.x = cvt_pk_bf16(a[0], a[1]); r.y = cvt_pk_bf16(a[2], a[3]); r.z = cvt_pk_bf16(b[0], b[1]); r.w = cvt_pk_bf16(b[2], b[3]); return __builtin_bit_cast(bf16x8, r); }
#define MFMA_BF(a, b, c) __builtin_amdgcn_mfma_f32_16x16x32_bf16((a), (b), (c), 0, 0, 0)
constexpr int RS = 72, PSt = 40, FS = 36, YS = 68;
__device__ __forceinline__ void rwkv_item(const Params& p, int b, int h, unsigned char* lds) {
    int tid_ = threadIdx.x; asm volatile("" : "+v"(tid_));
    const int tid = tid_, lane = tid & 63, wave = __builtin_amdgcn_readfirstlane(tid >> 6), fr = lane & 15, fq = lane >> 4;
    const f16* PB = (const f16*)(p.ws + WS_PB);
    const f16* LW = (const f16*)((unsigned char*)p.out + DO_LW); const f16* AA = (const f16*)((unsigned char*)p.out + DO_AA); const f16* GG = (const f16*)((unsigned char*)p.out + DO_GG);
    f16* OB = (f16*)(p.ws + WS_OB);
    constexpr int SETB = 4 * 32 * RS * 2 + 3 * 64 * PSt * 2 + 256 + 4608 * 4;
#define RW_SET(par_) bf16_t* sAt = (bf16_t*)(lds + (par_) * SETB); bf16_t* sRt = sAt + 32 * RS; bf16_t* sBt = sRt + 32 * RS; bf16_t* sKt = sBt + 32 * RS; \
        bf16_t* sBPT = sKt + 32 * RS; bf16_t* sKPT = sBPT + 64 * PSt; bf16_t* sVT = sKPT + 64 * PSt; float* sPL = (float*)(sVT + 64 * PSt); float* sFst = sPL + 64; \
        (void)sAt; (void)sRt; (void)sBt; (void)sKt; (void)sBPT; (void)sKPT; (void)sVT; (void)sPL; (void)sFst
    bf16_t* sAak = (bf16_t*)(lds + 2 * SETB); bf16_t* sMrb = sAak + 32 * PSt; bf16_t* sMrk = sMrb + 32 * PSt; bf16_t* sT = sMrk + 32 * PSt; bf16_t* sAabB = sT + 32 * PSt;
    float* sAabT = (float*)(sAabB + 16 * PSt); float* sTot = sAabT + 2 * 16 * FS; float* sY = sTot + 8 * 64;
    float* sEnd = sY + 32 * YS;
    float* sCst = sEnd;
    for (unsigned* z = (unsigned*)lds + tid; z < (unsigned*)sEnd; z += NT) *z = 0u;
    const int ps = tid >> 4, cg = tid & 15, c4 = cg * 4, hc = h * 64 + c4;
    const int chslot = 32 * (cg >> 3) + 8 * (cg & 3) + 4 * ((cg >> 2) & 1);
    const int pslot = 8 * ((ps & 15) >> 2) + 4 * (ps >> 4) + (ps & 3);
#define PSWZ(row, slot) ((row) * PSt + ((((slot) >> 3) ^ (((row) >> 3) & 3)) << 3) + ((slot) & 7))
    if (tid < 64) { sCst[tid] = p.b_mu[h * 64 + tid]; sCst[64 + tid] = p.b_mu[512 + h * 64 + tid]; sCst[128 + tid] = p.b_mu[1024 + h * 64 + tid]; sCst[192 + tid] = p.b_k_k[h * 64 + tid];
        sCst[256 + tid] = p.b_k_a[h * 64 + tid]; sCst[320 + tid] = p.b_r_k[h * 64 + tid]; sCst[384 + tid] = p.b_lnx_g[h * 64 + tid]; sCst[448 + tid] = p.b_lnx_b[h * 64 + tid]; }
    f32x4 Hacc[4];
#pragma unroll
    for (int i = 0; i < 4; ++i) Hacc[i] = (f32x4){0.f, 0.f, 0.f, 0.f};
    const f16x4 hz = (f16x4){(f16)0.f, (f16)0.f, (f16)0.f, (f16)0.f};
    f16x4 n_cr = hz, n_ck = hz, n_cv = hz, n_qr = hz, n_qk = hz, n_qv = hz, n_lw = hz, n_aa = hz, n_gg = hz;
#define RW_PREFETCH(tt) do { const int _t = (tt); n_cr = hz; n_ck = hz; n_cv = hz; n_qr = hz; n_qk = hz; n_qv = hz; n_lw = hz; n_aa = hz; n_gg = hz; \
        if (_t < TT) { const int _m = row_of(b, _t); const f16* _pr = PB + (size_t)_m * N1 + C_BC + hc; n_cr = *(const f16x4*)(_pr); n_ck = *(const f16x4*)(_pr + 512); n_cv = *(const f16x4*)(_pr + 1024); \
            if (_t > 0) { const f16* _pp = PB + (size_t)row_of(b, _t - 1) * N1 + C_BC + hc; n_qr = *(const f16x4*)(_pp); n_qk = *(const f16x4*)(_pp + 512); n_qv = *(const f16x4*)(_pp + 1024); } \
            n_lw = *(const f16x4*)(LW + (size_t)_m * 512 + hc); n_aa = *(const f16x4*)(AA + (size_t)_m * 512 + hc); n_gg = *(const f16x4*)(GG + (size_t)_m * 512 + hc); } } while (0)
    const f16* pf_pb = PB + (size_t)(b * SEQ + 32 - NMETA + ps) * N1 + C_BC + hc;
    size_t pf_lo = (size_t)(b * SEQ + 32 - NMETA + ps) * 512 + hc; int pf_t = 32 + ps;
#define RW_PREFETCH_INC() do { n_cr = hz; n_ck = hz; n_cv = hz; n_qr = hz; n_qk = hz; n_qv = hz; n_lw = hz; n_aa = hz; n_gg = hz; \
        if (pf_t < TT) { n_cr = *(const f16x4*)(pf_pb); n_ck = *(const f16x4*)(pf_pb + 512); n_cv = *(const f16x4*)(pf_pb + 1024); \
            n_qr = *(const f16x4*)(pf_pb - N1); n_qk = *(const f16x4*)(pf_pb - N1 + 512); n_qv = *(const f16x4*)(pf_pb - N1 + 1024); \
            n_lw = *(const f16x4*)(LW + pf_lo); n_aa = *(const f16x4*)(AA + pf_lo); n_gg = *(const f16x4*)(GG + pf_lo); } \
        pf_pb += 32 * N1; pf_lo += 32 * 512; pf_t += 32; } while (0)
    RW_PREFETCH(ps);
    __syncthreads();
#define RW_SCAN_LOCAL(dst, lwv) do { dst = (f32x4){(float)(lwv)[0], (float)(lwv)[1], (float)(lwv)[2], (float)(lwv)[3]}; f32x4 u1_; \
        _Pragma("unroll") for (int e = 0; e < 4; ++e) u1_[e] = __shfl_up(dst[e], 16); if (lane >= 16) dst += u1_; \
        _Pragma("unroll") for (int e = 0; e < 4; ++e) u1_[e] = __shfl_up(dst[e], 32); if (lane >= 32) dst += u1_; \
        if (lane >= 48) *(f32x4*)(sTot + wave * 64 + c4) = dst; } while (0)
#define RW_SCAN_FINISH(dst, totv) do { totv = (f32x4){0.f, 0.f, 0.f, 0.f}; f32x4 tw_[8]; \
        _Pragma("unroll") for (int w = 0; w < 8; ++w) tw_[w] = *(const f32x4*)(sTot + w * 64 + c4); \
        __builtin_amdgcn_sched_barrier(0); \
        _Pragma("unroll") for (int w = 0; w < 8; ++w) { totv += tw_[w]; const float msk_ = (w < wave) ? 1.f : 0.f; dst += tw_[w] * msk_; } } while (0)
    f32x4 cumC, totC;
    RW_SCAN_LOCAL(cumC, n_lw);
    __syncthreads();
    RW_SCAN_FINISH(cumC, totC);
    __syncthreads();
    constexpr int NCH = (TT + 31) / 32;
    { RW_SET(0); const int t = ps;
        f32x4 r4 = {0, 0, 0, 0}, k4 = r4, v4 = r4, kk4 = r4, a4 = r4, g4 = r4, lw4 = r4;
        f32x4 rkw;
        {
            const f16x4 cr = n_cr, ck = n_ck, cv = n_cv, qr = n_qr, qk = n_qk, qv = n_qv, lw = n_lw, aa = n_aa, gg = n_gg;
            RW_PREFETCH_INC();
            const f32x4 mu_r = *(const f32x4*)(sCst + c4), mu_k = *(const f32x4*)(sCst + 64 + c4), mu_v = *(const f32x4*)(sCst + 128 + c4), kkw = *(const f32x4*)(sCst + 192 + c4), kaw = *(const f32x4*)(sCst + 256 + c4);
            rkw = *(const f32x4*)(sCst + 320 + c4);
#pragma unroll
            for (int e = 0; e < 4; ++e) {
                const float c0 = (float)cr[e], c1 = (float)ck[e], c2 = (float)cv[e];
                r4[e] = c0 + ((float)qr[e] - c0) * mu_r[e];
                const float k0 = c1 + ((float)qk[e] - c1) * mu_k[e];
                v4[e] = c2 + ((float)qv[e] - c2) * mu_v[e];
                a4[e] = (float)aa[e]; lw4[e] = (float)lw[e]; g4[e] = (float)gg[e];
                kk4[e] = k0 * kkw[e];
                k4[e] = k0 * (1.f + (a4[e] - 1.f) * kaw[e]);
            }
        }
        float ss = kk4[0] * kk4[0] + kk4[1] * kk4[1] + kk4[2] * kk4[2] + kk4[3] * kk4[3];
        float bo = r4[0] * k4[0] * rkw[0] + r4[1] * k4[1] * rkw[1] + r4[2] * k4[2] * rkw[2] + r4[3] * k4[3] * rkw[3];
        ss = row16_sum(ss); bo = row16_sum(bo);
        *(f32x4*)(sFst + tid * 4) = v4; *(f32x4*)(sFst + 2048 + tid * 4) = g4; sFst[4096 + tid] = bo;
        const float rn = __builtin_amdgcn_rsqf(ss + 1e-12f);
        f32x4 bb4;
#pragma unroll
        for (int e = 0; e < 4; ++e) { kk4[e] *= rn; bb4[e] = kk4[e] * a4[e]; }
        const f32x4 cum = cumC, tot = totC;
        {
            f32x4 xa, xb, xk, xr, xbp, xkp;
#pragma unroll
            for (int e = 0; e < 4; ++e) { const float e1 = __expf(cum[e]), e2 = __expf(-cum[e]), e3 = __expf(cum[e] - lw4[e]), e4 = __expf(tot[e] - cum[e]);
                xa[e] = -kk4[e] * e3; xb[e] = bb4[e] * e2; xk[e] = k4[e] * e2; xr[e] = r4[e] * e1; xbp[e] = bb4[e] * e4; xkp[e] = k4[e] * e4; }
            *(u32x2*)(sAt + ps * RS + chslot) = pk4(xa); *(u32x2*)(sBt + ps * RS + chslot) = pk4(xb); *(u32x2*)(sKt + ps * RS + chslot) = pk4(xk); *(u32x2*)(sRt + ps * RS + chslot) = pk4(xr);
#pragma unroll
            for (int e = 0; e < 4; e += 2) { const unsigned pb_ = cvt_pk_bf16(xbp[e], xbp[e + 1]), pk_ = cvt_pk_bf16(xkp[e], xkp[e + 1]), pv_ = cvt_pk_bf16(v4[e], v4[e + 1]);
                sBPT[PSWZ(c4 + e, pslot)] = (bf16_t)pb_; sBPT[PSWZ(c4 + e + 1, pslot)] = (bf16_t)(pb_ >> 16); sKPT[PSWZ(c4 + e, pslot)] = (bf16_t)pk_; sKPT[PSWZ(c4 + e + 1, pslot)] = (bf16_t)(pk_ >> 16);
                sVT[PSWZ(c4 + e, pslot)] = (bf16_t)pv_; sVT[PSWZ(c4 + e + 1, pslot)] = (bf16_t)(pv_ >> 16); }
            if (ps == 0) { f32x4 pl;
#pragma unroll
                for (int e = 0; e < 4; ++e) pl[e] = __expf(tot[e]);
                *(f32x4*)(sPL + c4) = pl; }
        }
    }
    __syncthreads();
    { RW_SET(0);
        for (int jb = (wave < 2) ? wave : wave, jn = 0; jb < 12 && !(wave < 2 && jn > 0); jb += 6, ++jn) {
            const bf16_t *Ab, *Bb; int ta, tb;
            if (jb < 2) { ta = jb; tb = jb; Ab = sAt; Bb = sBt; }
            else if (jb == 2) { ta = 0; tb = 1; Ab = sBt; Bb = sAt; }
            else { const int ti = (jb - 3) % 3, prod = (jb - 3) / 3; ta = (ti == 2) ? 1 : 0; tb = (ti >= 1) ? 1 : 0; Ab = (prod == 1) ? sBt : sKt; Bb = (prod == 0) ? sAt : sRt; }
            f32x4 acc = {0, 0, 0, 0};
#pragma unroll
            for (int ks = 0; ks < 2; ++ks) { const bf16x8 a = *(const bf16x8*)(Ab + (16 * ta + fr) * RS + 32 * ks + 8 * fq); const bf16x8 bq = *(const bf16x8*)(Bb + (16 * tb + fr) * RS + 32 * ks + 8 * fq); acc = MFMA_BF(a, bq, acc); }
            const int rloc = 4 * fq, cloc = fr;
            if (jb < 2) {
#pragma unroll
                for (int e = 0; e < 4; ++e) acc[e] = (cloc < rloc + e) ? acc[e] : 0.f;
                *(f32x4*)(sAabT + jb * 16 * FS + cloc * FS + rloc) = acc;
                asm volatile("s_waitcnt lgkmcnt(0)" ::: "memory");
                if (lane < 16) {
                    const int col = lane;
                    const float* At_ = sAabT + jb * 16 * FS;
                    float x[16];
#pragma unroll
                    for (int s2 = 0; s2 < 16; ++s2) x[s2] = (s2 == col) ? 1.f : 0.f;
#define RW_INV_BATCH(J0, J1) do { f32x4 cv_[(J1) - (J0)][4]; \
                    _Pragma("unroll") for (int j = (J0); j < (J1); ++j) _Pragma("unroll") for (int q4 = (j + 1) / 4; q4 < 4; ++q4) cv_[j - (J0)][q4] = *(const f32x4*)(At_ + j * FS + 4 * q4); \
                    __builtin_amdgcn_sched_barrier(0); \
                    _Pragma("unroll") for (int j = (J0); j < (J1); ++j) { const float xj = x[j]; \
                        _Pragma("unroll") for (int q4 = (j + 1) / 4; q4 < 4; ++q4) _Pragma("unroll") for (int e = 0; e < 4; ++e) if (4 * q4 + e > j) x[4 * q4 + e] += cv_[j - (J0)][q4][e] * xj; } \
                    __builtin_amdgcn_sched_barrier(0); } while (0)
                    RW_INV_BATCH(0, 3); RW_INV_BATCH(3, 7); RW_INV_BATCH(7, 15);
#pragma unroll
                    for (int s2 = 0; s2 < 16; ++s2) sT[(16 * jb + s2) * PSt + 8 * (col >> 2) + (col & 3)] = f2bf(x[s2]);
                }
            } else if (jb == 2) {
                *(u32x2*)(sAabB + cloc * PSt + 8 * fq) = pk4(acc);
            } else {
                const int prod = (jb - 3) / 3; const int jrow = 16 * ta + rloc, scol = 16 * tb + cloc;
                if (prod == 0) {
#pragma unroll
                    for (int e = 0; e < 4; ++e) acc[e] = (jrow + e < scol) ? acc[e] : 0.f;
                } else {
#pragma unroll
                    for (int e = 0; e < 4; ++e) acc[e] = (jrow + e <= scol) ? acc[e] : 0.f;
                }
                *(u32x2*)(((prod == 0) ? sAak : (prod == 1) ? sMrb : sMrk) + scol * PSt + 8 * fq + 4 * ta) = pk4(acc);
            }
        }
    }
    { f32x4 cumN, totN; RW_SCAN_LOCAL(cumN, n_lw); __syncthreads(); RW_SCAN_FINISH(cumN, totN); cumC = cumN; totC = totN; }
    for (int c = 0; c < NCH; ++c) {
        const int par = c & 1; const bool more = (c + 1 < NCH);
        { RW_SET(par);
        if (wave < 4) {
            const int v0 = 16 * wave;
            const f32x4 z4 = {0.f, 0.f, 0.f, 0.f};
            const bf16x8 hb0 = pk8(Hacc[0], Hacc[1]), hb1 = pk8(Hacc[2], Hacc[3]);
            const bf16x8 vb = *(const bf16x8*)(sVT + PSWZ(v0 + fr, 8 * fq));
            bf16x8 fAt[2][2], fAak[2], fT[2], fAabB;
#pragma unroll
            for (int ts = 0; ts < 2; ++ts) { const bf16_t* atr = sAt + (16 * ts + fr) * RS;
                fAt[ts][0] = *(const bf16x8*)(atr + 8 * fq); fAt[ts][1] = *(const bf16x8*)(atr + 32 + 8 * fq); fAak[ts] = *(const bf16x8*)(sAak + (16 * ts + fr) * PSt + 8 * fq); fT[ts] = *(const bf16x8*)(sT + (16 * ts + fr) * PSt + 8 * fq); }
            fAabB = *(const bf16x8*)(sAabB + fr * PSt + 8 * fq);
            __builtin_amdgcn_sched_barrier(0);
            f32x4 zt = MFMA_BF(fAt[0][0], hb0, z4); f32x4 zb = MFMA_BF(fAt[1][0], hb0, z4);
            zt = MFMA_BF(fAt[0][1], hb1, zt); zb = MFMA_BF(fAt[1][1], hb1, zb);
            zt = MFMA_BF(fAak[0], vb, zt); zb = MFMA_BF(fAak[1], vb, zb);
            bf16x8 fRt[2][2], fMrk[2], fMrb[2];
#pragma unroll
            for (int ts = 0; ts < 2; ++ts) { const bf16_t* rtr = sRt + (16 * ts + fr) * RS;
                fRt[ts][0] = *(const bf16x8*)(rtr + 8 * fq); fRt[ts][1] = *(const bf16x8*)(rtr + 32 + 8 * fq);
                fMrk[ts] = *(const bf16x8*)(sMrk + (16 * ts + fr) * PSt + 8 * fq); fMrb[ts] = *(const bf16x8*)(sMrb + (16 * ts + fr) * PSt + 8 * fq); }
            __builtin_amdgcn_sched_barrier(0);
            const f32x4 ut = MFMA_BF(fT[0], pk8(zt, z4), z4);
            f32x4 y0 = MFMA_BF(fRt[0][0], hb0, z4); f32x4 y1 = MFMA_BF(fRt[1][0], hb0, z4);
            y0 = MFMA_BF(fRt[0][1], hb1, y0); y1 = MFMA_BF(fRt[1][1], hb1, y1);
            zb = MFMA_BF(fAabB, pk8(ut, z4), zb);
            y0 = MFMA_BF(fMrk[0], vb, y0); y1 = MFMA_BF(fMrk[1], vb, y1);
            const f32x4 ubt = MFMA_BF(fT[1], pk8(zb, z4), z4);
            const bf16x8 ub = pk8(ut, ubt);
            y0 = MFMA_BF(fMrb[0], ub, y0); y1 = MFMA_BF(fMrb[1], ub, y1);
#pragma unroll
            for (int e = 0; e < 4; ++e) { sY[(4 * fq + e) * YS + v0 + fr] = y0[e]; sY[(16 + 4 * fq + e) * YS + v0 + fr] = y1[e]; }
            __builtin_amdgcn_sched_barrier(0);
            bf16x8 fBP[4], fKP[4]; f32x4 fPL[4];
#pragma unroll
            for (int tc = 0; tc < 4; ++tc) { fBP[tc] = *(const bf16x8*)(sBPT + PSWZ(16 * tc + fr, 8 * fq)); fKP[tc] = *(const bf16x8*)(sKPT + PSWZ(16 * tc + fr, 8 * fq)); fPL[tc] = *(const f32x4*)(sPL + 16 * tc + 4 * fq); }
            __builtin_amdgcn_sched_barrier(0);
#pragma unroll
            for (int tc = 0; tc < 4; ++tc) {
                f32x4 acc = Hacc[tc] * fPL[tc];
                acc = MFMA_BF(fBP[tc], ub, acc);
                acc = MFMA_BF(fKP[tc], vb, acc);
                Hacc[tc] = acc; }
        }
        }
        if (more) { RW_SET(par ^ 1); const int t = 32 * (c + 1) + ps;
        f32x4 r4 = {0, 0, 0, 0}, k4 = r4, v4 = r4, kk4 = r4, a4 = r4, g4 = r4, lw4 = r4;
        f32x4 rkw;
        {
            const f16x4 cr = n_cr, ck = n_ck, cv = n_cv, qr = n_qr, qk = n_qk, qv = n_qv, lw = n_lw, aa = n_aa, gg = n_gg;
            RW_PREFETCH_INC();
            const f32x4 mu_r = *(const f32x4*)(sCst + c4), mu_k = *(const f32x4*)(sCst + 64 + c4), mu_v = *(const f32x4*)(sCst + 128 + c4), kkw = *(const f32x4*)(sCst + 192 + c4), kaw = *(const f32x4*)(sCst + 256 + c4);
            rkw = *(const f32x4*)(sCst + 320 + c4);
#pragma unroll
            for (int e = 0; e < 4; ++e) {
                const float c0 = (float)cr[e], c1 = (float)ck[e], c2 = (float)cv[e];
                r4[e] = c0 + ((float)qr[e] - c0) * mu_r[e];
                const float k0 = c1 + ((float)qk[e] - c1) * mu_k[e];
                v4[e] = c2 + ((float)qv[e] - c2) * mu_v[e];
                a4[e] = (float)aa[e]; lw4[e] = (float)lw[e]; g4[e] = (float)gg[e];
                kk4[e] = k0 * kkw[e];
                k4[e] = k0 * (1.f + (a4[e] - 1.f) * kaw[e]);
            }
        }
        float ss = kk4[0] * kk4[0] + kk4[1] * kk4[1] + kk4[2] * kk4[2] + kk4[3] * kk4[3];
        float bo = r4[0] * k4[0] * rkw[0] + r4[1] * k4[1] * rkw[1] + r4[2] * k4[2] * rkw[2] + r4[3] * k4[3] * rkw[3];
        ss = row16_sum(ss); bo = row16_sum(bo);
        *(f32x4*)(sFst + tid * 4) = v4; *(f32x4*)(sFst + 2048 + tid * 4) = g4; sFst[4096 + tid] = bo;
        const float rn = __builtin_amdgcn_rsqf(ss + 1e-12f);
        f32x4 bb4;
#pragma unroll
        for (int e = 0; e < 4; ++e) { kk4[e] *= rn; bb4[e] = kk4[e] * a4[e]; }
        const f32x4 cum = cumC, tot = totC;
        {
            f32x4 xa, xb, xk, xr, xbp, xkp;
#pragma unroll
            for (int e = 0; e < 4; ++e) { const float e1 = __expf(cum[e]), e2 = __expf(-cum[e]), e3 = __expf(cum[e] - lw4[e]), e4 = __expf(tot[e] - cum[e]);
                xa[e] = -kk4[e] * e3; xb[e] = bb4[e] * e2; xk[e] = k4[e] * e2; xr[e] = r4[e] * e1; xbp[e] = bb4[e] * e4; xkp[e] = k4[e] * e4; }
            *(u32x2*)(sAt + ps * RS + chslot) = pk4(xa); *(u32x2*)(sBt + ps * RS + chslot) = pk4(xb); *(u32x2*)(sKt + ps * RS + chslot) = pk4(xk); *(u32x2*)(sRt + ps * RS + chslot) = pk4(xr);
#pragma unroll
            for (int e = 0; e < 4; e += 2) { const unsigned pb_ = cvt_pk_bf16(xbp[e], xbp[e + 1]), pk_ = cvt_pk_bf16(xkp[e], xkp[e + 1]), pv_ = cvt_pk_bf16(v4[e], v4[e + 1]);
                sBPT[PSWZ(c4 + e, pslot)] = (bf16_t)pb_; sBPT[PSWZ(c4 + e + 1, pslot)] = (bf16_t)(pb_ >> 16); sKPT[PSWZ(c4 + e, pslot)] = (bf16_t)pk_; sKPT[PSWZ(c4 + e + 1, pslot)] = (bf16_t)(pk_ >> 16);
                sVT[PSWZ(c4 + e, pslot)] = (bf16_t)pv_; sVT[PSWZ(c4 + e + 1, pslot)] = (bf16_t)(pv_ >> 16); }
            if (ps == 0) { f32x4 pl;
#pragma unroll
                for (int e = 0; e < 4; ++e) pl[e] = __expf(tot[e]);
                *(f32x4*)(sPL + c4) = pl; }
        }
        }
        __syncthreads();
        { RW_SET(par);
#pragma unroll
          for (int rr = 0; rr < 2; ++rr) {
            const int vt = rr ? tid - 384 : tid; const bool act = rr ? (wave >= 6) : (wave >= 2);
            if (act) {
                const int psv = vt >> 4, tF = 32 * c + psv;
                const f32x4 y4 = *(const f32x4*)(sY + psv * YS + c4); const f32x4 lng = *(const f32x4*)(sCst + 384 + c4), lnb = *(const f32x4*)(sCst + 448 + c4);
                const f32x4 pv4 = *(const f32x4*)(sFst + vt * 4), pg4 = *(const f32x4*)(sFst + 2048 + vt * 4); const float pbo = sFst[4096 + vt];
                const float mean = row16_sum((y4[0] + y4[1]) + (y4[2] + y4[3])) * (1.f / 64.f);
                float q = 0.f;
#pragma unroll
                for (int e = 0; e < 4; ++e) { const float d = y4[e] - mean; q += d * d; }
                const float rstd = __builtin_amdgcn_rsqf(row16_sum(q) * (1.f / 64.f) + 64e-5f);
                if (tF < TT && tF >= NMETA) {
                    f16x4 o;
#pragma unroll
                    for (int e = 0; e < 4; ++e) o[e] = (f16)((((y4[e] - mean) * rstd) * lng[e] + lnb[e] + pbo * pv4[e]) * pg4[e]);
                    *(f16x4*)(OB + (size_t)(b * SEQ + (tF - NMETA)) * 512 + hc) = o;
                }
            }
          }
        }
        f32x4 cumN = {0.f, 0.f, 0.f, 0.f}, totN = cumN;
        if (more) { RW_SET(par ^ 1);
        for (int jb = (wave < 2) ? wave : wave, jn = 0; jb < 12 && !(wave < 2 && jn > 0); jb += 6, ++jn) {
            const bf16_t *Ab, *Bb; int ta, tb;
            if (jb < 2) { ta = jb; tb = jb; Ab = sAt; Bb = sBt; }
            else if (jb == 2) { ta = 0; tb = 1; Ab = sBt; Bb = sAt; }
            else { const int ti = (jb - 3) % 3, prod = (jb - 3) / 3; ta = (ti == 2) ? 1 : 0; tb = (ti >= 1) ? 1 : 0; Ab = (prod == 1) ? sBt : sKt; Bb = (prod == 0) ? sAt : sRt; }
            f32x4 acc = {0, 0, 0, 0};
#pragma unroll
            for (int ks = 0; ks < 2; ++ks) { const bf16x8 a = *(const bf16x8*)(Ab + (16 * ta + fr) * RS + 32 * ks + 8 * fq); const bf16x8 bq = *(const bf16x8*)(Bb + (16 * tb + fr) * RS + 32 * ks + 8 * fq); acc = MFMA_BF(a, bq, acc); }
            const int rloc = 4 * fq, cloc = fr;
            if (jb < 2) {
#pragma unroll
                for (int e = 0; e < 4; ++e) acc[e] = (cloc < rloc + e) ? acc[e] : 0.f;
                *(f32x4*)(sAabT + jb * 16 * FS + cloc * FS + rloc) = acc;
                asm volatile("s_waitcnt lgkmcnt(0)" ::: "memory");
                if (lane < 16) {
                    const int col = lane;
                    const float* At_ = sAabT + jb * 16 * FS;
                    float x[16];
#pragma unroll
                    for (int s2 = 0; s2 < 16; ++s2) x[s2] = (s2 == col) ? 1.f : 0.f;
#define RW_INV_BATCH(J0, J1) do { f32x4 cv_[(J1) - (J0)][4]; \
                    _Pragma("unroll") for (int j = (J0); j < (J1); ++j) _Pragma("unroll") for (int q4 = (j + 1) / 4; q4 < 4; ++q4) cv_[j - (J0)][q4] = *(const f32x4*)(At_ + j * FS + 4 * q4); \
                    __builtin_amdgcn_sched_barrier(0); \
                    _Pragma("unroll") for (int j = (J0); j < (J1); ++j) { const float xj = x[j]; \
                        _Pragma("unroll") for (int q4 = (j + 1) / 4; q4 < 4; ++q4) _Pragma("unroll") for (int e = 0; e < 4; ++e) if (4 * q4 + e > j) x[4 * q4 + e] += cv_[j - (J0)][q4][e] * xj; } \
                    __builtin_amdgcn_sched_barrier(0); } while (0)
                    RW_INV_BATCH(0, 3); RW_INV_BATCH(3, 7); RW_INV_BATCH(7, 15);
#pragma unroll
                    for (int s2 = 0; s2 < 16; ++s2) sT[(16 * jb + s2) * PSt + 8 * (col >> 2) + (col & 3)] = f2bf(x[s2]);
                }
            } else if (jb == 2) {
                *(u32x2*)(sAabB + cloc * PSt + 8 * fq) = pk4(acc);
            } else {
                const int prod = (jb - 3) / 3; const int jrow = 16 * ta + rloc, scol = 16 * tb + cloc;
                if (prod == 0) {
#pragma unroll
                    for (int e = 0; e < 4; ++e) acc[e] = (jrow + e < scol) ? acc[e] : 0.f;
                } else {
#pragma unroll
                    for (int e = 0; e < 4; ++e) acc[e] = (jrow + e <= scol) ? acc[e] : 0.f;
                }
                *(u32x2*)(((prod == 0) ? sAak : (prod == 1) ? sMrb : sMrk) + scol * PSt + 8 * fq + 4 * ta) = pk4(acc);
            }
        }
            RW_SCAN_LOCAL(cumN, n_lw);
        }
        __syncthreads();
        if (more) { RW_SCAN_FINISH(cumN, totN); cumC = cumN; totC = totN; }
    }
    __syncthreads();
}

constexpr int SCW = 8224;
__device__ __forceinline__ void dsa_item(const Params& p, int b, int g, unsigned char* lds) {
    int tid_ = threadIdx.x; asm volatile("" : "+v"(tid_));
    const int tid = tid_, lane = tid & 63, wave = __builtin_amdgcn_readfirstlane(tid >> 6);
    const f16* PB = (const f16*)(p.ws + WS_PB); const f16* CKV = (const f16*)(p.ws + WS_CKV); const f16* KIDX = (const f16*)(p.ws + WS_KIDX); const float* WIS = (const float*)(p.ws + WS_WIS);
    f16* OLAT = (f16*)(p.ws + WS_OLAT);
    float* sc = (float*)lds;
    unsigned* hist = (unsigned*)(lds + 4 * SCW * 4);
    unsigned short* sel = (unsigned short*)(lds + 4 * SCW * 4 + 4096);
    unsigned* misc = (unsigned*)(lds + 4 * SCW * 4 + 4096 + 2048);
    f16* sq = (f16*)(lds + 4 * SCW * 4 + 4096 + 2048 + 512);
    const int i0 = 4 * g, n_adm = 80 + 64 * (i0 >> 6), ntile = (n_adm + 31) >> 5;
    const int mq0 = b * SEQ + i0;
    {
        const int rho = lane & 31, hh = lane >> 5;
        const int q = 2 * ((rho >> 2) & 1) + (rho >> 4), hd = 4 * ((rho >> 3) & 1) + (rho & 3);
        const f16* qip = PB + (size_t)(mq0 + q) * N1 + C_QI + hd * 64 + 8 * hh;
        f16x8 af[4];
#pragma unroll
        for (int ks = 0; ks < 4; ++ks) af[ks] = *(const f16x8*)(qip + 16 * ks);
        float wsc[16];
#pragma unroll
        for (int j = 0; j < 16; ++j) wsc[j] = WIS[(size_t)(mq0 + 2 * hh + (j >> 3)) * 8 + (j & 7)];
        float mn0 = INFINITY, mx0 = -INFINITY, mn1 = INFINITY, mx1 = -INFINITY;
        f16x8 bn[2][4];
#pragma unroll
        for (int u = 0; u < 2; ++u) { const f16* kp = KIDX + (size_t)b * KIDX_B + (size_t)(wave + 8 * u) * 2048 + hh * 256 + (lane & 31) * 8;
#pragma unroll
          for (int ks = 0; ks < 4; ++ks) bn[u][ks] = *(const f16x8*)(kp + 512 * ks); }
        for (int kt = wave; kt < ntile; kt += 16) {
            f16x8 bf[2][4];
#pragma unroll
            for (int u = 0; u < 2; ++u)
#pragma unroll
                for (int ks = 0; ks < 4; ++ks) bf[u][ks] = bn[u][ks];
#pragma unroll
            for (int u = 0; u < 2; ++u) { int kn = kt + 16 + 8 * u; kn = (kn < ntile) ? kn : kt;
                const f16* kp = KIDX + (size_t)b * KIDX_B + (size_t)kn * 2048 + hh * 256 + (lane & 31) * 8;
#pragma unroll
                for (int ks = 0; ks < 4; ++ks) bn[u][ks] = *(const f16x8*)(kp + 512 * ks); }
            f32x16 acc0, acc1;
#pragma unroll
            for (int j = 0; j < 16; ++j) { acc0[j] = 0.f; acc1[j] = 0.f; }
#pragma unroll
            for (int ks = 0; ks < 4; ++ks) { acc0 = __builtin_amdgcn_mfma_f32_32x32x16_f16(af[ks], bf[0][ks], acc0, 0, 0, 0); acc1 = __builtin_amdgcn_mfma_f32_32x32x16_f16(af[ks], bf[1][ks], acc1, 0, 0, 0); }
            float sa0 = 0.f, sb0 = 0.f, sa1 = 0.f, sb1 = 0.f;
#pragma unroll
            for (int jj = 0; jj < 8; ++jj) { sa0 += wsc[jj] * fmaxf(acc0[jj], 0.f); sb0 += wsc[8 + jj] * fmaxf(acc0[8 + jj], 0.f); sa1 += wsc[jj] * fmaxf(acc1[jj], 0.f); sb1 += wsc[8 + jj] * fmaxf(acc1[8 + jj], 0.f); }
            const int key0 = kt * 32 + (lane & 31), key1 = key0 + 256;
            sc[(2 * hh) * SCW + key0] = sa0; sc[(2 * hh + 1) * SCW + key0] = sb0;
            if (key0 < n_adm) { mn0 = fminf(mn0, sa0); mx0 = fmaxf(mx0, sa0); mn1 = fminf(mn1, sb0); mx1 = fmaxf(mx1, sb0); }
            if (kt + 8 < ntile) { sc[(2 * hh) * SCW + key1] = sa1; sc[(2 * hh + 1) * SCW + key1] = sb1;
                if (key1 < n_adm) { mn0 = fminf(mn0, sa1); mx0 = fmaxf(mx0, sa1); mn1 = fminf(mn1, sb1); mx1 = fmaxf(mx1, sb1); } }
        }
#pragma unroll
        for (int o = 1; o < 32; o <<= 1) { mn0 = fminf(mn0, __shfl_xor(mn0, o)); mx0 = fmaxf(mx0, __shfl_xor(mx0, o)); mn1 = fminf(mn1, __shfl_xor(mn1, o)); mx1 = fmaxf(mx1, __shfl_xor(mx1, o)); }
        float* mm = (float*)(misc + 64);
        if ((lane & 31) == 0) { mm[((2 * hh) * 8 + wave) * 2] = mn0; mm[((2 * hh) * 8 + wave) * 2 + 1] = mx0; mm[((2 * hh + 1) * 8 + wave) * 2] = mn1; mm[((2 * hh + 1) * 8 + wave) * 2 + 1] = mx1; }
        *(f16x8*)(sq + tid * 8) = *(const f16x8*)(PB + (size_t)(mq0 + (tid >> 7)) * N1 + C_QABS + (tid & 127) * 8);
    }
    const int qs = tid >> 7, tl = tid & 127;
    if (n_adm > 256) { hist[qs * 256 + tl] = 0u; hist[qs * 256 + 128 + tl] = 0u; if (tl < 4) misc[qs * 8 + 2 + tl] = 0u; }
    __syncthreads();
    int nsel;
    {
        const float* scq = sc + qs * SCW;
        if (n_adm <= 256) { for (int idx = tl; idx < n_adm; idx += 128) sel[qs * 256 + idx] = (unsigned short)idx; nsel = n_adm; }
        else {
            constexpr int NK = 65;
            const float* mm = (const float*)(misc + 64);
            float lo = INFINITY, hi = -INFINITY;
#pragma unroll
            for (int w = 0; w < 8; ++w) { lo = fminf(lo, mm[(qs * 8 + w) * 2]); hi = fmaxf(hi, mm[(qs * 8 + w) * 2 + 1]); }
            const float scale = (hi > lo) ? 16777215.f / (hi - lo) : 0.f;
            unsigned kreg[NK];
#pragma unroll
            for (int i = 0; i < NK; ++i) { const int idx = tl + 128 * i; const float v = (idx < n_adm) ? scq[idx] : lo; unsigned k = (unsigned)((v - lo) * scale); k = k > 0xFFFFFFu ? 0xFFFFFFu : k; kreg[i] = k;
                if (idx < n_adm) atomicAdd(&hist[qs * 256 + (k >> 16)], 1u); }
            __syncthreads();
            if (tl < 64) {
                const int c0 = (int)hist[qs * 256 + 4 * tl], c1 = (int)hist[qs * 256 + 4 * tl + 1], c2 = (int)hist[qs * 256 + 4 * tl + 2], c3 = (int)hist[qs * 256 + 4 * tl + 3];
                const int tot = c0 + c1 + c2 + c3; int sfx = tot;
#pragma unroll
                for (int off = 1; off < 64; off <<= 1) { const int tv = __shfl_down(sfx, off); if (tl + off < 64) sfx += tv; }
                const int above = sfx - tot;
                if (above < 256 && 256 <= sfx) { const int rem = 256 - above; int bin, nk;
                    if (rem <= c3) { bin = 4 * tl + 3; nk = rem; } else if (rem <= c3 + c2) { bin = 4 * tl + 2; nk = rem - c3; }
                    else if (rem <= c3 + c2 + c1) { bin = 4 * tl + 1; nk = rem - c3 - c2; } else { bin = 4 * tl; nk = rem - c3 - c2 - c1; }
                    misc[qs * 8] = (unsigned)bin; misc[qs * 8 + 1] = (unsigned)nk; }
            }
            __syncthreads();
            const unsigned bin = misc[qs * 8]; const int need = (int)misc[qs * 8 + 1];
            unsigned* cand = (unsigned*)(sc + qs * SCW) + 0;
            const int lane_ = tid & 63;
            __syncthreads();
#pragma unroll
            for (int i = 0; i < NK; ++i) { const int idx = tl + 128 * i; const unsigned u = kreg[i]; const bool ok = idx < n_adm; const unsigned tb = u >> 16;
                if (ok && tb > bin) { const unsigned long long m = __ballot(1); const int leader = __ffsll((long long)m) - 1; unsigned base = 0u;
                    if (lane_ == leader) base = atomicAdd(&misc[qs * 8 + 2], (unsigned)__popcll(m));
                    base = __shfl(base, leader);
                    sel[qs * 256 + base + __popcll(m & ((1ull << lane_) - 1ull))] = (unsigned short)idx; }
                else if (ok && tb == bin) { const unsigned e = atomicAdd(&misc[qs * 8 + 3], 1u); if (e < 4096u) { cand[2 * e] = u; cand[2 * e + 1] = (unsigned)idx; } } }
            __syncthreads();
            { const int m = min((int)misc[qs * 8 + 3], 4096); const int base = (int)misc[qs * 8 + 2];
              for (int i = tl; i < m; i += 128) { const unsigned ku = cand[2 * i]; const unsigned ki = cand[2 * i + 1]; int rank = 0;
                  for (int j = 0; j < m; ++j) { const unsigned kj = cand[2 * j]; const unsigned ij = cand[2 * j + 1]; rank += (kj > ku || (kj == ku && ij < ki)) ? 1 : 0; }
                  if (rank < need) sel[qs * 256 + base + rank] = (unsigned short)ki; } }
            nsel = 256;
        }
    }
    __syncthreads();
    {
        int lane_ = lane; asm volatile("" : "+v"(lane_));
        const int fr = lane_ & 15, fq = lane_ >> 4, aq = wave >> 1, rh = wave & 1;
        const unsigned short* selq = sel + aq * 256;
        unsigned char* cq = lds + aq * 32768;
        f16x8 qf[4];
#pragma unroll
        for (int ks = 0; ks < 4; ++ks) { qf[ks] = *(const f16x8*)(sq + (aq * 8 + (fr & 7)) * 128 + 32 * ks + 8 * fq); if (fr >= 8) qf[ks] = (f16x8){(f16)0.f, (f16)0.f, (f16)0.f, (f16)0.f, (f16)0.f, (f16)0.f, (f16)0.f, (f16)0.f}; }
        f16x8 I0, I1;
#pragma unroll
        for (int j = 0; j < 8; ++j) { I0[j] = (8 * fq + j == fr) ? (f16)1.f : (f16)0.f; I1[j] = (8 * fq + j == 16 + fr) ? (f16)1.f : (f16)0.f; }
        f32x4 O[4];
#pragma unroll
        for (int j = 0; j < 4; ++j) O[j] = (f32x4){0.f, 0.f, 0.f, 0.f};
        float m_run = -1e30f, l_run = 0.f;
        for (int kb = 0; kb < 2; ++kb) {
            {
                f16x8 g[16];
#pragma unroll
                for (int i = 0; i < 16; ++i) { const int rl = 64 * rh + 4 * i + fq; const int kk = 128 * kb + rl; const int kidx = (kk < nsel) ? (int)selq[kk] : 0;
                    g[i] = *(const f16x8*)(CKV + (size_t)row_of(b, kidx) * 128 + fr * 8); }
                __builtin_amdgcn_sched_barrier(0);
#pragma unroll
                for (int i = 0; i < 16; ++i) { const int rl = 64 * rh + 4 * i + fq; *(f16x8*)(cq + rl * 256 + ((fr ^ (rl & 15)) << 4)) = g[i]; }
            }
            __syncthreads();
            f32x4 S[8];
#pragma unroll
            for (int kt = 0; kt < 8; ++kt) { const int rl = 16 * kt + fr; f16x8 a[4];
#pragma unroll
                for (int ks = 0; ks < 4; ++ks) a[ks] = *(const f16x8*)(cq + rl * 256 + (((4 * ks + fq) ^ fr) << 4));
                f32x4 acc = {0.f, 0.f, 0.f, 0.f};
#pragma unroll
                for (int ks = 0; ks < 4; ++ks) acc = __builtin_amdgcn_mfma_f32_16x16x32_f16(a[ks], qf[ks], acc, 0, 0, 0);
                S[kt] = acc; }
            float mx = -1e30f;
#pragma unroll
            for (int kt = 0; kt < 8; ++kt)
#pragma unroll
                for (int e = 0; e < 4; ++e) { const float v = (128 * kb + 16 * kt + 4 * fq + e < nsel) ? S[kt][e] * 0.125f : -1e30f; S[kt][e] = v; mx = fmaxf(mx, v); }
            mx = fmaxf(mx, __shfl_xor(mx, 16)); mx = fmaxf(mx, __shfl_xor(mx, 32));
            const float m_new = fmaxf(m_run, mx);
            const float alpha = __expf(m_run - m_new);
            float sum = 0.f;
#pragma unroll
            for (int kt = 0; kt < 8; ++kt)
#pragma unroll
                for (int e = 0; e < 4; ++e) { const float pv = (S[kt][e] > -1e29f) ? __expf(S[kt][e] - m_new) : 0.f; S[kt][e] = pv; sum += pv; }
            sum += __shfl_xor(sum, 16); sum += __shfl_xor(sum, 32);
            l_run = l_run * alpha + sum; m_run = m_new;
#pragma unroll
            for (int e = 0; e < 4; ++e) { const float al = __shfl(alpha, 4 * fq + e);
#pragma unroll
                for (int j = 0; j < 4; ++j) O[j][e] *= al; }
            f16x8 Pf[4];
#pragma unroll
            for (int i = 0; i < 4; ++i)
#pragma unroll
                for (int e = 0; e < 4; ++e) { Pf[i][e] = (f16)S[2 * i][e]; Pf[i][4 + e] = (f16)S[2 * i + 1][e]; }
#pragma unroll
            for (int i = 0; i < 4; ++i) {
                const int ra = 32 * i + fr, rb = ra + 16;
                f16x8 xa[2], xb[2];
#pragma unroll
                for (int u = 0; u < 2; ++u) { xa[u] = *(const f16x8*)(cq + ra * 256 + (((4 * (2 * rh + u) + fq) ^ fr) << 4)); xb[u] = *(const f16x8*)(cq + rb * 256 + (((4 * (2 * rh + u) + fq) ^ fr) << 4)); }
#pragma unroll
                for (int j = 0; j < 4; ++j) {
                    const f32x4 z = {0.f, 0.f, 0.f, 0.f};
                    const f32x4 da = __builtin_amdgcn_mfma_f32_16x16x32_f16(xa[j >> 1], (j & 1) ? I1 : I0, z, 0, 0, 0);
                    const f32x4 db = __builtin_amdgcn_mfma_f32_16x16x32_f16(xb[j >> 1], (j & 1) ? I1 : I0, z, 0, 0, 0);
                    f16x8 bfr;
#pragma unroll
                    for (int e = 0; e < 4; ++e) { bfr[e] = (f16)da[e]; bfr[4 + e] = (f16)db[e]; }
                    O[j] = __builtin_amdgcn_mfma_f32_16x16x32_f16(Pf[i], bfr, O[j], 0, 0, 0);
                }
            }
            __syncthreads();
        }
        const float inv = 1.f / l_run;
        if (fq < 2) {
#pragma unroll
            for (int e = 0; e < 4; ++e) { const float il = __shfl(inv, 4 * fq + e);
#pragma unroll
                for (int j = 0; j < 4; ++j) OLAT[(size_t)(mq0 + aq) * 1024 + (4 * fq + e) * 128 + 64 * rh + 16 * j + fr] = (f16)(O[j][e] * il); }
        }
    }
    __syncthreads();
}

__device__ __forceinline__ void phc2_mixers(const Params& p, unsigned char* lds, int rep) {
    unsigned* ctr = (unsigned*)(p.ws + WS_CTL) + 64 + 64 * rep;
    int* s_item = (int*)(lds + 150 * 1024 - 16);
    constexpr int NRW = 16, NDSA = 2 * (SEQ / 4), NFILL = 512;
    for (;;) {
        if (threadIdx.x == 0) *s_item = (int)atomicAdd(ctr, 1u);
        __syncthreads();
        const int item = *s_item;
        __syncthreads();
        if (item >= NRW + NDSA + NFILL) break;
        if (item >= NRW + NDSA) { ph0_prep<true>(p, lds, item - (NRW + NDSA), NFILL); __syncthreads(); continue; }
        if (item < NRW) rwkv_item(p, item >> 3, item & 7, lds);
        else { const int d = item - NRW; dsa_item(p, d & 1, (SEQ / 4 - 1) - (d >> 1), lds); }
    }
}

__device__ __forceinline__ void phd3_ln1(const Params& p) {
    const int tid = threadIdx.x, lane = tid & 63, wave = tid >> 6;
    const int gw = blockIdx.x * 8 + wave, NGW = gridDim.x * 8;
    f16* H1H = (f16*)(p.ws + WS_H1H);
    for (int m = gw; m < MREAL; m += NGW) {
        float* row = p.out + (size_t)m * D;
        f32x4 v[4]; float s = 0.f;
#pragma unroll
        for (int j = 0; j < 4; ++j) { v[j] = *(const f32x4*)(row + j * 256 + lane * 4); s += (v[j].x + v[j].y) + (v[j].z + v[j].w); }
        const float mean = wave_sum(s) * (1.f / D); float s2 = 0.f;
#pragma unroll
        for (int j = 0; j < 4; ++j) { v[j] = v[j] - mean; s2 += (v[j].x * v[j].x + v[j].y * v[j].y) + (v[j].z * v[j].z + v[j].w * v[j].w); }
        const float rstd = 1.f / sqrtf(wave_sum(s2) * (1.f / D) + LN_EPS);
#pragma unroll
        for (int j = 0; j < 4; ++j) { const f32x4 g = *(const f32x4*)(p.ln1_g + j * 256 + lane * 4), bb = *(const f32x4*)(p.ln1_b + j * 256 + lane * 4);
            const f32x4 o = v[j] * rstd * g + bb; *(f32x4*)(row + j * 256 + lane * 4) = o; *(f16x4*)(H1H + (size_t)m * D + j * 256 + lane * 4) = to_h4(o); }
    }
}

#define INS16(L, x_) do { unsigned x__ = (x_); _Pragma("unroll") for (int j_ = 0; j_ < 16; ++j_) { const unsigned hi_ = max(L[j_], x__); x__ = min(L[j_], x__); L[j_] = hi_; } } while (0)
__device__ __forceinline__ void top16_of_128(const unsigned short* src, unsigned (&L)[16]) {
#pragma unroll
    for (int j = 0; j < 16; ++j) L[j] = 0u;
#pragma unroll 1
    for (int hb = 0; hb < 2; ++hb) {
        u32x4 w[8];
#pragma unroll
        for (int c = 0; c < 8; ++c) w[c] = *(const u32x4*)(src + hb * 64 + c * 8);
        __builtin_amdgcn_sched_barrier(0);
#pragma unroll
        for (int c = 0; c < 8; ++c)
#pragma unroll
            for (int e = 0; e < 8; ++e) {
                const unsigned sc16 = (w[c][e >> 1] >> (16 * (e & 1))) & 0xFFFFu;
                const unsigned key = (sc16 << 16) | (unsigned)(127 - (hb * 64 + c * 8 + e));
                INS16(L, key);
            }
    }
}
__device__ __forceinline__ void phd5_topk(const Params& p) {
    const unsigned short* SC = (const unsigned short*)(p.ws + WS_SC);
    unsigned short* EIDX = (unsigned short*)(p.ws + WS_EIDX); float* EGATE = (float*)(p.ws + WS_EGATE);
    const long gt = (long)blockIdx.x * NT + threadIdx.x, NGT = (long)gridDim.x * NT;
    for (long e = gt; e < (long)MREAL * 8; e += NGT) {
        const int m = (int)(e >> 3), h = (int)(e & 7);
        unsigned A[16], B[16];
        top16_of_128(SC + (size_t)m * 2048 + h * 256, A);
        top16_of_128(SC + (size_t)m * 2048 + h * 256 + 128, B);
        unsigned T[16];
#pragma unroll
        for (int j = 0; j < 16; ++j) T[j] = 0u;
#pragma unroll
        for (int i = 0; i < 16; ++i)
#pragma unroll
            for (int j = 0; j < 16; ++j)
                if ((i + 1) * (j + 1) <= 16) {
                    const unsigned sum = (A[i] >> 16) + (B[j] >> 16);
                    const unsigned eid = (127u - (A[i] & 0xFFFFu)) * 128u + (127u - (B[j] & 0xFFFFu));
                    INS16(T, (sum << 14) | eid);
                }
        float sumf = 0.f; float ex[16];
        const int s0 = (int)(T[0] >> 14);
#pragma unroll
        for (int j = 0; j < 16; ++j) { ex[j] = __expf((float)((int)(T[j] >> 14) - s0) * (1.f / 8192.f)); sumf += ex[j]; }
        const float inv = 1.f / sumf;
#pragma unroll
        for (int j = 0; j < 16; ++j) { EIDX[(size_t)m * 128 + h * 16 + j] = (unsigned short)(T[j] & 0x3FFFu); EGATE[(size_t)m * 128 + h * 16 + j] = ex[j] * inv; }
    }
}

__device__ __forceinline__ void dec16(const u32x4 w, float (&o)[16]) {
#pragma unroll
    for (int q = 0; q < 4; ++q) { const f32x2 lo = __builtin_amdgcn_cvt_pk_f32_fp8((int)w[q], false), hi = __builtin_amdgcn_cvt_pk_f32_fp8((int)w[q], true); o[4 * q] = lo.x; o[4 * q + 1] = lo.y; o[4 * q + 2] = hi.x; o[4 * q + 3] = hi.y; }
}
__device__ __forceinline__ float wave_sum_u(float v) {
    v = row16_sum(v);
    const float a = __builtin_bit_cast(float, __builtin_amdgcn_readlane(__builtin_bit_cast(int, v), 0)), b = __builtin_bit_cast(float, __builtin_amdgcn_readlane(__builtin_bit_cast(int, v), 16));
    const float c = __builtin_bit_cast(float, __builtin_amdgcn_readlane(__builtin_bit_cast(int, v), 32)), d = __builtin_bit_cast(float, __builtin_amdgcn_readlane(__builtin_bit_cast(int, v), 48));
    return (a + b) + (c + d);
}
__device__ __forceinline__ void phd6_gather(const Params& p) {
    const int tid = threadIdx.x, lane = tid & 63, wave = tid >> 6;
    const int gw = blockIdx.x * 8 + wave, NGW = gridDim.x * 8;
    const unsigned char* U8 = p.ws + WS_U8; const unsigned char* V8A = p.ws + WS_V8A; const unsigned char* V8B = p.ws + WS_V8B - (size_t)V8A_ROWS * D;
    const unsigned short* EIDX = (const unsigned short*)(p.ws + WS_EIDX); const float* EGATE = (const float*)(p.ws + WS_EGATE);
    for (int m = gw; m < MREAL; m += NGW) {
        float* row = p.out + (size_t)m * D + 16 * lane;
        float hv[16];
#pragma unroll
        for (int q = 0; q < 4; ++q) { const f32x4 t4 = *(const f32x4*)(row + 4 * q); hv[4 * q] = t4.x; hv[4 * q + 1] = t4.y; hv[4 * q + 2] = t4.z; hv[4 * q + 3] = t4.w; }
        const int e_lo = (int)EIDX[(size_t)m * 128 + lane], e_hi = (int)EIDX[(size_t)m * 128 + 64 + lane];
        const float g_lo = EGATE[(size_t)m * 128 + lane], g_hi = EGATE[(size_t)m * 128 + 64 + lane];
        float hd_lo = 0.f, hd_hi = 0.f;
#define G_LOAD(buf, g_, TAB) do { _Pragma("unroll") for (int i_ = 0; i_ < 8; ++i_) { const int e_ = 8 * (g_) + i_; \
            const int id_ = (e_ < 64) ? __builtin_amdgcn_readlane(e_lo, e_ & 63) : __builtin_amdgcn_readlane(e_hi, e_ & 63); \
            buf[i_] = *(const u32x4*)(((TAB) ? ((id_ < V8A_ROWS) ? V8A : V8B) : U8) + (size_t)id_ * D + 16 * lane); } } while (0)
#define U_PROC(buf, g_) do { _Pragma("unroll") for (int i_ = 0; i_ < 8; ++i_) { const int e_ = 8 * (g_) + i_; float uf[16]; dec16(buf[i_], uf); float s_ = 0.f; \
            _Pragma("unroll") for (int j_ = 0; j_ < 16; ++j_) s_ += hv[j_] * uf[j_]; s_ = wave_sum_u(s_); \
            if (e_ < 64) { if (lane == (e_ & 63)) hd_lo = s_; } else { if (lane == (e_ & 63)) hd_hi = s_; } } } while (0)
        {
            u32x4 b0[8], b1[8];
            G_LOAD(b0, 0, 0);
            for (int g2 = 0; g2 < 16; g2 += 2) {
                G_LOAD(b1, g2 + 1, 0); __builtin_amdgcn_sched_barrier(0);
                U_PROC(b0, g2); __builtin_amdgcn_sched_barrier(0);
                if (g2 + 2 < 16) { G_LOAD(b0, g2 + 2, 0); } __builtin_amdgcn_sched_barrier(0);
                U_PROC(b1, g2 + 1); __builtin_amdgcn_sched_barrier(0);
            }
        }
        hd_lo *= (1.f / 256.f); hd_hi *= (1.f / 256.f);
        const float c_lo = g_lo * 0.5f * hd_lo * (1.f + erff(hd_lo * 0.70710678118654752f)) * (1.f / 16.f);
        const float c_hi = g_hi * 0.5f * hd_hi * (1.f + erff(hd_hi * 0.70710678118654752f)) * (1.f / 16.f);
        float acc[16];
#pragma unroll
        for (int j = 0; j < 16; ++j) acc[j] = 0.f;
#define V_PROC(buf, g_) do { _Pragma("unroll") for (int i_ = 0; i_ < 8; ++i_) { const int e_ = 8 * (g_) + i_; float vf[16]; dec16(buf[i_], vf); \
            const float cf_ = (e_ < 64) ? __builtin_bit_cast(float, __builtin_amdgcn_readlane(__builtin_bit_cast(int, c_lo), e_ & 63)) : __builtin_bit_cast(float, __builtin_amdgcn_readlane(__builtin_bit_cast(int, c_hi), e_ & 63)); \
            _Pragma("unroll") for (int j_ = 0; j_ < 16; ++j_) acc[j_] += cf_ * vf[j_]; } } while (0)
        {
            u32x4 b0[8], b1[8];
            G_LOAD(b0, 0, 1);
            for (int g2 = 0; g2 < 16; g2 += 2) {
                G_LOAD(b1, g2 + 1, 1); __builtin_amdgcn_sched_barrier(0);
                V_PROC(b0, g2); __builtin_amdgcn_sched_barrier(0);
                if (g2 + 2 < 16) { G_LOAD(b0, g2 + 2, 1); } __builtin_amdgcn_sched_barrier(0);
                V_PROC(b1, g2 + 1); __builtin_amdgcn_sched_barrier(0);
            }
        }
        float sm = 0.f;
#pragma unroll
        for (int j = 0; j < 16; ++j) { acc[j] += ALPHA * hv[j]; sm += acc[j]; }
        const float mean = wave_sum_u(sm) * (1.f / D); float s2 = 0.f;
#pragma unroll
        for (int j = 0; j < 16; ++j) { acc[j] -= mean; s2 += acc[j] * acc[j]; }
        const float rstd = __builtin_amdgcn_rsqf(wave_sum_u(s2) * (1.f / D) + LN_EPS);
#pragma unroll
        for (int q = 0; q < 4; ++q) { const int col = 16 * lane + 4 * q; const f32x4 g = *(const f32x4*)(p.ln2_g + col), bb = *(const f32x4*)(p.ln2_b + col);
            f32x4 o; o.x = acc[4 * q] * rstd * g.x + bb.x; o.y = acc[4 * q + 1] * rstd * g.y + bb.y; o.z = acc[4 * q + 2] * rstd * g.z + bb.z; o.w = acc[4 * q + 3] * rstd * g.w + bb.w;
            *(f32x4*)(row + 4 * q) = o; }
    }
}

__device__ __forceinline__ void phd6_u_plain(const Params& p) {
    const int tid = threadIdx.x, lane = tid & 63, wave = tid >> 6;
    const int gw = blockIdx.x * 8 + wave, NGW = gridDim.x * 8;
    const unsigned char* U8 = p.ws + WS_U8; const unsigned char* V8A = p.ws + WS_V8A; const unsigned char* V8B = p.ws + WS_V8B - (size_t)V8A_ROWS * D;
    const unsigned short* EIDX = (const unsigned short*)(p.ws + WS_EIDX); const float* EGATE = (const float*)(p.ws + WS_EGATE);
    for (int m = gw; m < MREAL; m += NGW) {
        float* row = p.out + (size_t)m * D + 16 * lane;
        float hv[16];
#pragma unroll
        for (int q = 0; q < 4; ++q) { const f32x4 t4 = *(const f32x4*)(row + 4 * q); hv[4 * q] = t4.x; hv[4 * q + 1] = t4.y; hv[4 * q + 2] = t4.z; hv[4 * q + 3] = t4.w; }
        const int e_lo = (int)EIDX[(size_t)m * 128 + lane], e_hi = (int)EIDX[(size_t)m * 128 + 64 + lane];
        const float g_lo = EGATE[(size_t)m * 128 + lane], g_hi = EGATE[(size_t)m * 128 + 64 + lane];
        float hd_lo = 0.f, hd_hi = 0.f;
#define G_LOAD(buf, g_, TAB) do { _Pragma("unroll") for (int i_ = 0; i_ < 8; ++i_) { const int e_ = 8 * (g_) + i_; \
            const int id_ = (e_ < 64) ? __builtin_amdgcn_readlane(e_lo, e_ & 63) : __builtin_amdgcn_readlane(e_hi, e_ & 63); \
            buf[i_] = *(const u32x4*)(((TAB) ? ((id_ < V8A_ROWS) ? V8A : V8B) : U8) + (size_t)id_ * D + 16 * lane); } } while (0)
#define U_PROC(buf, g_) do { _Pragma("unroll") for (int i_ = 0; i_ < 8; ++i_) { const int e_ = 8 * (g_) + i_; float uf[16]; dec16(buf[i_], uf); float s_ = 0.f; \
            _Pragma("unroll") for (int j_ = 0; j_ < 16; ++j_) s_ += hv[j_] * uf[j_]; s_ = wave_sum_u(s_); \
            if (e_ < 64) { if (lane == (e_ & 63)) hd_lo = s_; } else { if (lane == (e_ & 63)) hd_hi = s_; } } } while (0)
        {
            u32x4 b0[8], b1[8];
            G_LOAD(b0, 0, 0);
            for (int g2 = 0; g2 < 16; g2 += 2) {
                G_LOAD(b1, g2 + 1, 0); __builtin_amdgcn_sched_barrier(0);
                U_PROC(b0, g2); __builtin_amdgcn_sched_barrier(0);
                if (g2 + 2 < 16) { G_LOAD(b0, g2 + 2, 0); } __builtin_amdgcn_sched_barrier(0);
                U_PROC(b1, g2 + 1); __builtin_amdgcn_sched_barrier(0);
            }
        }
        hd_lo *= (1.f / 256.f); hd_hi *= (1.f / 256.f);
        const float c_lo = g_lo * 0.5f * hd_lo * (1.f + erff(hd_lo * 0.70710678118654752f)) * (1.f / 16.f);
        const float c_hi = g_hi * 0.5f * hd_hi * (1.f + erff(hd_hi * 0.70710678118654752f)) * (1.f / 16.f);
        float* ECOEF = (float*)(p.ws + WS_SC);
        ECOEF[(size_t)m * 128 + lane] = c_lo; ECOEF[(size_t)m * 128 + 64 + lane] = c_hi;
    }
}
__device__ __forceinline__ void phd6_u_item(const Params& p, int blk, int slice, unsigned char* lds) {
    const int tid = threadIdx.x, lane = tid & 63, wave = tid >> 6;
    const unsigned char* U8 = p.ws + WS_U8;
    const unsigned short* EIDX = (const unsigned short*)(p.ws + WS_EIDX); const f16* H1H = (const f16*)(p.ws + WS_H1H);
    float* PART = (float*)(p.ws + WS_SC);
    unsigned short* sID = (unsigned short*)lds;
    const int m0 = blk * 64;
#pragma unroll
    for (int i = 0; i < 2; ++i) { const int o = (i * NT + tid) * 8; *(u32x4*)(sID + o) = *(const u32x4*)(EIDX + (size_t)m0 * 128 + o); }
    const int tl = wave * 8 + (lane >> 3), ch = lane & 7;
    float hv[16];
    { const f16* hp = H1H + (size_t)(m0 + tl) * D + 128 * slice + 16 * ch; const f16x8 h0 = *(const f16x8*)hp, h1 = *(const f16x8*)(hp + 8);
#pragma unroll
      for (int e = 0; e < 8; ++e) { hv[e] = (float)h0[e]; hv[8 + e] = (float)h1[e]; } }
    __syncthreads();
    const unsigned short* idr = sID + tl * 128;
    float pk[16];
#pragma unroll
    for (int q = 0; q < 16; ++q) pk[q] = 0.f;
#define UC_LOAD(buf, e0_) do { _Pragma("unroll") for (int k = 0; k < 8; ++k) { const int id = (int)idr[(e0_) + k]; buf[k] = *(const u32x4*)(U8 + (size_t)id * D + 128 * slice + 16 * ch); } } while (0)
#define UC_PROC(buf, c_, i0_) do { _Pragma("unroll") for (int k = 0; k < 8; ++k) { float uf[16]; dec16(buf[k], uf); float s_ = 0.f; _Pragma("unroll") for (int q = 0; q < 16; ++q) s_ += hv[q] * uf[q]; \
            s_ += DPP_F(s_, 0xB1); s_ += DPP_F(s_, 0x4E); s_ += DPP_F(s_, 0x141); if (ch == (c_)) pk[(i0_) + k] = s_; } } while (0)
    {
        u32x4 b0[8], b1[8];
        UC_LOAD(b0, 0);
        for (int c = 0; c < 8; ++c) {
            UC_LOAD(b1, 16 * c + 8); __builtin_amdgcn_sched_barrier(0);
            UC_PROC(b0, c, 0); __builtin_amdgcn_sched_barrier(0);
            if (c < 7) { UC_LOAD(b0, 16 * c + 16); } __builtin_amdgcn_sched_barrier(0);
            UC_PROC(b1, c, 8); __builtin_amdgcn_sched_barrier(0);
        }
    }
    float* dst = PART + ((size_t)slice * MREAL + (m0 + tl)) * 128 + 16 * ch;
#pragma unroll
    for (int q4 = 0; q4 < 4; ++q4) *(f32x4*)(dst + 4 * q4) = (f32x4){pk[4 * q4], pk[4 * q4 + 1], pk[4 * q4 + 2], pk[4 * q4 + 3]};
    __syncthreads();
}
__device__ __forceinline__ void phd6_coef(const Params& p) {
    const float* PART = (const float*)(p.ws + WS_SC); float* EGATE = (float*)(p.ws + WS_EGATE);
    const long gt = (long)blockIdx.x * NT + threadIdx.x, NGT = (long)gridDim.x * NT;
    for (long e = gt; e < (long)MREAL * 32; e += NGT) {
        f32x4 a = {0.f, 0.f, 0.f, 0.f};
#pragma unroll
        for (int sl = 0; sl < 8; ++sl) a += *(const f32x4*)(PART + (size_t)sl * MREAL * 128 + e * 4);
        const f32x4 g = *(const f32x4*)(EGATE + e * 4); f32x4 o;
#pragma unroll
        for (int q = 0; q < 4; ++q) { const float hd = a[q] * (1.f / 256.f); o[q] = g[q] * 0.5f * hd * (1.f + erff(hd * 0.70710678118654752f)) * (1.f / 16.f); }
        *(f32x4*)(EGATE + e * 4) = o;
    }
}
__device__ __forceinline__ void phd6_v_item(const Params& p, int blk, int slice, unsigned char* lds) {
    const int tid = threadIdx.x, lane = tid & 63, wave = tid >> 6;
    const unsigned char* V8A = p.ws + WS_V8A; const unsigned char* V8B = p.ws + WS_V8B - (size_t)V8A_ROWS * D;
    const unsigned short* EIDX = (const unsigned short*)(p.ws + WS_EIDX); const float* ECOEF = (const float*)(p.ws + WS_EGATE);
    unsigned short* sID = (unsigned short*)lds;
    float* sC = (float*)(lds + 16384);
    const int m0 = blk * 64;
#pragma unroll
    for (int i = 0; i < 2; ++i) { const int o = (i * NT + tid) * 8; *(u32x4*)(sID + o) = *(const u32x4*)(EIDX + (size_t)m0 * 128 + o); }
#pragma unroll
    for (int i = 0; i < 4; ++i) { const int o = (i * NT + tid) * 4; *(f32x4*)(sC + o) = *(const f32x4*)(ECOEF + (size_t)m0 * 128 + o); }
    const int tl = wave * 8 + (lane >> 3), ch = lane & 7;
    float* row = p.out + (size_t)(m0 + tl) * D + 128 * slice + 16 * ch;
    f32x4 hr[4];
#pragma unroll
    for (int q4 = 0; q4 < 4; ++q4) hr[q4] = *(const f32x4*)(row + 4 * q4);
    __syncthreads();
    float acc[16];
#pragma unroll
    for (int q = 0; q < 16; ++q) acc[q] = 0.f;
    const unsigned short* idr = sID + tl * 128; const float* cr = sC + tl * 128;
#define VP_LOAD(buf, cf, e0_) do { _Pragma("unroll") for (int k = 0; k < 8; ++k) { const int id = (int)idr[(e0_) + k]; cf[k] = cr[(e0_) + k]; \
        buf[k] = *(const u32x4*)(((id < V8A_ROWS) ? V8A : V8B) + (size_t)id * D + 128 * slice + 16 * ch); } } while (0)
#define VP_PROC(buf, cf) do { _Pragma("unroll") for (int k = 0; k < 8; ++k) { float vf[16]; dec16(buf[k], vf); _Pragma("unroll") for (int q = 0; q < 16; ++q) acc[q] += cf[k] * vf[q]; } } while (0)
    {
        u32x4 b0[8], b1[8]; float c0[8], c1[8];
        VP_LOAD(b0, c0, 0);
        for (int e0 = 0; e0 < 128; e0 += 16) {
            VP_LOAD(b1, c1, e0 + 8); __builtin_amdgcn_sched_barrier(0);
            VP_PROC(b0, c0); __builtin_amdgcn_sched_barrier(0);
            if (e0 + 16 < 128) { VP_LOAD(b0, c0, e0 + 16); } __builtin_amdgcn_sched_barrier(0);
            VP_PROC(b1, c1); __builtin_amdgcn_sched_barrier(0);
        }
    }
#pragma unroll
    for (int q4 = 0; q4 < 4; ++q4) { f32x4 h4 = hr[q4]; h4.x = ALPHA * h4.x + acc[4 * q4]; h4.y = ALPHA * h4.y + acc[4 * q4 + 1]; h4.z = ALPHA * h4.z + acc[4 * q4 + 2]; h4.w = ALPHA * h4.w + acc[4 * q4 + 3];
        *(f32x4*)(row + 4 * q4) = h4; }
    __syncthreads();
}
template <int PHASEV>
__device__ __forceinline__ void phd6_sliced(const Params& p, unsigned char* lds) {
    unsigned* q = (unsigned*)(p.ws + WS_CTL) + 1024 + PHASEV * 512;
    int* s_it = (int*)(lds + 150 * 1024 - 16);
    const int xs = (int)((unsigned)__builtin_amdgcn_s_getreg((3 << 11) | 20) & 7u);
    for (int r = 0; r < 8; ++r) {
        const int slice = (xs + r) & 7;
        for (;;) {
            if (threadIdx.x == 0) *s_it = (int)atomicAdd(q + 64 * slice, 1u);
            __syncthreads();
            const int it = *s_it;
            __syncthreads();
            if (it >= MREAL / 64) break;
            if (PHASEV) phd6_v_item(p, it, slice, lds); else phd6_u_item(p, it, slice, lds);
        }
    }
}
__device__ __forceinline__ void phd6_ln2(const Params& p) {
    const int tid = threadIdx.x, lane = tid & 63, wave = tid >> 6;
    const int gw = blockIdx.x * 8 + wave, NGW = gridDim.x * 8;
    for (int m = gw; m < MREAL; m += NGW) {
        float* row = p.out + (size_t)m * D;
        f32x4 v[4]; float s = 0.f;
#pragma unroll
        for (int j = 0; j < 4; ++j) { v[j] = *(const f32x4*)(row + j * 256 + lane * 4); s += (v[j].x + v[j].y) + (v[j].z + v[j].w); }
        const float mean = wave_sum_u(s) * (1.f / D); float s2 = 0.f;
#pragma unroll
        for (int j = 0; j < 4; ++j) { v[j] = v[j] - mean; s2 += (v[j].x * v[j].x + v[j].y * v[j].y) + (v[j].z * v[j].z + v[j].w * v[j].w); }
        const float rstd = __builtin_amdgcn_rsqf(wave_sum_u(s2) * (1.f / D) + LN_EPS);
#pragma unroll
        for (int j = 0; j < 4; ++j) { const f32x4 g = *(const f32x4*)(p.ln2_g + j * 256 + lane * 4), bb = *(const f32x4*)(p.ln2_b + j * 256 + lane * 4);
            *(f32x4*)(row + j * 256 + lane * 4) = v[j] * rstd * g + bb; }
    }
}

struct EpiLora {
    f16 *LW, *AA, *GG; const float *w0, *a0;
    __device__ __forceinline__ void operator()(const f32x4 (&acc)[2][2][4][2], const pg8::Unit& u, int wr, int wc, int fr, int fq) const {
        const int row0 = u.pm * 256 + wr * 64 + fr, col0 = (u.pn & 1) * 256 + wc * 32 + 4 * fq;
        if (u.pn < 2) {
#pragma unroll
            for (int bj = 0; bj < 2; ++bj)
#pragma unroll
                for (int n = 0; n < 2; ++n) { const int col = col0 + bj * 128 + n * 16; const f32x4 c = *(const f32x4*)(w0 + col);
#pragma unroll
                    for (int ai = 0; ai < 2; ++ai)
#pragma unroll
                        for (int m = 0; m < 4; ++m) { const f32x4 v = acc[ai][bj][m][n]; f16x4 o;
#pragma unroll
                            for (int e = 0; e < 4; ++e) { const float wl = -softplusf_(-(c[e] + v[e])) - 0.5f; o[e] = (f16)(-__expf(wl)); }
                            *(f16x4*)(LW + (size_t)(row0 + ai * 128 + m * 16) * 512 + col) = o; } }
        } else if (u.pn < 4) {
#pragma unroll
            for (int bj = 0; bj < 2; ++bj)
#pragma unroll
                for (int n = 0; n < 2; ++n) { const int col = col0 + bj * 128 + n * 16; const f32x4 c = *(const f32x4*)(a0 + col);
#pragma unroll
                    for (int ai = 0; ai < 2; ++ai)
#pragma unroll
                        for (int m = 0; m < 4; ++m) { const f32x4 v = acc[ai][bj][m][n]; f16x4 o;
#pragma unroll
                            for (int e = 0; e < 4; ++e) o[e] = (f16)sigmoidf_(c[e] + v[e]);
                            *(f16x4*)(AA + (size_t)(row0 + ai * 128 + m * 16) * 512 + col) = o; } }
        } else {
#pragma unroll
            for (int bj = 0; bj < 2; ++bj)
#pragma unroll
                for (int n = 0; n < 2; ++n) { const int col = col0 + bj * 128 + n * 16;
#pragma unroll
                    for (int ai = 0; ai < 2; ++ai)
#pragma unroll
                        for (int m = 0; m < 4; ++m) *(f16x4*)(GG + (size_t)(row0 + ai * 128 + m * 16) * 512 + col) = to_h4(acc[ai][bj][m][n]); }
        }
    }
};

#define XB_TMO      128
#define XB_XCNT(j)  (256  + 64 * (j))
#define XB_XSUB(j)  (1280 + 64 * (j))
#define XB_XGEN(j)  (2304 + 64 * (j))
#define XB_TOP      3328
#define XB_TOPGEN   3392
#define XCD_BAR_WORDS 3456
#define XB_SPIN_CAP (1u << 20)
__device__ __forceinline__ unsigned xb_ld(unsigned* p)              { return __hip_atomic_load(p, __ATOMIC_RELAXED, __HIP_MEMORY_SCOPE_AGENT); }
__device__ __forceinline__ unsigned xb_add(unsigned* p, unsigned v) { return __hip_atomic_fetch_add(p, v, __ATOMIC_RELAXED, __HIP_MEMORY_SCOPE_AGENT); }
__device__ __forceinline__ unsigned xb_xcc_id() { return (unsigned)__builtin_amdgcn_s_getreg((3 << 11) | 20) & 0xFu; }
#define XB_SPIN(cond, bar) do { unsigned _sp = 0; while (cond) { __builtin_amdgcn_s_sleep(1); \
    if ((++_sp & 255u) == 0u) { if (xb_ld(&(bar)[XB_TMO])) break; if (_sp > XB_SPIN_CAP) { atomicAdd(&(bar)[XB_TMO], 1u); break; } } } } while (0)
struct XcdBarrier { unsigned* bar; unsigned x; volatile LAS unsigned* st; };
__device__ __forceinline__ XcdBarrier xcd_barrier_post(unsigned* bar, volatile LAS unsigned* st) {
    XcdBarrier b; b.bar = bar; b.x = xb_xcc_id(); b.st = st;
    if (threadIdx.x == 0) (void)xb_add(&bar[XB_XCNT(b.x)], 1u);
    return b;
}
__device__ __forceinline__ void xcd_barrier_complete(unsigned* bar, unsigned x, unsigned& nloc, unsigned& nx) {
    const unsigned G = gridDim.x * gridDim.y * gridDim.z;
    unsigned sum, cnt, mine, sp = 0u;
    for (;;) {
        sum = 0u; cnt = 0u; mine = 0u;
#pragma unroll
        for (unsigned j = 0; j < 16; ++j) { const unsigned c = xb_ld(&bar[XB_XCNT(j)]); sum += c; cnt += (c > 0u) ? 1u : 0u; mine = (j == x) ? c : mine; }
        if (sum == G) break;
        __builtin_amdgcn_s_sleep(1);
        if ((++sp & 255u) == 0u) { if (xb_ld(&bar[XB_TMO])) break; if (sp > XB_SPIN_CAP) { atomicAdd(&bar[XB_TMO], 1u); break; } }
    }
    nloc = mine > 0u ? mine : 1u; nx = cnt > 0u ? cnt : 1u;
}
__device__ __forceinline__ void xcd_barrier(const XcdBarrier& b) {
    asm volatile("s_waitcnt vmcnt(0)" ::: "memory");
    __syncthreads();
    if (threadIdx.x == 0) {
        unsigned* bar = b.bar;
        __builtin_amdgcn_s_waitcnt(0);
        unsigned nloc = b.st[0], nx = b.st[1];
        if (nloc == 0u) { xcd_barrier_complete(bar, b.x, nloc, nx); b.st[0] = nloc; b.st[1] = nx; }
        const unsigned old = xb_add(&bar[XB_XSUB(b.x)], 1u);
        const unsigned gen = old / nloc;
        if (old + 1u == (gen + 1u) * nloc) {
            __builtin_amdgcn_fence(__ATOMIC_RELEASE, "agent");
            asm volatile("s_waitcnt vmcnt(0)" ::: "memory");
            const unsigned og = xb_add(&bar[XB_TOP], 1u);
            const unsigned tg = og / nx;
            if (og + 1u == (tg + 1u) * nx) xb_add(&bar[XB_TOPGEN], 1u);
            else XB_SPIN(xb_ld(&bar[XB_TOPGEN]) == tg, bar);
            __builtin_amdgcn_fence(__ATOMIC_ACQUIRE, "agent");
            xb_add(&bar[XB_XGEN(b.x)], 1u);
            asm volatile("s_waitcnt vmcnt(0)" ::: "memory");
        } else {
            XB_SPIN(xb_ld(&bar[XB_XGEN(b.x)]) == gen, bar);
            __builtin_amdgcn_fence(__ATOMIC_ACQUIRE, "agent");
            asm volatile("s_waitcnt vmcnt(0)" ::: "memory");
        }
    }
    __syncthreads();
}

constexpr int LDS_BYTES = 150 * 1024;
constexpr int REP0 = 1, REP1 = 1, REP4 = 1, REP5 = 1, REP8 = 1, REP9 = 1;
constexpr int NPHASE = 14;
__global__ void __launch_bounds__(NT) mk_fwd(Params p) {
    extern __shared__ __attribute__((aligned(16))) unsigned char lds[];
    unsigned char* ws = p.ws;
    const int lo = p.ph_lo, hi = p.ph_hi;
    volatile LAS unsigned* bst = (volatile LAS unsigned*)((LAS unsigned char*)lds + LDS_BYTES - 64);
    if (threadIdx.x < 2) bst[threadIdx.x] = 0u;
    __syncthreads();
    const XcdBarrier xbar = xcd_barrier_post((unsigned*)(ws + WS_CTL) + 4096, bst);
#define IN(k) (lo <= (k) && (k) < hi)
#define SEAM(k) do { if (IN(k) && IN((k) + 1)) xcd_barrier(xbar); } while (0)
    if (IN(0)) ph0_prep<false>(p, lds, (int)blockIdx.x, (int)gridDim.x);
    SEAM(0);
    if (IN(1)) {
        f16* PB = (f16*)(ws + WS_PB);
        auto f = [=](int row, int col, f32x4 v) { *(f16x4*)(PB + (size_t)row * N1 + col) = to_h4(v); };
        pg8::run_gemm(lds, (const f16*)(ws + WS_H0), (const f16*)(ws + WS_W1T), MR, N1, D, f);
    }
    SEAM(1);
    if (IN(2)) phc1_rowprep(p);
    SEAM(2);
    if (IN(3)) {
        pg8::Gemm g{(const f16*)((unsigned char*)p.out + DO_LORAIN), (const f16*)(ws + WS_WLT), MR, 1536, 256}; pg8::StaticOrder S; S.init(MR, 1536, (int)gridDim.x, (int)blockIdx.x);
        EpiLora E{(f16*)((unsigned char*)p.out + DO_LW), (f16*)((unsigned char*)p.out + DO_AA), (f16*)((unsigned char*)p.out + DO_GG), p.b_w0, p.b_a0};
        pg8::gemm_phase<EpiLora>((PG8_LAS unsigned char*)lds, g, S, E);
        __syncthreads();
    }
    SEAM(3);
    if (IN(4)) for (int rep = 0; rep < REP4; ++rep) { if (rep) xcd_barrier(xbar); phc2_mixers(p, lds, rep); }
    SEAM(4);
    if (IN(5)) {
        f16* MIX = (f16*)(ws + WS_MIXED); f16* TMP = (f16*)(ws + WS_TMP); const float* bg = p.b_gate;
        auto f1 = [=](int row, int col, f32x4 v) { const f32x4 c = *(const f32x4*)(bg + col); f16x4 o;
#pragma unroll
            for (int e = 0; e < 4; ++e) o[e] = (f16)sigmoidf_(v[e] + c[e]);
            *(f16x4*)(MIX + (size_t)row * D + col) = o; };
        pg8::run_gemm(lds, (const f16*)(ws + WS_H0), (const f16*)(ws + WS_WGT), MREAL, D, D, f1);
        auto f2 = [=](int row, int col, f32x4 v) { f16x4* q = (f16x4*)(MIX + (size_t)row * D + col); const f16x4 gq = *q; f16x4 o;
#pragma unroll
            for (int e = 0; e < 4; ++e) o[e] = (f16)((float)gq[e] * v[e]);
            *q = o; };
        pg8::run_gemm(lds, (const f16*)(ws + WS_OLAT), (const f16*)(ws + WS_WPAT), MREAL, D, D, f2);
        auto f3 = [=](int row, int col, f32x4 v) { const f32x4 c = *(const f32x4*)(bg + 1024 + col); f16x4 o;
#pragma unroll
            for (int e = 0; e < 4; ++e) o[e] = (f16)sigmoidf_(v[e] + c[e]);
            *(f16x4*)(TMP + (size_t)row * D + col) = o; };
        pg8::run_gemm(lds, (const f16*)(ws + WS_H0), (const f16*)(ws + WS_WGT) + (size_t)1024 * D, MREAL, D, D, f3);
        auto f4 = [=](int row, int col, f32x4 v) { f16x4* q = (f16x4*)(MIX + (size_t)row * D + col); const f16x4 m0 = *q; const f16x4 gq = *(const f16x4*)(TMP + (size_t)row * D + col); f16x4 o;
#pragma unroll
            for (int e = 0; e < 4; ++e) o[e] = (f16)((float)m0[e] + (float)gq[e] * v[e]);
            *q = o; };
        pg8::run_gemm(lds, (const f16*)(ws + WS_OB), (const f16*)(ws + WS_WPBT), MREAL, D, 512, f4);
    }
    SEAM(5);
    if (IN(6)) {
        const float* x = p.x; const float* STAT = (const float*)(ws + WS_STAT); const float* lg = p.ln_in_g; const float* lb = p.ln_in_b; float* out = p.out;
        auto f = [=](int row, int col, f32x4 v) { const f32x4 xv = *(const f32x4*)(x + (size_t)row * D + col); const float mean = STAT[2 * row], rstd = STAT[2 * row + 1];
            const f32x4 g = *(const f32x4*)(lg + col), bb = *(const f32x4*)(lb + col);
            *(f32x4*)(out + (size_t)row * D + col) = ((xv - mean) * rstd * g + bb) * ALPHA + v; };
        pg8::run_gemm(lds, (const f16*)(ws + WS_MIXED), (const f16*)(ws + WS_WOT), MREAL, D, D, f);
    }
    SEAM(6);
    if (IN(7)) phd3_ln1(p);
    SEAM(7);
    if (IN(8)) {
        unsigned short* SC = (unsigned short*)(ws + WS_SC);
        auto f = [=](int row, int col, f32x4 v) { u32x2 o; unsigned q[4];
#pragma unroll
            for (int e = 0; e < 4; ++e) q[e] = (unsigned)__float2int_rn(fminf(fmaxf((v[e] + 2.f) * 8192.f, 0.f), 65535.f));
            o.x = q[0] | (q[1] << 16); o.y = q[2] | (q[3] << 16); *(u32x2*)(SC + (size_t)row * 2048 + col) = o; };
        pg8::run_gemm(lds, (const f16*)(ws + WS_H1H), (const f16*)(ws + WS_WSKT), MREAL, 2048, D, f);
    }
    SEAM(8);
    if (IN(9)) phd5_topk(p);
    SEAM(9);
    if (IN(10)) phd6_sliced<0>(p, lds);
    SEAM(10);
    if (IN(11)) phd6_coef(p);
    SEAM(11);
    if (IN(12)) phd6_sliced<1>(p, lds);
    SEAM(12);
    if (IN(13)) phd6_ln2(p);
#undef IN
#undef SEAM
}

extern "C" void kernel_launch(void* const* d_in, const int* in_sizes, int n_in, void* d_out, int out_size, void* d_ws, size_t ws_size, hipStream_t stream) {
    static int grid = 0;
    if (grid == 0) {
        int dev = 0, cus = 0, per_cu = 0;
        if (hipGetDevice(&dev) != hipSuccess || hipDeviceGetAttribute(&cus, hipDeviceAttributeMultiprocessorCount, dev) != hipSuccess) { fprintf(stderr, "kernel_launch: device query failed\n"); grid = -1; return; }
        if (hipFuncSetAttribute((const void*)mk_fwd, hipFuncAttributeMaxDynamicSharedMemorySize, LDS_BYTES) != hipSuccess) { fprintf(stderr, "kernel_launch: hipFuncSetAttribute failed\n"); grid = -1; return; }
        if (hipOccupancyMaxActiveBlocksPerMultiprocessor(&per_cu, (const void*)mk_fwd, NT, LDS_BYTES) != hipSuccess || per_cu < 1) { fprintf(stderr, "kernel_launch: occupancy query says %d\n", per_cu); grid = -1; return; }
        if (n_in != 33 || out_size != MREAL * D || ws_size < WS_END) { fprintf(stderr, "kernel_launch: unexpected shapes n_in %d out %d ws %zu\n", n_in, out_size, ws_size); grid = -1; return; }
        grid = cus;
    }
    if (grid < 0) return;
    (void)hipMemsetAsync((char*)d_ws + WS_CTL, 0, 1 * MiB, stream);
    Params p{};
    const float** pf = (const float**)&p;
    for (int i = 0; i < 33; ++i) pf[i] = (const float*)d_in[i];
    p.out = (float*)d_out; p.ws = (unsigned char*)d_ws; p.ph_lo = 0; p.ph_hi = NPHASE;
    void* args[] = {&p};
    hipError_t e = hipLaunchCooperativeKernel((void*)mk_fwd, dim3(grid), dim3(NT), args, LDS_BYTES, stream);
    if (e != hipSuccess) fprintf(stderr, "kernel_launch: cooperative launch failed: %s (grid %d)\n", hipGetErrorString(e), grid);
}
```
